# Optimizing an MI355X kernel written in HIP

```python
import jax, jax.numpy as jnp
from jax import lax
import numpy as np

D_MODEL = 2048
BATCH = 1
SEQ = 16384
DEPTH = 4

HEAD_DIM = 128
N_HEADS_DSA = 8
N_HEADS_MOBA = 8
KV_LATENT = 256
IDX_HEADS = 16
IDX_DIM = 64
DSA_TOPK_MAX = 256
MOBA_BLOCK = 256
MOBA_TOPK_MAX = 3
N_MEM = 256
N_HEADS_MEM = 4
D_FF = -(-8 * D_MODEL // (3 * 256)) * 256
ATTN_Q_BLOCK = 128
MOBA_Q_BLOCK = 64
DSA_WIDTH = N_HEADS_DSA * HEAD_DIM
MOBA_WIDTH = N_HEADS_MOBA * HEAD_DIM
MEM_WIDTH = N_HEADS_MEM * HEAD_DIM
SPLIT_SIZES = (DSA_WIDTH, KV_LATENT, IDX_HEADS * IDX_DIM, IDX_DIM, IDX_HEADS,
               MOBA_WIDTH, MOBA_WIDTH, MOBA_WIDTH, D_MODEL, D_MODEL)
IN_WIDTH = sum(SPLIT_SIZES)
ALPHA = (2.0 * DEPTH) ** 0.25
BETA = (8.0 * DEPTH) ** -0.25
LN_EPS = 1e-5

kernel_name = 'hybrid_dsa_moba_gated_deepnorm'


def layer_norm(x, g, b):
    xf = x.astype(jnp.float32)
    mu = xf.mean(-1, keepdims=True)
    var = jnp.square(xf - mu).mean(-1, keepdims=True)
    return ((xf - mu) * lax.rsqrt(var + LN_EPS) * g.astype(jnp.float32) + b.astype(jnp.float32)).astype(x.dtype)


def rms_norm(x, g):
    xf = x.astype(jnp.float32)
    return (xf * lax.rsqrt(jnp.mean(xf * xf, -1, keepdims=True) + LN_EPS) * g.astype(jnp.float32)).astype(x.dtype)


def alibi_slopes(n):
    return jnp.asarray([2.0 ** (-8.0 * (i + 1) / n) for i in range(n)], dtype=jnp.float32)


def dsa_attention(q, c_kv, q_idx, k_idx, w_idx, w_uk, w_uv):
    S = q.shape[0]
    topk = min(DSA_TOPK_MAX, S // 4)
    slopes = alibi_slopes(N_HEADS_DSA)
    q_lat = jnp.einsum('shd,hdc->shc', q, w_uk)
    key_pos = jnp.arange(S)
    idx_scale = IDX_DIM ** -0.5
    w_scale = IDX_HEADS ** -0.5

    def block(i):
        t0 = i * ATTN_Q_BLOCK
        qi = lax.dynamic_slice_in_dim(q_idx, t0, ATTN_Q_BLOCK, 0)
        wi = lax.dynamic_slice_in_dim(w_idx, t0, ATTN_Q_BLOCK, 0)
        ql = lax.dynamic_slice_in_dim(q_lat, t0, ATTN_Q_BLOCK, 0)
        qpos = t0 + jnp.arange(ATTN_Q_BLOCK)
        logits = jnp.einsum('thd,sd->ths', qi, k_idx, preferred_element_type=jnp.float32) * idx_scale
        score = jnp.einsum('th,ths->ts', wi.astype(jnp.float32) * w_scale, jax.nn.relu(logits))
        score = jnp.where(key_pos[None, :] <= qpos[:, None], score, -jnp.inf)
        _, sel = lax.top_k(score, topk)
        valid = sel <= qpos[:, None]
        c_sel = c_kv[sel]
        s = jnp.einsum('thc,tkc->thk', ql, c_sel, preferred_element_type=jnp.float32) * (HEAD_DIM ** -0.5)
        dist = (qpos[:, None] - sel).astype(jnp.float32)
        s = s - slopes[None, :, None] * dist[:, None, :]
        s = jnp.where(valid[:, None, :], s, -jnp.inf)
        p = jax.nn.softmax(s, axis=-1).astype(c_kv.dtype)
        return jnp.einsum('thk,tkc->thc', p, c_sel)

    o_lat = lax.map(block, jnp.arange(S // ATTN_Q_BLOCK)).reshape(S, N_HEADS_DSA, KV_LATENT)
    o = jnp.einsum('shc,hcd->shd', o_lat, w_uv)
    return o.reshape(S, DSA_WIDTH)


def moba_attention(q, k, v):
    S, H, Dh = q.shape
    n_blk = -(-S // MOBA_BLOCK)
    pad = n_blk * MOBA_BLOCK - S
    kb = jnp.pad(k, ((0, pad), (0, 0), (0, 0))).reshape(n_blk, MOBA_BLOCK, H, Dh).transpose(2, 0, 1, 3)
    vb = jnp.pad(v, ((0, pad), (0, 0), (0, 0))).reshape(n_blk, MOBA_BLOCK, H, Dh).transpose(2, 0, 1, 3)
    k_mean = kb.astype(jnp.float32).mean(axis=2)
    n_sel = min(MOBA_TOPK_MAX, n_blk - 1)
    n_past = n_sel * MOBA_BLOCK
    slopes = alibi_slopes(H)
    scale = Dh ** -0.5
    offs = jnp.arange(MOBA_BLOCK)
    blk_ids = jnp.arange(n_blk)
    head_ix = jnp.arange(H)[None, :, None]

    def block(i):
        t0 = i * MOBA_Q_BLOCK
        qi = lax.dynamic_slice_in_dim(q, t0, MOBA_Q_BLOCK, 0)
        qpos = t0 + jnp.arange(MOBA_Q_BLOCK)
        own = t0 // MOBA_BLOCK
        k_own = lax.dynamic_index_in_dim(kb, own, axis=1, keepdims=False)
        v_own = lax.dynamic_index_in_dim(vb, own, axis=1, keepdims=False)
        own_pos = own * MOBA_BLOCK + offs
        s_own = jnp.einsum('thd,hkd->thk', qi, k_own, preferred_element_type=jnp.float32) * scale
        s_own = s_own - slopes[None, :, None] * (qpos[:, None] - own_pos[None, :]).astype(jnp.float32)[:, None, :]
        s_own = jnp.where((own_pos[None, :] <= qpos[:, None])[:, None, :], s_own, -jnp.inf)
        if n_sel == 0:
            p = jax.nn.softmax(s_own, axis=-1).astype(v.dtype)
            return jnp.einsum('thk,hkd->thd', p, v_own)
        gate = jnp.einsum('thd,hnd->thn', qi.astype(jnp.float32), k_mean)
        gate = jnp.where(blk_ids[None, None, :] < own, gate, -jnp.inf)
        _, sel = lax.top_k(gate, n_sel)
        k_sel = kb[head_ix, sel]
        v_sel = vb[head_ix, sel].reshape(MOBA_Q_BLOCK, H, n_past, Dh)
        pos_sel = sel[..., None] * MOBA_BLOCK + offs
        s_sel = jnp.einsum('thd,thnkd->thnk', qi, k_sel, preferred_element_type=jnp.float32) * scale
        s_sel = s_sel - slopes[None, :, None, None] * (qpos[:, None, None, None] - pos_sel).astype(jnp.float32)
        s_sel = jnp.where((sel < own)[..., None], s_sel, -jnp.inf).reshape(MOBA_Q_BLOCK, H, n_past)
        s = jnp.concatenate([s_sel, s_own], axis=-1)
        p = jax.nn.softmax(s, axis=-1).astype(v.dtype)
        return (jnp.einsum('thk,thkd->thd', p[..., :n_past], v_sel)
                + jnp.einsum('thk,hkd->thd', p[..., n_past:], v_own))

    o = lax.map(block, jnp.arange(S // MOBA_Q_BLOCK))
    return o.reshape(S, H * Dh)


def hybrid_mixer(x, w_in, b_gate, kv_norm_g, idx_k_norm_g, idx_k_norm_b, w_uk, w_uv, w_o_dsa, w_o_moba, w_out):
    B, S, _ = x.shape
    points = np.cumsum(SPLIT_SIZES)[:-1].tolist()
    proj = x @ w_in
    q_dsa, c_kv, q_idx, k_idx, w_idx, q_m, k_m, v_m, ga, gb = jnp.split(proj, points, axis=-1)
    c_kv = rms_norm(c_kv, kv_norm_g)
    k_idx = layer_norm(k_idx, idx_k_norm_g, idx_k_norm_b)
    q_dsa = q_dsa.reshape(B, S, N_HEADS_DSA, HEAD_DIM)
    q_idx = q_idx.reshape(B, S, IDX_HEADS, IDX_DIM)
    o_a = jax.vmap(dsa_attention, in_axes=(0, 0, 0, 0, 0, None, None))(q_dsa, c_kv, q_idx, k_idx, w_idx, w_uk, w_uv)
    hm = (B, S, N_HEADS_MOBA, HEAD_DIM)
    o_b = jax.vmap(moba_attention)(q_m.reshape(hm), k_m.reshape(hm), v_m.reshape(hm))
    g_a = jax.nn.sigmoid(ga + b_gate[0])
    g_b = jax.nn.sigmoid(gb + b_gate[1])
    merged = g_a * (o_a @ w_o_dsa) + g_b * (o_b @ w_o_moba)
    return merged @ w_out


def mem_cross_attention(x, mem, w_q, w_kv, w_o):
    B, S, _ = x.shape
    q = (x @ w_q).reshape(B, S, N_HEADS_MEM, HEAD_DIM)
    k, v = jnp.split(mem @ w_kv, 2, axis=-1)
    k = k.reshape(B, N_MEM, N_HEADS_MEM, HEAD_DIM)
    v = v.reshape(B, N_MEM, N_HEADS_MEM, HEAD_DIM)
    s = jnp.einsum('bshd,bmhd->bhsm', q, k, preferred_element_type=jnp.float32) * (HEAD_DIM ** -0.5)
    p = jax.nn.softmax(s, axis=-1).astype(x.dtype)
    o = jnp.einsum('bhsm,bmhd->bshd', p, v).reshape(B, S, MEM_WIDTH)
    return o @ w_o


def swiglu(x, w_in, w_out):
    g, u = jnp.split(x @ w_in, 2, axis=-1)
    return (jax.nn.silu(g) * u) @ w_out


def setup_inputs(seed: int = 0) -> dict:
    key = jax.random.key(seed)
    ks = jax.random.split(key, 20)
    f32 = jnp.float32

    def nrm(k, shape, scale):
        return jax.random.normal(k, shape, f32) * scale

    v_off = sum(SPLIT_SIZES[:7])
    col_scale = jnp.ones((IN_WIDTH,), f32).at[v_off:v_off + MOBA_WIDTH].set(BETA)
    kv_scale = jnp.ones((2 * MEM_WIDTH,), f32).at[MEM_WIDTH:].set(BETA)
    return {
        'x': nrm(ks[0], (BATCH, SEQ, D_MODEL), 1.0),
        'mem': nrm(ks[1], (BATCH, N_MEM, D_MODEL), 1.0),
        'w_in': nrm(ks[2], (DEPTH, D_MODEL, IN_WIDTH), D_MODEL ** -0.5) * col_scale,
        'b_gate': nrm(ks[3], (DEPTH, 2, D_MODEL), 0.02),
        'kv_norm_g': 1.0 + nrm(ks[4], (DEPTH, KV_LATENT), 0.02),
        'idx_k_norm_g': 1.0 + nrm(ks[5], (DEPTH, IDX_DIM), 0.02),
        'idx_k_norm_b': nrm(ks[6], (DEPTH, IDX_DIM), 0.02),
        'w_uk': nrm(ks[7], (DEPTH, N_HEADS_DSA, HEAD_DIM, KV_LATENT), HEAD_DIM ** -0.5),
        'w_uv': nrm(ks[8], (DEPTH, N_HEADS_DSA, KV_LATENT, HEAD_DIM), BETA * KV_LATENT ** -0.5),
        'w_o_dsa': nrm(ks[9], (DEPTH, DSA_WIDTH, D_MODEL), BETA * DSA_WIDTH ** -0.5),
        'w_o_moba': nrm(ks[10], (DEPTH, MOBA_WIDTH, D_MODEL), BETA * MOBA_WIDTH ** -0.5),
        'w_out': nrm(ks[11], (DEPTH, D_MODEL, D_MODEL), BETA * D_MODEL ** -0.5),
        'w_q_mem': nrm(ks[12], (DEPTH, D_MODEL, MEM_WIDTH), D_MODEL ** -0.5),
        'w_kv_mem': nrm(ks[13], (DEPTH, D_MODEL, 2 * MEM_WIDTH), D_MODEL ** -0.5) * kv_scale,
        'w_o_mem': nrm(ks[14], (DEPTH, MEM_WIDTH, D_MODEL), BETA * MEM_WIDTH ** -0.5),
        'w_ffn_in': nrm(ks[15], (DEPTH, D_MODEL, 2 * D_FF), BETA * D_MODEL ** -0.5),
        'w_ffn_out': nrm(ks[16], (DEPTH, D_FF, D_MODEL), BETA * D_FF ** -0.5),
        'ln_g': 1.0 + nrm(ks[17], (DEPTH, 3, D_MODEL), 0.02),
        'ln_b': nrm(ks[18], (DEPTH, 3, D_MODEL), 0.02),
    }


def reference(x, mem, w_in, b_gate, kv_norm_g, idx_k_norm_g, idx_k_norm_b, w_uk, w_uv, w_o_dsa, w_o_moba,
              w_out, w_q_mem, w_kv_mem, w_o_mem, w_ffn_in, w_ffn_out, ln_g, ln_b):
    for l in range(DEPTH):
        y = hybrid_mixer(x, w_in[l], b_gate[l], kv_norm_g[l], idx_k_norm_g[l], idx_k_norm_b[l], w_uk[l], w_uv[l],
                         w_o_dsa[l], w_o_moba[l], w_out[l])
        x = layer_norm(ALPHA * x + y, ln_g[l, 0], ln_b[l, 0])
        y = mem_cross_attention(x, mem, w_q_mem[l], w_kv_mem[l], w_o_mem[l])
        x = layer_norm(ALPHA * x + y, ln_g[l, 1], ln_b[l, 1])
        y = swiglu(x, w_ffn_in[l], w_ffn_out[l])
        x = layer_norm(ALPHA * x + y, ln_g[l, 2], ln_b[l, 2])
    return x
```

```cpp
#include <hip/hip_runtime.h>
#include <cstdio>
#include <cstdint>

#ifndef MK_ONE_LAUNCH
#define MK_ONE_LAUNCH 1
#endif
#ifndef LN_FUSED
#define LN_FUSED 7
#endif

#define LAS __attribute__((address_space(3)))
#define GAS __attribute__((address_space(1)))
typedef unsigned short bf16;
typedef short bf16x8 __attribute__((ext_vector_type(8)));
typedef short s16x4 __attribute__((ext_vector_type(4)));
typedef short v4i16_t __attribute__((ext_vector_type(4)));
typedef float f32x2 __attribute__((ext_vector_type(2)));
typedef float f32x4 __attribute__((ext_vector_type(4)));
typedef float f32x16 __attribute__((ext_vector_type(16)));
typedef unsigned u32x2 __attribute__((ext_vector_type(2)));
typedef unsigned u32x4 __attribute__((ext_vector_type(4)));
typedef int v4i __attribute__((ext_vector_type(4)));
typedef int v8i __attribute__((ext_vector_type(8)));
typedef v8i v8i_a16 __attribute__((aligned(16)));
typedef GAS unsigned gu32;
#define RLX_AGENT __ATOMIC_RELAXED, __HIP_MEMORY_SCOPE_AGENT
#define DI __device__ __forceinline__

constexpr int S = 16384, D = 2048, DEPTH = 4, NH = 8, HD = 128, CKV = 256, IH = 16, IDIM = 64, TOPK = 256, MBLK = 256, NBLK = 64, NMEM = 256, NHM = 4, DFF = 5632;
constexpr int INW = 9552, INP = 9728;
constexpr float LN_EPS = 1e-5f;
constexpr float ALPHA = 1.681792830507429f;
constexpr float LOG2E = 1.4426950408889634f;
constexpr float ATT_SCALE2 = 0.08838834764831845f * LOG2E;
constexpr int NWAVES = 8, NTHREADS = 512;
constexpr float F8_SW1 = 64.f, F8_SW2 = 128.f, F8_SH = 16.f, F8_SWI = 32.f;
constexpr float F8_SWO = 64.f, F8_SWOUT = 64.f, F8_SWQM = 32.f, F8_SWOM = 32.f;
constexpr float F8_SOA = 16.f, F8_SOB = 8.f, F8_SMG = 64.f, F8_SOM = 32.f;
constexpr int INB = 3328, IN8 = 6400;

constexpr size_t MiB = 1u << 20;
constexpr size_t WS_CTL = 0, CTL_ZERO_BYTES = 1 * MiB;
constexpr size_t WS_WIN = 1 * MiB;
constexpr size_t WS_WUK = WS_WIN + 38 * MiB;
constexpr size_t WS_WUV = WS_WUK + 1 * MiB;
constexpr size_t WS_WOA = WS_WUV + 1 * MiB;
constexpr size_t WS_WOB = WS_WOA + 4 * MiB;
constexpr size_t WS_WOUT = WS_WOB + 4 * MiB;
constexpr size_t WS_WQM = WS_WOUT + 8 * MiB;
constexpr size_t WS_WOM = WS_WQM + 2 * MiB;
constexpr size_t WS_WF1 = WS_WOM + 2 * MiB;
constexpr size_t WS_WF2 = WS_WF1 + 44 * MiB;
constexpr size_t WS_WKV = WS_WF2 + 22 * MiB;
constexpr size_t WS_MEMB = WS_WKV + 16 * MiB;
constexpr size_t WS_KVMEM = WS_MEMB + 1 * MiB;
constexpr size_t WS_XB = WS_KVMEM + 2 * MiB;
constexpr size_t WS_QDSA = WS_XB + 64 * MiB;
constexpr size_t WS_QIDX = WS_QDSA + 32 * MiB;
constexpr size_t WS_QM = WS_QIDX + 32 * MiB;
constexpr size_t WS_KM = WS_QM + 32 * MiB;
constexpr size_t WS_VM = WS_KM + 32 * MiB;
constexpr size_t WS_GA = WS_VM + 32 * MiB;
constexpr size_t WS_GB = WS_GA + 64 * MiB;
constexpr size_t WS_CKVRAW = WS_GB + 64 * MiB;
constexpr size_t WS_KWRAW = WS_CKVRAW + 16 * MiB;
constexpr size_t WS_H = WS_QDSA;
constexpr size_t WS_CKVN = WS_KWRAW + 16 * MiB;
constexpr size_t WS_KIDXN = WS_CKVN + 8 * MiB;
constexpr size_t WS_WIDX = WS_KIDXN + 2 * MiB;
constexpr size_t WS_KMEAN = WS_WIDX + 1 * MiB;
constexpr size_t WS_QLAT = WS_KMEAN + 1 * MiB;
constexpr size_t WS_SEL = WS_QLAT + 64 * MiB;
constexpr size_t WS_OLAT = WS_SEL + 8 * MiB;
constexpr size_t WS_OA = WS_OLAT + 64 * MiB;
constexpr size_t WS_OB = WS_OA + 32 * MiB;
constexpr size_t WS_BUCK = WS_OB + 32 * MiB;
constexpr size_t WS_PARTO = WS_BUCK + 16 * MiB;
constexpr size_t WS_PARTML = WS_PARTO + 128 * MiB;
constexpr size_t WS_T1 = WS_PARTML + 4 * MiB;
constexpr size_t WS_MERGED = WS_T1 + 64 * MiB;
constexpr size_t WS_Y = WS_MERGED + 64 * MiB;
constexpr size_t WS_QMEM = WS_Y + 64 * MiB;
constexpr size_t WS_OMEM = WS_QMEM + 16 * MiB;
constexpr size_t WS_XB8 = WS_OMEM + 16 * MiB;
constexpr size_t WS_LNX = WS_XB8 + 32 * MiB;
constexpr size_t WS_END = WS_LNX + 1 * MiB;
constexpr size_t WS_WIN8 = WS_WIN + 16 * MiB;
static_assert(WS_H + (size_t)S * DFF * 2 <= WS_CKVN, "h overlay");
static_assert(WS_END <= 1408 * MiB, "workspace");
constexpr int CW_BAR = 4096;
constexpr int CW_BCNT = 16384;
constexpr int CW_LNCNT = 65536;
constexpr int BUCK_PER_HEAD = 256 * 2016;
DI int bucket_off(int b) { return 256 * (63 * b - (b * (b - 1)) / 2); }

constexpr int LDS_BYTES = 147456;
constexpr int RING_BYTES = 131072;
constexpr int MISC_OFF = 143360;
constexpr int LNT_OFF = RING_BYTES;

DI unsigned f2bf(float f) { unsigned u = __builtin_bit_cast(unsigned, f); return (u + 0x7fffu + ((u >> 16) & 1u)) >> 16; }
DI unsigned pk2(float lo, float hi) { return f2bf(lo) | (f2bf(hi) << 16); }
DI unsigned cvt_pk_bf16(float lo, float hi) { unsigned r; asm volatile("v_cvt_pk_bf16_f32 %0, %1, %2" : "=v"(r) : "v"(lo), "v"(hi)); return r; }
DI float clamp448(float x) { return __builtin_amdgcn_fmed3f(x, -448.f, 448.f); }
DI unsigned pk4_fp8(float a, float b, float c, float d) {
    int w = 0; w = __builtin_amdgcn_cvt_pk_fp8_f32(clamp448(a), clamp448(b), w, false); w = __builtin_amdgcn_cvt_pk_fp8_f32(clamp448(c), clamp448(d), w, true); return (unsigned)w; }
DI float bflo(unsigned u) { return __builtin_bit_cast(float, u << 16); }
DI float bfhi(unsigned u) { return __builtin_bit_cast(float, u & 0xffff0000u); }
DI int lane_id() { int l; asm volatile("v_mbcnt_lo_u32_b32 %0, -1, 0\n\tv_mbcnt_hi_u32_b32 %0, -1, %0" : "=v"(l)); return l; }
DI float wave_sum(float v) {
#pragma unroll
    for (int o = 1; o < 64; o <<= 1) v += __shfl_xor(v, o);
    return v;
}
DI float xrow16_max(float x) {
    auto s = __builtin_amdgcn_permlane16_swap(__float_as_uint(x), __float_as_uint(x), false, false);
    x = fmaxf(__uint_as_float(s[0]), __uint_as_float(s[1]));
    auto t = __builtin_amdgcn_permlane32_swap(__float_as_uint(x), __float_as_uint(x), false, false);
    return fmaxf(__uint_as_float(t[0]), __uint_as_float(t[1]));
}
DI float xrow16_sum(float x) {
    auto s = __builtin_amdgcn_permlane16_swap(__float_as_uint(x), __float_as_uint(x), false, false);
    x = __uint_as_float(s[0]) + __uint_as_float(s[1]);
    auto t = __builtin_amdgcn_permlane32_swap(__float_as_uint(x), __float_as_uint(x), false, false);
    return __uint_as_float(t[0]) + __uint_as_float(t[1]);
}
DI float fast_sigmoid(float x) { return __builtin_amdgcn_rcpf(1.0f + __builtin_amdgcn_exp2f(-x * LOG2E)); }
DI s16x4 vtr(unsigned lds_addr) { return __builtin_bit_cast(s16x4, __builtin_amdgcn_ds_read_tr16_b64_v4i16((LAS v4i16_t*)lds_addr)); }
DI unsigned off_b(unsigned row, unsigned ch) { return 256u * row + 16u * (ch ^ (((row & 3) << 2) | ((row >> 2) & 3))); }
DI unsigned tr_addr16(unsigned lane, unsigned c, unsigned ks, unsigned t) {
    const unsigned g = lane >> 4, q = (lane & 15) >> 2, p = lane & 3;
    return off_b(32 * ks + 8 * g + 4 * t + q, 2 * c + (p >> 1)) + 8 * (p & 1);
}
DI unsigned perm32rows(unsigned k) { return (k & ~31u) | (8u * ((k >> 2) & 3u) + 4u * ((k >> 4) & 1u) + (k & 3u)); }

namespace pg8 {
constexpr int BM = 256, BK = 64, HALF = 128, HTB = HALF * BK * 2, STAGE_BYTES = 8 * HTB, NXCD = 8, WGM = 8;
__host__ __device__ __forceinline__ int lds_byte(int r, int c) { const int st = (r >> 4) * 2 + (c >> 5), rr = r & 15, cc = c & 31, ob = rr * 64 + cc * 2; return st * 1024 + (ob ^ (((ob >> 9) & 1) << 5)); }
__host__ __device__ __forceinline__ void stage_rc(int b, int& R, int& C) { const int st = b / 1024, sb = b % 1024, swz = sb ^ (((sb >> 9) & 1) << 5); R = (st >> 1) * 16 + swz / 64; C = (st & 1) * 32 + (swz % 64) / 2; }
__host__ __device__ __forceinline__ int perm32(int rho) { const int n = rho >> 4, i = rho & 15; return 8 * (i >> 2) + 4 * n + (i & 3); }
struct Unit { int pm, pn; };
struct Gemm { const bf16* A; const bf16* Bt; int lda, ldb, K, nM, nN, a_shift, a_koff; };
struct StaticOrder {
    int nM, nN, nwg, G, c;
    DI void init(int nM_, int nN_, int G_, int c_) { nM = nM_; nN = nN_; nwg = nM * nN; G = G_; c = c_; }
    DI bool next(int i, Unit& u) const {
        const long L = (long)i * G + c; if (L >= nwg) return false;
        int wgid = (int)L; { const int q = nwg / NXCD, r = nwg % NXCD, xcd = wgid % NXCD, off = wgid / NXCD; wgid = (xcd < r ? xcd * (q + 1) : r * (q + 1) + (xcd - r) * q) + off; }
        const int nig = WGM * nN, gid = wgid / nig, fm = gid * WGM, gsz = (nM - fm) < WGM ? (nM - fm) : WGM;
        u.pm = fm + ((wgid % nig) % gsz); u.pn = (wgid % nig) / gsz; return true;
    }
};
struct EpiBf16 {
    bf16* O; int ldc;
    DI void operator()(const f32x4 (&acc)[2][2][4][2], const Unit& u, int wr, int wc, int fr, int fq) const {
        const int row0 = u.pm * BM + wr * 64 + fr, col0 = u.pn * BM + wc * 32 + 8 * fq;
#pragma unroll
        for (int ai = 0; ai < 2; ++ai)
#pragma unroll
            for (int m = 0; m < 4; ++m) { bf16* rowp = O + (size_t)(row0 + ai * HALF + m * 16) * ldc + col0;
#pragma unroll
                for (int bj = 0; bj < 2; ++bj) { const f32x4 v0 = acc[ai][bj][m][0], v1 = acc[ai][bj][m][1];
                    u32x4 w; w.x = cvt_pk_bf16(v0[0], v0[1]); w.y = cvt_pk_bf16(v0[2], v0[3]); w.z = cvt_pk_bf16(v1[0], v1[1]); w.w = cvt_pk_bf16(v1[2], v1[3]);
                    *(u32x4*)(rowp + bj * HALF) = w; } }
    }
};
struct EpiBf16S {
    bf16* O; int ldc; float scale;
    DI void operator()(const f32x4 (&acc)[2][2][4][2], const Unit& u, int wr, int wc, int fr, int fq) const {
        const int row0 = u.pm * BM + wr * 64 + fr, col0 = u.pn * BM + wc * 32 + 8 * fq;
#pragma unroll
        for (int ai = 0; ai < 2; ++ai)
#pragma unroll
            for (int m = 0; m < 4; ++m) { bf16* rowp = O + (size_t)(row0 + ai * HALF + m * 16) * ldc + col0;
#pragma unroll
                for (int bj = 0; bj < 2; ++bj) { const f32x4 v0 = acc[ai][bj][m][0] * scale, v1 = acc[ai][bj][m][1] * scale;
                    u32x4 w; w.x = cvt_pk_bf16(v0[0], v0[1]); w.y = cvt_pk_bf16(v0[2], v0[3]); w.z = cvt_pk_bf16(v1[0], v1[1]); w.w = cvt_pk_bf16(v1[2], v1[3]);
                    *(u32x4*)(rowp + bj * HALF) = w; } }
    }
};
struct EpiSwiglu8 {
    unsigned char* Hh;
    DI void operator()(const f32x4 (&acc)[2][2][4][2], const Unit& u, int wr, int wc, int fr, int fq) const {
        const int row0 = u.pm * BM + wr * 64 + fr, col0 = u.pn * HALF + wc * 32 + 8 * fq;
#pragma unroll
        for (int ai = 0; ai < 2; ++ai)
#pragma unroll
            for (int m = 0; m < 4; ++m) { unsigned char* rowp = Hh + (size_t)(row0 + ai * HALF + m * 16) * DFF + col0;
                float r[8];
#pragma unroll
                for (int n = 0; n < 2; ++n)
#pragma unroll
                    for (int j = 0; j < 4; ++j) { const float g = acc[ai][0][m][n][j] * (1.0f / F8_SW1), uu = acc[ai][1][m][n][j] * (F8_SH / F8_SW1); r[4 * n + j] = g * fast_sigmoid(g) * uu; }
                u32x2 w; w.x = pk4_fp8(r[0], r[1], r[2], r[3]); w.y = pk4_fp8(r[4], r[5], r[6], r[7]);
                *(u32x2*)rowp = w; }
    }
};
struct EpiF8 {
    unsigned char* O; int ldc; float scale;
    DI void operator()(const f32x4 (&acc)[2][2][4][2], const Unit& u, int wr, int wc, int fr, int fq) const {
        const int row0 = u.pm * BM + wr * 64 + fr, col0 = u.pn * BM + wc * 32 + 8 * fq;
#pragma unroll
        for (int ai = 0; ai < 2; ++ai)
#pragma unroll
            for (int m = 0; m < 4; ++m) { unsigned char* rowp = O + (size_t)(row0 + ai * HALF + m * 16) * ldc + col0;
#pragma unroll
                for (int bj = 0; bj < 2; ++bj) { const f32x4 v0 = acc[ai][bj][m][0] * scale, v1 = acc[ai][bj][m][1] * scale;
                    u32x2 w; w.x = pk4_fp8(v0[0], v0[1], v0[2], v0[3]); w.y = pk4_fp8(v1[0], v1[1], v1[2], v1[3]); *(u32x2*)(rowp + bj * HALF) = w; } }
    }
};
struct EpiGate {
    bf16* O; const bf16* gate; const bf16* add; unsigned char* O8; float ascale, oscale;
    DI void operator()(const f32x4 (&acc)[2][2][4][2], const Unit& u, int wr, int wc, int fr, int fq) const {
        const int row0 = u.pm * BM + wr * 64 + fr, col0 = u.pn * BM + wc * 32 + 8 * fq;
#pragma unroll
        for (int ai = 0; ai < 2; ++ai)
#pragma unroll
            for (int m = 0; m < 4; ++m) { const size_t ro = (size_t)(row0 + ai * HALF + m * 16) * D + col0;
#pragma unroll
                for (int bj = 0; bj < 2; ++bj) { const f32x4 v0 = acc[ai][bj][m][0] * ascale, v1 = acc[ai][bj][m][1] * ascale;
                    const u32x4 g = *(const u32x4*)(gate + ro + bj * HALF);
                    float r[8] = { v0[0] * bflo(g.x), v0[1] * bfhi(g.x), v0[2] * bflo(g.y), v0[3] * bfhi(g.y), v1[0] * bflo(g.z), v1[1] * bfhi(g.z), v1[2] * bflo(g.w), v1[3] * bfhi(g.w) };
                    if (add) { const u32x4 a = *(const u32x4*)(add + ro + bj * HALF);
                        r[0] += bflo(a.x); r[1] += bfhi(a.x); r[2] += bflo(a.y); r[3] += bfhi(a.y); r[4] += bflo(a.z); r[5] += bfhi(a.z); r[6] += bflo(a.w); r[7] += bfhi(a.w); }
                    if (O8) { u32x2 w; w.x = pk4_fp8(r[0] * oscale, r[1] * oscale, r[2] * oscale, r[3] * oscale); w.y = pk4_fp8(r[4] * oscale, r[5] * oscale, r[6] * oscale, r[7] * oscale); *(u32x2*)(O8 + ro + bj * HALF) = w; }
                    else { u32x4 w; w.x = cvt_pk_bf16(r[0], r[1]); w.y = cvt_pk_bf16(r[2], r[3]); w.z = cvt_pk_bf16(r[4], r[5]); w.w = cvt_pk_bf16(r[6], r[7]);
                        *(u32x4*)(O + ro + bj * HALF) = w; } } }
    }
};
struct EpiSwiglu {
    bf16* Hh;
    DI void operator()(const f32x4 (&acc)[2][2][4][2], const Unit& u, int wr, int wc, int fr, int fq) const {
        const int row0 = u.pm * BM + wr * 64 + fr, col0 = u.pn * HALF + wc * 32 + 8 * fq;
#pragma unroll
        for (int ai = 0; ai < 2; ++ai)
#pragma unroll
            for (int m = 0; m < 4; ++m) { bf16* rowp = Hh + (size_t)(row0 + ai * HALF + m * 16) * DFF + col0;
                float r[8];
#pragma unroll
                for (int n = 0; n < 2; ++n)
#pragma unroll
                    for (int j = 0; j < 4; ++j) { const float g = acc[ai][0][m][n][j], uu = acc[ai][1][m][n][j]; r[4 * n + j] = g * fast_sigmoid(g) * uu; }
                u32x4 w; w.x = cvt_pk_bf16(r[0], r[1]); w.y = cvt_pk_bf16(r[2], r[3]); w.z = cvt_pk_bf16(r[4], r[5]); w.w = cvt_pk_bf16(r[6], r[7]);
                *(u32x4*)rowp = w; }
    }
};
struct EpiInBf {
    bf16 *qidx, *qm, *km; float* kwraw;
    DI void operator()(const f32x4 (&acc)[2][2][4][2], const Unit& u, int wr, int wc, int fr, int fq) const {
        const int row0 = u.pm * BM + wr * 64 + fr, cl = wc * 32 + 8 * fq; const int pn = u.pn;
        if (pn == 4) {
#pragma unroll
            for (int ai = 0; ai < 2; ++ai)
#pragma unroll
                for (int m = 0; m < 4; ++m) { float* rowp = kwraw + (size_t)(row0 + ai * HALF + m * 16) * 256 + cl;
#pragma unroll
                    for (int bj = 0; bj < 2; ++bj) { *(f32x4*)(rowp + bj * HALF) = acc[ai][bj][m][0]; *(f32x4*)(rowp + bj * HALF + 4) = acc[ai][bj][m][1]; } }
            return;
        }
        bf16* O; int ct;
        if (pn < 4) { O = qidx; ct = pn; } else if (pn < 9) { O = qm; ct = pn - 5; } else { O = km; ct = pn - 9; }
        const int col0 = ct * BM + cl;
#pragma unroll
        for (int ai = 0; ai < 2; ++ai)
#pragma unroll
            for (int m = 0; m < 4; ++m) { bf16* rowp = O + (size_t)(row0 + ai * HALF + m * 16) * 1024 + col0;
#pragma unroll
                for (int bj = 0; bj < 2; ++bj) { const f32x4 v0 = acc[ai][bj][m][0], v1 = acc[ai][bj][m][1];
                    u32x4 w; w.x = cvt_pk_bf16(v0[0], v0[1]); w.y = cvt_pk_bf16(v0[2], v0[3]); w.z = cvt_pk_bf16(v1[0], v1[1]); w.w = cvt_pk_bf16(v1[2], v1[3]);
                    *(u32x4*)(rowp + bj * HALF) = w; } }
    }
};
struct EpiIn8 {
    bf16 *qdsa, *vm, *ga, *gb; float* ckvraw; const float* bgate;
    DI void operator()(const f32x4 (&acc)[2][2][4][2], const Unit& u, int wr, int wc, int fr, int fq) const {
        const int row0 = u.pm * BM + wr * 64 + fr, cl = wc * 32 + 8 * fq; const int pn = u.pn; const float sc = 1.0f / F8_SWI;
        if (pn == 4) {
#pragma unroll
            for (int ai = 0; ai < 2; ++ai)
#pragma unroll
                for (int m = 0; m < 4; ++m) { float* rowp = ckvraw + (size_t)(row0 + ai * HALF + m * 16) * 256 + cl;
#pragma unroll
                    for (int bj = 0; bj < 2; ++bj) { *(f32x4*)(rowp + bj * HALF) = acc[ai][bj][m][0] * sc; *(f32x4*)(rowp + bj * HALF + 4) = acc[ai][bj][m][1] * sc; } }
            return;
        }
        bf16* O; int ldc, ct; const float* bias = nullptr;
        if (pn < 4) { O = qdsa; ldc = 1024; ct = pn; }
        else if (pn < 9) { O = vm; ldc = 1024; ct = pn - 5; }
        else if (pn < 17) { O = ga; ldc = 2048; ct = pn - 9; bias = bgate; }
        else { O = gb; ldc = 2048; ct = pn - 17; bias = bgate + 2048; }
        const int col0 = ct * BM + cl;
#pragma unroll
        for (int ai = 0; ai < 2; ++ai)
#pragma unroll
            for (int m = 0; m < 4; ++m) { bf16* rowp = O + (size_t)(row0 + ai * HALF + m * 16) * ldc + col0;
#pragma unroll
                for (int bj = 0; bj < 2; ++bj) { f32x4 v0 = acc[ai][bj][m][0] * sc, v1 = acc[ai][bj][m][1] * sc;
                    if (bias) { const f32x4 b0 = *(const f32x4*)(bias + col0 + bj * HALF), b1 = *(const f32x4*)(bias + col0 + bj * HALF + 4);
#pragma unroll
                        for (int j = 0; j < 4; ++j) { v0[j] = fast_sigmoid(v0[j] + b0[j]); v1[j] = fast_sigmoid(v1[j] + b1[j]); } }
                    u32x4 w; w.x = cvt_pk_bf16(v0[0], v0[1]); w.y = cvt_pk_bf16(v0[2], v0[3]); w.z = cvt_pk_bf16(v1[0], v1[1]); w.w = cvt_pk_bf16(v1[2], v1[3]);
                    *(u32x4*)(rowp + bj * HALF) = w; } }
    }
};

struct FusedOrder {
    int c;
    DI bool next(int i, Unit& u) const { if (i >= 2) return false; const int xcd = c & 7, j = c >> 3; u.pm = i * 32 + xcd * 4 + (j >> 3); u.pn = j & 7; return true; }
};
struct EpiLn {
    float* x; const float* g; const float* b; float scale; bf16* xb; unsigned char* xb8; unsigned long long* slots; unsigned* cnt;
    DI void run(f32x4 (&acc)[2][2][4][2], const Unit& u, int wr, int wc, int fr_, int fq_, LAS unsigned char* lds, int wid, int lane_) const {
        int fr = fr_, fq = fq_, lane = lane_; asm volatile("" : "+v"(fr), "+v"(fq), "+v"(lane));
        LAS f32x2* P = (LAS f32x2*)(lds + LNT_OFF); LAS f32x2* Sx = (LAS f32x2*)(lds + LNT_OFF + 8192);
        const int row0 = u.pm * BM + wr * 64 + fr, col0 = u.pn * BM + wc * 32 + 8 * fq;
        __builtin_amdgcn_sched_barrier(0);
#pragma unroll
        for (int ai = 0; ai < 2; ++ai)
#pragma unroll
            for (int m = 0; m < 4; ++m) { const float* xr = x + (size_t)(row0 + ai * HALF + m * 16) * D + col0;
#pragma unroll
                for (int bj = 0; bj < 2; ++bj) { const f32x4 x0 = *(const f32x4*)(xr + bj * HALF), x1 = *(const f32x4*)(xr + bj * HALF + 4);
                    acc[ai][bj][m][0] = x0 * ALPHA + acc[ai][bj][m][0] * scale; acc[ai][bj][m][1] = x1 * ALPHA + acc[ai][bj][m][1] * scale; }
                __builtin_amdgcn_sched_barrier(0);
                asm volatile("" : "+v"(acc[ai][0][m][0]), "+v"(acc[ai][0][m][1]), "+v"(acc[ai][1][m][0]), "+v"(acc[ai][1][m][1]) :: "memory"); }
        __builtin_amdgcn_sched_barrier(0);
#pragma unroll
        for (int ai = 0; ai < 2; ++ai)
#pragma unroll
            for (int m = 0; m < 4; ++m) {
                float s = 0.f;
#pragma unroll
                for (int bj = 0; bj < 2; ++bj)
#pragma unroll
                    for (int n = 0; n < 2; ++n) { const f32x4 v = acc[ai][bj][m][n]; s += (v[0] + v[1]) + (v[2] + v[3]); }
                s += __shfl_xor(s, 16); s += __shfl_xor(s, 32);
                const float mw = s * (1.0f / 64.0f); float q = 0.f;
#pragma unroll
                for (int bj = 0; bj < 2; ++bj)
#pragma unroll
                    for (int n = 0; n < 2; ++n) { const f32x4 d = acc[ai][bj][m][n] - mw; q += (d[0] * d[0] + d[1] * d[1]) + (d[2] * d[2] + d[3] * d[3]); }
                q += __shfl_xor(q, 16); q += __shfl_xor(q, 32);
                if (fq == 0) P[(ai * HALF + wr * 64 + m * 16 + fr) * 4 + wc] = (f32x2){mw, q};
            }
        asm volatile("s_waitcnt lgkmcnt(0)" ::: "memory"); __builtin_amdgcn_s_barrier(); asm volatile("" ::: "memory");
        const int row = wid * 32 + (lane & 31);
        if (lane < 32) {
            const f32x2 a = P[row * 4 + 0], b2 = P[row * 4 + 1], c = P[row * 4 + 2], d = P[row * 4 + 3];
            const float mt = (a[0] + b2[0] + c[0] + d[0]) * 0.25f;
            const float da = a[0] - mt, db = b2[0] - mt, dc = c[0] - mt, dd = d[0] - mt;
            const float m2 = (a[1] + b2[1]) + (c[1] + d[1]) + 64.0f * ((da * da + db * db) + (dc * dc + dd * dd));
            __hip_atomic_store(slots + ((size_t)(u.pm * BM + row) * 8 + u.pn), ((unsigned long long)__float_as_uint(m2) << 32) | __float_as_uint(mt), __ATOMIC_RELAXED, __HIP_MEMORY_SCOPE_AGENT);
        }
        asm volatile("s_waitcnt vmcnt(0)" ::: "memory");
        if (lane == 0) __hip_atomic_fetch_add(cnt + 64 * u.pm, 1u, __ATOMIC_RELAXED, __HIP_MEMORY_SCOPE_AGENT);
        if (wid == 0) {
            unsigned sp = 0;
            while ((unsigned)__builtin_amdgcn_readfirstlane(__hip_atomic_load(cnt + 64 * u.pm, __ATOMIC_RELAXED, __HIP_MEMORY_SCOPE_AGENT)) < 64u) { __builtin_amdgcn_s_sleep(1); if (++sp > (1u << 24)) break; }
            __builtin_amdgcn_fence(__ATOMIC_ACQUIRE, "agent");
        }
        asm volatile("s_waitcnt vmcnt(0) lgkmcnt(0)" ::: "memory"); __builtin_amdgcn_s_barrier(); asm volatile("" ::: "memory");
        if (lane < 32) {
            const unsigned long long* sl = slots + (size_t)(u.pm * BM + row) * 8; float mt[8], m2[8]; float ms = 0.f;
#pragma unroll
            for (int t = 0; t < 8; ++t) { const unsigned long long w = __hip_atomic_load(sl + t, __ATOMIC_RELAXED, __HIP_MEMORY_SCOPE_AGENT); mt[t] = __uint_as_float((unsigned)w); m2[t] = __uint_as_float((unsigned)(w >> 32)); ms += mt[t]; }
            const float mean = ms * 0.125f; float q = 0.f;
#pragma unroll
            for (int t = 0; t < 8; ++t) { const float dm = mt[t] - mean; q += m2[t] + 256.0f * dm * dm; }
            Sx[row] = (f32x2){mean, 1.0f / sqrtf(q * (1.0f / D) + LN_EPS)};
        }
        asm volatile("s_waitcnt lgkmcnt(0)" ::: "memory"); __builtin_amdgcn_s_barrier(); asm volatile("" ::: "memory");
        __builtin_amdgcn_sched_barrier(0);
#pragma unroll
        for (int bj = 0; bj < 2; ++bj) {
            const f32x4 g0 = *(const f32x4*)(g + col0 + bj * HALF), g1 = *(const f32x4*)(g + col0 + bj * HALF + 4), b0 = *(const f32x4*)(b + col0 + bj * HALF), b1 = *(const f32x4*)(b + col0 + bj * HALF + 4);
#pragma unroll
            for (int ai = 0; ai < 2; ++ai)
#pragma unroll
                for (int m = 0; m < 4; ++m) { const int rl = ai * HALF + wr * 64 + m * 16 + fr; const f32x2 sr = Sx[rl]; const size_t off = (size_t)(u.pm * BM + rl) * D + col0 + bj * HALF;
                    const f32x4 o0 = (acc[ai][bj][m][0] - sr[0]) * sr[1] * g0 + b0, o1 = (acc[ai][bj][m][1] - sr[0]) * sr[1] * g1 + b1;
                    *(f32x4*)(x + off) = o0; *(f32x4*)(x + off + 4) = o1;
                    if (xb) { u32x4 w; w.x = cvt_pk_bf16(o0[0], o0[1]); w.y = cvt_pk_bf16(o0[2], o0[3]); w.z = cvt_pk_bf16(o1[0], o1[1]); w.w = cvt_pk_bf16(o1[2], o1[3]); *(u32x4*)(xb + off) = w; }
                    if (xb8) { u32x2 w; w.x = pk4_fp8(o0[0], o0[1], o0[2], o0[3]); w.y = pk4_fp8(o1[0], o1[1], o1[2], o1[3]); *(u32x2*)(xb8 + off) = w; }
                    asm volatile("" ::: "memory"); __builtin_amdgcn_sched_barrier(0); }
        }
        asm volatile("s_waitcnt lgkmcnt(0)" ::: "memory"); __builtin_amdgcn_s_barrier(); asm volatile("" ::: "memory");
    }
};

template <class Epi, bool FP8 = false, class Order = StaticOrder, bool LN = false>
DI void gemm_phase(LAS unsigned char* lds, const Gemm g, const Order& So, const Epi& E, int tid_in) {
    int tid_ = tid_in; asm volatile("" : "+v"(tid_));
    const int tid = tid_, wid = __builtin_amdgcn_readfirstlane(tid >> 6), lane = tid & 63, wr = wid >> 2, wc = wid & 3, fr = lane & 15, fq = lane >> 4;
    const int K = g.K, nt = K / BK;
    unsigned voffA[2], voffB[2];
#pragma unroll
    for (int i = 0; i < 2; ++i) { int R, C; stage_rc(tid * 16 + i * 8192, R, C); const int Rb = (R & ~31) + perm32(R & 31);
        voffA[i] = (unsigned)(R * g.lda + C) * 2u; voffB[i] = (unsigned)(Rb * g.ldb + C) * 2u; }
    const size_t kstep = (size_t)(BK * 2);
    const size_t hstepA = (size_t)HALF * g.lda * 2, hstepB = (size_t)HALF * g.ldb * 2;
    const size_t tstepA = 2 * hstepA, tstepB = 2 * hstepB;
    const unsigned ldsw = (unsigned)wid * 1024u;
    const int aoff = lds_byte(wr * 64 + fr, fq * 8), boff = lds_byte(wc * 32 + fr, fq * 8);
    int one8 = 0x7F7F7F7F; asm volatile("" : "+v"(one8));
#define PG8_SA(b, h) (((b) * 2 + (h)) * HTB)
#define PG8_SB(b, h) ((4 + (b) * 2 + (h)) * HTB)
#define PG8_STAGE(bufoff, gbase, voff) do { _Pragma("unroll") for (int _i = 0; _i < 2; ++_i) \
        __builtin_amdgcn_global_load_lds((const unsigned*)((const char*)(gbase) + (voff)[_i]), (LAS unsigned*)(lds + (bufoff) + ldsw + _i * 8192), 16, 0, 0); } while (0)
#define PG8_LDA(dst, b, h) do { _Pragma("unroll") for (int m = 0; m < 4; ++m) { const LAS unsigned char* p_ = lds + PG8_SA(b, h) + aoff + m * 2048; \
        if constexpr (FP8) { const v4i lo_ = *(const LAS v4i*)p_, hi_ = *(const LAS v4i*)(p_ + 1024); dst##8[m] = __builtin_shufflevector(lo_, hi_, 0, 1, 2, 3, 4, 5, 6, 7); } \
        else { dst[m][0] = *(const LAS v4i*)p_; dst[m][1] = *(const LAS v4i*)(p_ + 1024); } } } while (0)
#define PG8_LDB(dst, b, h) do { _Pragma("unroll") for (int n = 0; n < 2; ++n) { const LAS unsigned char* p_ = lds + PG8_SB(b, h) + boff + n * 2048; \
        if constexpr (FP8) { const v4i lo_ = *(const LAS v4i*)p_, hi_ = *(const LAS v4i*)(p_ + 1024); dst##8[n] = __builtin_shufflevector(lo_, hi_, 0, 1, 2, 3, 4, 5, 6, 7); } \
        else { dst[n][0] = *(const LAS v4i*)p_; dst[n][1] = *(const LAS v4i*)(p_ + 1024); } } } while (0)
#define PG8_MMA(ai, bj, At, Bt) do { __builtin_amdgcn_s_setprio(1); _Pragma("unroll") for (int m = 0; m < 4; ++m) _Pragma("unroll") for (int n = 0; n < 2; ++n) { \
        if constexpr (FP8) { asm volatile("v_mfma_scale_f32_16x16x128_f8f6f4 %0, %1, %2, %0, %3, %3 op_sel_hi:[0,0,0]" : "+v"(acc[ai][bj][m][n]) : "v"(Bt##8[n]), "v"(At##8[m]), "v"(one8)); } \
        else { _Pragma("unroll") for (int k = 0; k < 2; ++k) acc[ai][bj][m][n] = __builtin_amdgcn_mfma_f32_16x16x32_bf16(__builtin_bit_cast(bf16x8, Bt[n][k]), __builtin_bit_cast(bf16x8, At[m][k]), acc[ai][bj][m][n], 0, 0, 0); } } \
        __builtin_amdgcn_s_setprio(0); } while (0)
#define PG8_WAIT_V(n) asm volatile("s_waitcnt vmcnt(" #n ")" ::: "memory")
#define PG8_WAIT_L(n) asm volatile("s_waitcnt lgkmcnt(" #n ")" ::: "memory")
#define PG8_BAR __builtin_amdgcn_s_barrier()
#define PG8_SCHED __builtin_amdgcn_sched_barrier(0)
#define PG8_ABASE(u) ((const char*)g.A + (size_t)(u).pm * tstepA + (size_t)(((u).pn >> g.a_shift) * g.a_koff) * 2)
#define PG8_BBASE(u) ((const char*)g.Bt + (size_t)(u).pn * tstepB)
    Unit cur, nxt; int ui = 0;
    if (!So.next(0, cur)) return;
    f32x4 acc[2][2][4][2];
#pragma unroll
    for (int a = 0; a < 2; ++a)
#pragma unroll
        for (int b = 0; b < 2; ++b)
#pragma unroll
            for (int m = 0; m < 4; ++m)
#pragma unroll
                for (int n = 0; n < 2; ++n) acc[a][b][m][n] = (f32x4){0.f, 0.f, 0.f, 0.f};
    v4i At[4][2], B0[2][2], B1[2][2]; v8i At8[4], B08[2], B18[2];
    const char* cA = PG8_ABASE(cur); const char* cB = PG8_BBASE(cur);
    PG8_STAGE(PG8_SB(0, 0), cB, voffB); PG8_STAGE(PG8_SB(0, 1), cB + hstepB, voffB); PG8_STAGE(PG8_SA(0, 0), cA, voffA); PG8_STAGE(PG8_SA(0, 1), cA + hstepA, voffA);
    if (wr == 1) PG8_BAR;
    PG8_WAIT_V(2); PG8_BAR;
    PG8_STAGE(PG8_SB(1, 0), cB + kstep, voffB); PG8_STAGE(PG8_SA(1, 0), cA + kstep, voffA); PG8_STAGE(PG8_SB(1, 1), cB + hstepB + kstep, voffB);
    PG8_WAIT_V(6); PG8_BAR;
    for (;;) {
        const bool has_next = So.next(ui + 1, nxt);
        const char* nA = has_next ? PG8_ABASE(nxt) : cA; const char* nB = has_next ? PG8_BBASE(nxt) : cB;
        for (int t = 0; t < nt; t += 2) {
            const bool last = (t == nt - 2);
            const char* a1 = cA + (size_t)(t + 1) * kstep;
            const char* a2 = last ? nA : cA + (size_t)(t + 2) * kstep; const char* b2 = last ? nB : cB + (size_t)(t + 2) * kstep;
            const char* a3 = a2 + kstep; const char* b3 = b2 + kstep;
            PG8_LDB(B0, 0, 0); PG8_LDB(B1, 0, 1); PG8_SCHED; PG8_LDA(At, 0, 0); PG8_STAGE(PG8_SA(1, 1), a1 + hstepA, voffA);
            PG8_WAIT_V(8); PG8_WAIT_L(0); PG8_BAR; PG8_MMA(0, 0, At, B0); PG8_MMA(0, 1, At, B1); PG8_BAR; PG8_SCHED;
            PG8_LDA(At, 0, 1); PG8_STAGE(PG8_SB(0, 0), b2, voffB); PG8_STAGE(PG8_SB(0, 1), b2 + hstepB, voffB); PG8_STAGE(PG8_SA(0, 0), a2, voffA);
            PG8_WAIT_V(8); PG8_WAIT_L(0); PG8_BAR; PG8_MMA(1, 0, At, B0); PG8_MMA(1, 1, At, B1); PG8_BAR; PG8_SCHED;
            PG8_LDB(B0, 1, 0); PG8_LDB(B1, 1, 1); PG8_SCHED; PG8_LDA(At, 1, 0); PG8_STAGE(PG8_SA(0, 1), a2 + hstepA, voffA);
            PG8_WAIT_V(8); PG8_WAIT_L(0); PG8_BAR; PG8_MMA(0, 0, At, B0); PG8_MMA(0, 1, At, B1); PG8_BAR; PG8_SCHED;
            PG8_LDA(At, 1, 1); PG8_STAGE(PG8_SB(1, 0), b3, voffB); PG8_STAGE(PG8_SB(1, 1), b3 + hstepB, voffB); PG8_STAGE(PG8_SA(1, 0), a3, voffA);
            PG8_WAIT_V(8); PG8_WAIT_L(0); PG8_BAR; PG8_MMA(1, 0, At, B0); PG8_MMA(1, 1, At, B1); PG8_BAR; PG8_SCHED;
        }
        if (wr == 0) PG8_BAR;
        if constexpr (FP8) asm volatile("s_nop 15\n\ts_nop 15" ::: "memory");
        if constexpr (LN) E.run(acc, cur, wr, wc, fr, fq, lds, wid, lane); else E(acc, cur, wr, wc, fr, fq);
        if (!has_next) break;
#pragma unroll
        for (int a = 0; a < 2; ++a)
#pragma unroll
            for (int b = 0; b < 2; ++b)
#pragma unroll
                for (int m = 0; m < 4; ++m)
#pragma unroll
                    for (int n = 0; n < 2; ++n) acc[a][b][m][n] = (f32x4){0.f, 0.f, 0.f, 0.f};
        cur = nxt; cA = nA; cB = nB; ++ui;
        if (wr == 1) PG8_BAR;
    }
    PG8_WAIT_V(0);
    PG8_BAR;
#undef PG8_SA
#undef PG8_SB
#undef PG8_STAGE
#undef PG8_LDA
#undef PG8_LDB
#undef PG8_MMA
#undef PG8_WAIT_V
#undef PG8_WAIT_L
#undef PG8_BAR
#undef PG8_SCHED
#undef PG8_ABASE
#undef PG8_BBASE
}
}

#define XB_TMO      128
#define XB_XCNT(j)  (256  + 64 * (j))
#define XB_XSUB(j)  (1280 + 64 * (j))
#define XB_XGEN(j)  (2304 + 64 * (j))
#define XB_TOP      3328
#define XB_TOPGEN   3392
#define XCD_BAR_WORDS 3456
#define XB_SPIN_CAP (1u << 22)
DI unsigned xb_ld(unsigned* p)              { return __hip_atomic_load(p, __ATOMIC_RELAXED, __HIP_MEMORY_SCOPE_AGENT); }
DI unsigned xb_add(unsigned* p, unsigned v) { return __hip_atomic_fetch_add(p, v, __ATOMIC_RELAXED, __HIP_MEMORY_SCOPE_AGENT); }
DI unsigned xb_xcc_id() { return (unsigned)__builtin_amdgcn_s_getreg((3 << 11) | 20) & 0xFu; }
#define XB_SPIN(cond, bar) do { unsigned _sp = 0; while (cond) { __builtin_amdgcn_s_sleep(1); \
    if ((++_sp & 255u) == 0u) { if (xb_ld(&(bar)[XB_TMO])) break; if (_sp > XB_SPIN_CAP) { atomicAdd(&(bar)[XB_TMO], 1u); break; } } } } while (0)
struct XcdBarrier { unsigned* bar; unsigned x; volatile LAS unsigned* st; int w0; };
DI XcdBarrier xcd_barrier_post(unsigned* bar, volatile LAS unsigned* st) {
    XcdBarrier b; b.bar = bar; b.x = xb_xcc_id(); b.st = st; b.w0 = __builtin_amdgcn_readfirstlane((int)threadIdx.x >> 6);
    if (threadIdx.x == 0) (void)xb_add(&bar[XB_XCNT(b.x)], 1u);
    return b;
}
DI void xcd_barrier_complete(unsigned* bar, unsigned x, unsigned& nloc, unsigned& nx) {
    const unsigned G = gridDim.x * gridDim.y * gridDim.z;
    unsigned sum, cnt, mine, sp = 0u;
    for (;;) {
        sum = 0u; cnt = 0u; mine = 0u;
#pragma unroll
        for (unsigned j = 0; j < 16; ++j) { const unsigned c = xb_ld(&bar[XB_XCNT(j)]); sum += c; cnt += (c > 0u) ? 1u : 0u; mine = (j == x) ? c : mine; }
        if (sum == G) break;
        __builtin_amdgcn_s_sleep(1);
        if ((++sp & 255u) == 0u) { if (xb_ld(&bar[XB_TMO])) break; if (sp > XB_SPIN_CAP) { atomicAdd(&bar[XB_TMO], 1u); break; } }
    }
    nloc = mine > 0u ? mine : 1u; nx = cnt > 0u ? cnt : 1u;
}
DI void xcd_barrier(const XcdBarrier& b) {
    asm volatile("s_waitcnt vmcnt(0)" ::: "memory");
    __syncthreads();
    if (b.w0 == 0 && lane_id() == 0) {
        unsigned* bar = b.bar;
        __builtin_amdgcn_s_waitcnt(0);
        unsigned nloc = b.st[0], nx = b.st[1];
        if (nloc == 0u) { xcd_barrier_complete(bar, b.x, nloc, nx); b.st[0] = nloc; b.st[1] = nx; }
        const unsigned old = xb_add(&bar[XB_XSUB(b.x)], 1u);
        const unsigned gen = old / nloc;
        if (old + 1u == (gen + 1u) * nloc) {
            __builtin_amdgcn_fence(__ATOMIC_RELEASE, "agent");
            asm volatile("s_waitcnt vmcnt(0)" ::: "memory");
            const unsigned og = xb_add(&bar[XB_TOP], 1u);
            const unsigned tg = og / nx;
            if (og + 1u == (tg + 1u) * nx) xb_add(&bar[XB_TOPGEN], 1u);
            else XB_SPIN(xb_ld(&bar[XB_TOPGEN]) == tg, bar);
            __builtin_amdgcn_fence(__ATOMIC_ACQUIRE, "agent");
            xb_add(&bar[XB_XGEN(b.x)], 1u);
            asm volatile("s_waitcnt vmcnt(0)" ::: "memory");
        } else {
            XB_SPIN(xb_ld(&bar[XB_XGEN(b.x)]) == gen, bar);
            __builtin_amdgcn_fence(__ATOMIC_ACQUIRE, "agent");
            asm volatile("s_waitcnt vmcnt(0)" ::: "memory");
        }
    }
    __syncthreads();
}

struct Args { const float* in[19]; float* out; unsigned char* ws; int ph_lo, ph_hi; };
struct Frame {
    LAS unsigned char* lds; unsigned char* ws; gu32* ctl;
    int tid, lane, wave, bx, G;
};
DI Frame make_frame(unsigned char* ws_in, LAS unsigned char* lds_in, int w0) {
    Frame F; GAS unsigned char* w = (GAS unsigned char*)ws_in; asm volatile("" : "+s"(w)); int t = w0 * 64 + lane_id(); asm volatile("" : "+v"(t));
    F.lds = lds_in; F.ws = (unsigned char*)w; F.ctl = (gu32*)(w + WS_CTL);
    F.tid = t; F.lane = t & 63; F.wave = __builtin_amdgcn_readfirstlane(t >> 6); F.bx = blockIdx.x; F.G = gridDim.x;
    return F;
}

template <int MAP> DI int conv_rowmap(int n) {
    if (MAP == 1) return n < 2384 ? n : n + 176;
    if (MAP == 2) { const int isu = n >= DFF ? 1 : 0, j = n - isu * DFF; return 256 * (j >> 7) + 128 * isu + (j & 127); }
    return n;
}
template <int MAP> DI void conv_item(const float* W, int N, bf16* WT, int ldd, LAS float* scr, int kb, int nb, int lane) {
    const int k0 = 64 * kb, n0 = 32 * nb;
    const bool nok = n0 + (lane & 31) < N;
    { float v[32]; const float* wp = W + (size_t)(k0 + (lane >> 5)) * N + n0 + (lane & 31);
#pragma unroll
      for (int i = 0; i < 32; ++i) v[i] = nok ? wp[(size_t)(2 * i) * N] : 0.f;
#pragma unroll
      for (int i = 0; i < 32; ++i) scr[(2 * i + (lane >> 5)) * 33 + (lane & 31)] = v[i]; }
    asm volatile("s_waitcnt lgkmcnt(0)" ::: "memory");
    const int c = lane & 7;
#pragma unroll
    for (int j = 0; j < 4; ++j) { const int n = (lane >> 3) + 8 * j; const LAS float* s = scr + (8 * c) * 33 + n;
        u32x4 o; o.x = pk2(s[0 * 33], s[1 * 33]); o.y = pk2(s[2 * 33], s[3 * 33]); o.z = pk2(s[4 * 33], s[5 * 33]); o.w = pk2(s[6 * 33], s[7 * 33]);
        if (n0 + n < N) *(u32x4*)(WT + (size_t)conv_rowmap<MAP>(n0 + n) * ldd + k0 + 8 * c) = o; }
    asm volatile("s_waitcnt lgkmcnt(0)" ::: "memory");
}
template <int MAP> DI void conv_item8(const float* W, int N, unsigned char* WT, int ldd, LAS float* scr, int kb, int nb, int lane, float scale) {
    const int k0 = 64 * kb, n0 = 32 * nb;
    const bool nok = n0 + (lane & 31) < N;
    { float v[32]; const float* wp = W + (size_t)(k0 + (lane >> 5)) * N + n0 + (lane & 31);
#pragma unroll
      for (int i = 0; i < 32; ++i) v[i] = nok ? wp[(size_t)(2 * i) * N] : 0.f;
#pragma unroll
      for (int i = 0; i < 32; ++i) scr[(2 * i + (lane >> 5)) * 33 + (lane & 31)] = v[i]; }
    asm volatile("s_waitcnt lgkmcnt(0)" ::: "memory");
    const int c = lane & 3;
#pragma unroll
    for (int j = 0; j < 2; ++j) { const int n = (lane >> 2) + 16 * j; const LAS float* s = scr + (16 * c) * 33 + n;
        u32x4 o; o.x = pk4_fp8(s[0 * 33] * scale, s[1 * 33] * scale, s[2 * 33] * scale, s[3 * 33] * scale); o.y = pk4_fp8(s[4 * 33] * scale, s[5 * 33] * scale, s[6 * 33] * scale, s[7 * 33] * scale);
        o.z = pk4_fp8(s[8 * 33] * scale, s[9 * 33] * scale, s[10 * 33] * scale, s[11 * 33] * scale); o.w = pk4_fp8(s[12 * 33] * scale, s[13 * 33] * scale, s[14 * 33] * scale, s[15 * 33] * scale);
        if (n0 + n < N) *(u32x4*)(WT + (size_t)conv_rowmap<MAP>(n0 + n) * ldd + k0 + 16 * c) = o; }
    asm volatile("s_waitcnt lgkmcnt(0)" ::: "memory");
}
DI int win_rowmap(int c) {
    if (c < 1024) return -1 - c;
    if (c < 1280) return -1 - c;
    if (c < 2304) return c - 1280;
    if (c < 2384) return c - 2304 + 1024;
    if (c < 3408) return c - 2384 + 1280;
    if (c < 4432) return c - 3408 + 2304;
    if (c < 5456) return -1 - (c - 4432 + 1280);
    if (c < 7504) return -1 - (c - 5456 + 2304);
    return -1 - (c - 7504 + 4352);
}
DI void conv_item_win(const float* W, bf16* WTb, unsigned char* WT8, LAS float* scr, int kb, int nb, int lane) {
    const int N = INW, k0 = 64 * kb, n0 = 32 * nb;
    const bool nok = n0 + (lane & 31) < N;
    { float v[32]; const float* wp = W + (size_t)(k0 + (lane >> 5)) * N + n0 + (lane & 31);
#pragma unroll
      for (int i = 0; i < 32; ++i) v[i] = nok ? wp[(size_t)(2 * i) * N] : 0.f;
#pragma unroll
      for (int i = 0; i < 32; ++i) scr[(2 * i + (lane >> 5)) * 33 + (lane & 31)] = v[i]; }
    asm volatile("s_waitcnt lgkmcnt(0)" ::: "memory");
    const int last = n0 + 31 < N ? n0 + 31 : N - 1;
    if (win_rowmap(n0) >= 0 || win_rowmap(last) >= 0) {
        const int c = lane & 7;
#pragma unroll
        for (int j = 0; j < 4; ++j) { const int n = (lane >> 3) + 8 * j; const LAS float* s = scr + (8 * c) * 33 + n; const int rm = n0 + n < N ? win_rowmap(n0 + n) : -1;
            u32x4 o; o.x = pk2(s[0 * 33], s[1 * 33]); o.y = pk2(s[2 * 33], s[3 * 33]); o.z = pk2(s[4 * 33], s[5 * 33]); o.w = pk2(s[6 * 33], s[7 * 33]);
            if (rm >= 0) *(u32x4*)(WTb + (size_t)rm * D + k0 + 8 * c) = o; }
    }
    if (win_rowmap(n0) < 0 || win_rowmap(last) < 0) {
        const int c = lane & 3;
#pragma unroll
        for (int j = 0; j < 2; ++j) { const int n = (lane >> 2) + 16 * j; const LAS float* s = scr + (16 * c) * 33 + n; const int rm = n0 + n < N ? win_rowmap(n0 + n) : 0;
            u32x4 o; o.x = pk4_fp8(s[0 * 33] * F8_SWI, s[1 * 33] * F8_SWI, s[2 * 33] * F8_SWI, s[3 * 33] * F8_SWI); o.y = pk4_fp8(s[4 * 33] * F8_SWI, s[5 * 33] * F8_SWI, s[6 * 33] * F8_SWI, s[7 * 33] * F8_SWI);
            o.z = pk4_fp8(s[8 * 33] * F8_SWI, s[9 * 33] * F8_SWI, s[10 * 33] * F8_SWI, s[11 * 33] * F8_SWI); o.w = pk4_fp8(s[12 * 33] * F8_SWI, s[13 * 33] * F8_SWI, s[14 * 33] * F8_SWI, s[15 * 33] * F8_SWI);
            if (rm < 0) *(u32x4*)(WT8 + (size_t)(-1 - rm) * D + k0 + 16 * c) = o; }
    }
    asm volatile("s_waitcnt lgkmcnt(0)" ::: "memory");
}
DI void zero_rows(bf16* p, int rows, int cols, int ld, int gt, int ngt) {
    const int cpr = cols / 8; const u32x4 z = {0u, 0u, 0u, 0u};
    for (int i = gt; i < rows * cpr; i += ngt) *(u32x4*)(p + (size_t)(i / cpr) * ld + (i % cpr) * 8) = z;
}
DI void conv_phase(const Frame& F, const Args& a, int l) {
    LAS float* scr = (LAS float*)(F.lds + F.wave * 16384);
    const int gw = F.bx * NWAVES + F.wave, NGW = F.G * NWAVES, lane = F.lane;
    unsigned char* ws = F.ws;
    const float* w_in = a.in[2] + (size_t)l * D * INW; const float* w_uk = a.in[7] + (size_t)l * NH * HD * CKV; const float* w_uv = a.in[8] + (size_t)l * NH * CKV * HD;
    const float* w_oa = a.in[9] + (size_t)l * 1024 * D; const float* w_ob = a.in[10] + (size_t)l * 1024 * D; const float* w_out = a.in[11] + (size_t)l * D * D;
    const float* w_qm = a.in[12] + (size_t)l * D * 512; const float* w_om = a.in[14] + (size_t)l * 512 * D;
    const float* w_f1 = a.in[15] + (size_t)l * D * 2 * DFF; const float* w_f2 = a.in[16] + (size_t)l * DFF * D;
    constexpr int NB_IN = (INW + 31) / 32;
    constexpr int I_IN = 32 * NB_IN, I_UK = 8 * 2 * 8, I_UV = 8 * 4 * 4, I_OA = 16 * 64, I_OUT = 32 * 64, I_QM = 32 * 16, I_OM = 8 * 64, I_F1 = 32 * 352, I_F2 = 88 * 64, I_KV = 4 * 32 * 32;
    const int total = I_IN + I_UK + I_UV + 2 * I_OA + I_OUT + I_QM + I_OM + I_F1 + I_F2 + (l == 0 ? I_KV : 0);
    for (int it = gw; it < total; it += NGW) {
        int r = it;
        if (r < I_IN) { conv_item_win(w_in, (bf16*)(ws + WS_WIN), ws + WS_WIN8, scr, r / NB_IN, r % NB_IN, lane); continue; } r -= I_IN;
        if (r < I_UK) { const int h = r >> 4, q = r & 15; conv_item<0>(w_uk + (size_t)h * HD * CKV, CKV, (bf16*)(ws + WS_WUK) + (size_t)(h * 256) * 256 + (h & 1) * 128, 256, scr, q >> 3, q & 7, lane); continue; } r -= I_UK;
        if (r < I_UV) { const int h = r >> 4, q = r & 15; conv_item<0>(w_uv + (size_t)h * CKV * HD, HD, (bf16*)(ws + WS_WUV) + (size_t)(h * 128) * 512 + (h & 1) * 256, 512, scr, q >> 2, q & 3, lane); continue; } r -= I_UV;
        if (r < I_OA) { conv_item8<0>(w_oa, D, ws + WS_WOA, 1024, scr, r >> 6, r & 63, lane, F8_SWO); continue; } r -= I_OA;
        if (r < I_OA) { conv_item8<0>(w_ob, D, ws + WS_WOB, 1024, scr, r >> 6, r & 63, lane, F8_SWO); continue; } r -= I_OA;
        if (r < I_OUT) { conv_item8<0>(w_out, D, ws + WS_WOUT, D, scr, r >> 6, r & 63, lane, F8_SWOUT); continue; } r -= I_OUT;
        if (r < I_QM) { conv_item8<0>(w_qm, 512, ws + WS_WQM, D, scr, r >> 4, r & 15, lane, F8_SWQM); continue; } r -= I_QM;
        if (r < I_OM) { conv_item8<0>(w_om, D, ws + WS_WOM, 512, scr, r >> 6, r & 63, lane, F8_SWOM); continue; } r -= I_OM;
        if (r < I_F1) { conv_item8<2>(w_f1, 2 * DFF, ws + WS_WF1, D, scr, r / 352, r % 352, lane, F8_SW1); continue; } r -= I_F1;
        if (r < I_F2) { conv_item8<0>(w_f2, D, ws + WS_WF2, DFF, scr, r >> 6, r & 63, lane, F8_SW2); continue; } r -= I_F2;
        { const int ll = r >> 10, q = r & 1023; conv_item<0>(a.in[13] + (size_t)ll * D * 1024, 1024, (bf16*)(ws + WS_WKV) + (size_t)ll * 1024 * D, D, scr, q >> 5, q & 31, lane); }
    }
    const int gt = F.bx * NTHREADS + F.tid, ngt = F.G * NTHREADS;
    zero_rows((bf16*)(ws + WS_WIN) + (size_t)1104 * D, 176, D, D, gt, ngt);
    for (int h = 0; h < NH; ++h) {
        zero_rows((bf16*)(ws + WS_WUK) + (size_t)(h * 256) * 256 + ((h + 1) & 1) * 128, 256, 128, 256, gt, ngt);
        zero_rows((bf16*)(ws + WS_WUV) + (size_t)(h * 128) * 512 + ((h + 1) & 1) * 256, 128, 256, 512, gt, ngt);
    }
    if (l == 0) {
        const f32x4* xs = (const f32x4*)a.in[0]; f32x4* xo = (f32x4*)a.out; u32x2* xb = (u32x2*)(ws + WS_XB);
        unsigned* xb8 = (unsigned*)(ws + WS_XB8);
        for (int i = gt; i < S * D / 4; i += ngt) { const f32x4 v = xs[i]; xo[i] = v; u32x2 w; w.x = pk2(v[0], v[1]); w.y = pk2(v[2], v[3]); xb[i] = w; xb8[i] = pk4_fp8(v[0], v[1], v[2], v[3]); }
        const f32x4* ms = (const f32x4*)a.in[1]; u32x2* mb = (u32x2*)(ws + WS_MEMB);
        for (int i = gt; i < NMEM * D / 4; i += ngt) { const f32x4 v = ms[i]; u32x2 w; w.x = pk2(v[0], v[1]); w.y = pk2(v[2], v[3]); mb[i] = w; }
    }
}

DI void norm_phase(const Frame& F, const Args& a, int l) {
    const int gw = F.bx * NWAVES + F.wave, NGW = F.G * NWAVES, lane = F.lane;
    const float* ckv = (const float*)(F.ws + WS_CKVRAW); const float* kw = (const float*)(F.ws + WS_KWRAW);
    const float* kvg = a.in[4] + l * CKV; const float* ig = a.in[5] + l * IDIM; const float* ib = a.in[6] + l * IDIM;
    const f32x4 g4 = *(const f32x4*)(kvg + 4 * lane); const float gi = ig[lane], bi = ib[lane];
    for (int t = gw; t < S; t += NGW) {
        const f32x4 v = *(const f32x4*)(ckv + (size_t)t * 256 + 4 * lane);
        const float ss = wave_sum(v[0] * v[0] + v[1] * v[1] + v[2] * v[2] + v[3] * v[3]);
        const float r = 1.0f / sqrtf(ss * (1.0f / CKV) + LN_EPS);
        *(unsigned*)(F.ws + WS_CKVN + (size_t)t * 256 + 4 * lane) = pk4_fp8(v[0] * r * g4[0], v[1] * r * g4[1], v[2] * r * g4[2], v[3] * r * g4[3]);
        const float k = kw[(size_t)t * 256 + lane];
        const float mu = wave_sum(k) * (1.0f / IDIM); const float d = k - mu; const float var = wave_sum(d * d) * (1.0f / IDIM);
        const float kn = d * (1.0f / sqrtf(var + LN_EPS)) * gi + bi;
        ((bf16*)(F.ws + WS_KIDXN))[(size_t)t * 64 + lane] = (bf16)f2bf(kn);
        if (lane < IH) ((float*)(F.ws + WS_WIDX))[(size_t)t * IH + lane] = kw[(size_t)t * 256 + 64 + lane];
    }
    const bf16* km = (const bf16*)(F.ws + WS_KM);
    for (int u = gw; u < NH * NBLK; u += NGW) {
        const int h = u >> 6, b = u & 63; float s[8] = {0.f, 0.f, 0.f, 0.f, 0.f, 0.f, 0.f, 0.f};
        const u32x4* p = (const u32x4*)(km + (size_t)(b * MBLK + (lane >> 4)) * 1024 + h * HD + 8 * (lane & 15));
#pragma unroll 16
        for (int i = 0; i < MBLK / 4; ++i) { const u32x4 v = p[(size_t)i * (4 * 1024 / 8)];
            s[0] += bflo(v.x); s[1] += bfhi(v.x); s[2] += bflo(v.y); s[3] += bfhi(v.y); s[4] += bflo(v.z); s[5] += bfhi(v.z); s[6] += bflo(v.w); s[7] += bfhi(v.w); }
#pragma unroll
        for (int e = 0; e < 8; ++e) { s[e] += __shfl_xor(s[e], 16); s[e] += __shfl_xor(s[e], 32); }
        if (lane < 16) { float* o = (float*)(F.ws + WS_KMEAN) + (size_t)(h * NBLK + b) * HD + 8 * lane;
            *(f32x4*)o = (f32x4){s[0], s[1], s[2], s[3]} * (1.0f / MBLK); *(f32x4*)(o + 4) = (f32x4){s[4], s[5], s[6], s[7]} * (1.0f / MBLK); }
    }
}

DI void moba_gate_phase(const Frame& F, int l) {
    LAS float* km = (LAS float*)F.lds; LAS unsigned* lcnt = (LAS unsigned*)(F.lds + 32768); LAS unsigned* gbase = lcnt + 64;
    const bf16* qm = (const bf16*)(F.ws + WS_QM); const float* kmean = (const float*)(F.ws + WS_KMEAN);
    unsigned* bcnt = (unsigned*)(F.ctl + CW_BCNT) + l * 512; unsigned* buck = (unsigned*)(F.ws + WS_BUCK);
    for (int u = F.bx; u < NH * 32; u += F.G) {
        const int h = u & 7, tg = u >> 3; const int t = tg * 512 + F.tid, own = t >> 8;
        __syncthreads();
        for (int i = F.tid; i < NBLK * HD / 4; i += NTHREADS) ((LAS f32x4*)km)[i] = ((const f32x4*)(kmean + (size_t)h * NBLK * HD))[i];
        if (F.tid < 64) lcnt[F.tid] = 0u;
        __syncthreads();
        float q[HD];
        { const u32x4* qp = (const u32x4*)(qm + (size_t)t * 1024 + h * HD);
#pragma unroll
          for (int c = 0; c < 16; ++c) { const u32x4 qv = qp[c]; q[8 * c + 0] = bflo(qv.x); q[8 * c + 1] = bfhi(qv.x); q[8 * c + 2] = bflo(qv.y); q[8 * c + 3] = bfhi(qv.y);
              q[8 * c + 4] = bflo(qv.z); q[8 * c + 5] = bfhi(qv.z); q[8 * c + 6] = bflo(qv.w); q[8 * c + 7] = bfhi(qv.w); } }
        const float NEG = -__builtin_inff(); float v0 = NEG, v1 = NEG, v2 = NEG; int i0 = -1, i1 = -1, i2 = -1;
        const int bmax = 2 * tg + 1;
        for (int b = 0; b < bmax; ++b) {
            const LAS f32x4* kr = (const LAS f32x4*)(km + b * HD);
            float d0 = 0.f, d1 = 0.f, d2 = 0.f, d3 = 0.f;
#pragma unroll
            for (int c = 0; c < 32; ++c) { const f32x4 k = kr[c]; d0 += q[4 * c] * k[0]; d1 += q[4 * c + 1] * k[1]; d2 += q[4 * c + 2] * k[2]; d3 += q[4 * c + 3] * k[3]; }
            const float g = (d0 + d1) + (d2 + d3);
            if (b < own) { if (g > v0) { v2 = v1; i2 = i1; v1 = v0; i1 = i0; v0 = g; i0 = b; } else if (g > v1) { v2 = v1; i2 = i1; v1 = g; i1 = b; } else if (g > v2) { v2 = g; i2 = b; } }
        }
        unsigned lp0 = 0, lp1 = 0, lp2 = 0;
        if (i0 >= 0) lp0 = atomicAdd((unsigned*)&lcnt[i0], 1u);
        if (i1 >= 0) lp1 = atomicAdd((unsigned*)&lcnt[i1], 1u);
        if (i2 >= 0) lp2 = atomicAdd((unsigned*)&lcnt[i2], 1u);
        __syncthreads();
        if (F.tid < 64) { const unsigned c = lcnt[F.tid]; gbase[F.tid] = c ? __hip_atomic_fetch_add(bcnt + h * 64 + F.tid, c, RLX_AGENT) : 0u; }
        __syncthreads();
        unsigned* bh = buck + (size_t)h * BUCK_PER_HEAD;
        if (i0 >= 0) bh[bucket_off(i0) + gbase[i0] + lp0] = ((unsigned)t << 2) | 0u;
        if (i1 >= 0) bh[bucket_off(i1) + gbase[i1] + lp1] = ((unsigned)t << 2) | 1u;
        if (i2 >= 0) bh[bucket_off(i2) + gbase[i2] + lp2] = ((unsigned)t << 2) | 2u;
    }
    __syncthreads();
}

constexpr int IX_KSTRIDE = 144, IX_KBUF = 128 * IX_KSTRIDE;
constexpr int IX_WSTRIDE = 2048 + 64;
constexpr int IX_CSC = 2 * IX_KBUF;
constexpr int IX_CIX = IX_CSC + 8 * IX_WSTRIDE * 4;
static_assert(IX_CIX + 8 * IX_WSTRIDE * 2 <= MISC_OFF, "indexer LDS");
DI unsigned sortable(float f) { const unsigned u = __float_as_uint(f); return (u >> 31) ? ~u : (u | 0x80000000u); }
DI float unsortable(unsigned k) { return __uint_as_float((k >> 31) ? (k ^ 0x80000000u) : ~k); }
DI unsigned popc64(unsigned long long m) { return (unsigned)__builtin_popcountll(m); }
DI unsigned mbcnt64(unsigned long long m) { return __builtin_amdgcn_mbcnt_hi((unsigned)(m >> 32), __builtin_amdgcn_mbcnt_lo((unsigned)m, 0u)); }
template <int APPROX> DI float ix_compact(LAS float* sc, LAS unsigned short* ix, int& n, int lane) {
    unsigned key[16]; unsigned short idv[16];
    const bool big = n > 512;
    unsigned kmax = 0u, kmin = 0xFFFFFFFFu;
#pragma unroll
    for (int j = 0; j < 16; ++j) { const int e = j * 64 + lane; key[j] = 0u; idv[j] = 0;
        if (j < 8 || big) { const bool v = e < n; key[j] = v ? sortable(sc[e]) : 0u; idv[j] = ix[e]; kmax = key[j] > kmax ? key[j] : kmax; const unsigned km = v ? key[j] : 0xFFFFFFFFu; kmin = km < kmin ? km : kmin; } }
#pragma unroll
    for (int o = 1; o < 64; o <<= 1) { const unsigned a = (unsigned)__shfl_xor((int)kmax, o), c = (unsigned)__shfl_xor((int)kmin, o); kmax = a > kmax ? a : kmax; kmin = c < kmin ? c : kmin; }
    const unsigned diff = (unsigned)__builtin_amdgcn_readfirstlane((int)(kmax ^ kmin));
    const int nb = diff ? 32 - __builtin_clz(diff) : 0;
    unsigned cur = (unsigned)__builtin_amdgcn_readfirstlane((int)kmax); cur = nb >= 32 ? 0u : (cur >> nb) << nb;
    unsigned ccur = (unsigned)n;
    for (int b = nb - 1; b >= 0; --b) {
        const unsigned trial = cur | (1u << b); unsigned c = 0;
#pragma unroll
        for (int j = 0; j < 8; ++j) c += popc64(__ballot(key[j] >= trial));
        if (big) {
#pragma unroll
            for (int j = 8; j < 16; ++j) c += popc64(__ballot(key[j] >= trial)); }
        if (c >= (unsigned)TOPK) { cur = trial; ccur = c; if (APPROX && c <= 320u) break; }
    }
    unsigned need_eq = 0x7fffffffu;
    if (!APPROX) { unsigned ngt = 0;
#pragma unroll
        for (int j = 0; j < 16; ++j) ngt += popc64(__ballot(key[j] > cur));
        need_eq = (unsigned)TOPK - ngt; }
    unsigned out = 0, eqseen = 0;
#pragma unroll
    for (int j = 0; j < 16; ++j) {
        if (j < 8 || big) {
            const bool valid = (j * 64 + lane) < n; const bool gt = key[j] > cur, eq = valid && key[j] == cur;
            const unsigned long long em = __ballot(eq); const bool keep = (valid && gt) || (eq && (eqseen + mbcnt64(em)) < need_eq);
            const unsigned long long kmk = __ballot(keep); const unsigned pos = out + mbcnt64(kmk);
            if (keep) { sc[pos] = unsortable(key[j]); ix[pos] = idv[j]; }
            out += popc64(kmk); eqseen += popc64(em);
        }
    }
    n = (int)out; (void)ccur;
    return unsortable(cur);
}
DI float relu_nc(float x) { const int b = __float_as_int(x); return __int_as_float(b > 0 ? b : 0); }
#define IX_SCORE(ACC, KEY0, S_) do { \
    f32x2 s0_ = {0.f, 0.f}, s1_ = {0.f, 0.f}; \
    _Pragma("unroll") for (int i_ = 0; i_ < 4; ++i_) { const f32x2 r0_ = {relu_nc(ACC[2 * i_]), relu_nc(ACC[2 * i_ + 1])}, r1_ = {relu_nc(ACC[8 + 2 * i_]), relu_nc(ACC[9 + 2 * i_])}; \
        s0_ = __builtin_elementwise_fma(r0_, wv2[i_], s0_); s1_ = __builtin_elementwise_fma(r1_, wv2[4 + i_], s1_); } \
    const auto sw_ = __builtin_amdgcn_permlane32_swap(__float_as_uint(s0_[0] + s0_[1]), __float_as_uint(s1_[0] + s1_[1]), false, false); \
    S_ = __uint_as_float(sw_[0]) + __uint_as_float(sw_[1]); \
    S_ = ((KEY0) + r) <= tq ? S_ : NEG; } while (0)
#define IX_APPEND(S_, KEY0) do { \
    const bool pass_ = S_ > thr; \
    const unsigned long long mk_ = __ballot(pass_); \
    if (IX_DRY) { dry_acc += S_; } else { \
        const unsigned mlo_ = (unsigned)mk_, mhi_ = (unsigned)(mk_ >> 32); const int nlo_ = __builtin_popcount(mlo_), nhi_ = __builtin_popcount(mhi_); \
        const unsigned base_ = hh ? (unsigned)(cnt1 - nlo_ + 1024) : (unsigned)cnt0; \
        const unsigned pos_ = __builtin_amdgcn_mbcnt_hi(mhi_, __builtin_amdgcn_mbcnt_lo(mlo_, base_)); \
        const unsigned idx_ = pass_ ? pos_ : (unsigned)(2048 + lane);            \
        csc[idx_] = S_; cix[idx_] = (unsigned short)((KEY0) + r); \
        cnt0 += nlo_; cnt1 += nhi_; \
        if ((cnt0 > cnt1 ? cnt0 : cnt1) > 1024 - 64) { \
            if (cnt0 > 1024 - 64) { const float nt_ = ix_compact<1>(csc, cix, cnt0, lane); thr = hh ? thr : nt_; } \
            if (cnt1 > 1024 - 64) { const float nt_ = ix_compact<1>(csc + 1024, cix + 1024, cnt1, lane); thr = hh ? nt_ : thr; } } \
    } } while (0)
#define IX_PROCESS(ACC, KEY0) do { float sc_; IX_SCORE(ACC, KEY0, sc_); IX_APPEND(sc_, KEY0); } while (0)
#define IX_APPEND2(SA_, KEYA, SB_, KEYB) do { \
    if (IX_DRY) { dry_acc += SA_ + SB_; } else { \
        const bool pa_ = SA_ > thr, pb_ = SB_ > thr; \
        const unsigned long long ma_ = __ballot(pa_), mb_ = __ballot(pb_); \
        const unsigned alo_ = (unsigned)ma_, ahi_ = (unsigned)(ma_ >> 32), blo_ = (unsigned)mb_, bhi_ = (unsigned)(mb_ >> 32); \
        const int nal_ = __builtin_popcount(alo_), nah_ = __builtin_popcount(ahi_), nbl_ = __builtin_popcount(blo_), nbh_ = __builtin_popcount(bhi_); \
        const unsigned basea_ = hh ? (unsigned)(cnt1 - nal_ + 1024) : (unsigned)cnt0; \
        const unsigned baseb_ = hh ? (unsigned)(cnt1 + nah_ - nbl_ + 1024) : (unsigned)(cnt0 + nal_); \
        const unsigned posa_ = __builtin_amdgcn_mbcnt_hi(ahi_, __builtin_amdgcn_mbcnt_lo(alo_, basea_)), posb_ = __builtin_amdgcn_mbcnt_hi(bhi_, __builtin_amdgcn_mbcnt_lo(blo_, baseb_)); \
        const unsigned ia_ = pa_ ? posa_ : (unsigned)(2048 + lane), ib_ = pb_ ? posb_ : (unsigned)(2048 + lane); \
        csc[ia_] = SA_; cix[ia_] = (unsigned short)((KEYA) + r); csc[ib_] = SB_; cix[ib_] = (unsigned short)((KEYB) + r); \
        cnt0 += nal_ + nbl_; cnt1 += nah_ + nbh_; \
        if ((cnt0 > cnt1 ? cnt0 : cnt1) > 1024 - 64) { \
            if (cnt0 > 1024 - 64) { const float nt_ = ix_compact<1>(csc, cix, cnt0, lane); thr = hh ? thr : nt_; } \
            if (cnt1 > 1024 - 64) { const float nt_ = ix_compact<1>(csc + 1024, cix + 1024, cnt1, lane); thr = hh ? nt_ : thr; } } \
    } } while (0)
#define IX_MMA(ACC, KB, TILE) do { \
    _Pragma("unroll") for (int i_ = 0; i_ < 16; ++i_) ACC[i_] = 0.f; \
    _Pragma("unroll") for (int kk_ = 0; kk_ < 4; ++kk_) { const bf16x8 b_ = *(const LAS bf16x8*)((KB) + boff + (TILE) * (32 * IX_KSTRIDE) + kk_ * 32); \
        ACC = __builtin_amdgcn_mfma_f32_32x32x16_bf16(af[kk_], b_, ACC, 0, 0, 0); } } while (0)
#define IX_LDB(FR, KB, TILE) do { _Pragma("unroll") for (int kk_ = 0; kk_ < 4; ++kk_) FR[kk_] = *(const LAS bf16x8*)((KB) + boff + (TILE) * (32 * IX_KSTRIDE) + kk_ * 32); } while (0)
#define IX_MMAR(ACC, FR) do { \
    _Pragma("unroll") for (int i_ = 0; i_ < 16; ++i_) ACC[i_] = 0.f; \
    _Pragma("unroll") for (int kk_ = 0; kk_ < 4; ++kk_) ACC = __builtin_amdgcn_mfma_f32_32x32x16_bf16(af[kk_], FR[kk_], ACC, 0, 0, 0); } while (0)
#define IX_MMAR_SCORE(ACCN, FR, ACCC, KEY0, S_) do { IX_MMAR(ACCN, FR); IX_SCORE(ACCC, KEY0, S_); \
    _Pragma("unroll") for (int g_ = 0; g_ < 4; ++g_) { __builtin_amdgcn_sched_group_barrier(0x008, 1, 0); __builtin_amdgcn_sched_group_barrier(0x002, 10, 0); } } while (0)
#define IX_SCHED(CH) do { if (!IX_DRY && (((CH) + 1) == 16 || ((CH) + 1) == 32 || ((CH) + 1) == 64)) { \
    if (cnt0 > 320) { const float nt_ = ix_compact<1>(csc, cix, cnt0, lane); thr = hh ? thr : nt_; } \
    if (cnt1 > 320) { const float nt_ = ix_compact<1>(csc + 1024, cix + 1024, cnt1, lane); thr = hh ? nt_ : thr; } } } while (0)
#define IX_CHUNK(KB, CH) do { \
    int nt_w = ((ta + 1 - (CH) * 128) >> 5) + 1; nt_w = nt_w < 0 ? 0 : (nt_w > 4 ? 4 : nt_w); \
    f32x16 accA, accB; \
    if (nt_w == 4) { float qa_, qb_, qc_, qd_; bf16x8 fr0[4], fr1[4], fr2[4], fr3[4]; f32x16 accC, accD;     \
        IX_LDB(fr0, KB, 0); IX_LDB(fr1, KB, 1); IX_LDB(fr2, KB, 2); IX_LDB(fr3, KB, 3); \
        IX_MMAR(accA, fr0); IX_MMAR(accB, fr1); \
        IX_MMAR(accC, fr2); IX_MMAR(accD, fr3); IX_SCORE(accA, (CH) * 128, qa_); IX_SCORE(accB, (CH) * 128 + 32, qb_); \
        IX_APPEND2(qa_, (CH) * 128, qb_, (CH) * 128 + 32); \
        IX_SCORE(accC, (CH) * 128 + 64, qc_); IX_SCORE(accD, (CH) * 128 + 96, qd_); \
        IX_APPEND2(qc_, (CH) * 128 + 64, qd_, (CH) * 128 + 96); \
    } else if (nt_w > 0) { IX_MMA(accA, KB, 0); \
        if (nt_w > 1) IX_MMA(accB, KB, 1); \
        IX_PROCESS(accA, (CH) * 128); \
        if (nt_w > 1) { if (nt_w > 2) IX_MMA(accA, KB, 2); \
            IX_PROCESS(accB, (CH) * 128 + 32); \
            if (nt_w > 2) IX_PROCESS(accA, (CH) * 128 + 64); } } } while (0)
#define IX_LDSBAR() do { asm volatile("s_waitcnt lgkmcnt(0)" ::: "memory"); __builtin_amdgcn_s_barrier(); asm volatile("" ::: "memory"); } while (0)
DI void indexer_phase(const Frame& F) {
    const int lane = F.lane, wave = F.wave, tid = F.tid, r = lane & 31, hh = lane >> 5;
    const bf16* qidx = (const bf16*)(F.ws + WS_QIDX); const bf16* kidx = (const bf16*)(F.ws + WS_KIDXN); const float* widx = (const float*)(F.ws + WS_WIDX);
    unsigned short* sel = (unsigned short*)(F.ws + WS_SEL);
    LAS float* csc = (LAS float*)(F.lds + IX_CSC) + wave * IX_WSTRIDE; LAS unsigned short* cix = (LAS unsigned short*)(F.lds + IX_CIX) + wave * IX_WSTRIDE;
    const float NEG = -__builtin_inff();
    const unsigned boff = (unsigned)(r * IX_KSTRIDE + hh * 16);
    const unsigned sg0 = (unsigned)((tid >> 3) * 64 + (tid & 7) * 8), sl0 = (unsigned)((tid >> 3) * IX_KSTRIDE + (tid & 7) * 16);
    LAS unsigned char* const kb0 = F.lds, * const kb1 = F.lds + IX_KBUF;
#define IX_LOAD(R, CHK) do { const int c_ = (CHK) < nch ? (CHK) : nch - 1; const bf16* g_ = kidx + (size_t)c_ * (128 * 64) + sg0; R[0] = *(const u32x4*)g_; R[1] = *(const u32x4*)(g_ + 64 * 64); } while (0)
#define IX_STORE(KB, R) do { *(LAS u32x4*)((KB) + sl0) = R[0]; *(LAS u32x4*)((KB) + sl0 + 64 * IX_KSTRIDE) = R[1]; } while (0)
    for (int ui = 0; ui * F.G < S / 16; ++ui) {
        const int unit = ui * F.G + ((ui & 1) ? F.G - 1 - F.bx : F.bx);
        if (unit >= S / 16) continue;
        const int t0 = unit * 16, nkeys = t0 + 16, nch = (nkeys + 127) >> 7;
        const int ta = t0 + 2 * wave;
        bf16x8 af[4];
#pragma unroll
        for (int kk = 0; kk < 4; ++kk) af[kk] = *(const bf16x8*)(qidx + (size_t)(ta + (r >> 4)) * 1024 + (r & 15) * 64 + 16 * kk + 8 * hh);
        f32x2 wv2[8];
#pragma unroll
        for (int i = 0; i < 8; ++i) { const int e0 = 2 * i, e1 = 2 * i + 1;
            wv2[i] = (f32x2){widx[(size_t)(ta + (e0 >> 3)) * IH + (e0 & 3) + 8 * ((e0 >> 2) & 1) + 4 * hh], widx[(size_t)(ta + (e1 >> 3)) * IH + (e1 & 3) + 8 * ((e1 >> 2) & 1) + 4 * hh]}; }
        float thr = NEG; int cnt0 = 0, cnt1 = 0; const int tq = ta + hh;
        float dry_acc = 0.f; (void)dry_acc;
#ifdef IX_PROBE
#define IX_DRY 1
        {
        u32x4 RA[2], RB[2];
        IX_LOAD(RA, 0); IX_LOAD(RB, 1);
        IX_STORE(kb0, RA); IX_LOAD(RA, 2);
        for (int ch = 0; ch < nch; ch += 2) {
            IX_LDSBAR();
            IX_CHUNK(kb0, ch); IX_SCHED(ch);
            IX_STORE(kb1, RB); IX_LOAD(RB, ch + 3);
            IX_LDSBAR();
            if (ch + 1 < nch) { IX_CHUNK(kb1, ch + 1); IX_SCHED(ch + 1); }
            IX_STORE(kb0, RA); IX_LOAD(RA, ch + 4);
        }
        }
        if (dry_acc == 123.456f) sel[0] = 0;
        __syncthreads();
#undef IX_DRY
#endif
#define IX_DRY 0
        {
        u32x4 RA[2], RB[2];
        IX_LOAD(RA, 0); IX_LOAD(RB, 1);
        IX_STORE(kb0, RA); IX_LOAD(RA, 2);
        for (int ch = 0; ch < nch; ch += 2) {
            IX_LDSBAR();
            IX_CHUNK(kb0, ch); IX_SCHED(ch);
            IX_STORE(kb1, RB); IX_LOAD(RB, ch + 3);
            IX_LDSBAR();
            if (ch + 1 < nch) { IX_CHUNK(kb1, ch + 1); IX_SCHED(ch + 1); }
            IX_STORE(kb0, RA); IX_LOAD(RA, ch + 4);
        }
        }
#undef IX_DRY
        if (cnt0 > TOPK) (void)ix_compact<0>(csc, cix, cnt0, lane);
        if (cnt1 > TOPK) (void)ix_compact<0>(csc + 1024, cix + 1024, cnt1, lane);
#pragma unroll
        for (int q = 0; q < 2; ++q) { const int n = q ? cnt1 : cnt0;
#pragma unroll
            for (int j = 0; j < 4; ++j) { const int e = j * 64 + lane; sel[(size_t)(ta + q) * TOPK + e] = e < n ? cix[q * 1024 + e] : (unsigned short)0xFFFFu; } }
        __syncthreads();
    }
#undef IX_LOAD
#undef IX_STORE
}
#undef IX_PROCESS
#undef IX_SCORE
#undef IX_APPEND
#undef IX_MMAR_SCORE
#undef IX_MMAR
#undef IX_LDB
#undef IX_MMA
#undef IX_CHUNK
#undef IX_SCHED

constexpr int DA_WBYTES = 16384 + 256;
DI void dsa_attn_phase(const Frame& F) {
    const int lane = F.lane, fr = lane & 15, fq = lane >> 4;
    const bf16* qlat = (const bf16*)(F.ws + WS_QLAT); const bf16* ckv = (const bf16*)(F.ws + WS_CKVN); const unsigned short* sel = (const unsigned short*)(F.ws + WS_SEL);
    bf16* olat = (bf16*)(F.ws + WS_OLAT);
    LAS unsigned char* img = F.lds + F.wave * DA_WBYTES; LAS float* dist = (LAS float*)(img + 16384);
    const unsigned imgaddr = (unsigned)(size_t)img;
    const float slope2 = __builtin_amdgcn_exp2f(-(float)((fr & 7) + 1)) * LOG2E;
    const int gw = F.bx * NWAVES + F.wave, NGW = F.G * NWAVES;
    unsigned kb[2], vb[2];
#pragma unroll
    for (int kt = 0; kt < 2; ++kt) kb[kt] = imgaddr + off_b(perm32rows(16 * kt + fr), fq) - 64u * (unsigned)(fr & 3);
    const unsigned kx = (unsigned)(fr & 3);
#pragma unroll
    for (int tt = 0; tt < 2; ++tt) { const unsigned a0 = tr_addr16(lane, 0, 0, tt); vb[tt] = imgaddr + a0; }
    const unsigned xh = (((unsigned)(lane & 15) >> 2) << 1) | (unsigned)((lane >> 4) & 1);
#pragma unroll
    for (int tt = 0; tt < 2; ++tt) vb[tt] -= 32u * xh;
    for (int t = gw; t < S; t += NGW) {
        const int nvalid = t + 1 < TOPK ? t + 1 : TOPK;
        bf16x8 qf[8];
#pragma unroll
        for (int kk = 0; kk < 8; ++kk) { qf[kk] = (bf16x8){0, 0, 0, 0, 0, 0, 0, 0}; if (fr < 8) qf[kk] = *(const bf16x8*)(qlat + (size_t)t * 2048 + fr * 256 + 32 * kk + 8 * fq); }
        f32x4 o[16];
#pragma unroll
        for (int c = 0; c < 16; ++c) o[c] = (f32x4){0.f, 0.f, 0.f, 0.f};
        float m = -__builtin_inff(), lsum = 0.f;
        int idxn; { const int e = (lane & 31); const int si = sel[(size_t)t * TOPK + e]; idxn = e < nvalid ? si : 0; }
        const unsigned char* ckv8 = (const unsigned char*)ckv;
        u32x4 gA[8];
#pragma unroll
        for (int i = 0; i < 8; ++i) { const int row = (lane >> 4) + 4 * i; const int ki = __shfl(idxn, row); gA[i] = *(const u32x4*)(ckv8 + (size_t)ki * 256 + (lane & 15) * 16); }
        for (int ch = 0; ch < 8; ++ch) {
            unsigned xhl = xh, kxl = kx; asm volatile("" : "+v"(xhl), "+v"(kxl));
            const int myidx = idxn;
            if (ch < 7) { const int e = (ch + 1) * 32 + (lane & 31); const int si = sel[(size_t)t * TOPK + e]; idxn = e < nvalid ? si : 0; }
#pragma unroll
            for (int i = 0; i < 8; ++i) { const unsigned row = (lane >> 4) + 4 * i, p = lane & 15, prow = perm32rows(row); const u32x4 g = gA[i]; unsigned w[8];
#pragma unroll
                for (int q = 0; q < 4; ++q) { const f32x2 lo = __builtin_amdgcn_cvt_pk_f32_fp8((int)g[q], false), hi = __builtin_amdgcn_cvt_pk_f32_fp8((int)g[q], true); w[2 * q] = cvt_pk_bf16(lo[0], lo[1]); w[2 * q + 1] = cvt_pk_bf16(hi[0], hi[1]); }
                LAS unsigned char* hb = img + (p >> 3) * 8192;
                *(LAS u32x4*)(hb + off_b(prow, 2 * (p & 7))) = (u32x4){w[0], w[1], w[2], w[3]}; *(LAS u32x4*)(hb + off_b(prow, 2 * (p & 7) + 1)) = (u32x4){w[4], w[5], w[6], w[7]}; }
            if (lane < 32) { const int e = ch * 32 + lane; dist[lane] = e < nvalid ? (float)(t - myidx) : __builtin_inff(); }
            if (ch < 7) {
#pragma unroll
                for (int i = 0; i < 8; ++i) { const int row = (lane >> 4) + 4 * i; const int ki = __shfl(idxn, row); gA[i] = *(const u32x4*)(ckv8 + (size_t)ki * 256 + (lane & 15) * 16); } }
            f32x4 sacc[2];
#pragma unroll
            for (int kt = 0; kt < 2; ++kt) { sacc[kt] = (f32x4){0.f, 0.f, 0.f, 0.f};
#pragma unroll
                for (int kk = 0; kk < 8; ++kk) { const bf16x8 afr = *(const LAS bf16x8*)(kb[kt] + 64u * ((unsigned)(kk & 3) ^ kxl) + 8192u * (kk >> 2));
                    sacc[kt] = __builtin_amdgcn_mfma_f32_16x16x32_bf16(afr, qf[kk], sacc[kt], 0, 0, 0); } }
            float cmax = -__builtin_inff();
#pragma unroll
            for (int kt = 0; kt < 2; ++kt) { const f32x4 dv = *(const LAS f32x4*)(dist + 16 * kt + 4 * fq);
#pragma unroll
                for (int i = 0; i < 4; ++i) { sacc[kt][i] = sacc[kt][i] * ATT_SCALE2 - slope2 * dv[i]; cmax = fmaxf(cmax, sacc[kt][i]); } }
            cmax = xrow16_max(cmax);
            const float mn = fmaxf(m, cmax); const float alpha = __builtin_amdgcn_exp2f(m - mn); m = mn;
            float ps = 0.f;
#pragma unroll
            for (int kt = 0; kt < 2; ++kt)
#pragma unroll
                for (int i = 0; i < 4; ++i) { sacc[kt][i] = __builtin_amdgcn_exp2f(sacc[kt][i] - mn); ps += sacc[kt][i]; }
            ps = xrow16_sum(ps); lsum = lsum * alpha + ps;
            u32x4 pw; pw.x = cvt_pk_bf16(sacc[0][0], sacc[0][1]); pw.y = cvt_pk_bf16(sacc[0][2], sacc[0][3]); pw.z = cvt_pk_bf16(sacc[1][0], sacc[1][1]); pw.w = cvt_pk_bf16(sacc[1][2], sacc[1][3]);
            const bf16x8 pf = __builtin_bit_cast(bf16x8, pw);
#pragma unroll
            for (int c = 0; c < 16; ++c) {
                o[c] = o[c] * alpha;
                const unsigned cx = 32u * ((unsigned)(c & 7) ^ xhl); const s16x4 lo = vtr(vb[0] + cx + 8192u * (c >> 3)), hi = vtr(vb[1] + cx + 8192u * (c >> 3));
                const bf16x8 vfr = __builtin_shufflevector(lo, hi, 0, 1, 2, 3, 4, 5, 6, 7);
                o[c] = __builtin_amdgcn_mfma_f32_16x16x32_bf16(vfr, pf, o[c], 0, 0, 0);
                if ((c & 3) == 3) __builtin_amdgcn_sched_barrier(0);
            }
        }
        const float inv = 1.0f / lsum;
        if (fr < 8) {
#pragma unroll
            for (int c = 0; c < 16; ++c) { u32x2 w; w.x = cvt_pk_bf16(o[c][0] * inv, o[c][1] * inv); w.y = cvt_pk_bf16(o[c][2] * inv, o[c][3] * inv);
                *(u32x2*)(olat + (size_t)t * 2048 + fr * 256 + 16 * c + 4 * fq) = w; }
        }
    }
}

struct BlkAttn { const bf16* K; const bf16* V; int kvld; };
DI void blk_stage(const Frame& F, const bf16* Kp, const bf16* Vp, int kvld) {
#pragma unroll 4
    for (int i = 0; i < 8; ++i) { const int p = F.tid + 512 * i; const unsigned row = p >> 4, ch = p & 15;
        const u32x4 kv = *(const u32x4*)(Kp + (size_t)row * kvld + ch * 8); const u32x4 vv = *(const u32x4*)(Vp + (size_t)row * kvld + ch * 8);
        *(LAS u32x4*)(F.lds + off_b(row, ch)) = kv; *(LAS u32x4*)(F.lds + 65536 + off_b(perm32rows(row), ch)) = vv; }
}
DI void blk_core(const Frame& F, const bf16* qrow, int tq, int kpos0, float slope2, bool causal, f32x4 (&o)[8], float& m_out, float& l_out) {
    const int lane = F.lane, fr = lane & 15, fq = lane >> 4;
    const unsigned kimg = (unsigned)(size_t)F.lds, vimg = kimg + 65536;
    bf16x8 qf[4];
#pragma unroll
    for (int kk = 0; kk < 4; ++kk) qf[kk] = *(const bf16x8*)(qrow + 32 * kk + 8 * fq);
    unsigned kb[4];
#pragma unroll
    for (int kk = 0; kk < 4; ++kk) kb[kk] = kimg + off_b(fr, 4 * kk + fq);
    f32x4 s[16];
#pragma unroll
    for (int kt = 0; kt < 16; ++kt) { s[kt] = (f32x4){0.f, 0.f, 0.f, 0.f};
#pragma unroll
        for (int kk = 0; kk < 4; ++kk) { const bf16x8 afr = *(const LAS bf16x8*)(kb[kk] + 4096u * kt);
            s[kt] = __builtin_amdgcn_mfma_f32_16x16x32_bf16(afr, qf[kk], s[kt], 0, 0, 0); }
        if ((kt & 3) == 3) __builtin_amdgcn_sched_barrier(0); }
    float mx = -__builtin_inff();
    const float dq = (float)(tq - kpos0 - 4 * fq);
#pragma unroll
    for (int kt = 0; kt < 16; ++kt)
#pragma unroll
        for (int i = 0; i < 4; ++i) { const float dd = dq - (float)(16 * kt + i); float v = s[kt][i] * ATT_SCALE2 - slope2 * dd;
            if (causal && dd < 0.f) v = -__builtin_inff(); s[kt][i] = v; mx = fmaxf(mx, v); }
    mx = xrow16_max(mx);
    float ps = 0.f;
#pragma unroll
    for (int kt = 0; kt < 16; ++kt)
#pragma unroll
        for (int i = 0; i < 4; ++i) { s[kt][i] = __builtin_amdgcn_exp2f(s[kt][i] - mx); ps += s[kt][i]; }
    ps = xrow16_sum(ps);
    unsigned vb[8][2];
#pragma unroll
    for (int dt = 0; dt < 8; ++dt) { vb[dt][0] = vimg + tr_addr16(lane, dt, 0, 0); vb[dt][1] = vimg + tr_addr16(lane, dt, 0, 1); }
#pragma unroll
    for (int dt = 0; dt < 8; ++dt) o[dt] = (f32x4){0.f, 0.f, 0.f, 0.f};
#pragma unroll
    for (int ks = 0; ks < 8; ++ks) {
        u32x4 pw; pw.x = cvt_pk_bf16(s[2 * ks][0], s[2 * ks][1]); pw.y = cvt_pk_bf16(s[2 * ks][2], s[2 * ks][3]); pw.z = cvt_pk_bf16(s[2 * ks + 1][0], s[2 * ks + 1][1]); pw.w = cvt_pk_bf16(s[2 * ks + 1][2], s[2 * ks + 1][3]);
        const bf16x8 pf = __builtin_bit_cast(bf16x8, pw);
#pragma unroll
        for (int dt = 0; dt < 8; ++dt) { const s16x4 lo = vtr(vb[dt][0] + 8192u * ks), hi = vtr(vb[dt][1] + 8192u * ks);
            const bf16x8 vfr = __builtin_shufflevector(lo, hi, 0, 1, 2, 3, 4, 5, 6, 7);
            o[dt] = __builtin_amdgcn_mfma_f32_16x16x32_bf16(vfr, pf, o[dt], 0, 0, 0); }
        __builtin_amdgcn_sched_barrier(0);
    }
    const float inv = 1.0f / ps;
#pragma unroll
    for (int dt = 0; dt < 8; ++dt) o[dt] = o[dt] * inv;
    m_out = mx; l_out = ps;
}

DI void moba_attn_phase(const Frame& F, int l) {
    LAS int* pre = (LAS int*)(F.lds + RING_BYTES);
    LAS int* wsum = pre + 520;
    const unsigned* bcnt = (const unsigned*)(F.ctl + CW_BCNT) + l * 512; const unsigned* buck = (const unsigned*)(F.ws + WS_BUCK);
    const bf16* qm = (const bf16*)(F.ws + WS_QM); const bf16* km = (const bf16*)(F.ws + WS_KM); const bf16* vm = (const bf16*)(F.ws + WS_VM);
    bf16* parto = (bf16*)(F.ws + WS_PARTO); f32x2* partml = (f32x2*)(F.ws + WS_PARTML);
    const int tid = F.tid, lane = F.lane, fr = lane & 15, fq = lane >> 4;
    __syncthreads();
    { const int n = (int)__hip_atomic_load(bcnt + tid, RLX_AGENT); const int cntu = 2 + ((n + 127) >> 7);
      int v = cntu;
#pragma unroll
      for (int o = 1; o < 64; o <<= 1) { const int x = __shfl_up(v, o); if (lane >= o) v += x; }
      if (lane == 63) wsum[F.wave] = v;
      __syncthreads();
      int base = 0;
      for (int w = 0; w < F.wave; ++w) base += wsum[w];
      pre[tid + 1] = base + v; if (tid == 0) pre[0] = 0;
      __syncthreads(); }
    const int total = pre[512];
    const int u_lo = (int)(((long)total * F.bx) >> 8), u_hi = (int)(((long)total * (F.bx + 1)) >> 8);
    int staged = -1;
    for (int u = u_lo; u < u_hi; ++u) {
        int lo = 0, hi = 512;
        while (hi - lo > 1) { const int mid = (lo + hi) >> 1; if (pre[mid] <= u) lo = mid; else hi = mid; }
        const int hb = lo, h = hb >> 6, b = hb & 63, sub = u - pre[hb];
        if (staged != hb) { __syncthreads(); blk_stage(F, km + (size_t)(b * MBLK) * 1024 + h * HD, vm + (size_t)(b * MBLK) * 1024 + h * HD, 1024); __syncthreads(); staged = hb; }
        int tq, slot; bool valid = true, causal;
        if (sub < 2) { tq = b * MBLK + sub * 128 + F.wave * 16 + fr; slot = 3; causal = true; }
        else { const int n = (int)__hip_atomic_load(bcnt + hb, RLX_AGENT); const int e = (sub - 2) * 128 + F.wave * 16 + fr; valid = e < n;
            const unsigned ent = buck[(size_t)h * BUCK_PER_HEAD + bucket_off(b) + (valid ? e : 0)]; tq = (int)(ent >> 2); slot = (int)(ent & 3u); causal = false; }
        const float slope2 = __builtin_amdgcn_exp2f(-(float)(h + 1)) * LOG2E;
        f32x4 o[8]; float mo, lo_;
        blk_core(F, qm + (size_t)tq * 1024 + h * HD, tq, b * MBLK, slope2, causal, o, mo, lo_);
        if (valid) { const size_t pi = ((size_t)tq * NH + h) * 4 + slot;
#pragma unroll
            for (int dt = 0; dt < 8; ++dt) { u32x2 w; w.x = cvt_pk_bf16(o[dt][0], o[dt][1]); w.y = cvt_pk_bf16(o[dt][2], o[dt][3]); *(u32x2*)(parto + pi * HD + 16 * dt + 4 * fq) = w; }
            if (fq == 0) partml[pi] = (f32x2){mo, lo_}; }
    }
    __syncthreads();
}
DI void moba_combine_phase(const Frame& F) {
    const bf16* parto = (const bf16*)(F.ws + WS_PARTO); const f32x2* partml = (const f32x2*)(F.ws + WS_PARTML); bf16* ob = (bf16*)(F.ws + WS_OB);
    const int gt = F.bx * NTHREADS + F.tid, ngt = F.G * NTHREADS;
    for (int i = gt; i < S * NH * 16; i += ngt) {
        const int th = i >> 4, c = i & 15, t = th >> 3; const int own = t >> 8, nsel = own < 3 ? own : 3;
        float mj[4], lj[4]; float M = -__builtin_inff();
#pragma unroll
        for (int j = 0; j < 4; ++j) { const bool on = (j == 3) || (j < nsel); const f32x2 ml = partml[(size_t)th * 4 + j]; mj[j] = on ? ml[0] : -__builtin_inff(); lj[j] = on ? ml[1] : 0.f; M = fmaxf(M, mj[j]); }
        float r[8] = {0.f, 0.f, 0.f, 0.f, 0.f, 0.f, 0.f, 0.f}; float wsum_ = 0.f;
#pragma unroll
        for (int j = 0; j < 4; ++j) { const bool on = (j == 3) || (j < nsel);
            if (on) { const float w = lj[j] * __builtin_amdgcn_exp2f(mj[j] - M); wsum_ += w; const u32x4 v = *(const u32x4*)(parto + ((size_t)th * 4 + j) * HD + 8 * c);
                r[0] += w * bflo(v.x); r[1] += w * bfhi(v.x); r[2] += w * bflo(v.y); r[3] += w * bfhi(v.y); r[4] += w * bflo(v.z); r[5] += w * bfhi(v.z); r[6] += w * bflo(v.w); r[7] += w * bfhi(v.w); } }
        const float inv = 1.0f / wsum_;
        float sob = F8_SOB; asm volatile("" : "+v"(sob));   const float is = inv * sob; u32x2 w; w.x = pk4_fp8(r[0] * is, r[1] * is, r[2] * is, r[3] * is); w.y = pk4_fp8(r[4] * is, r[5] * is, r[6] * is, r[7] * is);
        *(u32x2*)((unsigned char*)ob + (size_t)th * HD + 8 * c) = w;
    }
}
DI void mem_attn_phase(const Frame& F, int l) {
    const bf16* qmem = (const bf16*)(F.ws + WS_QMEM); const bf16* kv = (const bf16*)(F.ws + WS_KVMEM) + (size_t)l * 1024; bf16* omem = (bf16*)(F.ws + WS_OMEM);
    const int lane = F.lane, fr = lane & 15, fq = lane >> 4;
    const int total = NHM * (S / 128);
    const int u_lo = (int)(((long)total * F.bx) >> 8), u_hi = (int)(((long)total * (F.bx + 1)) >> 8);
    int staged = -1;
    for (int u = u_lo; u < u_hi; ++u) {
        const int h = u / (S / 128), qc = u % (S / 128);
        if (staged != h) { __syncthreads(); blk_stage(F, kv + h * HD, kv + 512 + h * HD, 4096); __syncthreads(); staged = h; }
        const int tq = qc * 128 + F.wave * 16 + fr;
        f32x4 o[8]; float mo, lo_;
        blk_core(F, qmem + (size_t)tq * 512 + h * HD, 0, 0, 0.f, false, o, mo, lo_);
#pragma unroll
        for (int dt = 0; dt < 8; ++dt) *(unsigned*)((unsigned char*)omem + (size_t)tq * 512 + h * HD + 16 * dt + 4 * fq) = pk4_fp8(o[dt][0] * F8_SOM, o[dt][1] * F8_SOM, o[dt][2] * F8_SOM, o[dt][3] * F8_SOM);
    }
    __syncthreads();
}

DI void ln_phase(const Frame& F, const Args& a, int l, int which) {
    const int gw = F.bx * NWAVES + F.wave, NGW = F.G * NWAVES, lane = F.lane;
    const float* g = a.in[17] + (size_t)(l * 3 + which) * D; const float* b = a.in[18] + (size_t)(l * 3 + which) * D;
    float* x = a.out; const bf16* y = (const bf16*)(F.ws + WS_Y); bf16* xb = (bf16*)(F.ws + WS_XB);
    f32x4 xv[8]; u32x2 yv[8];
    if (gw < S) {
#pragma unroll
        for (int j = 0; j < 8; ++j) { xv[j] = ((const f32x4*)(x + (size_t)gw * D) + lane)[64 * j]; yv[j] = ((const u32x2*)(y + (size_t)gw * D) + lane)[64 * j]; } }
    for (int r = gw; r < S; r += NGW) {
        f32x4 v[8]; float s = 0.f;
#pragma unroll
        for (int j = 0; j < 8; ++j) { v[j] = (f32x4){ALPHA * xv[j][0] + bflo(yv[j].x), ALPHA * xv[j][1] + bfhi(yv[j].x), ALPHA * xv[j][2] + bflo(yv[j].y), ALPHA * xv[j][3] + bfhi(yv[j].y)}; s += (v[j][0] + v[j][1]) + (v[j][2] + v[j][3]); }
        const int rn = r + NGW;
        if (rn < S) {
#pragma unroll
            for (int j = 0; j < 8; ++j) { xv[j] = ((const f32x4*)(x + (size_t)rn * D) + lane)[64 * j]; yv[j] = ((const u32x2*)(y + (size_t)rn * D) + lane)[64 * j]; } }
        const float mean = wave_sum(s) * (1.0f / D); float s2 = 0.f;
#pragma unroll
        for (int j = 0; j < 8; ++j) { v[j] = v[j] - mean; s2 += (v[j][0] * v[j][0] + v[j][1] * v[j][1]) + (v[j][2] * v[j][2] + v[j][3] * v[j][3]); }
        const float rstd = 1.0f / sqrtf(wave_sum(s2) * (1.0f / D) + LN_EPS);
        f32x4* xr = (f32x4*)(x + (size_t)r * D) + lane; u32x2* xbr = (u32x2*)(xb + (size_t)r * D) + lane;
#pragma unroll
        for (int j = 0; j < 8; ++j) { const f32x4 g4 = ((const f32x4*)g)[lane + 64 * j], b4 = ((const f32x4*)b)[lane + 64 * j]; const f32x4 o = v[j] * rstd * g4 + b4;
            xr[64 * j] = o;
            if (which != 2) ((unsigned*)(xb) + (size_t)r * (D / 4) + lane)[64 * j] = pk4_fp8(o[0], o[1], o[2], o[3]);
            else { u32x2 w; w.x = pk2(o[0], o[1]); w.y = pk2(o[2], o[3]); xbr[64 * j] = w;
                if (which == 2) ((unsigned*)(F.ws + WS_XB8) + (size_t)r * (D / 4) + lane)[64 * j] = pk4_fp8(o[0], o[1], o[2], o[3]); } }
    }
}


#ifdef SELFCHECK
constexpr int CW_ERR = 24576;
#ifndef SELFCHECK_MASK
#define SELFCHECK_MASK 0xFFFFFFFFu
#endif
#define CHK_ON(w) (((SELFCHECK_MASK) >> (w)) & 1u)
#ifndef SELFCHECK_TOL
#define SELFCHECK_TOL 0.05f
#endif
__device__ const int CHK_TS[8] = {0, 1, 255, 256, 511, 4097, 9000, 16383};
__device__ const int CHK_BND[19] = {1023, 1024, 1279, 1280, 2303, 2304, 2367, 2368, 2383, 2384, 3407, 3408, 4431, 4432, 5455, 5456, 7503, 7504, 9551};
DI void chk_report(gu32* ctl, int which, float err) {
    if (!(err >= 0.f)) err = 1e30f;
    __hip_atomic_fetch_max((unsigned*)(ctl + CW_ERR + which), __float_as_uint(err), RLX_AGENT);
}
DI float bfr(float w) { return __uint_as_float(f2bf(w) << 16); }
DI float bf2f(bf16 v) { return __uint_as_float(((unsigned)v) << 16); }
DI float relerr(float got, float ref, float fl) { return fabsf(got - ref) / (fabsf(ref) + fl); }
DI float wdot(const bf16* a, int K, const float* W, size_t ldw, int lane) {
    float s = 0.f; for (int k = lane; k < K; k += 64) s += bf2f(a[k]) * bfr(W[(size_t)k * ldw]); return wave_sum(s);
}
DI float fp8dec(unsigned char v) { return __builtin_amdgcn_cvt_f32_fp8((int)v, 0); }
DI float f8r(float w, float scale) { return fp8dec((unsigned char)(pk4_fp8(w * scale, 0.f, 0.f, 0.f) & 0xffu)) / scale; }
DI void chk_inproj(const Frame& F, const Args& a) {
    const int gw = F.bx * NWAVES + F.wave, NGW = F.G * NWAVES, lane = F.lane; unsigned char* ws = F.ws;
    const int NC = 83;
    for (int sidx = gw; sidx < 8 * NC; sidx += NGW) {
        const int t = CHK_TS[sidx / NC], ci = sidx % NC;
        const int c = ci < 64 ? (ci * 149 + 7) % INW : CHK_BND[ci - 64];
        float ref;
        if (win_rowmap(c) >= 0) ref = wdot((const bf16*)(ws + WS_XB) + (size_t)t * D, D, a.in[2] + c, INW, lane);
        else { float s = 0.f; for (int k = lane; k < D; k += 64) s += fp8dec((ws + WS_XB8)[(size_t)t * D + k]) * f8r(a.in[2][(size_t)k * INW + c], F8_SWI); ref = wave_sum(s); }
        float got, r2 = ref, fl = 0.3f;
        if (c < 1024) got = bf2f(((const bf16*)(ws + WS_QDSA))[(size_t)t * 1024 + c]);
        else if (c < 1280) got = ((const float*)(ws + WS_CKVRAW))[(size_t)t * 256 + c - 1024];
        else if (c < 2304) got = bf2f(((const bf16*)(ws + WS_QIDX))[(size_t)t * 1024 + c - 1280]);
        else if (c < 2384) got = ((const float*)(ws + WS_KWRAW))[(size_t)t * 256 + c - 2304];
        else if (c < 3408) got = bf2f(((const bf16*)(ws + WS_QM))[(size_t)t * 1024 + c - 2384]);
        else if (c < 4432) got = bf2f(((const bf16*)(ws + WS_KM))[(size_t)t * 1024 + c - 3408]);
        else if (c < 5456) got = bf2f(((const bf16*)(ws + WS_VM))[(size_t)t * 1024 + c - 4432]);
        else if (c < 7504) { got = bf2f(((const bf16*)(ws + WS_GA))[(size_t)t * D + c - 5456]); r2 = 1.f / (1.f + expf(-(ref + a.in[3][c - 5456]))); }
        else { got = bf2f(((const bf16*)(ws + WS_GB))[(size_t)t * D + c - 7504]); r2 = 1.f / (1.f + expf(-(ref + a.in[3][D + c - 7504]))); }
        if (lane == 0) chk_report(F.ctl, 0, relerr(got, r2, fl));
    }
}
DI void chk_norms(const Frame& F, const Args& a) {
    const int gw = F.bx * NWAVES + F.wave, NGW = F.G * NWAVES, lane = F.lane; unsigned char* ws = F.ws;
    for (int sidx = gw; sidx < 8; sidx += NGW) {
        const int t = CHK_TS[sidx]; const float* cr = (const float*)(ws + WS_CKVRAW) + (size_t)t * 256; const float* kw = (const float*)(ws + WS_KWRAW) + (size_t)t * 256;
        float ss = 0.f; for (int c = 0; c < 256; ++c) ss += cr[c] * cr[c];
        const float r = 1.f / sqrtf(ss / 256.f + LN_EPS); float e = 0.f;
        for (int c = lane; c < 256; c += 64) e = fmaxf(e, relerr(fp8dec((ws + WS_CKVN)[(size_t)t * 256 + c]), cr[c] * r * a.in[4][c], 0.3f));
        float mu = 0.f; for (int c = 0; c < 64; ++c) mu += kw[c]; mu /= 64.f; float var = 0.f; for (int c = 0; c < 64; ++c) var += (kw[c] - mu) * (kw[c] - mu); var /= 64.f;
        e = fmaxf(e, relerr(bf2f(((const bf16*)(ws + WS_KIDXN))[(size_t)t * 64 + lane]), (kw[lane] - mu) / sqrtf(var + LN_EPS) * a.in[5][lane] + a.in[6][lane], 0.3f));
        if (lane < 16) e = fmaxf(e, relerr(((const float*)(ws + WS_WIDX))[(size_t)t * 16 + lane], kw[64 + lane], 0.01f));
        chk_report(F.ctl, 1, e);
    }
    for (int sidx = gw; sidx < 8 * 64; sidx += NGW) {
        const int t = CHK_TS[sidx >> 6], h = sidx & 7, c = (((sidx >> 3) & 7) * 37 + (sidx & 7) * 3) & 255;
        const float ref = wdot((const bf16*)(ws + WS_QDSA) + (size_t)t * 1024 + h * HD, HD, a.in[7] + (size_t)h * HD * CKV + c, CKV, lane);
        if (lane == 0) chk_report(F.ctl, 1, relerr(bf2f(((const bf16*)(ws + WS_QLAT))[(size_t)t * 2048 + h * 256 + c]), ref, 0.3f));
    }
    for (int sidx = gw; sidx < 64; sidx += NGW) {
        const int h = sidx & 7, b = ((sidx >> 3) * 9) & 63; float s0 = 0.f, s1 = 0.f;
        for (int k = 0; k < MBLK; ++k) { s0 += bf2f(((const bf16*)(ws + WS_KM))[(size_t)(b * MBLK + k) * 1024 + h * HD + lane]); s1 += bf2f(((const bf16*)(ws + WS_KM))[(size_t)(b * MBLK + k) * 1024 + h * HD + 64 + lane]); }
        const float* km = (const float*)(ws + WS_KMEAN) + (size_t)(h * NBLK + b) * HD;
        chk_report(F.ctl, 1, fmaxf(relerr(km[lane], s0 / 256.f, 0.02f), relerr(km[64 + lane], s1 / 256.f, 0.02f)));
    }
}
DI float chk_score(const unsigned char* ws, int t, int key) {
    const bf16* q = (const bf16*)(ws + WS_QIDX) + (size_t)t * 1024; const bf16* k = (const bf16*)(ws + WS_KIDXN) + (size_t)key * 64; const float* w = (const float*)(ws + WS_WIDX) + (size_t)t * 16;
    float s = 0.f;
    for (int h = 0; h < 16; ++h) { float d = 0.f; for (int i = 0; i < 64; ++i) d += bf2f(q[h * 64 + i]) * bf2f(k[i]); s += w[h] * fmaxf(d, 0.f); }
    return s;
}
DI void chk_topk(const Frame& F, int l) {
    const int gw = F.bx * NWAVES + F.wave, NGW = F.G * NWAVES, lane = F.lane; unsigned char* ws = F.ws;
    for (int sidx = gw; sidx < 8; sidx += NGW) {
        const int t = CHK_TS[sidx]; const unsigned short* sel = (const unsigned short*)(ws + WS_SEL) + (size_t)t * TOPK; const int nsel = t + 1 < TOPK ? t + 1 : TOPK;
        float bad = 0.f, mn = __builtin_inff();
        for (int i = lane; i < TOPK; i += 64) {
            const int k = sel[i];
            if (i < nsel) { if (k > t) bad += 1.f; else mn = fminf(mn, chk_score(ws, t, k)); if (i + 1 < nsel && sel[i + 1] <= k) bad += 1.f; }
            else if (k != 0xFFFF) bad += 1.f;
        }
#pragma unroll
        for (int o = 1; o < 64; o <<= 1) mn = fminf(mn, __shfl_xor(mn, o));
        float cnt = 0.f; for (int k = lane; k <= t; k += 64) if (chk_score(ws, t, k) > mn * (mn > 0.f ? 1.00001f : 0.99999f) + 1e-6f) cnt += 1.f;
        cnt = wave_sum(cnt); bad = wave_sum(bad);
        const float extra = cnt - (float)(nsel - 1); chk_report(F.ctl, 2, (bad + (extra > 0.f ? extra : 0.f)) / 16.f);
    }
    for (int sidx = gw; sidx < 64; sidx += NGW) {
        const int t = CHK_TS[sidx >> 3], h = sidx & 7, own = t >> 8; const bf16* q = (const bf16*)(ws + WS_QM) + (size_t)t * 1024 + h * HD;
        float g = -__builtin_inff();
        if (lane < own) { g = 0.f; const float* km = (const float*)(ws + WS_KMEAN) + (size_t)(h * NBLK + lane) * HD; for (int d = 0; d < HD; ++d) g += bf2f(q[d]) * km[d]; }
        float bad = 0.f; const int nsel = own < 3 ? own : 3; float gg = g;
        for (int j = 0; j < nsel; ++j) {
            float mx = gg; int mi = lane;
#pragma unroll
            for (int o = 1; o < 64; o <<= 1) { const float ov = __shfl_xor(mx, o); const int oi = __shfl_xor(mi, o); if (ov > mx || (ov == mx && oi < mi)) { mx = ov; mi = oi; } }
            float g2 = (lane == mi) ? -__builtin_inff() : gg;
#pragma unroll
            for (int o = 1; o < 64; o <<= 1) g2 = fmaxf(g2, __shfl_xor(g2, o));
            const bool neartie = (mx - g2) < 1e-4f * (fabsf(mx) + 1e-3f);
            const unsigned n = ((const unsigned*)(F.ctl + CW_BCNT))[l * 512 + h * 64 + mi]; const unsigned* bk = (const unsigned*)(ws + WS_BUCK) + (size_t)h * BUCK_PER_HEAD + bucket_off(mi);
            float found = 0.f; for (unsigned i = lane; i < n; i += 64) if (bk[i] == (((unsigned)t << 2) | (unsigned)j)) found = 1.f;
            if (wave_sum(found) != 1.f && !neartie) bad += 1.f;
            if (lane == mi) gg = -__builtin_inff();
        }
        chk_report(F.ctl, 3, bad);
    }
}
DI void chk_attn(const Frame& F, const Args& a) {
    const int gw = F.bx * NWAVES + F.wave, NGW = F.G * NWAVES, lane = F.lane; unsigned char* ws = F.ws;
    for (int sidx = gw; sidx < 64; sidx += NGW) {
        const int t = CHK_TS[sidx >> 3], h = sidx & 7; const float slope = exp2f(-(float)(h + 1));
        {
            const unsigned short* sel = (const unsigned short*)(ws + WS_SEL) + (size_t)t * TOPK; const int nsel = t + 1 < TOPK ? t + 1 : TOPK;
            const bf16* q = (const bf16*)(ws + WS_QLAT) + (size_t)t * 2048 + h * 256; const unsigned char* ck = ws + WS_CKVN;
            float sc[4]; float mx = -__builtin_inff();
#pragma unroll
            for (int j = 0; j < 4; ++j) { const int i = lane + 64 * j; sc[j] = -__builtin_inff();
                if (i < nsel) { const int k = sel[i]; float d = 0.f; for (int c = 0; c < 256; ++c) d += bf2f(q[c]) * fp8dec(ck[(size_t)k * 256 + c]); sc[j] = d * 0.08838834764831845f - slope * (float)(t - k); }
                mx = fmaxf(mx, sc[j]); }
#pragma unroll
            for (int o = 1; o < 64; o <<= 1) mx = fmaxf(mx, __shfl_xor(mx, o));
            float p[4], ps = 0.f;
#pragma unroll
            for (int j = 0; j < 4; ++j) { p[j] = expf(sc[j] - mx); ps += p[j]; } ps = wave_sum(ps);
            float o4[4] = {0.f, 0.f, 0.f, 0.f};
#pragma unroll
            for (int j = 0; j < 4; ++j) for (int src = 0; src < 64; ++src) { const float pp = __shfl(p[j], src); const int i = src + 64 * j; if (i < nsel) { const int k = sel[i];
                _Pragma("unroll") for (int e = 0; e < 4; ++e) o4[e] += pp * fp8dec(ck[(size_t)k * 256 + lane * 4 + e]); } }
            float er = 0.f;
#pragma unroll
            for (int e = 0; e < 4; ++e) er = fmaxf(er, relerr(bf2f(((const bf16*)(ws + WS_OLAT))[(size_t)t * 2048 + h * 256 + lane * 4 + e]), o4[e] / ps, 0.05f));
            chk_report(F.ctl, 4, er);
        }
        {
            const int own = t >> 8; const bf16* q = (const bf16*)(ws + WS_QM) + (size_t)t * 1024 + h * HD; const bf16* kk = (const bf16*)(ws + WS_KM); const bf16* vv = (const bf16*)(ws + WS_VM);
            float g = -__builtin_inff();
            if (lane < own) { g = 0.f; const float* km = (const float*)(ws + WS_KMEAN) + (size_t)(h * NBLK + lane) * HD; for (int d = 0; d < HD; ++d) g += bf2f(q[d]) * km[d]; }
            int blks[4] = {-1, -1, -1, own}; const int nsel = own < 3 ? own : 3; float gg = g;
#pragma unroll
            for (int j = 0; j < 3; ++j) { if (j < nsel) { float mx = gg; int mi = lane;
#pragma unroll
                for (int o = 1; o < 64; o <<= 1) { const float ov = __shfl_xor(mx, o); const int oi = __shfl_xor(mi, o); if (ov > mx || (ov == mx && oi < mi)) { mx = ov; mi = oi; } }
                blks[j] = mi; if (lane == mi) gg = -__builtin_inff(); } }
            float M = -__builtin_inff();
#pragma unroll
            for (int bi = 0; bi < 4; ++bi) { if (blks[bi] >= 0) for (int k0 = lane; k0 < MBLK; k0 += 64) { const int kp = blks[bi] * MBLK + k0; if (kp <= t) { float d = 0.f; for (int e = 0; e < HD; ++e) d += bf2f(q[e]) * bf2f(kk[(size_t)kp * 1024 + h * HD + e]);
                M = fmaxf(M, d * 0.08838834764831845f - slope * (float)(t - kp)); } } }
#pragma unroll
            for (int o = 1; o < 64; o <<= 1) M = fmaxf(M, __shfl_xor(M, o));
            float ps = 0.f, o0 = 0.f, o1 = 0.f;
#pragma unroll
            for (int bi = 0; bi < 4; ++bi) { if (blks[bi] >= 0) for (int kb = 0; kb < MBLK; kb += 64) { const int kp = blks[bi] * MBLK + kb + lane; float p = 0.f;
                if (kp <= t) { float d = 0.f; for (int e = 0; e < HD; ++e) d += bf2f(q[e]) * bf2f(kk[(size_t)kp * 1024 + h * HD + e]); p = expf(d * 0.08838834764831845f - slope * (float)(t - kp) - M); }
                ps += p;
                for (int src = 0; src < 64; ++src) { const float pp = __shfl(p, src); const int kq = blks[bi] * MBLK + kb + src; if (kq <= t) { o0 += pp * bf2f(vv[(size_t)kq * 1024 + h * HD + 2 * lane]); o1 += pp * bf2f(vv[(size_t)kq * 1024 + h * HD + 2 * lane + 1]); } } } }
            ps = wave_sum(ps);
            const unsigned char* ob = ws + WS_OB + (size_t)t * 1024 + h * HD;
            chk_report(F.ctl, 5, fmaxf(relerr(fp8dec(ob[2 * lane]) / F8_SOB, o0 / ps, 0.1f), relerr(fp8dec(ob[2 * lane + 1]) / F8_SOB, o1 / ps, 0.1f)));
        }
        {
            float r0 = 0.f, r1 = 0.f; const bf16* ol = (const bf16*)(ws + WS_OLAT) + (size_t)t * 2048 + h * 256; const float* wu = a.in[8] + (size_t)h * CKV * HD;
            for (int c = 0; c < 256; ++c) { r0 += bf2f(ol[c]) * bfr(wu[c * HD + lane]); r1 += bf2f(ol[c]) * bfr(wu[c * HD + 64 + lane]); }
            const unsigned char* oa = ws + WS_OA + (size_t)t * 1024 + h * HD;
            chk_report(F.ctl, 6, fmaxf(relerr(fp8dec(oa[lane]) / F8_SOA, r0, 0.05f), relerr(fp8dec(oa[64 + lane]) / F8_SOA, r1, 0.05f)));
        }
    }
}
DI void chk_dense(const Frame& F, int word, const bf16* act, int lda, int K, const float* W, int N, const bf16* out, int ldo, float fl) {
    const int gw = F.bx * NWAVES + F.wave, NGW = F.G * NWAVES, lane = F.lane;
    for (int sidx = gw; sidx < 8 * 24; sidx += NGW) { const int t = CHK_TS[sidx / 24], n = ((sidx % 24) * 211 + 5) % N;
        const float ref = wdot(act + (size_t)t * lda, K, W + n, N, lane);
        if (lane == 0) chk_report(F.ctl, word, relerr(bf2f(out[(size_t)t * ldo + n]), ref, fl)); }
}
DI float wdot8r(const unsigned char* a8, int K, const float* W, size_t ldw, float wscale, int lane) {
    float s = 0.f; for (int k = lane; k < K; k += 64) s += fp8dec(a8[k]) * f8r(W[(size_t)k * ldw], wscale); return wave_sum(s);
}
DI void chk_merged(const Frame& F, const Args& a) {
    const int gw = F.bx * NWAVES + F.wave, NGW = F.G * NWAVES, lane = F.lane; unsigned char* ws = F.ws;
    for (int sidx = gw; sidx < 8 * 24; sidx += NGW) { const int t = CHK_TS[sidx / 24], n = ((sidx % 24) * 211 + 5) % D;
        const float pa = wdot8r(ws + WS_OA + (size_t)t * 1024, 1024, a.in[9] + n, D, F8_SWO, lane) / F8_SOA, pb = wdot8r(ws + WS_OB + (size_t)t * 1024, 1024, a.in[10] + n, D, F8_SWO, lane) / F8_SOB;
        const float ref = bf2f(((const bf16*)(ws + WS_GA))[(size_t)t * D + n]) * pa + bf2f(((const bf16*)(ws + WS_GB))[(size_t)t * D + n]) * pb;
        if (lane == 0) chk_report(F.ctl, 6, relerr(fp8dec((ws + WS_MERGED)[(size_t)t * D + n]) / F8_SMG, ref, 0.02f)); }
}
DI void chk_dense8(const Frame& F, int word, const unsigned char* act8, int lda, int K, float ascale, const float* W, int N, float wscale, const bf16* out, int ldo, float fl) {
    const int gw = F.bx * NWAVES + F.wave, NGW = F.G * NWAVES, lane = F.lane;
    for (int sidx = gw; sidx < 8 * 24; sidx += NGW) { const int t = CHK_TS[sidx / 24], n = ((sidx % 24) * 211 + 5) % N;
        const float ref = wdot8r(act8 + (size_t)t * lda, K, W + n, N, wscale, lane) / ascale;
        if (lane == 0) chk_report(F.ctl, word, relerr(bf2f(out[(size_t)t * ldo + n]), ref, fl)); }
}
DI void chk_ln1(const Frame& F, const Args& a) {
    const int gw = F.bx * NWAVES + F.wave, NGW = F.G * NWAVES, lane = F.lane; unsigned char* ws = F.ws;
    for (int sidx = gw; sidx < 8; sidx += NGW) { const int t = CHK_TS[sidx]; const float* x = a.in[0] + (size_t)t * D; const bf16* y = (const bf16*)(ws + WS_Y) + (size_t)t * D;
        float s = 0.f; for (int c = lane; c < D; c += 64) s += ALPHA * x[c] + bf2f(y[c]); const float mu = wave_sum(s) / D;
        float q = 0.f; for (int c = lane; c < D; c += 64) { const float d = ALPHA * x[c] + bf2f(y[c]) - mu; q += d * d; } const float rs = 1.f / sqrtf(wave_sum(q) / D + LN_EPS);
        float e = 0.f; for (int c = lane; c < D; c += 64) { const float ref = (ALPHA * x[c] + bf2f(y[c]) - mu) * rs * a.in[17][c] + a.in[18][c];
            e = fmaxf(e, relerr(a.out[(size_t)t * D + c], ref, 0.5f) * 20.f); e = fmaxf(e, relerr(fp8dec((ws + WS_XB)[(size_t)t * D + c]), ref, 0.5f)); }
        chk_report(F.ctl, 7, e); }
}
DI void chk_memattn(const Frame& F, int l) {
    const int gw = F.bx * NWAVES + F.wave, NGW = F.G * NWAVES, lane = F.lane; unsigned char* ws = F.ws;
    for (int sidx = gw; sidx < 32; sidx += NGW) { const int t = CHK_TS[sidx >> 2], h = sidx & 3; const bf16* q = (const bf16*)(ws + WS_QMEM) + (size_t)t * 512 + h * HD; const bf16* kv = (const bf16*)(ws + WS_KVMEM) + (size_t)l * 1024;
        float sc[4], mx = -__builtin_inff();
#pragma unroll
        for (int j = 0; j < 4; ++j) { const int m = lane + 64 * j; float d = 0.f; for (int e = 0; e < HD; ++e) d += bf2f(q[e]) * bf2f(kv[(size_t)m * 4096 + h * HD + e]); sc[j] = d * 0.08838834764831845f; mx = fmaxf(mx, sc[j]); }
#pragma unroll
        for (int o = 1; o < 64; o <<= 1) mx = fmaxf(mx, __shfl_xor(mx, o));
        float ps = 0.f, o0 = 0.f, o1 = 0.f;
#pragma unroll
        for (int j = 0; j < 4; ++j) { const float p = expf(sc[j] - mx); ps += p; for (int src = 0; src < 64; ++src) { const float pp = __shfl(p, src); const int m = src + 64 * j;
            o0 += pp * bf2f(kv[(size_t)m * 4096 + 512 + h * HD + 2 * lane]); o1 += pp * bf2f(kv[(size_t)m * 4096 + 512 + h * HD + 2 * lane + 1]); } }
        ps = wave_sum(ps); const unsigned char* om = ws + WS_OMEM + (size_t)t * 512 + h * HD;
        chk_report(F.ctl, 9, fmaxf(relerr(fp8dec(om[2 * lane]) / F8_SOM, o0 / ps, 0.05f), relerr(fp8dec(om[2 * lane + 1]) / F8_SOM, o1 / ps, 0.05f))); }
}
DI void chk_kvmem(const Frame& F, const Args& a) {
    const int gw = F.bx * NWAVES + F.wave, NGW = F.G * NWAVES, lane = F.lane; unsigned char* ws = F.ws;
    for (int sidx = gw; sidx < 4 * 48; sidx += NGW) { const int ll = sidx / 48, m = ((sidx % 48) * 37) & 255, n = ((sidx % 48) * 211 + 3) & 1023;
        const float ref = wdot((const bf16*)(ws + WS_MEMB) + (size_t)m * D, D, a.in[13] + (size_t)ll * D * 1024 + n, 1024, lane);
        if (lane == 0) chk_report(F.ctl, 8, relerr(bf2f(((const bf16*)(ws + WS_KVMEM))[(size_t)m * 4096 + ll * 1024 + n]), ref, 0.3f)); }
}
DI float wdot8(const unsigned char* a8, int K, const float* W, size_t ldw, int lane) {
    float s = 0.f; for (int k = lane; k < K; k += 64) s += fp8dec(a8[k]) * W[(size_t)k * ldw]; return wave_sum(s);
}
DI void chk_swiglu(const Frame& F, const Args& a) {
    const int gw = F.bx * NWAVES + F.wave, NGW = F.G * NWAVES, lane = F.lane; unsigned char* ws = F.ws;
    for (int sidx = gw; sidx < 8 * 24; sidx += NGW) { const int t = CHK_TS[sidx / 24], j = ((sidx % 24) * 509 + 11) % DFF;
        const float g = wdot8(ws + WS_XB + (size_t)t * D, D, a.in[15] + j, 2 * DFF, lane), u = wdot8(ws + WS_XB + (size_t)t * D, D, a.in[15] + DFF + j, 2 * DFF, lane);
        if (lane == 0) chk_report(F.ctl, 11, relerr(fp8dec((ws + WS_H)[(size_t)t * DFF + j]) * (1.0f / F8_SH), g / (1.f + expf(-g)) * u, 0.05f)); }
}
DI void chk_ffn2(const Frame& F, const Args& a) {
    const int gw = F.bx * NWAVES + F.wave, NGW = F.G * NWAVES, lane = F.lane; unsigned char* ws = F.ws;
    for (int sidx = gw; sidx < 8 * 24; sidx += NGW) { const int t = CHK_TS[sidx / 24], n = ((sidx % 24) * 211 + 5) % D;
        const float ref = wdot8(ws + WS_H + (size_t)t * DFF, DFF, a.in[16] + n, D, lane) * (1.0f / F8_SH);
        if (lane == 0) chk_report(F.ctl, 12, relerr(bf2f(((const bf16*)(ws + WS_Y))[(size_t)t * D + n]), ref, 0.01f)); }
}
DI void chk_encode(const Frame& F, const Args& a) {
    float B = 0.f, wgt = 0.5f;
    for (int i = 0; i < 32; ++i) if ((SELFCHECK_MASK >> i) & 1u) { const float e = __uint_as_float(__hip_atomic_load((unsigned*)(F.ctl + CW_ERR + i), RLX_AGENT)); if (e > SELFCHECK_TOL) B += wgt; wgt *= 0.5f; }
    const float sc = 1.f - 0.5f * B;
    f32x4* o = (f32x4*)a.out; const int gt = F.bx * NTHREADS + F.tid, ngt = F.G * NTHREADS;
    for (int i = gt; i < S * D / 4; i += ngt) o[i] = o[i] * sc;
}
#endif

constexpr int NPH = 17;
__global__ void __launch_bounds__(NTHREADS, 2) fwd_kernel(Args args) {
    extern __shared__ __attribute__((aligned(16))) unsigned char lds_raw[];
    LAS unsigned char* const lds = (LAS unsigned char*)lds_raw;
    volatile LAS unsigned* MISC = (volatile LAS unsigned*)(lds + MISC_OFF);
    if (threadIdx.x < 32) MISC[threadIdx.x] = 0u;
    __syncthreads();
#if MK_ONE_LAUNCH
    constexpr int lo = 0, hi = DEPTH * NPH;
#else
    const int lo = args.ph_lo, hi = args.ph_hi;
#endif
    XcdBarrier bar; bar.bar = (unsigned*)(args.ws + WS_CTL) + CW_BAR; bar.x = 0; bar.st = nullptr; bar.w0 = __builtin_amdgcn_readfirstlane((int)threadIdx.x >> 6);
    if (hi - lo > 1) bar = xcd_barrier_post((unsigned*)(args.ws + WS_CTL) + CW_BAR, MISC + 8);
#ifdef ONLY_PH
#define IN(k) (((k) - p0) == ONLY_PH && lo <= (k) && (k) < hi)
#else
#define IN(k) (lo <= (k) && (k) < hi)
#endif
#define SEAM(k) do { if (lo <= (k) && (k) + 1 < hi) { XcdBarrier b2_ = bar; asm volatile("" : "+s"(b2_.bar), "+s"(b2_.x)); xcd_barrier(b2_); } } while (0)
#ifdef REPEAT_MASK
#define NREP(bit) ((((unsigned long long)REPEAT_MASK >> (bit)) & 1ull) ? 2 : 1)
#else
#define NREP(bit) 1
#endif
#define FRAME() const Frame F = make_frame(args.ws, lds, bar.w0); unsigned char* const ws = F.ws; (void)ws; int lq = l; asm volatile("" : "+s"(lq)); (void)lq
    for (int l = 0; l < DEPTH; ++l) {
        const int p0 = l * NPH;
        if (IN(p0 + 0)) { FRAME(); for (int rep = 0; rep < NREP(0); ++rep) conv_phase(F, args, lq); } SEAM(p0 + 0);
        if (IN(p0 + 1)) {
#ifndef SKIP_A
            if (l == 0) { FRAME(); pg8::Gemm g{(const bf16*)(ws + WS_MEMB), (const bf16*)(ws + WS_WKV), D, D, D, 1, 16, 0, 0}; pg8::StaticOrder So; So.init(1, 16, F.G, F.G - 1 - F.bx);
                pg8::EpiBf16 E{(bf16*)(ws + WS_KVMEM), 4096}; pg8::gemm_phase(lds, g, So, E, F.tid); }
#endif
#ifndef SKIP_B
            { FRAME(); pg8::Gemm g{(const bf16*)(ws + WS_XB8), (const bf16*)(ws + WS_WIN8), D / 2, D / 2, D / 2, S / 256, IN8 / 256, 0, 0}; pg8::StaticOrder So; So.init(S / 256, IN8 / 256, F.G, F.bx);
            pg8::EpiIn8 E{(bf16*)(ws + WS_QDSA), (bf16*)(ws + WS_VM), (bf16*)(ws + WS_GA), (bf16*)(ws + WS_GB), (float*)(ws + WS_CKVRAW), args.in[3] + (size_t)lq * 2 * D};
            for (int rep = 0; rep < NREP(1); ++rep) pg8::gemm_phase<pg8::EpiIn8, true>(lds, g, So, E, F.tid); }
            { FRAME(); pg8::Gemm g{(const bf16*)(ws + WS_XB), (const bf16*)(ws + WS_WIN), D, D, D, S / 256, INB / 256, 0, 0}; pg8::StaticOrder So; So.init(S / 256, INB / 256, F.G, (F.bx + 3 * F.G / 4) % F.G);
            pg8::EpiInBf E{(bf16*)(ws + WS_QIDX), (bf16*)(ws + WS_QM), (bf16*)(ws + WS_KM), (float*)(ws + WS_KWRAW)};
            for (int rep = 0; rep < NREP(1); ++rep) pg8::gemm_phase(lds, g, So, E, F.tid); }
#endif
        } SEAM(p0 + 1);
        if (IN(p0 + 2)) {
#ifdef SELFCHECK
            if (l == 0 && CHK_ON(0)) { FRAME(); chk_inproj(F, args); }
#endif
#ifndef SKIP_A
            { FRAME(); for (int rep = 0; rep < NREP(2); ++rep) norm_phase(F, args, lq); }
#endif
#ifndef SKIP_B
            { FRAME(); pg8::Gemm g{(const bf16*)(ws + WS_QDSA), (const bf16*)(ws + WS_WUK), 1024, 256, 256, S / 256, 8, 1, 256}; pg8::StaticOrder So; So.init(S / 256, 8, F.G, F.bx);
            pg8::EpiBf16 E{(bf16*)(ws + WS_QLAT), 2048}; for (int rep = 0; rep < NREP(3); ++rep) pg8::gemm_phase(lds, g, So, E, F.tid); }
#endif
        } SEAM(p0 + 2);
        if (IN(p0 + 3)) {
#ifdef SELFCHECK
            if (l == 0) { FRAME(); if (CHK_ON(1)) chk_norms(F, args); if (CHK_ON(8)) chk_kvmem(F, args); }
#endif
#ifndef SKIP_A
            { FRAME(); moba_gate_phase(F, lq); }
#endif
#ifndef SKIP_B
            { FRAME(); for (int rep = 0; rep < NREP(5); ++rep) indexer_phase(F); }
#endif
        } SEAM(p0 + 3);
        if (IN(p0 + 4)) {
#ifdef SELFCHECK
            if (l == 0 && (CHK_ON(2) || CHK_ON(3))) { FRAME(); chk_topk(F, lq); }
#endif
#ifndef SKIP_A
            { FRAME(); for (int rep = 0; rep < NREP(6); ++rep) moba_attn_phase(F, lq); }
#endif
#ifndef SKIP_B
            { FRAME(); for (int rep = 0; rep < NREP(7); ++rep) dsa_attn_phase(F); }
#endif
        } SEAM(p0 + 4);
        if (IN(p0 + 5)) {
            { FRAME(); for (int rep = 0; rep < NREP(8); ++rep) moba_combine_phase(F); }
            { FRAME(); pg8::Gemm g{(const bf16*)(ws + WS_OLAT), (const bf16*)(ws + WS_WUV), 2048, 512, 512, S / 256, 4, 0, 512}; pg8::StaticOrder So; So.init(S / 256, 4, F.G, F.bx);
            pg8::EpiF8 E{ws + WS_OA, 1024, F8_SOA}; for (int rep = 0; rep < NREP(9); ++rep) pg8::gemm_phase(lds, g, So, E, F.tid); }
        } SEAM(p0 + 5);
#ifdef SELFCHECK
        if (l == 0 && IN(p0 + 6) && (CHK_ON(4) || CHK_ON(5) || CHK_ON(6))) { FRAME(); chk_attn(F, args); }
#endif
        if (IN(p0 + 6)) { FRAME(); pg8::Gemm g{(const bf16*)(ws + WS_OA), (const bf16*)(ws + WS_WOA), 512, 512, 512, S / 256, 8, 0, 0}; pg8::StaticOrder So; So.init(S / 256, 8, F.G, F.bx);
            pg8::EpiGate E{(bf16*)(ws + WS_T1), (const bf16*)(ws + WS_GA), nullptr, nullptr, 1.0f / (F8_SOA * F8_SWO), 0.f}; for (int rep = 0; rep < NREP(10); ++rep) pg8::gemm_phase<pg8::EpiGate, true>(lds, g, So, E, F.tid); } SEAM(p0 + 6);
        if (IN(p0 + 7)) { FRAME(); pg8::Gemm g{(const bf16*)(ws + WS_OB), (const bf16*)(ws + WS_WOB), 512, 512, 512, S / 256, 8, 0, 0}; pg8::StaticOrder So; So.init(S / 256, 8, F.G, F.bx);
            pg8::EpiGate E{nullptr, (const bf16*)(ws + WS_GB), (const bf16*)(ws + WS_T1), ws + WS_MERGED, 1.0f / (F8_SOB * F8_SWO), F8_SMG}; for (int rep = 0; rep < NREP(11); ++rep) pg8::gemm_phase<pg8::EpiGate, true>(lds, g, So, E, F.tid); } SEAM(p0 + 7);
#ifdef SELFCHECK
        if (l == 0 && IN(p0 + 8) && CHK_ON(6)) { FRAME(); chk_merged(F, args); }
#endif
#if (LN_FUSED & 1)
        if (IN(p0 + 8)) { FRAME(); pg8::Gemm g{(const bf16*)(ws + WS_MERGED), (const bf16*)(ws + WS_WOUT), D / 2, D / 2, D / 2, S / 256, 8, 0, 0}; pg8::FusedOrder So{F.bx};
            pg8::EpiLn E{args.out, args.in[17] + (size_t)(lq * 3 + 0) * D, args.in[18] + (size_t)(lq * 3 + 0) * D, 1.0f / (F8_SMG * F8_SWOUT), nullptr, ws + WS_XB, (unsigned long long*)(ws + WS_LNX), (unsigned*)(F.ctl + CW_LNCNT) + (lq * 3 + 0) * 64 * 64};
            pg8::gemm_phase<pg8::EpiLn, true, pg8::FusedOrder, true>(lds, g, So, E, F.tid); } SEAM(p0 + 8);
#else
        if (IN(p0 + 8)) { FRAME(); pg8::Gemm g{(const bf16*)(ws + WS_MERGED), (const bf16*)(ws + WS_WOUT), D / 2, D / 2, D / 2, S / 256, 8, 0, 0}; pg8::StaticOrder So; So.init(S / 256, 8, F.G, F.bx);
            pg8::EpiBf16S E{(bf16*)(ws + WS_Y), D, 1.0f / (F8_SMG * F8_SWOUT)}; for (int rep = 0; rep < NREP(12); ++rep) pg8::gemm_phase<pg8::EpiBf16S, true>(lds, g, So, E, F.tid); } SEAM(p0 + 8);
        if (IN(p0 + 9)) { FRAME(); ln_phase(F, args, l, 0); } SEAM(p0 + 9);
#endif
#ifdef SELFCHECK
        if (l == 0 && IN(p0 + 10) && CHK_ON(7)) { FRAME(); chk_ln1(F, args); }
#endif
        if (IN(p0 + 10)) { FRAME(); pg8::Gemm g{(const bf16*)(ws + WS_XB), (const bf16*)(ws + WS_WQM), D / 2, D / 2, D / 2, S / 256, 2, 0, 0}; pg8::StaticOrder So; So.init(S / 256, 2, F.G, F.bx);
            pg8::EpiBf16S E{(bf16*)(ws + WS_QMEM), 512, 1.0f / F8_SWQM}; for (int rep = 0; rep < NREP(14); ++rep) pg8::gemm_phase<pg8::EpiBf16S, true>(lds, g, So, E, F.tid); } SEAM(p0 + 10);
#ifdef SELFCHECK
        if (l == 0 && IN(p0 + 11) && CHK_ON(8)) { FRAME(); chk_dense8(F, 8, ws + WS_XB, D, D, 1.f, args.in[12], 512, F8_SWQM, (const bf16*)(ws + WS_QMEM), 512, 0.3f); }
#endif
        if (IN(p0 + 11)) { FRAME(); for (int rep = 0; rep < NREP(15); ++rep) mem_attn_phase(F, lq); } SEAM(p0 + 11);
#ifdef SELFCHECK
        if (l == 0 && IN(p0 + 12) && CHK_ON(9)) { FRAME(); chk_memattn(F, lq); }
#endif
#if (LN_FUSED & 2)
        if (IN(p0 + 12)) { FRAME(); pg8::Gemm g{(const bf16*)(ws + WS_OMEM), (const bf16*)(ws + WS_WOM), 256, 256, 256, S / 256, 8, 0, 0}; pg8::FusedOrder So{F.bx};
            pg8::EpiLn E{args.out, args.in[17] + (size_t)(lq * 3 + 1) * D, args.in[18] + (size_t)(lq * 3 + 1) * D, 1.0f / (F8_SOM * F8_SWOM), nullptr, ws + WS_XB, (unsigned long long*)(ws + WS_LNX), (unsigned*)(F.ctl + CW_LNCNT) + (lq * 3 + 1) * 64 * 64};
            pg8::gemm_phase<pg8::EpiLn, true, pg8::FusedOrder, true>(lds, g, So, E, F.tid); } SEAM(p0 + 12);
#else
        if (IN(p0 + 12)) { FRAME(); pg8::Gemm g{(const bf16*)(ws + WS_OMEM), (const bf16*)(ws + WS_WOM), 256, 256, 256, S / 256, 8, 0, 0}; pg8::StaticOrder So; So.init(S / 256, 8, F.G, F.bx);
            pg8::EpiBf16S E{(bf16*)(ws + WS_Y), D, 1.0f / (F8_SOM * F8_SWOM)}; for (int rep = 0; rep < NREP(16); ++rep) pg8::gemm_phase<pg8::EpiBf16S, true>(lds, g, So, E, F.tid); } SEAM(p0 + 12);
        if (IN(p0 + 13)) { FRAME(); ln_phase(F, args, l, 1); } SEAM(p0 + 13);
#endif
        if (IN(p0 + 14)) { FRAME(); pg8::Gemm g{(const bf16*)(ws + WS_XB), (const bf16*)(ws + WS_WF1), D / 2, D / 2, D / 2, S / 256, 2 * DFF / 256, 0, 0}; pg8::StaticOrder So; So.init(S / 256, 2 * DFF / 256, F.G, F.bx);
            pg8::EpiSwiglu8 E{ws + WS_H}; for (int rep = 0; rep < NREP(18); ++rep) pg8::gemm_phase<pg8::EpiSwiglu8, true>(lds, g, So, E, F.tid); } SEAM(p0 + 14);
#ifdef SELFCHECK
        if (l == 0 && IN(p0 + 15) && CHK_ON(11)) { FRAME(); chk_swiglu(F, args); }
#endif
#if (LN_FUSED & 4)
        if (IN(p0 + 15)) { FRAME(); pg8::Gemm g{(const bf16*)(ws + WS_H), (const bf16*)(ws + WS_WF2), DFF / 2, DFF / 2, DFF / 2, S / 256, 8, 0, 0}; pg8::FusedOrder So{F.bx};
            pg8::EpiLn E{args.out, args.in[17] + (size_t)(lq * 3 + 2) * D, args.in[18] + (size_t)(lq * 3 + 2) * D, 1.0f / (F8_SH * F8_SW2), (bf16*)(ws + WS_XB), ws + WS_XB8, (unsigned long long*)(ws + WS_LNX), (unsigned*)(F.ctl + CW_LNCNT) + (lq * 3 + 2) * 64 * 64};
            pg8::gemm_phase<pg8::EpiLn, true, pg8::FusedOrder, true>(lds, g, So, E, F.tid); } SEAM(p0 + 15);
#else
        if (IN(p0 + 15)) { FRAME(); pg8::Gemm g{(const bf16*)(ws + WS_H), (const bf16*)(ws + WS_WF2), DFF / 2, DFF / 2, DFF / 2, S / 256, 8, 0, 0}; pg8::StaticOrder So; So.init(S / 256, 8, F.G, F.bx);
            pg8::EpiBf16S E{(bf16*)(ws + WS_Y), D, 1.0f / (F8_SH * F8_SW2)}; for (int rep = 0; rep < NREP(19); ++rep) pg8::gemm_phase<pg8::EpiBf16S, true>(lds, g, So, E, F.tid); } SEAM(p0 + 15);
        if (IN(p0 + 16)) { FRAME(); ln_phase(F, args, l, 2); } SEAM(p0 + 16);
#endif
    }
#ifdef SELFCHECK
    { xcd_barrier(bar); const int l = 0; FRAME(); chk_encode(F, args); }
#endif
#undef IN
#undef SEAM
#undef FRAME
}

extern "C" void kernel_launch(void* const* d_in, const int* in_sizes, int n_in, void* d_out, int out_size, void* d_ws, size_t ws_size, hipStream_t stream) {
    static int grid = 0;
    if (grid == 0) {
        if (n_in != 19 || out_size != S * D || ws_size < WS_END) { fprintf(stderr, "kernel_launch: unexpected shapes (n_in %d, out %d, ws %zu < %zu)\n", n_in, out_size, ws_size, (size_t)WS_END); grid = -1; return; }
        int dev = 0, cus = 0, per_cu = 0;
        if (hipGetDevice(&dev) != hipSuccess || hipDeviceGetAttribute(&cus, hipDeviceAttributeMultiprocessorCount, dev) != hipSuccess) { grid = -1; return; }
        if (hipFuncSetAttribute((const void*)fwd_kernel, hipFuncAttributeMaxDynamicSharedMemorySize, LDS_BYTES) != hipSuccess) { fprintf(stderr, "kernel_launch: hipFuncSetAttribute failed\n"); grid = -1; return; }
        if (hipOccupancyMaxActiveBlocksPerMultiprocessor(&per_cu, (const void*)fwd_kernel, NTHREADS, LDS_BYTES) != hipSuccess || per_cu < 1) fprintf(stderr, "kernel_launch: occupancy query says %d\n", per_cu);
        (void)hipGetLastError();
        grid = cus;
        if (grid != 256) { fprintf(stderr, "kernel_launch: %d CUs; this kernel is built for the 256-workgroup grid of an MI355X; nothing launched\n", grid); grid = -1; return; }
    }
    if (grid < 0) return;
    (void)in_sizes;
    if (hipMemsetAsync((char*)d_ws + WS_CTL, 0, CTL_ZERO_BYTES, stream) != hipSuccess) return;
    Args a{};
    for (int i = 0; i < 19; ++i) a.in[i] = (const float*)d_in[i];
    a.out = (float*)d_out; a.ws = (unsigned char*)d_ws;
#if MK_ONE_LAUNCH
    a.ph_lo = 0; a.ph_hi = DEPTH * NPH;
    hipLaunchKernelGGL(fwd_kernel, dim3(grid), dim3(NTHREADS), LDS_BYTES, stream, a);
#else
    for (int p = 0; p < DEPTH * NPH; ++p) { a.ph_lo = p; a.ph_hi = p + 1; hipLaunchKernelGGL(fwd_kernel, dim3(grid), dim3(NTHREADS), LDS_BYTES, stream, a); }
#endif
}
```

```cpp
#include <hip/hip_runtime.h>
#include <cstdio>
#include <cstdint>

#ifndef MK_ONE_LAUNCH
#define MK_ONE_LAUNCH 1
#endif
#ifndef LN_FUSED
#define LN_FUSED 7
#endif

#define LAS __attribute__((address_space(3)))
#define GAS __attribute__((address_space(1)))
typedef unsigned short bf16;
typedef short bf16x8 __attribute__((ext_vector_type(8)));
typedef short s16x4 __attribute__((ext_vector_type(4)));
typedef short v4i16_t __attribute__((ext_vector_type(4)));
typedef float f32x2 __attribute__((ext_vector_type(2)));
typedef float f32x4 __attribute__((ext_vector_type(4)));
typedef float f32x16 __attribute__((ext_vector_type(16)));
typedef unsigned u32x2 __attribute__((ext_vector_type(2)));
typedef unsigned u32x4 __attribute__((ext_vector_type(4)));
typedef int v4i __attribute__((ext_vector_type(4)));
typedef int v8i __attribute__((ext_vector_type(8)));
typedef v8i v8i_a16 __attribute__((aligned(16)));
typedef GAS unsigned gu32;
#define RLX_AGENT __ATOMIC_RELAXED, __HIP_MEMORY_SCOPE_AGENT
#define DI __device__ __forceinline__

constexpr int S = 16384, D = 2048, DEPTH = 4, NH = 8, HD = 128, CKV = 256, IH = 16, IDIM = 64, TOPK = 256, MBLK = 256, NBLK = 64, NMEM = 256, NHM = 4, DFF = 5632;
constexpr int INW = 9552, INP = 9728;
constexpr float LN_EPS = 1e-5f;
constexpr float ALPHA = 1.681792830507429f;
constexpr float LOG2E = 1.4426950408889634f;
constexpr float ATT_SCALE2 = 0.08838834764831845f * LOG2E;
constexpr int NWAVES = 8, NTHREADS = 512;
constexpr float F8_SW1 = 64.f, F8_SW2 = 128.f, F8_SH = 16.f, F8_SWI = 32.f;
constexpr float F8_SWO = 64.f, F8_SWOUT = 64.f, F8_SWQM = 32.f, F8_SWOM = 32.f;
constexpr float F8_SOA = 16.f, F8_SOB = 8.f, F8_SMG = 64.f, F8_SOM = 32.f;
constexpr int INB = 3328, IN8 = 6400;

constexpr size_t MiB = 1u << 20;
constexpr size_t WS_CTL = 0, CTL_ZERO_BYTES = 1 * MiB;
constexpr size_t WS_WIN = 1 * MiB;
constexpr size_t WS_WUK = WS_WIN + 38 * MiB;
constexpr size_t WS_WUV = WS_WUK + 1 * MiB;
constexpr size_t WS_WOA = WS_WUV + 1 * MiB;
constexpr size_t WS_WOB = WS_WOA + 4 * MiB;
constexpr size_t WS_WOUT = WS_WOB + 4 * MiB;
constexpr size_t WS_WQM = WS_WOUT + 8 * MiB;
constexpr size_t WS_WOM = WS_WQM + 2 * MiB;
constexpr size_t WS_WF1 = WS_WOM + 2 * MiB;
constexpr size_t WS_WF2 = WS_WF1 + 44 * MiB;
constexpr size_t WS_WKV = WS_WF2 + 22 * MiB;
constexpr size_t WS_MEMB = WS_WKV + 16 * MiB;
constexpr size_t WS_KVMEM = WS_MEMB + 1 * MiB;
constexpr size_t WS_XB = WS_KVMEM + 2 * MiB;
constexpr size_t WS_QDSA = WS_XB + 64 * MiB;
constexpr size_t WS_QIDX = WS_QDSA + 32 * MiB;
constexpr size_t WS_QM = WS_QIDX + 32 * MiB;
constexpr size_t WS_KM = WS_QM + 32 * MiB;
constexpr size_t WS_VM = WS_KM + 32 * MiB;
constexpr size_t WS_GA = WS_VM + 32 * MiB;
constexpr size_t WS_GB = WS_GA + 64 * MiB;
constexpr size_t WS_CKVRAW = WS_GB + 64 * MiB;
constexpr size_t WS_KWRAW = WS_CKVRAW + 16 * MiB;
constexpr size_t WS_H = WS_QDSA;
constexpr size_t WS_CKVN = WS_KWRAW + 16 * MiB;
constexpr size_t WS_KIDXN = WS_CKVN + 8 * MiB;
constexpr size_t WS_WIDX = WS_KIDXN + 2 * MiB;
constexpr size_t WS_KMEAN = WS_WIDX + 1 * MiB;
constexpr size_t WS_QLAT = WS_KMEAN + 1 * MiB;
constexpr size_t WS_SEL = WS_QLAT + 64 * MiB;
constexpr size_t WS_OLAT = WS_SEL + 8 * MiB;
constexpr size_t WS_OA = WS_OLAT + 64 * MiB;
constexpr size_t WS_OB = WS_OA + 32 * MiB;
constexpr size_t WS_BUCK = WS_OB + 32 * MiB;
constexpr size_t WS_PARTO = WS_BUCK + 16 * MiB;
constexpr size_t WS_PARTML = WS_PARTO + 128 * MiB;
constexpr size_t WS_T1 = WS_PARTML + 4 * MiB;
constexpr size_t WS_MERGED = WS_T1 + 64 * MiB;
constexpr size_t WS_Y = WS_MERGED + 64 * MiB;
constexpr size_t WS_QMEM = WS_Y + 64 * MiB;
constexpr size_t WS_OMEM = WS_QMEM + 16 * MiB;
constexpr size_t WS_XB8 = WS_OMEM + 16 * MiB;
constexpr size_t WS_LNX = WS_XB8 + 32 * MiB;
constexpr size_t WS_END = WS_LNX + 1 * MiB;
constexpr size_t WS_WIN8 = WS_WIN + 16 * MiB;
static_assert(WS_H + (size_t)S * DFF * 2 <= WS_CKVN, "h overlay");
static_assert(WS_END <= 1408 * MiB, "workspace");
constexpr int CW_BAR = 4096;
constexpr int CW_BCNT = 16384;
constexpr int CW_LNCNT = 65536;
constexpr int BUCK_PER_HEAD = 256 * 2016;
DI int bucket_off(int b) { return 256 * (63 * b - (b * (b - 1)) / 2); }

constexpr int LDS_BYTES = 147456;
constexpr int RING_BYTES = 131072;
constexpr int MISC_OFF = 143360;
constexpr int LNT_OFF = RING_BYTES;

DI unsigned f2bf(float f) { unsigned u = __builtin_bit_cast(unsigned, f); return (u + 0x7fffu + ((u >> 16) & 1u)) >> 16; }
DI unsigned pk2(float lo, float hi) { return f2bf(lo) | (f2bf(hi) << 16); }
DI unsigned cvt_pk_bf16(float lo, float hi) { unsigned r; asm volatile("v_cvt_pk_bf16_f32 %0, %1, %2" : "=v"(r) : "v"(lo), "v"(hi)); return r; }
DI float clamp448(float x) { return __builtin_amdgcn_fmed3f(x, -448.f, 448.f); }
DI unsigned pk4_fp8(float a, float b, float c, float d) {
    int w = 0; w = __builtin_amdgcn_cvt_pk_fp8_f32(clamp448(a), clamp448(b), w, false); w = __builtin_amdgcn_cvt_pk_fp8_f32(clamp448(c), clamp448(d), w, true); return (unsigned)w; }
DI float bflo(unsigned u) { return __builtin_bit_cast(float, u << 16); }
DI float bfhi(unsigned u) { return __builtin_bit_cast(float, u & 0xffff0000u); }
DI int lane_id() { int l; asm volatile("v_mbcnt_lo_u32_b32 %0, -1, 0\n\tv_mbcnt_hi_u32_b32 %0, -1, %0" : "=v"(l)); return l; }
DI float wave_sum(float v) {
#pragma unroll
    for (int o = 1; o < 64; o <<= 1) v += __shfl_xor(v, o);
    return v;
}
DI float xrow16_max(float x) {
    auto s = __builtin_amdgcn_permlane16_swap(__float_as_uint(x), __float_as_uint(x), false, false);
    x = fmaxf(__uint_as_float(s[0]), __uint_as_float(s[1]));
    auto t = __builtin_amdgcn_permlane32_swap(__float_as_uint(x), __float_as_uint(x), false, false);
    return fmaxf(__uint_as_float(t[0]), __uint_as_float(t[1]));
}
DI float xrow16_sum(float x) {
    auto s = __builtin_amdgcn_permlane16_swap(__float_as_uint(x), __float_as_uint(x), false, false);
    x = __uint_as_float(s[0]) + __uint_as_float(s[1]);
    auto t = __builtin_amdgcn_permlane32_swap(__float_as_uint(x), __float_as_uint(x), false, false);
    return __uint_as_float(t[0]) + __uint_as_float(t[1]);
}
DI float fast_sigmoid(float x) { return __builtin_amdgcn_rcpf(1.0f + __builtin_amdgcn_exp2f(-x * LOG2E)); }
DI s16x4 vtr(unsigned lds_addr) { return __builtin_bit_cast(s16x4, __builtin_amdgcn_ds_read_tr16_b64_v4i16((LAS v4i16_t*)lds_addr)); }
DI unsigned off_b(unsigned row, unsigned ch) { return 256u * row + 16u * (ch ^ (((row & 3) << 2) | ((row >> 2) & 3))); }
DI unsigned tr_addr16(unsigned lane, unsigned c, unsigned ks, unsigned t) {
    const unsigned g = lane >> 4, q = (lane & 15) >> 2, p = lane & 3;
    return off_b(32 * ks + 8 * g + 4 * t + q, 2 * c + (p >> 1)) + 8 * (p & 1);
}
DI unsigned perm32rows(unsigned k) { return (k & ~31u) | (8u * ((k >> 2) & 3u) + 4u * ((k >> 4) & 1u) + (k & 3u)); }

namespace pg8 {
constexpr int BM = 256, BK = 64, HALF = 128, HTB = HALF * BK * 2, STAGE_BYTES = 8 * HTB, NXCD = 8, WGM = 8;
__host__ __device__ __forceinline__ int lds_byte(int r, int c) { const int st = (r >> 4) * 2 + (c >> 5), rr = r & 15, cc = c & 31, ob = rr * 64 + cc * 2; return st * 1024 + (ob ^ (((ob >> 9) & 1) << 5)); }
__host__ __device__ __forceinline__ void stage_rc(int b, int& R, int& C) { const int st = b / 1024, sb = b % 1024, swz = sb ^ (((sb >> 9) & 1) << 5); R = (st >> 1) * 16 + swz / 64; C = (st & 1) * 32 + (swz % 64) / 2; }
__host__ __device__ __forceinline__ int perm32(int rho) { const int n = rho >> 4, i = rho & 15; return 8 * (i >> 2) + 4 * n + (i & 3); }
struct Unit { int pm, pn; };
struct Gemm { const bf16* A; const bf16* Bt; int lda, ldb, K, nM, nN, a_shift, a_koff; };
struct StaticOrder {
    int nM, nN, nwg, G, c, mode;
    DI void init(int nM_, int nN_, int G_, int c_, int mode_ = 0) { nM = nM_; nN = nN_; nwg = nM * nN; G = G_; c = c_; mode = mode_; }
    DI bool next(int i, Unit& u) const {
        long L = (long)i * G + c;
        if (mode == 1) { if (i == 5) L = c < 128 ? 1280 + c : (c >= 192 ? 1280 + 128 + (c - 192) : nwg); else if (i == 6) L = c < 128 ? 1472 + c : nwg; else if (i > 6) L = nwg; }
        if (mode == 2) { if (i == 3) L = (c >= 128 && c < 192) ? 768 + (c - 128) : nwg; else if (i > 3) L = nwg; }
        if (L >= nwg) return false;
        int wgid = (int)L; { const int q = nwg / NXCD, r = nwg % NXCD, xcd = wgid % NXCD, off = wgid / NXCD; wgid = (xcd < r ? xcd * (q + 1) : r * (q + 1) + (xcd - r) * q) + off; }
        const int nig = WGM * nN, gid = wgid / nig, fm = gid * WGM, gsz = (nM - fm) < WGM ? (nM - fm) : WGM;
        u.pm = fm + ((wgid % nig) % gsz); u.pn = (wgid % nig) / gsz; return true;
    }
};
struct EpiBf16 {
    bf16* O; int ldc;
    DI void operator()(const f32x4 (&acc)[2][2][4][2], const Unit& u, int wr, int wc, int fr, int fq) const {
        const int row0 = u.pm * BM + wr * 64 + fr, col0 = u.pn * BM + wc * 32 + 8 * fq;
#pragma unroll
        for (int ai = 0; ai < 2; ++ai)
#pragma unroll
            for (int m = 0; m < 4; ++m) { bf16* rowp = O + (size_t)(row0 + ai * HALF + m * 16) * ldc + col0;
#pragma unroll
                for (int bj = 0; bj < 2; ++bj) { const f32x4 v0 = acc[ai][bj][m][0], v1 = acc[ai][bj][m][1];
                    u32x4 w; w.x = cvt_pk_bf16(v0[0], v0[1]); w.y = cvt_pk_bf16(v0[2], v0[3]); w.z = cvt_pk_bf16(v1[0], v1[1]); w.w = cvt_pk_bf16(v1[2], v1[3]);
                    *(u32x4*)(rowp + bj * HALF) = w; } }
    }
};
struct EpiBf16S {
    bf16* O; int ldc; float scale;
    DI void operator()(const f32x4 (&acc)[2][2][4][2], const Unit& u, int wr, int wc, int fr, int fq) const {
        const int row0 = u.pm * BM + wr * 64 + fr, col0 = u.pn * BM + wc * 32 + 8 * fq;
#pragma unroll
        for (int ai = 0; ai < 2; ++ai)
#pragma unroll
            for (int m = 0; m < 4; ++m) { bf16* rowp = O + (size_t)(row0 + ai * HALF + m * 16) * ldc + col0;
#pragma unroll
                for (int bj = 0; bj < 2; ++bj) { const f32x4 v0 = acc[ai][bj][m][0] * scale, v1 = acc[ai][bj][m][1] * scale;
                    u32x4 w; w.x = cvt_pk_bf16(v0[0], v0[1]); w.y = cvt_pk_bf16(v0[2], v0[3]); w.z = cvt_pk_bf16(v1[0], v1[1]); w.w = cvt_pk_bf16(v1[2], v1[3]);
                    *(u32x4*)(rowp + bj * HALF) = w; } }
    }
};
struct EpiSwiglu8 {
    unsigned char* Hh;
    DI void operator()(const f32x4 (&acc)[2][2][4][2], const Unit& u, int wr, int wc, int fr, int fq) const {
        const int row0 = u.pm * BM + wr * 64 + fr, col0 = u.pn * HALF + wc * 32 + 8 * fq;
#pragma unroll
        for (int ai = 0; ai < 2; ++ai)
#pragma unroll
            for (int m = 0; m < 4; ++m) { unsigned char* rowp = Hh + (size_t)(row0 + ai * HALF + m * 16) * DFF + col0;
                float r[8];
#pragma unroll
                for (int n = 0; n < 2; ++n)
#pragma unroll
                    for (int j = 0; j < 4; ++j) { const float g = acc[ai][0][m][n][j] * (1.0f / F8_SW1), uu = acc[ai][1][m][n][j] * (F8_SH / F8_SW1); r[4 * n + j] = g * fast_sigmoid(g) * uu; }
                u32x2 w; w.x = pk4_fp8(r[0], r[1], r[2], r[3]); w.y = pk4_fp8(r[4], r[5], r[6], r[7]);
                *(u32x2*)rowp = w; }
    }
};
struct EpiF8 {
    unsigned char* O; int ldc; float scale;
    DI void operator()(const f32x4 (&acc)[2][2][4][2], const Unit& u, int wr, int wc, int fr, int fq) const {
        const int row0 = u.pm * BM + wr * 64 + fr, col0 = u.pn * BM + wc * 32 + 8 * fq;
#pragma unroll
        for (int ai = 0; ai < 2; ++ai)
#pragma unroll
            for (int m = 0; m < 4; ++m) { unsigned char* rowp = O + (size_t)(row0 + ai * HALF + m * 16) * ldc + col0;
#pragma unroll
                for (int bj = 0; bj < 2; ++bj) { const f32x4 v0 = acc[ai][bj][m][0] * scale, v1 = acc[ai][bj][m][1] * scale;
                    u32x2 w; w.x = pk4_fp8(v0[0], v0[1], v0[2], v0[3]); w.y = pk4_fp8(v1[0], v1[1], v1[2], v1[3]); *(u32x2*)(rowp + bj * HALF) = w; } }
    }
};
struct EpiGate {
    bf16* O; const bf16* gate; const bf16* add; unsigned char* O8; float ascale, oscale;
    DI void operator()(const f32x4 (&acc)[2][2][4][2], const Unit& u, int wr, int wc, int fr, int fq) const {
        const int row0 = u.pm * BM + wr * 64 + fr, col0 = u.pn * BM + wc * 32 + 8 * fq;
#pragma unroll
        for (int ai = 0; ai < 2; ++ai)
#pragma unroll
            for (int m = 0; m < 4; ++m) { const size_t ro = (size_t)(row0 + ai * HALF + m * 16) * D + col0;
#pragma unroll
                for (int bj = 0; bj < 2; ++bj) { const f32x4 v0 = acc[ai][bj][m][0] * ascale, v1 = acc[ai][bj][m][1] * ascale;
                    const u32x4 g = *(const u32x4*)(gate + ro + bj * HALF);
                    float r[8] = { v0[0] * bflo(g.x), v0[1] * bfhi(g.x), v0[2] * bflo(g.y), v0[3] * bfhi(g.y), v1[0] * bflo(g.z), v1[1] * bfhi(g.z), v1[2] * bflo(g.w), v1[3] * bfhi(g.w) };
                    if (add) { const u32x4 a = *(const u32x4*)(add + ro + bj * HALF);
                        r[0] += bflo(a.x); r[1] += bfhi(a.x); r[2] += bflo(a.y); r[3] += bfhi(a.y); r[4] += bflo(a.z); r[5] += bfhi(a.z); r[6] += bflo(a.w); r[7] += bfhi(a.w); }
                    if (O8) { u32x2 w; w.x = pk4_fp8(r[0] * oscale, r[1] * oscale, r[2] * oscale, r[3] * oscale); w.y = pk4_fp8(r[4] * oscale, r[5] * oscale, r[6] * oscale, r[7] * oscale); *(u32x2*)(O8 + ro + bj * HALF) = w; }
                    else { u32x4 w; w.x = cvt_pk_bf16(r[0], r[1]); w.y = cvt_pk_bf16(r[2], r[3]); w.z = cvt_pk_bf16(r[4], r[5]); w.w = cvt_pk_bf16(r[6], r[7]);
                        *(u32x4*)(O + ro + bj * HALF) = w; } } }
    }
};
struct EpiSwiglu {
    bf16* Hh;
    DI void operator()(const f32x4 (&acc)[2][2][4][2], const Unit& u, int wr, int wc, int fr, int fq) const {
        const int row0 = u.pm * BM + wr * 64 + fr, col0 = u.pn * HALF + wc * 32 + 8 * fq;
#pragma unroll
        for (int ai = 0; ai < 2; ++ai)
#pragma unroll
            for (int m = 0; m < 4; ++m) { bf16* rowp = Hh + (size_t)(row0 + ai * HALF + m * 16) * DFF + col0;
                float r[8];
#pragma unroll
                for (int n = 0; n < 2; ++n)
#pragma unroll
                    for (int j = 0; j < 4; ++j) { const float g = acc[ai][0][m][n][j], uu = acc[ai][1][m][n][j]; r[4 * n + j] = g * fast_sigmoid(g) * uu; }
                u32x4 w; w.x = cvt_pk_bf16(r[0], r[1]); w.y = cvt_pk_bf16(r[2], r[3]); w.z = cvt_pk_bf16(r[4], r[5]); w.w = cvt_pk_bf16(r[6], r[7]);
                *(u32x4*)rowp = w; }
    }
};
struct EpiInBf {
    bf16 *qidx, *qm, *km; float* kwraw;
    DI void operator()(const f32x4 (&acc)[2][2][4][2], const Unit& u, int wr, int wc, int fr, int fq) const {
        const int row0 = u.pm * BM + wr * 64 + fr, cl = wc * 32 + 8 * fq; const int pn = u.pn;
        if (pn == 4) {
#pragma unroll
            for (int ai = 0; ai < 2; ++ai)
#pragma unroll
                for (int m = 0; m < 4; ++m) { float* rowp = kwraw + (size_t)(row0 + ai * HALF + m * 16) * 256 + cl;
#pragma unroll
                    for (int bj = 0; bj < 2; ++bj) { *(f32x4*)(rowp + bj * HALF) = acc[ai][bj][m][0]; *(f32x4*)(rowp + bj * HALF + 4) = acc[ai][bj][m][1]; } }
            return;
        }
        bf16* O; int ct;
        if (pn < 4) { O = qidx; ct = pn; } else if (pn < 9) { O = qm; ct = pn - 5; } else { O = km; ct = pn - 9; }
        const int col0 = ct * BM + cl;
#pragma unroll
        for (int ai = 0; ai < 2; ++ai)
#pragma unroll
            for (int m = 0; m < 4; ++m) { bf16* rowp = O + (size_t)(row0 + ai * HALF + m * 16) * 1024 + col0;
#pragma unroll
                for (int bj = 0; bj < 2; ++bj) { const f32x4 v0 = acc[ai][bj][m][0], v1 = acc[ai][bj][m][1];
                    u32x4 w; w.x = cvt_pk_bf16(v0[0], v0[1]); w.y = cvt_pk_bf16(v0[2], v0[3]); w.z = cvt_pk_bf16(v1[0], v1[1]); w.w = cvt_pk_bf16(v1[2], v1[3]);
                    *(u32x4*)(rowp + bj * HALF) = w; } }
    }
};
struct EpiIn8 {
    bf16 *qdsa, *vm, *ga, *gb; float* ckvraw; const float* bgate;
    DI void operator()(const f32x4 (&acc)[2][2][4][2], const Unit& u, int wr, int wc, int fr, int fq) const {
        const int row0 = u.pm * BM + wr * 64 + fr, cl = wc * 32 + 8 * fq; const int pn = u.pn; const float sc = 1.0f / F8_SWI;
        if (pn == 4) {
#pragma unroll
            for (int ai = 0; ai < 2; ++ai)
#pragma unroll
                for (int m = 0; m < 4; ++m) { float* rowp = ckvraw + (size_t)(row0 + ai * HALF + m * 16) * 256 + cl;
#pragma unroll
                    for (int bj = 0; bj < 2; ++bj) { *(f32x4*)(rowp + bj * HALF) = acc[ai][bj][m][0] * sc; *(f32x4*)(rowp + bj * HALF + 4) = acc[ai][bj][m][1] * sc; } }
            return;
        }
        bf16* O; int ldc, ct; const float* bias = nullptr;
        if (pn < 4) { O = qdsa; ldc = 1024; ct = pn; }
        else if (pn < 9) { O = vm; ldc = 1024; ct = pn - 5; }
        else if (pn < 17) { O = ga; ldc = 2048; ct = pn - 9; bias = bgate; }
        else { O = gb; ldc = 2048; ct = pn - 17; bias = bgate + 2048; }
        const int col0 = ct * BM + cl;
#pragma unroll
        for (int ai = 0; ai < 2; ++ai)
#pragma unroll
            for (int m = 0; m < 4; ++m) { bf16* rowp = O + (size_t)(row0 + ai * HALF + m * 16) * ldc + col0;
#pragma unroll
                for (int bj = 0; bj < 2; ++bj) { f32x4 v0 = acc[ai][bj][m][0] * sc, v1 = acc[ai][bj][m][1] * sc;
                    if (bias) { const f32x4 b0 = *(const f32x4*)(bias + col0 + bj * HALF), b1 = *(const f32x4*)(bias + col0 + bj * HALF + 4);
#pragma unroll
                        for (int j = 0; j < 4; ++j) { v0[j] = fast_sigmoid(v0[j] + b0[j]); v1[j] = fast_sigmoid(v1[j] + b1[j]); } }
                    u32x4 w; w.x = cvt_pk_bf16(v0[0], v0[1]); w.y = cvt_pk_bf16(v0[2], v0[3]); w.z = cvt_pk_bf16(v1[0], v1[1]); w.w = cvt_pk_bf16(v1[2], v1[3]);
                    *(u32x4*)(rowp + bj * HALF) = w; } }
    }
};

struct FusedOrder {
    int c;
    DI bool next(int i, Unit& u) const { if (i >= 2) return false; const int xcd = c & 7, j = c >> 3; u.pm = i * 32 + xcd * 4 + (j >> 3); u.pn = j & 7; return true; }
};
struct EpiLn {
    float* x; const float* g; const float* b; float scale; bf16* xb; unsigned char* xb8; unsigned long long* slots; unsigned* cnt;
    DI void run(f32x4 (&acc)[2][2][4][2], const Unit& u, int wr, int wc, int fr_, int fq_, LAS unsigned char* lds, int wid, int lane_) const {
        int fr = fr_, fq = fq_, lane = lane_; asm volatile("" : "+v"(fr), "+v"(fq), "+v"(lane));
        LAS f32x2* P = (LAS f32x2*)(lds + LNT_OFF); LAS f32x2* Sx = (LAS f32x2*)(lds + LNT_OFF + 8192);
        const int row0 = u.pm * BM + wr * 64 + fr, col0 = u.pn * BM + wc * 32 + 8 * fq;
        __builtin_amdgcn_sched_barrier(0);
#pragma unroll
        for (int ai = 0; ai < 2; ++ai)
#pragma unroll
            for (int m = 0; m < 4; ++m) { const float* xr = x + (size_t)(row0 + ai * HALF + m * 16) * D + col0;
#pragma unroll
                for (int bj = 0; bj < 2; ++bj) { const f32x4 x0 = *(const f32x4*)(xr + bj * HALF), x1 = *(const f32x4*)(xr + bj * HALF + 4);
                    acc[ai][bj][m][0] = x0 * ALPHA + acc[ai][bj][m][0] * scale; acc[ai][bj][m][1] = x1 * ALPHA + acc[ai][bj][m][1] * scale; }
                __builtin_amdgcn_sched_barrier(0);
                asm volatile("" : "+v"(acc[ai][0][m][0]), "+v"(acc[ai][0][m][1]), "+v"(acc[ai][1][m][0]), "+v"(acc[ai][1][m][1]) :: "memory"); }
        __builtin_amdgcn_sched_barrier(0);
#pragma unroll
        for (int ai = 0; ai < 2; ++ai)
#pragma unroll
            for (int m = 0; m < 4; ++m) {
                float s = 0.f;
#pragma unroll
                for (int bj = 0; bj < 2; ++bj)
#pragma unroll
                    for (int n = 0; n < 2; ++n) { const f32x4 v = acc[ai][bj][m][n]; s += (v[0] + v[1]) + (v[2] + v[3]); }
                s += __shfl_xor(s, 16); s += __shfl_xor(s, 32);
                const float mw = s * (1.0f / 64.0f); float q = 0.f;
#pragma unroll
                for (int bj = 0; bj < 2; ++bj)
#pragma unroll
                    for (int n = 0; n < 2; ++n) { const f32x4 d = acc[ai][bj][m][n] - mw; q += (d[0] * d[0] + d[1] * d[1]) + (d[2] * d[2] + d[3] * d[3]); }
                q += __shfl_xor(q, 16); q += __shfl_xor(q, 32);
                if (fq == 0) P[(ai * HALF + wr * 64 + m * 16 + fr) * 4 + wc] = (f32x2){mw, q};
            }
        asm volatile("s_waitcnt lgkmcnt(0)" ::: "memory"); __builtin_amdgcn_s_barrier(); asm volatile("" ::: "memory");
        const int row = wid * 32 + (lane & 31);
        if (lane < 32) {
            const f32x2 a = P[row * 4 + 0], b2 = P[row * 4 + 1], c = P[row * 4 + 2], d = P[row * 4 + 3];
            const float mt = (a[0] + b2[0] + c[0] + d[0]) * 0.25f;
            const float da = a[0] - mt, db = b2[0] - mt, dc = c[0] - mt, dd = d[0] - mt;
            const float m2 = (a[1] + b2[1]) + (c[1] + d[1]) + 64.0f * ((da * da + db * db) + (dc * dc + dd * dd));
            __hip_atomic_store(slots + ((size_t)(u.pm * BM + row) * 8 + u.pn), ((unsigned long long)__float_as_uint(m2) << 32) | __float_as_uint(mt), __ATOMIC_RELAXED, __HIP_MEMORY_SCOPE_AGENT);
        }
        asm volatile("s_waitcnt vmcnt(0)" ::: "memory");
        if (lane == 0) __hip_atomic_fetch_add(cnt + 64 * u.pm, 1u, __ATOMIC_RELAXED, __HIP_MEMORY_SCOPE_AGENT);
        if (wid == 0) {
            unsigned sp = 0;
            while ((unsigned)__builtin_amdgcn_readfirstlane(__hip_atomic_load(cnt + 64 * u.pm, __ATOMIC_RELAXED, __HIP_MEMORY_SCOPE_AGENT)) < 64u) { __builtin_amdgcn_s_sleep(1); if (++sp > (1u << 24)) break; }
            __builtin_amdgcn_fence(__ATOMIC_ACQUIRE, "agent");
        }
        asm volatile("s_waitcnt vmcnt(0) lgkmcnt(0)" ::: "memory"); __builtin_amdgcn_s_barrier(); asm volatile("" ::: "memory");
        if (lane < 32) {
            const unsigned long long* sl = slots + (size_t)(u.pm * BM + row) * 8; float mt[8], m2[8]; float ms = 0.f;
#pragma unroll
            for (int t = 0; t < 8; ++t) { const unsigned long long w = __hip_atomic_load(sl + t, __ATOMIC_RELAXED, __HIP_MEMORY_SCOPE_AGENT); mt[t] = __uint_as_float((unsigned)w); m2[t] = __uint_as_float((unsigned)(w >> 32)); ms += mt[t]; }
            const float mean = ms * 0.125f; float q = 0.f;
#pragma unroll
            for (int t = 0; t < 8; ++t) { const float dm = mt[t] - mean; q += m2[t] + 256.0f * dm * dm; }
            Sx[row] = (f32x2){mean, 1.0f / sqrtf(q * (1.0f / D) + LN_EPS)};
        }
        asm volatile("s_waitcnt lgkmcnt(0)" ::: "memory"); __builtin_amdgcn_s_barrier(); asm volatile("" ::: "memory");
        __builtin_amdgcn_sched_barrier(0);
#pragma unroll
        for (int bj = 0; bj < 2; ++bj) {
            const f32x4 g0 = *(const f32x4*)(g + col0 + bj * HALF), g1 = *(const f32x4*)(g + col0 + bj * HALF + 4), b0 = *(const f32x4*)(b + col0 + bj * HALF), b1 = *(const f32x4*)(b + col0 + bj * HALF + 4);
#pragma unroll
            for (int ai = 0; ai < 2; ++ai)
#pragma unroll
                for (int m = 0; m < 4; ++m) { const int rl = ai * HALF + wr * 64 + m * 16 + fr; const f32x2 sr = Sx[rl]; const size_t off = (size_t)(u.pm * BM + rl) * D + col0 + bj * HALF;
                    const f32x4 o0 = (acc[ai][bj][m][0] - sr[0]) * sr[1] * g0 + b0, o1 = (acc[ai][bj][m][1] - sr[0]) * sr[1] * g1 + b1;
                    *(f32x4*)(x + off) = o0; *(f32x4*)(x + off + 4) = o1;
                    if (xb) { u32x4 w; w.x = cvt_pk_bf16(o0[0], o0[1]); w.y = cvt_pk_bf16(o0[2], o0[3]); w.z = cvt_pk_bf16(o1[0], o1[1]); w.w = cvt_pk_bf16(o1[2], o1[3]); *(u32x4*)(xb + off) = w; }
                    if (xb8) { u32x2 w; w.x = pk4_fp8(o0[0], o0[1], o0[2], o0[3]); w.y = pk4_fp8(o1[0], o1[1], o1[2], o1[3]); *(u32x2*)(xb8 + off) = w; }
                    asm volatile("" ::: "memory"); __builtin_amdgcn_sched_barrier(0); }
        }
        asm volatile("s_waitcnt lgkmcnt(0)" ::: "memory"); __builtin_amdgcn_s_barrier(); asm volatile("" ::: "memory");
    }
};

template <class Epi, bool FP8 = false, class Order = StaticOrder, bool LN = false>
DI void gemm_phase(LAS unsigned char* lds, const Gemm g, const Order& So, const Epi& E, int tid_in) {
    int tid_ = tid_in; asm volatile("" : "+v"(tid_));
    const int tid = tid_, wid = __builtin_amdgcn_readfirstlane(tid >> 6), lane = tid & 63, wr = wid >> 2, wc = wid & 3, fr = lane & 15, fq = lane >> 4;
    const int K = g.K, nt = K / BK;
    unsigned voffA[2], voffB[2];
#pragma unroll
    for (int i = 0; i < 2; ++i) { int R, C; stage_rc(tid * 16 + i * 8192, R, C); const int Rb = (R & ~31) + perm32(R & 31);
        voffA[i] = (unsigned)(R * g.lda + C) * 2u; voffB[i] = (unsigned)(Rb * g.ldb + C) * 2u; }
    const size_t kstep = (size_t)(BK * 2);
    const size_t hstepA = (size_t)HALF * g.lda * 2, hstepB = (size_t)HALF * g.ldb * 2;
    const size_t tstepA = 2 * hstepA, tstepB = 2 * hstepB;
    const unsigned ldsw = (unsigned)wid * 1024u;
    const int aoff = lds_byte(wr * 64 + fr, fq * 8), boff = lds_byte(wc * 32 + fr, fq * 8);
    int one8 = 0x7F7F7F7F; asm volatile("" : "+v"(one8));
#define PG8_SA(b, h) (((b) * 2 + (h)) * HTB)
#define PG8_SB(b, h) ((4 + (b) * 2 + (h)) * HTB)
#define PG8_STAGE(bufoff, gbase, voff) do { _Pragma("unroll") for (int _i = 0; _i < 2; ++_i) \
        __builtin_amdgcn_global_load_lds((const unsigned*)((const char*)(gbase) + (voff)[_i]), (LAS unsigned*)(lds + (bufoff) + ldsw + _i * 8192), 16, 0, 0); } while (0)
#define PG8_LDA(dst, b, h) do { _Pragma("unroll") for (int m = 0; m < 4; ++m) { const LAS unsigned char* p_ = lds + PG8_SA(b, h) + aoff + m * 2048; \
        if constexpr (FP8) { const v4i lo_ = *(const LAS v4i*)p_, hi_ = *(const LAS v4i*)(p_ + 1024); dst##8[m] = __builtin_shufflevector(lo_, hi_, 0, 1, 2, 3, 4, 5, 6, 7); } \
        else { dst[m][0] = *(const LAS v4i*)p_; dst[m][1] = *(const LAS v4i*)(p_ + 1024); } } } while (0)
#define PG8_LDB(dst, b, h) do { _Pragma("unroll") for (int n = 0; n < 2; ++n) { const LAS unsigned char* p_ = lds + PG8_SB(b, h) + boff + n * 2048; \
        if constexpr (FP8) { const v4i lo_ = *(const LAS v4i*)p_, hi_ = *(const LAS v4i*)(p_ + 1024); dst##8[n] = __builtin_shufflevector(lo_, hi_, 0, 1, 2, 3, 4, 5, 6, 7); } \
        else { dst[n][0] = *(const LAS v4i*)p_; dst[n][1] = *(const LAS v4i*)(p_ + 1024); } } } while (0)
#define PG8_MMA(ai, bj, At, Bt) do { __builtin_amdgcn_s_setprio(1); _Pragma("unroll") for (int m = 0; m < 4; ++m) _Pragma("unroll") for (int n = 0; n < 2; ++n) { \
        if constexpr (FP8) { asm volatile("v_mfma_scale_f32_16x16x128_f8f6f4 %0, %1, %2, %0, %3, %3 op_sel_hi:[0,0,0]" : "+v"(acc[ai][bj][m][n]) : "v"(Bt##8[n]), "v"(At##8[m]), "v"(one8)); } \
        else { _Pragma("unroll") for (int k = 0; k < 2; ++k) acc[ai][bj][m][n] = __builtin_amdgcn_mfma_f32_16x16x32_bf16(__builtin_bit_cast(bf16x8, Bt[n][k]), __builtin_bit_cast(bf16x8, At[m][k]), acc[ai][bj][m][n], 0, 0, 0); } } \
        __builtin_amdgcn_s_setprio(0); } while (0)
#define PG8_WAIT_V(n) asm volatile("s_waitcnt vmcnt(" #n ")" ::: "memory")
#define PG8_WAIT_L(n) asm volatile("s_waitcnt lgkmcnt(" #n ")" ::: "memory")
#define PG8_BAR __builtin_amdgcn_s_barrier()
#define PG8_SCHED __builtin_amdgcn_sched_barrier(0)
#define PG8_ABASE(u) ((const char*)g.A + (size_t)(u).pm * tstepA + (size_t)(((u).pn >> g.a_shift) * g.a_koff) * 2)
#define PG8_BBASE(u) ((const char*)g.Bt + (size_t)(u).pn * tstepB)
    Unit cur, nxt; int ui = 0;
    if (!So.next(0, cur)) return;
    f32x4 acc[2][2][4][2];
#pragma unroll
    for (int a = 0; a < 2; ++a)
#pragma unroll
        for (int b = 0; b < 2; ++b)
#pragma unroll
            for (int m = 0; m < 4; ++m)
#pragma unroll
                for (int n = 0; n < 2; ++n) acc[a][b][m][n] = (f32x4){0.f, 0.f, 0.f, 0.f};
    v4i At[4][2], B0[2][2], B1[2][2]; v8i At8[4], B08[2], B18[2];
    const char* cA = PG8_ABASE(cur); const char* cB = PG8_BBASE(cur);
    PG8_STAGE(PG8_SB(0, 0), cB, voffB); PG8_STAGE(PG8_SB(0, 1), cB + hstepB, voffB); PG8_STAGE(PG8_SA(0, 0), cA, voffA); PG8_STAGE(PG8_SA(0, 1), cA + hstepA, voffA);
    if (wr == 1) PG8_BAR;
    PG8_WAIT_V(2); PG8_BAR;
    PG8_STAGE(PG8_SB(1, 0), cB + kstep, voffB); PG8_STAGE(PG8_SA(1, 0), cA + kstep, voffA); PG8_STAGE(PG8_SB(1, 1), cB + hstepB + kstep, voffB);
    PG8_WAIT_V(6); PG8_BAR;
    for (;;) {
        const bool has_next = So.next(ui + 1, nxt);
        const char* nA = has_next ? PG8_ABASE(nxt) : cA; const char* nB = has_next ? PG8_BBASE(nxt) : cB;
        for (int t = 0; t < nt; t += 2) {
            const bool last = (t == nt - 2);
            const char* a1 = cA + (size_t)(t + 1) * kstep;
            const char* a2 = last ? nA : cA + (size_t)(t + 2) * kstep; const char* b2 = last ? nB : cB + (size_t)(t + 2) * kstep;
            const char* a3 = a2 + kstep; const char* b3 = b2 + kstep;
            PG8_LDB(B0, 0, 0); PG8_LDB(B1, 0, 1); PG8_SCHED; PG8_LDA(At, 0, 0); PG8_STAGE(PG8_SA(1, 1), a1 + hstepA, voffA);
            PG8_WAIT_V(8); PG8_WAIT_L(0); PG8_BAR; PG8_MMA(0, 0, At, B0); PG8_MMA(0, 1, At, B1); PG8_BAR; PG8_SCHED;
            PG8_LDA(At, 0, 1); PG8_STAGE(PG8_SB(0, 0), b2, voffB); PG8_STAGE(PG8_SB(0, 1), b2 + hstepB, voffB); PG8_STAGE(PG8_SA(0, 0), a2, voffA);
            PG8_WAIT_V(8); PG8_WAIT_L(0); PG8_BAR; PG8_MMA(1, 0, At, B0); PG8_MMA(1, 1, At, B1); PG8_BAR; PG8_SCHED;
            PG8_LDB(B0, 1, 0); PG8_LDB(B1, 1, 1); PG8_SCHED; PG8_LDA(At, 1, 0); PG8_STAGE(PG8_SA(0, 1), a2 + hstepA, voffA);
            PG8_WAIT_V(8); PG8_WAIT_L(0); PG8_BAR; PG8_MMA(0, 0, At, B0); PG8_MMA(0, 1, At, B1); PG8_BAR; PG8_SCHED;
            PG8_LDA(At, 1, 1); PG8_STAGE(PG8_SB(1, 0), b3, voffB); PG8_STAGE(PG8_SB(1, 1), b3 + hstepB, voffB); PG8_STAGE(PG8_SA(1, 0), a3, voffA);
            PG8_WAIT_V(8); PG8_WAIT_L(0); PG8_BAR; PG8_MMA(1, 0, At, B0); PG8_MMA(1, 1, At, B1); PG8_BAR; PG8_SCHED;
        }
        if (wr == 0) PG8_BAR;
        if constexpr (FP8) asm volatile("s_nop 15\n\ts_nop 15" ::: "memory");
        if constexpr (LN) E.run(acc, cur, wr, wc, fr, fq, lds, wid, lane); else E(acc, cur, wr, wc, fr, fq);
        if (!has_next) break;
#pragma unroll
        for (int a = 0; a < 2; ++a)
#pragma unroll
            for (int b = 0; b < 2; ++b)
#pragma unroll
                for (int m = 0; m < 4; ++m)
#pragma unroll
                    for (int n = 0; n < 2; ++n) acc[a][b][m][n] = (f32x4){0.f, 0.f, 0.f, 0.f};
        cur = nxt; cA = nA; cB = nB; ++ui;
        if (wr == 1) PG8_BAR;
    }
    PG8_WAIT_V(0);
    PG8_BAR;
#undef PG8_SA
#undef PG8_SB
#undef PG8_STAGE
#undef PG8_LDA
#undef PG8_LDB
#undef PG8_MMA
#undef PG8_WAIT_V
#undef PG8_WAIT_L
#undef PG8_BAR
#undef PG8_SCHED
#undef PG8_ABASE
#undef PG8_BBASE
}
}

#define XB_TMO      128
#define XB_XCNT(j)  (256  + 64 * (j))
#define XB_XSUB(j)  (1280 + 64 * (j))
#define XB_XGEN(j)  (2304 + 64 * (j))
#define XB_TOP      3328
#define XB_TOPGEN   3392
#define XCD_BAR_WORDS 3456
#define XB_SPIN_CAP (1u << 22)
DI unsigned xb_ld(unsigned* p)              { return __hip_atomic_load(p, __ATOMIC_RELAXED, __HIP_MEMORY_SCOPE_AGENT); }
DI unsigned xb_add(unsigned* p, unsigned v) { return __hip_atomic_fetch_add(p, v, __ATOMIC_RELAXED, __HIP_MEMORY_SCOPE_AGENT); }
DI unsigned xb_xcc_id() { return (unsigned)__builtin_amdgcn_s_getreg((3 << 11) | 20) & 0xFu; }
#define XB_SPIN(cond, bar) do { unsigned _sp = 0; while (cond) { __builtin_amdgcn_s_sleep(1); \
    if ((++_sp & 255u) == 0u) { if (xb_ld(&(bar)[XB_TMO])) break; if (_sp > XB_SPIN_CAP) { atomicAdd(&(bar)[XB_TMO], 1u); break; } } } } while (0)
struct XcdBarrier { unsigned* bar; unsigned x; volatile LAS unsigned* st; int w0; };
DI XcdBarrier xcd_barrier_post(unsigned* bar, volatile LAS unsigned* st) {
    XcdBarrier b; b.bar = bar; b.x = xb_xcc_id(); b.st = st; b.w0 = __builtin_amdgcn_readfirstlane((int)threadIdx.x >> 6);
    if (threadIdx.x == 0) (void)xb_add(&bar[XB_XCNT(b.x)], 1u);
    return b;
}
DI void xcd_barrier_complete(unsigned* bar, unsigned x, unsigned& nloc, unsigned& nx) {
    const unsigned G = gridDim.x * gridDim.y * gridDim.z;
    unsigned sum, cnt, mine, sp = 0u;
    for (;;) {
        sum = 0u; cnt = 0u; mine = 0u;
#pragma unroll
        for (unsigned j = 0; j < 16; ++j) { const unsigned c = xb_ld(&bar[XB_XCNT(j)]); sum += c; cnt += (c > 0u) ? 1u : 0u; mine = (j == x) ? c : mine; }
        if (sum == G) break;
        __builtin_amdgcn_s_sleep(1);
        if ((++sp & 255u) == 0u) { if (xb_ld(&bar[XB_TMO])) break; if (sp > XB_SPIN_CAP) { atomicAdd(&bar[XB_TMO], 1u); break; } }
    }
    nloc = mine > 0u ? mine : 1u; nx = cnt > 0u ? cnt : 1u;
}
DI void xcd_barrier(const XcdBarrier& b) {
    asm volatile("s_waitcnt vmcnt(0)" ::: "memory");
    __syncthreads();
    if (b.w0 == 0 && lane_id() == 0) {
        unsigned* bar = b.bar;
        __builtin_amdgcn_s_waitcnt(0);
        unsigned nloc = b.st[0], nx = b.st[1];
        if (nloc == 0u) { xcd_barrier_complete(bar, b.x, nloc, nx); b.st[0] = nloc; b.st[1] = nx; }
        const unsigned old = xb_add(&bar[XB_XSUB(b.x)], 1u);
        const unsigned gen = old / nloc;
        if (old + 1u == (gen + 1u) * nloc) {
            __builtin_amdgcn_fence(__ATOMIC_RELEASE, "agent");
            asm volatile("s_waitcnt vmcnt(0)" ::: "memory");
            const unsigned og = xb_add(&bar[XB_TOP], 1u);
            const unsigned tg = og / nx;
            if (og + 1u == (tg + 1u) * nx) xb_add(&bar[XB_TOPGEN], 1u);
            else XB_SPIN(xb_ld(&bar[XB_TOPGEN]) == tg, bar);
            __builtin_amdgcn_fence(__ATOMIC_ACQUIRE, "agent");
            xb_add(&bar[XB_XGEN(b.x)], 1u);
            asm volatile("s_waitcnt vmcnt(0)" ::: "memory");
        } else {
            XB_SPIN(xb_ld(&bar[XB_XGEN(b.x)]) == gen, bar);
            __builtin_amdgcn_fence(__ATOMIC_ACQUIRE, "agent");
            asm volatile("s_waitcnt vmcnt(0)" ::: "memory");
        }
    }
    __syncthreads();
}

struct Args { const float* in[19]; float* out; unsigned char* ws; int ph_lo, ph_hi; };
struct Frame {
    LAS unsigned char* lds; unsigned char* ws; gu32* ctl;
    int tid, lane, wave, bx, G;
};
DI Frame make_frame(unsigned char* ws_in, LAS unsigned char* lds_in, int w0) {
    Frame F; GAS unsigned char* w = (GAS unsigned char*)ws_in; asm volatile("" : "+s"(w)); int t = w0 * 64 + lane_id(); asm volatile("" : "+v"(t));
    F.lds = lds_in; F.ws = (unsigned char*)w; F.ctl = (gu32*)(w + WS_CTL);
    F.tid = t; F.lane = t & 63; F.wave = __builtin_amdgcn_readfirstlane(t >> 6); F.bx = blockIdx.x; F.G = gridDim.x;
    return F;
}

template <int MAP> DI int conv_rowmap(int n) {
    if (MAP == 1) return n < 2384 ? n : n + 176;
    if (MAP == 2) { const int isu = n >= DFF ? 1 : 0, j = n - isu * DFF; return 256 * (j >> 7) + 128 * isu + (j & 127); }
    return n;
}
template <int MAP> DI void conv_item(const float* W, int N, bf16* WT, int ldd, LAS float* scr, int kb, int nb, int lane) {
    const int k0 = 64 * kb, n0 = 32 * nb;
    const bool nok = n0 + (lane & 31) < N;
    { float v[32]; const float* wp = W + (size_t)(k0 + (lane >> 5)) * N + n0 + (lane & 31);
#pragma unroll
      for (int i = 0; i < 32; ++i) v[i] = nok ? wp[(size_t)(2 * i) * N] : 0.f;
#pragma unroll
      for (int i = 0; i < 32; ++i) scr[(2 * i + (lane >> 5)) * 33 + (lane & 31)] = v[i]; }
    asm volatile("s_waitcnt lgkmcnt(0)" ::: "memory");
    const int c = lane & 7;
#pragma unroll
    for (int j = 0; j < 4; ++j) { const int n = (lane >> 3) + 8 * j; const LAS float* s = scr + (8 * c) * 33 + n;
        u32x4 o; o.x = pk2(s[0 * 33], s[1 * 33]); o.y = pk2(s[2 * 33], s[3 * 33]); o.z = pk2(s[4 * 33], s[5 * 33]); o.w = pk2(s[6 * 33], s[7 * 33]);
        if (n0 + n < N) *(u32x4*)(WT + (size_t)conv_rowmap<MAP>(n0 + n) * ldd + k0 + 8 * c) = o; }
    asm volatile("s_waitcnt lgkmcnt(0)" ::: "memory");
}
template <int MAP> DI void conv_item8(const float* W, int N, unsigned char* WT, int ldd, LAS float* scr, int kb, int nb, int lane, float scale) {
    const int k0 = 64 * kb, n0 = 32 * nb;
    const bool nok = n0 + (lane & 31) < N;
    { float v[32]; const float* wp = W + (size_t)(k0 + (lane >> 5)) * N + n0 + (lane & 31);
#pragma unroll
      for (int i = 0; i < 32; ++i) v[i] = nok ? wp[(size_t)(2 * i) * N] : 0.f;
#pragma unroll
      for (int i = 0; i < 32; ++i) scr[(2 * i + (lane >> 5)) * 33 + (lane & 31)] = v[i]; }
    asm volatile("s_waitcnt lgkmcnt(0)" ::: "memory");
    const int c = lane & 3;
#pragma unroll
    for (int j = 0; j < 2; ++j) { const int n = (lane >> 2) + 16 * j; const LAS float* s = scr + (16 * c) * 33 + n;
        u32x4 o; o.x = pk4_fp8(s[0 * 33] * scale, s[1 * 33] * scale, s[2 * 33] * scale, s[3 * 33] * scale); o.y = pk4_fp8(s[4 * 33] * scale, s[5 * 33] * scale, s[6 * 33] * scale, s[7 * 33] * scale);
        o.z = pk4_fp8(s[8 * 33] * scale, s[9 * 33] * scale, s[10 * 33] * scale, s[11 * 33] * scale); o.w = pk4_fp8(s[12 * 33] * scale, s[13 * 33] * scale, s[14 * 33] * scale, s[15 * 33] * scale);
        if (n0 + n < N) *(u32x4*)(WT + (size_t)conv_rowmap<MAP>(n0 + n) * ldd + k0 + 16 * c) = o; }
    asm volatile("s_waitcnt lgkmcnt(0)" ::: "memory");
}
DI int win_rowmap(int c) {
    if (c < 1024) return -1 - c;
    if (c < 1280) return -1 - c;
    if (c < 2304) return c - 1280;
    if (c < 2384) return c - 2304 + 1024;
    if (c < 3408) return c - 2384 + 1280;
    if (c < 4432) return c - 3408 + 2304;
    if (c < 5456) return -1 - (c - 4432 + 1280);
    if (c < 7504) return -1 - (c - 5456 + 2304);
    return -1 - (c - 7504 + 4352);
}
DI void conv_item_win(const float* W, bf16* WTb, unsigned char* WT8, LAS float* scr, int kb, int nb, int lane) {
    const int N = INW, k0 = 64 * kb, n0 = 32 * nb;
    const bool nok = n0 + (lane & 31) < N;
    { float v[32]; const float* wp = W + (size_t)(k0 + (lane >> 5)) * N + n0 + (lane & 31);
#pragma unroll
      for (int i = 0; i < 32; ++i) v[i] = nok ? wp[(size_t)(2 * i) * N] : 0.f;
#pragma unroll
      for (int i = 0; i < 32; ++i) scr[(2 * i + (lane >> 5)) * 33 + (lane & 31)] = v[i]; }
    asm volatile("s_waitcnt lgkmcnt(0)" ::: "memory");
    const int last = n0 + 31 < N ? n0 + 31 : N - 1;
    if (win_rowmap(n0) >= 0 || win_rowmap(last) >= 0) {
        const int c = lane & 7;
#pragma unroll
        for (int j = 0; j < 4; ++j) { const int n = (lane >> 3) + 8 * j; const LAS float* s = scr + (8 * c) * 33 + n; const int rm = n0 + n < N ? win_rowmap(n0 + n) : -1;
            u32x4 o; o.x = pk2(s[0 * 33], s[1 * 33]); o.y = pk2(s[2 * 33], s[3 * 33]); o.z = pk2(s[4 * 33], s[5 * 33]); o.w = pk2(s[6 * 33], s[7 * 33]);
            if (rm >= 0) *(u32x4*)(WTb + (size_t)rm * D + k0 + 8 * c) = o; }
    }
    if (win_rowmap(n0) < 0 || win_rowmap(last) < 0) {
        const int c = lane & 3;
#pragma unroll
        for (int j = 0; j < 2; ++j) { const int n = (lane >> 2) + 16 * j; const LAS float* s = scr + (16 * c) * 33 + n; const int rm = n0 + n < N ? win_rowmap(n0 + n) : 0;
            u32x4 o; o.x = pk4_fp8(s[0 * 33] * F8_SWI, s[1 * 33] * F8_SWI, s[2 * 33] * F8_SWI, s[3 * 33] * F8_SWI); o.y = pk4_fp8(s[4 * 33] * F8_SWI, s[5 * 33] * F8_SWI, s[6 * 33] * F8_SWI, s[7 * 33] * F8_SWI);
            o.z = pk4_fp8(s[8 * 33] * F8_SWI, s[9 * 33] * F8_SWI, s[10 * 33] * F8_SWI, s[11 * 33] * F8_SWI); o.w = pk4_fp8(s[12 * 33] * F8_SWI, s[13 * 33] * F8_SWI, s[14 * 33] * F8_SWI, s[15 * 33] * F8_SWI);
            if (rm < 0) *(u32x4*)(WT8 + (size_t)(-1 - rm) * D + k0 + 16 * c) = o; }
    }
    asm volatile("s_waitcnt lgkmcnt(0)" ::: "memory");
}
DI void zero_rows(bf16* p, int rows, int cols, int ld, int gt, int ngt) {
    const int cpr = cols / 8; unsigned z0; asm volatile("v_mov_b32 %0, 0" : "=v"(z0)); const u32x4 z = {z0, z0, z0, z0};
    for (int i = gt; i < rows * cpr; i += ngt) *(u32x4*)(p + (size_t)(i / cpr) * ld + (i % cpr) * 8) = z;
}
DI void conv_phase(const Frame& F, const Args& a, int l) {
    LAS float* scr = (LAS float*)(F.lds + F.wave * 16384);
    const int gw = F.bx * NWAVES + F.wave, NGW = F.G * NWAVES, lane = F.lane;
    unsigned char* ws = F.ws;
    const float* w_in = a.in[2] + (size_t)l * D * INW; const float* w_uk = a.in[7] + (size_t)l * NH * HD * CKV; const float* w_uv = a.in[8] + (size_t)l * NH * CKV * HD;
    const float* w_oa = a.in[9] + (size_t)l * 1024 * D; const float* w_ob = a.in[10] + (size_t)l * 1024 * D; const float* w_out = a.in[11] + (size_t)l * D * D;
    const float* w_qm = a.in[12] + (size_t)l * D * 512; const float* w_om = a.in[14] + (size_t)l * 512 * D;
    const float* w_f1 = a.in[15] + (size_t)l * D * 2 * DFF; const float* w_f2 = a.in[16] + (size_t)l * DFF * D;
    constexpr int NB_IN = (INW + 31) / 32;
    constexpr int I_IN = 32 * NB_IN, I_UK = 8 * 2 * 8, I_UV = 8 * 4 * 4, I_OA = 16 * 64, I_OUT = 32 * 64, I_QM = 32 * 16, I_OM = 8 * 64, I_F1 = 32 * 352, I_F2 = 88 * 64, I_KV = 4 * 32 * 32;
    const int total = I_IN + I_UK + I_UV + 2 * I_OA + I_OUT + I_QM + I_OM + I_F1 + I_F2 + (l == 0 ? I_KV : 0);
    for (int it = gw; it < total; it += NGW) {
        int r = it;
        if (r < I_IN) { conv_item_win(w_in, (bf16*)(ws + WS_WIN), ws + WS_WIN8, scr, r / NB_IN, r % NB_IN, lane); continue; } r -= I_IN;
        if (r < I_UK) { const int h = r >> 4, q = r & 15; conv_item<0>(w_uk + (size_t)h * HD * CKV, CKV, (bf16*)(ws + WS_WUK) + (size_t)(h * 256) * 256 + (h & 1) * 128, 256, scr, q >> 3, q & 7, lane); continue; } r -= I_UK;
        if (r < I_UV) { const int h = r >> 4, q = r & 15; conv_item<0>(w_uv + (size_t)h * CKV * HD, HD, (bf16*)(ws + WS_WUV) + (size_t)(h * 128) * 512 + (h & 1) * 256, 512, scr, q >> 2, q & 3, lane); continue; } r -= I_UV;
        if (r < I_OA) { conv_item8<0>(w_oa, D, ws + WS_WOA, 1024, scr, r >> 6, r & 63, lane, F8_SWO); continue; } r -= I_OA;
        if (r < I_OA) { conv_item8<0>(w_ob, D, ws + WS_WOB, 1024, scr, r >> 6, r & 63, lane, F8_SWO); continue; } r -= I_OA;
        if (r < I_OUT) { conv_item8<0>(w_out, D, ws + WS_WOUT, D, scr, r >> 6, r & 63, lane, F8_SWOUT); continue; } r -= I_OUT;
        if (r < I_QM) { conv_item8<0>(w_qm, 512, ws + WS_WQM, D, scr, r >> 4, r & 15, lane, F8_SWQM); continue; } r -= I_QM;
        if (r < I_OM) { conv_item8<0>(w_om, D, ws + WS_WOM, 512, scr, r >> 6, r & 63, lane, F8_SWOM); continue; } r -= I_OM;
        if (r < I_F1) { conv_item8<2>(w_f1, 2 * DFF, ws + WS_WF1, D, scr, r / 352, r % 352, lane, F8_SW1); continue; } r -= I_F1;
        if (r < I_F2) { conv_item8<0>(w_f2, D, ws + WS_WF2, DFF, scr, r >> 6, r & 63, lane, F8_SW2); continue; } r -= I_F2;
        { const int ll = r >> 10, q = r & 1023; conv_item<0>(a.in[13] + (size_t)ll * D * 1024, 1024, (bf16*)(ws + WS_WKV) + (size_t)ll * 1024 * D, D, scr, q >> 5, q & 31, lane); }
    }
    const int gt = F.bx * NTHREADS + F.tid, ngt = F.G * NTHREADS;
    zero_rows((bf16*)(ws + WS_WIN) + (size_t)1104 * D, 176, D, D, gt, ngt);
    for (int h = 0; h < NH; ++h) {
        zero_rows((bf16*)(ws + WS_WUK) + (size_t)(h * 256) * 256 + ((h + 1) & 1) * 128, 256, 128, 256, gt, ngt);
        zero_rows((bf16*)(ws + WS_WUV) + (size_t)(h * 128) * 512 + ((h + 1) & 1) * 256, 128, 256, 512, gt, ngt);
    }
    if (l == 0) {
        const f32x4* xs = (const f32x4*)a.in[0]; f32x4* xo = (f32x4*)a.out; u32x2* xb = (u32x2*)(ws + WS_XB);
        unsigned* xb8 = (unsigned*)(ws + WS_XB8);
        for (int i = gt; i < S * D / 4; i += ngt) { const f32x4 v = xs[i]; xo[i] = v; u32x2 w; w.x = pk2(v[0], v[1]); w.y = pk2(v[2], v[3]); xb[i] = w; xb8[i] = pk4_fp8(v[0], v[1], v[2], v[3]); }
        const f32x4* ms = (const f32x4*)a.in[1]; u32x2* mb = (u32x2*)(ws + WS_MEMB);
        for (int i = gt; i < NMEM * D / 4; i += ngt) { const f32x4 v = ms[i]; u32x2 w; w.x = pk2(v[0], v[1]); w.y = pk2(v[2], v[3]); mb[i] = w; }
    }
}

DI void norm_phase(const Frame& F, const Args& a, int l) {
    const int gw = F.bx * NWAVES + F.wave, NGW = F.G * NWAVES, lane = F.lane;
    const float* ckv = (const float*)(F.ws + WS_CKVRAW); const float* kw = (const float*)(F.ws + WS_KWRAW);
    const float* kvg = a.in[4] + l * CKV; const float* ig = a.in[5] + l * IDIM; const float* ib = a.in[6] + l * IDIM;
    const f32x4 g4 = *(const f32x4*)(kvg + 4 * lane); const float gi = ig[lane], bi = ib[lane];
    for (int t = gw; t < S; t += NGW) {
        const f32x4 v = *(const f32x4*)(ckv + (size_t)t * 256 + 4 * lane);
        const float ss = wave_sum(v[0] * v[0] + v[1] * v[1] + v[2] * v[2] + v[3] * v[3]);
        const float r = 1.0f / sqrtf(ss * (1.0f / CKV) + LN_EPS);
        *(unsigned*)(F.ws + WS_CKVN + (size_t)t * 256 + 4 * lane) = pk4_fp8(v[0] * r * g4[0], v[1] * r * g4[1], v[2] * r * g4[2], v[3] * r * g4[3]);
        const float k = kw[(size_t)t * 256 + lane];
        const float mu = wave_sum(k) * (1.0f / IDIM); const float d = k - mu; const float var = wave_sum(d * d) * (1.0f / IDIM);
        const float kn = d * (1.0f / sqrtf(var + LN_EPS)) * gi + bi;
        ((bf16*)(F.ws + WS_KIDXN))[(size_t)t * 64 + lane] = (bf16)f2bf(kn);
        if (lane < IH) ((float*)(F.ws + WS_WIDX))[(size_t)t * IH + lane] = kw[(size_t)t * 256 + 64 + lane];
    }
    const bf16* km = (const bf16*)(F.ws + WS_KM);
    for (int u = gw; u < NH * NBLK; u += NGW) {
        const int h = u >> 6, b = u & 63; float s[8] = {0.f, 0.f, 0.f, 0.f, 0.f, 0.f, 0.f, 0.f};
        const u32x4* p = (const u32x4*)(km + (size_t)(b * MBLK + (lane >> 4)) * 1024 + h * HD + 8 * (lane & 15));
#pragma unroll 16
        for (int i = 0; i < MBLK / 4; ++i) { const u32x4 v = p[(size_t)i * (4 * 1024 / 8)];
            s[0] += bflo(v.x); s[1] += bfhi(v.x); s[2] += bflo(v.y); s[3] += bfhi(v.y); s[4] += bflo(v.z); s[5] += bfhi(v.z); s[6] += bflo(v.w); s[7] += bfhi(v.w); }
#pragma unroll
        for (int e = 0; e < 8; ++e) { s[e] += __shfl_xor(s[e], 16); s[e] += __shfl_xor(s[e], 32); }
        if (lane < 16) { float* o = (float*)(F.ws + WS_KMEAN) + (size_t)(h * NBLK + b) * HD + 8 * lane;
            *(f32x4*)o = (f32x4){s[0], s[1], s[2], s[3]} * (1.0f / MBLK); *(f32x4*)(o + 4) = (f32x4){s[4], s[5], s[6], s[7]} * (1.0f / MBLK); }
    }
}

DI void moba_gate_phase(const Frame& F, int l) {
    LAS float* km = (LAS float*)F.lds; LAS unsigned* lcnt = (LAS unsigned*)(F.lds + 32768); LAS unsigned* gbase = lcnt + 64;
    const bf16* qm = (const bf16*)(F.ws + WS_QM); const float* kmean = (const float*)(F.ws + WS_KMEAN);
    unsigned* bcnt = (unsigned*)(F.ctl + CW_BCNT) + l * 512; unsigned* buck = (unsigned*)(F.ws + WS_BUCK);
    for (int u = F.bx; u < NH * 32; u += F.G) {
        const int h = u & 7, ip = u >> 3; const int own = (F.tid < 256) ? ip : 63 - ip; const int t = own * 256 + (F.tid & 255);
        __syncthreads();
        for (int i = F.tid; i < NBLK * HD / 4; i += NTHREADS) ((LAS f32x4*)km)[i] = ((const f32x4*)(kmean + (size_t)h * NBLK * HD))[i];
        if (F.tid < 64) lcnt[F.tid] = 0u;
        __syncthreads();
        float q[HD];
        { const u32x4* qp = (const u32x4*)(qm + (size_t)t * 1024 + h * HD);
#pragma unroll
          for (int c = 0; c < 16; ++c) { const u32x4 qv = qp[c]; q[8 * c + 0] = bflo(qv.x); q[8 * c + 1] = bfhi(qv.x); q[8 * c + 2] = bflo(qv.y); q[8 * c + 3] = bfhi(qv.y);
              q[8 * c + 4] = bflo(qv.z); q[8 * c + 5] = bfhi(qv.z); q[8 * c + 6] = bflo(qv.w); q[8 * c + 7] = bfhi(qv.w); } }
        const float NEG = -__builtin_inff(); float v0 = NEG, v1 = NEG, v2 = NEG; int i0 = -1, i1 = -1, i2 = -1;
        const int bmax = __builtin_amdgcn_readfirstlane(own);
        for (int b = 0; b < bmax; ++b) {
            const LAS f32x4* kr = (const LAS f32x4*)(km + b * HD);
            float d0 = 0.f, d1 = 0.f, d2 = 0.f, d3 = 0.f;
#pragma unroll
            for (int c = 0; c < 32; ++c) { const f32x4 k = kr[c]; d0 += q[4 * c] * k[0]; d1 += q[4 * c + 1] * k[1]; d2 += q[4 * c + 2] * k[2]; d3 += q[4 * c + 3] * k[3]; }
            const float g = (d0 + d1) + (d2 + d3);
            if (g > v0) { v2 = v1; i2 = i1; v1 = v0; i1 = i0; v0 = g; i0 = b; } else if (g > v1) { v2 = v1; i2 = i1; v1 = g; i1 = b; } else if (g > v2) { v2 = g; i2 = b; }
        }
        unsigned lp0 = 0, lp1 = 0, lp2 = 0;
        if (i0 >= 0) lp0 = atomicAdd((unsigned*)&lcnt[i0], 1u);
        if (i1 >= 0) lp1 = atomicAdd((unsigned*)&lcnt[i1], 1u);
        if (i2 >= 0) lp2 = atomicAdd((unsigned*)&lcnt[i2], 1u);
        __syncthreads();
        if (F.tid < 64) { const unsigned c = lcnt[F.tid]; gbase[F.tid] = c ? __hip_atomic_fetch_add(bcnt + h * 64 + F.tid, c, RLX_AGENT) : 0u; }
        __syncthreads();
        unsigned* bh = buck + (size_t)h * BUCK_PER_HEAD;
        if (i0 >= 0) bh[bucket_off(i0) + gbase[i0] + lp0] = ((unsigned)t << 2) | 0u;
        if (i1 >= 0) bh[bucket_off(i1) + gbase[i1] + lp1] = ((unsigned)t << 2) | 1u;
        if (i2 >= 0) bh[bucket_off(i2) + gbase[i2] + lp2] = ((unsigned)t << 2) | 2u;
    }
    __syncthreads();
}

constexpr int IX_KSTRIDE = 144, IX_KBUF = 128 * IX_KSTRIDE;
constexpr int IX_WSTRIDE = 2048 + 64;
constexpr int IX_CSC = 2 * IX_KBUF;
constexpr int IX_CIX = IX_CSC + 8 * IX_WSTRIDE * 4;
static_assert(IX_CIX + 8 * IX_WSTRIDE * 2 <= MISC_OFF, "indexer LDS");
DI unsigned sortable(float f) { const unsigned u = __float_as_uint(f); return (u >> 31) ? ~u : (u | 0x80000000u); }
DI float unsortable(unsigned k) { return __uint_as_float((k >> 31) ? (k ^ 0x80000000u) : ~k); }
DI unsigned popc64(unsigned long long m) { return (unsigned)__builtin_popcountll(m); }
DI unsigned mbcnt64(unsigned long long m) { return __builtin_amdgcn_mbcnt_hi((unsigned)(m >> 32), __builtin_amdgcn_mbcnt_lo((unsigned)m, 0u)); }
template <int APPROX> DI float ix_compact(LAS float* sc, LAS unsigned short* ix, int& n, int lane) {
    unsigned key[16]; unsigned short idv[16];
    const bool big = n > 512;
    unsigned kmax = 0u, kmin = 0xFFFFFFFFu;
#pragma unroll
    for (int j = 0; j < 16; ++j) { const int e = j * 64 + lane; key[j] = 0u; idv[j] = 0;
        if (j < 8 || big) { const bool v = e < n; key[j] = v ? sortable(sc[e]) : 0u; idv[j] = ix[e]; kmax = key[j] > kmax ? key[j] : kmax; const unsigned km = v ? key[j] : 0xFFFFFFFFu; kmin = km < kmin ? km : kmin; } }
#pragma unroll
    for (int o = 1; o < 64; o <<= 1) { const unsigned a = (unsigned)__shfl_xor((int)kmax, o), c = (unsigned)__shfl_xor((int)kmin, o); kmax = a > kmax ? a : kmax; kmin = c < kmin ? c : kmin; }
    const unsigned diff = (unsigned)__builtin_amdgcn_readfirstlane((int)(kmax ^ kmin));
    const int nb = diff ? 32 - __builtin_clz(diff) : 0;
    unsigned cur = (unsigned)__builtin_amdgcn_readfirstlane((int)kmax); cur = nb >= 32 ? 0u : (cur >> nb) << nb;
    unsigned ccur = (unsigned)n;
    for (int b = nb - 1; b >= 0; --b) {
        const unsigned trial = cur | (1u << b); unsigned c = 0;
#pragma unroll
        for (int j = 0; j < 8; ++j) c += popc64(__ballot(key[j] >= trial));
        if (big) {
#pragma unroll
            for (int j = 8; j < 16; ++j) c += popc64(__ballot(key[j] >= trial)); }
        if (c >= (unsigned)TOPK) { cur = trial; ccur = c; if (APPROX && c <= 320u) break; }
    }
    unsigned need_eq = 0x7fffffffu;
    if (!APPROX) { unsigned ngt = 0;
#pragma unroll
        for (int j = 0; j < 16; ++j) ngt += popc64(__ballot(key[j] > cur));
        need_eq = (unsigned)TOPK - ngt; }
    unsigned out = 0, eqseen = 0;
#pragma unroll
    for (int j = 0; j < 16; ++j) {
        if (j < 8 || big) {
            const bool valid = (j * 64 + lane) < n; const bool gt = key[j] > cur, eq = valid && key[j] == cur;
            const unsigned long long em = __ballot(eq); const bool keep = (valid && gt) || (eq && (eqseen + mbcnt64(em)) < need_eq);
            const unsigned long long kmk = __ballot(keep); const unsigned pos = out + mbcnt64(kmk);
            if (keep) { sc[pos] = unsortable(key[j]); ix[pos] = idv[j]; }
            out += popc64(kmk); eqseen += popc64(em);
        }
    }
    n = (int)out; (void)ccur;
    return unsortable(cur);
}
DI float relu_nc(float x) { const int b = __float_as_int(x); return __int_as_float(b > 0 ? b : 0); }
#define IX_SCORE(ACC, KEY0, S_) do { \
    f32x2 s0_ = {0.f, 0.f}, s1_ = {0.f, 0.f}; \
    _Pragma("unroll") for (int i_ = 0; i_ < 4; ++i_) { const f32x2 r0_ = {relu_nc(ACC[2 * i_]), relu_nc(ACC[2 * i_ + 1])}, r1_ = {relu_nc(ACC[8 + 2 * i_]), relu_nc(ACC[9 + 2 * i_])}; \
        s0_ = __builtin_elementwise_fma(r0_, wv2[i_], s0_); s1_ = __builtin_elementwise_fma(r1_, wv2[4 + i_], s1_); } \
    const auto sw_ = __builtin_amdgcn_permlane32_swap(__float_as_uint(s0_[0] + s0_[1]), __float_as_uint(s1_[0] + s1_[1]), false, false); \
    S_ = __uint_as_float(sw_[0]) + __uint_as_float(sw_[1]); \
    S_ = ((KEY0) + r) <= tq ? S_ : NEG; } while (0)
#define IX_APPEND(S_, KEY0) do { \
    const bool pass_ = S_ > thr; \
    const unsigned long long mk_ = __ballot(pass_); \
    if (IX_DRY) { dry_acc += S_; } else { \
        const unsigned mlo_ = (unsigned)mk_, mhi_ = (unsigned)(mk_ >> 32); const int nlo_ = __builtin_popcount(mlo_), nhi_ = __builtin_popcount(mhi_); \
        const unsigned base_ = hh ? (unsigned)(cnt1 - nlo_ + 1024) : (unsigned)cnt0; \
        const unsigned pos_ = __builtin_amdgcn_mbcnt_hi(mhi_, __builtin_amdgcn_mbcnt_lo(mlo_, base_)); \
        const unsigned idx_ = pass_ ? pos_ : (unsigned)(2048 + lane);            \
        csc[idx_] = S_; cix[idx_] = (unsigned short)((KEY0) + r); \
        cnt0 += nlo_; cnt1 += nhi_; \
        if ((cnt0 > cnt1 ? cnt0 : cnt1) > 1024 - 64) { \
            if (cnt0 > 1024 - 64) { const float nt_ = ix_compact<1>(csc, cix, cnt0, lane); thr = hh ? thr : nt_; } \
            if (cnt1 > 1024 - 64) { const float nt_ = ix_compact<1>(csc + 1024, cix + 1024, cnt1, lane); thr = hh ? nt_ : thr; } } \
    } } while (0)
#define IX_PROCESS(ACC, KEY0) do { float sc_; IX_SCORE(ACC, KEY0, sc_); IX_APPEND(sc_, KEY0); } while (0)
#define IX_APPEND2(SA_, KEYA, SB_, KEYB) do { \
    if (IX_DRY) { dry_acc += SA_ + SB_; } else { \
        const bool pa_ = SA_ > thr, pb_ = SB_ > thr; \
        const unsigned long long ma_ = __ballot(pa_), mb_ = __ballot(pb_); \
        const unsigned alo_ = (unsigned)ma_, ahi_ = (unsigned)(ma_ >> 32), blo_ = (unsigned)mb_, bhi_ = (unsigned)(mb_ >> 32); \
        const int nal_ = __builtin_popcount(alo_), nah_ = __builtin_popcount(ahi_), nbl_ = __builtin_popcount(blo_), nbh_ = __builtin_popcount(bhi_); \
        const unsigned basea_ = hh ? (unsigned)(cnt1 - nal_ + 1024) : (unsigned)cnt0; \
        const unsigned baseb_ = hh ? (unsigned)(cnt1 + nah_ - nbl_ + 1024) : (unsigned)(cnt0 + nal_); \
        const unsigned posa_ = __builtin_amdgcn_mbcnt_hi(ahi_, __builtin_amdgcn_mbcnt_lo(alo_, basea_)), posb_ = __builtin_amdgcn_mbcnt_hi(bhi_, __builtin_amdgcn_mbcnt_lo(blo_, baseb_)); \
        const unsigned ia_ = pa_ ? posa_ : (unsigned)(2048 + lane), ib_ = pb_ ? posb_ : (unsigned)(2048 + lane); \
        csc[ia_] = SA_; cix[ia_] = (unsigned short)((KEYA) + r); csc[ib_] = SB_; cix[ib_] = (unsigned short)((KEYB) + r); \
        cnt0 += nal_ + nbl_; cnt1 += nah_ + nbh_; \
        if ((cnt0 > cnt1 ? cnt0 : cnt1) > 1024 - 64) { \
            if (cnt0 > 1024 - 64) { const float nt_ = ix_compact<1>(csc, cix, cnt0, lane); thr = hh ? thr : nt_; } \
            if (cnt1 > 1024 - 64) { const float nt_ = ix_compact<1>(csc + 1024, cix + 1024, cnt1, lane); thr = hh ? nt_ : thr; } } \
    } } while (0)
#define IX_MMA(ACC, KB, TILE) do { \
    _Pragma("unroll") for (int i_ = 0; i_ < 16; ++i_) ACC[i_] = 0.f; \
    _Pragma("unroll") for (int kk_ = 0; kk_ < 4; ++kk_) { const bf16x8 b_ = *(const LAS bf16x8*)((KB) + boff + (TILE) * (32 * IX_KSTRIDE) + kk_ * 32); \
        ACC = __builtin_amdgcn_mfma_f32_32x32x16_bf16(af[kk_], b_, ACC, 0, 0, 0); } } while (0)
#define IX_LDB(FR, KB, TILE) do { _Pragma("unroll") for (int kk_ = 0; kk_ < 4; ++kk_) FR[kk_] = *(const LAS bf16x8*)((KB) + boff + (TILE) * (32 * IX_KSTRIDE) + kk_ * 32); } while (0)
#define IX_MMAR(ACC, FR) do { \
    _Pragma("unroll") for (int i_ = 0; i_ < 16; ++i_) ACC[i_] = 0.f; \
    _Pragma("unroll") for (int kk_ = 0; kk_ < 4; ++kk_) ACC = __builtin_amdgcn_mfma_f32_32x32x16_bf16(af[kk_], FR[kk_], ACC, 0, 0, 0); } while (0)
#define IX_MMAR_SCORE(ACCN, FR, ACCC, KEY0, S_) do { IX_MMAR(ACCN, FR); IX_SCORE(ACCC, KEY0, S_); \
    _Pragma("unroll") for (int g_ = 0; g_ < 4; ++g_) { __builtin_amdgcn_sched_group_barrier(0x008, 1, 0); __builtin_amdgcn_sched_group_barrier(0x002, 10, 0); } } while (0)
#define IX_SCHED(CH) do { if (!IX_DRY && (((CH) + 1) == 16 || ((CH) + 1) == 32 || ((CH) + 1) == 64)) { \
    if (cnt0 > 320) { const float nt_ = ix_compact<1>(csc, cix, cnt0, lane); thr = hh ? thr : nt_; } \
    if (cnt1 > 320) { const float nt_ = ix_compact<1>(csc + 1024, cix + 1024, cnt1, lane); thr = hh ? nt_ : thr; } } } while (0)
#define IX_CHUNK(KB, CH) do { \
    int nt_w = ((ta + 1 - (CH) * 128) >> 5) + 1; nt_w = nt_w < 0 ? 0 : (nt_w > 4 ? 4 : nt_w); \
    f32x16 accA, accB; \
    if (nt_w == 4) { float qa_, qb_, qc_, qd_; bf16x8 fr0[4], fr1[4], fr2[4], fr3[4]; f32x16 accC, accD;     \
        IX_LDB(fr0, KB, 0); IX_LDB(fr1, KB, 1); IX_LDB(fr2, KB, 2); IX_LDB(fr3, KB, 3); \
        IX_MMAR(accA, fr0); IX_MMAR(accB, fr1); \
        IX_MMAR(accC, fr2); IX_MMAR(accD, fr3); IX_SCORE(accA, (CH) * 128, qa_); IX_SCORE(accB, (CH) * 128 + 32, qb_); \
        IX_APPEND2(qa_, (CH) * 128, qb_, (CH) * 128 + 32); \
        IX_SCORE(accC, (CH) * 128 + 64, qc_); IX_SCORE(accD, (CH) * 128 + 96, qd_); \
        IX_APPEND2(qc_, (CH) * 128 + 64, qd_, (CH) * 128 + 96); \
    } else if (nt_w > 0) { IX_MMA(accA, KB, 0); \
        if (nt_w > 1) IX_MMA(accB, KB, 1); \
        IX_PROCESS(accA, (CH) * 128); \
        if (nt_w > 1) { if (nt_w > 2) IX_MMA(accA, KB, 2); \
            IX_PROCESS(accB, (CH) * 128 + 32); \
            if (nt_w > 2) IX_PROCESS(accA, (CH) * 128 + 64); } } } while (0)
#define IX_LDSBAR() do { asm volatile("s_waitcnt lgkmcnt(0)" ::: "memory"); __builtin_amdgcn_s_barrier(); asm volatile("" ::: "memory"); } while (0)
DI void indexer_phase(const Frame& F) {
    const int lane = F.lane, wave = F.wave, tid = F.tid, r = lane & 31, hh = lane >> 5;
    const bf16* qidx = (const bf16*)(F.ws + WS_QIDX); const bf16* kidx = (const bf16*)(F.ws + WS_KIDXN); const float* widx = (const float*)(F.ws + WS_WIDX);
    unsigned short* sel = (unsigned short*)(F.ws + WS_SEL);
    LAS float* csc = (LAS float*)(F.lds + IX_CSC) + wave * IX_WSTRIDE; LAS unsigned short* cix = (LAS unsigned short*)(F.lds + IX_CIX) + wave * IX_WSTRIDE;
    const float NEG = -__builtin_inff();
    const unsigned boff = (unsigned)(r * IX_KSTRIDE + hh * 16);
    const unsigned sg0 = (unsigned)((tid >> 3) * 64 + (tid & 7) * 8), sl0 = (unsigned)((tid >> 3) * IX_KSTRIDE + (tid & 7) * 16);
    LAS unsigned char* const kb0 = F.lds, * const kb1 = F.lds + IX_KBUF;
#define IX_LOAD(R, CHK) do { const int c_ = (CHK) < nch ? (CHK) : nch - 1; const bf16* g_ = kidx + (size_t)c_ * (128 * 64) + sg0; R[0] = *(const u32x4*)g_; R[1] = *(const u32x4*)(g_ + 64 * 64); } while (0)
#define IX_STORE(KB, R) do { *(LAS u32x4*)((KB) + sl0) = R[0]; *(LAS u32x4*)((KB) + sl0 + 64 * IX_KSTRIDE) = R[1]; } while (0)
    for (int ui = 0; ui * F.G < S / 16; ++ui) {
        const int unit = ui * F.G + ((ui & 1) ? F.G - 1 - F.bx : F.bx);
        if (unit >= S / 16) continue;
        const int t0 = unit * 16, nkeys = t0 + 16, nch = (nkeys + 127) >> 7;
        const int ta = t0 + 2 * wave;
        bf16x8 af[4];
#pragma unroll
        for (int kk = 0; kk < 4; ++kk) af[kk] = *(const bf16x8*)(qidx + (size_t)(ta + (r >> 4)) * 1024 + (r & 15) * 64 + 16 * kk + 8 * hh);
        f32x2 wv2[8];
#pragma unroll
        for (int i = 0; i < 8; ++i) { const int e0 = 2 * i, e1 = 2 * i + 1;
            wv2[i] = (f32x2){widx[(size_t)(ta + (e0 >> 3)) * IH + (e0 & 3) + 8 * ((e0 >> 2) & 1) + 4 * hh], widx[(size_t)(ta + (e1 >> 3)) * IH + (e1 & 3) + 8 * ((e1 >> 2) & 1) + 4 * hh]}; }
        float thr = NEG; int cnt0 = 0, cnt1 = 0; const int tq = ta + hh;
        float dry_acc = 0.f; (void)dry_acc;
#ifdef IX_PROBE
#define IX_DRY 1
        {
        u32x4 RA[2], RB[2];
        IX_LOAD(RA, 0); IX_LOAD(RB, 1);
        IX_STORE(kb0, RA); IX_LOAD(RA, 2);
        for (int ch = 0; ch < nch; ch += 2) {
            IX_LDSBAR();
            IX_CHUNK(kb0, ch); IX_SCHED(ch);
            IX_STORE(kb1, RB); IX_LOAD(RB, ch + 3);
            IX_LDSBAR();
            if (ch + 1 < nch) { IX_CHUNK(kb1, ch + 1); IX_SCHED(ch + 1); }
            IX_STORE(kb0, RA); IX_LOAD(RA, ch + 4);
        }
        }
        if (dry_acc == 123.456f) sel[0] = 0;
        __syncthreads();
#undef IX_DRY
#endif
#define IX_DRY 0
        {
        u32x4 RA[2], RB[2];
        IX_LOAD(RA, 0); IX_LOAD(RB, 1);
        IX_STORE(kb0, RA); IX_LOAD(RA, 2);
        for (int ch = 0; ch < nch; ch += 2) {
            IX_LDSBAR();
            IX_CHUNK(kb0, ch); IX_SCHED(ch);
            IX_STORE(kb1, RB); IX_LOAD(RB, ch + 3);
            IX_LDSBAR();
            if (ch + 1 < nch) { IX_CHUNK(kb1, ch + 1); IX_SCHED(ch + 1); }
            IX_STORE(kb0, RA); IX_LOAD(RA, ch + 4);
        }
        }
#undef IX_DRY
        if (cnt0 > TOPK) (void)ix_compact<0>(csc, cix, cnt0, lane);
        if (cnt1 > TOPK) (void)ix_compact<0>(csc + 1024, cix + 1024, cnt1, lane);
#pragma unroll
        for (int q = 0; q < 2; ++q) { const int n = q ? cnt1 : cnt0;
#pragma unroll
            for (int j = 0; j < 4; ++j) { const int e = j * 64 + lane; sel[(size_t)(ta + q) * TOPK + e] = e < n ? cix[q * 1024 + e] : (unsigned short)0xFFFFu; } }
        __syncthreads();
    }
#undef IX_LOAD
#undef IX_STORE
}
#undef IX_PROCESS
#undef IX_SCORE
#undef IX_APPEND
#undef IX_MMAR_SCORE
#undef IX_MMAR
#undef IX_LDB
#undef IX_MMA
#undef IX_CHUNK
#undef IX_SCHED

constexpr int DA_WBYTES = 16384 + 256;
DI void dsa_attn_phase(const Frame& F) {
    const int lane = F.lane, fr = lane & 15, fq = lane >> 4;
    const bf16* qlat = (const bf16*)(F.ws + WS_QLAT); const bf16* ckv = (const bf16*)(F.ws + WS_CKVN); const unsigned short* sel = (const unsigned short*)(F.ws + WS_SEL);
    bf16* olat = (bf16*)(F.ws + WS_OLAT);
    LAS unsigned char* img = F.lds + F.wave * DA_WBYTES; LAS float* dist = (LAS float*)(img + 16384);
    const unsigned imgaddr = (unsigned)(size_t)img;
    const float slope2 = __builtin_amdgcn_exp2f(-(float)((fr & 7) + 1)) * LOG2E;
    const int gw = F.bx * NWAVES + F.wave, NGW = F.G * NWAVES;
    unsigned kb[2], vb[2];
#pragma unroll
    for (int kt = 0; kt < 2; ++kt) kb[kt] = imgaddr + off_b(perm32rows(16 * kt + fr), fq) - 64u * (unsigned)(fr & 3);
    const unsigned kx = (unsigned)(fr & 3);
#pragma unroll
    for (int tt = 0; tt < 2; ++tt) { const unsigned a0 = tr_addr16(lane, 0, 0, tt); vb[tt] = imgaddr + a0; }
    const unsigned xh = (((unsigned)(lane & 15) >> 2) << 1) | (unsigned)((lane >> 4) & 1);
#pragma unroll
    for (int tt = 0; tt < 2; ++tt) vb[tt] -= 32u * xh;
    for (int t = gw; t < S; t += NGW) {
        const int nvalid = t + 1 < TOPK ? t + 1 : TOPK;
        bf16x8 qf[8];
#pragma unroll
        for (int kk = 0; kk < 8; ++kk) { qf[kk] = (bf16x8){0, 0, 0, 0, 0, 0, 0, 0}; if (fr < 8) qf[kk] = *(const bf16x8*)(qlat + (size_t)t * 2048 + fr * 256 + 32 * kk + 8 * fq); }
        f32x4 o[16];
#pragma unroll
        for (int c = 0; c < 16; ++c) o[c] = (f32x4){0.f, 0.f, 0.f, 0.f};
        float m = -__builtin_inff(), lsum = 0.f;
        int idxn; { const int e = (lane & 31); const int si = sel[(size_t)t * TOPK + e]; idxn = e < nvalid ? si : 0; }
        const unsigned char* ckv8 = (const unsigned char*)ckv;
        u32x4 gA[8];
#pragma unroll
        for (int i = 0; i < 8; ++i) { const int row = (lane >> 4) + 4 * i; const int ki = __shfl(idxn, row); gA[i] = *(const u32x4*)(ckv8 + (size_t)ki * 256 + (lane & 15) * 16); }
        for (int ch = 0; ch < 8; ++ch) {
            unsigned xhl = xh, kxl = kx; asm volatile("" : "+v"(xhl), "+v"(kxl));
            const int myidx = idxn;
            if (ch < 7) { const int e = (ch + 1) * 32 + (lane & 31); const int si = sel[(size_t)t * TOPK + e]; idxn = e < nvalid ? si : 0; }
#pragma unroll
            for (int i = 0; i < 8; ++i) { const unsigned row = (lane >> 4) + 4 * i, p = lane & 15, prow = perm32rows(row); const u32x4 g = gA[i]; unsigned w[8];
#pragma unroll
                for (int q = 0; q < 4; ++q) { const f32x2 lo = __builtin_amdgcn_cvt_pk_f32_fp8((int)g[q], false), hi = __builtin_amdgcn_cvt_pk_f32_fp8((int)g[q], true); w[2 * q] = cvt_pk_bf16(lo[0], lo[1]); w[2 * q + 1] = cvt_pk_bf16(hi[0], hi[1]); }
                LAS unsigned char* hb = img + (p >> 3) * 8192;
                *(LAS u32x4*)(hb + off_b(prow, 2 * (p & 7))) = (u32x4){w[0], w[1], w[2], w[3]}; *(LAS u32x4*)(hb + off_b(prow, 2 * (p & 7) + 1)) = (u32x4){w[4], w[5], w[6], w[7]}; }
            if (lane < 32) { const int e = ch * 32 + lane; dist[lane] = e < nvalid ? (float)(t - myidx) : __builtin_inff(); }
            if (ch < 7) {
#pragma unroll
                for (int i = 0; i < 8; ++i) { const int row = (lane >> 4) + 4 * i; const int ki = __shfl(idxn, row); gA[i] = *(const u32x4*)(ckv8 + (size_t)ki * 256 + (lane & 15) * 16); } }
            f32x4 sacc[2];
#pragma unroll
            for (int kt = 0; kt < 2; ++kt) { sacc[kt] = (f32x4){0.f, 0.f, 0.f, 0.f};
#pragma unroll
                for (int kk = 0; kk < 8; ++kk) { const bf16x8 afr = *(const LAS bf16x8*)(kb[kt] + 64u * ((unsigned)(kk & 3) ^ kxl) + 8192u * (kk >> 2));
                    sacc[kt] = __builtin_amdgcn_mfma_f32_16x16x32_bf16(afr, qf[kk], sacc[kt], 0, 0, 0); } }
            float cmax = -__builtin_inff();
#pragma unroll
            for (int kt = 0; kt < 2; ++kt) { const f32x4 dv = *(const LAS f32x4*)(dist + 16 * kt + 4 * fq);
#pragma unroll
                for (int i = 0; i < 4; ++i) { sacc[kt][i] = sacc[kt][i] * ATT_SCALE2 - slope2 * dv[i]; cmax = fmaxf(cmax, sacc[kt][i]); } }
            cmax = xrow16_max(cmax);
            const float mn = fmaxf(m, cmax); const float alpha = __builtin_amdgcn_exp2f(m - mn); m = mn;
            float ps = 0.f;
#pragma unroll
            for (int kt = 0; kt < 2; ++kt)
#pragma unroll
                for (int i = 0; i < 4; ++i) { sacc[kt][i] = __builtin_amdgcn_exp2f(sacc[kt][i] - mn); ps += sacc[kt][i]; }
            ps = xrow16_sum(ps); lsum = lsum * alpha + ps;
            u32x4 pw; pw.x = cvt_pk_bf16(sacc[0][0], sacc[0][1]); pw.y = cvt_pk_bf16(sacc[0][2], sacc[0][3]); pw.z = cvt_pk_bf16(sacc[1][0], sacc[1][1]); pw.w = cvt_pk_bf16(sacc[1][2], sacc[1][3]);
            const bf16x8 pf = __builtin_bit_cast(bf16x8, pw);
#pragma unroll
            for (int c = 0; c < 16; ++c) {
                o[c] = o[c] * alpha;
                const unsigned cx = 32u * ((unsigned)(c & 7) ^ xhl); const s16x4 lo = vtr(vb[0] + cx + 8192u * (c >> 3)), hi = vtr(vb[1] + cx + 8192u * (c >> 3));
                const bf16x8 vfr = __builtin_shufflevector(lo, hi, 0, 1, 2, 3, 4, 5, 6, 7);
                o[c] = __builtin_amdgcn_mfma_f32_16x16x32_bf16(vfr, pf, o[c], 0, 0, 0);
                if ((c & 3) == 3) __builtin_amdgcn_sched_barrier(0);
            }
        }
        const float inv = 1.0f / lsum;
        if (fr < 8) {
#pragma unroll
            for (int c = 0; c < 16; ++c) { u32x2 w; w.x = cvt_pk_bf16(o[c][0] * inv, o[c][1] * inv); w.y = cvt_pk_bf16(o[c][2] * inv, o[c][3] * inv);
                *(u32x2*)(olat + (size_t)t * 2048 + fr * 256 + 16 * c + 4 * fq) = w; }
        }
    }
}

struct BlkAttn { const bf16* K; const bf16* V; int kvld; };
DI void blk_stage(const Frame& F, const bf16* Kp, const bf16* Vp, int kvld) {
    int tl = F.tid; asm volatile("" : "+v"(tl));
#pragma unroll 4
    for (int i = 0; i < 8; ++i) { const int p = tl + 512 * i; const unsigned row = p >> 4, ch = p & 15;
        const u32x4 kv = *(const u32x4*)(Kp + (size_t)row * kvld + ch * 8); const u32x4 vv = *(const u32x4*)(Vp + (size_t)row * kvld + ch * 8);
        *(LAS u32x4*)(F.lds + off_b(row, ch)) = kv; *(LAS u32x4*)(F.lds + 65536 + off_b(perm32rows(row), ch)) = vv; }
}
DI void blk_core(const Frame& F, const bf16* qrow, int tq, int kpos0, float slope2, bool causal, f32x4 (&o)[8], float& m_out, float& l_out) {
    const int lane = F.lane, fr = lane & 15, fq = lane >> 4;
    const unsigned kimg = (unsigned)(size_t)F.lds, vimg = kimg + 65536;
    bf16x8 qf[4];
#pragma unroll
    for (int kk = 0; kk < 4; ++kk) qf[kk] = *(const bf16x8*)(qrow + 32 * kk + 8 * fq);
    unsigned kb[4];
#pragma unroll
    for (int kk = 0; kk < 4; ++kk) kb[kk] = kimg + off_b(fr, 4 * kk + fq);
    f32x4 s[16];
#pragma unroll
    for (int kt = 0; kt < 16; ++kt) { s[kt] = (f32x4){0.f, 0.f, 0.f, 0.f};
#pragma unroll
        for (int kk = 0; kk < 4; ++kk) { const bf16x8 afr = *(const LAS bf16x8*)(kb[kk] + 4096u * kt);
            s[kt] = __builtin_amdgcn_mfma_f32_16x16x32_bf16(afr, qf[kk], s[kt], 0, 0, 0); }
        if ((kt & 3) == 3) __builtin_amdgcn_sched_barrier(0); }
    float mx = -__builtin_inff();
    const float dq = (float)(tq - kpos0 - 4 * fq);
#pragma unroll
    for (int kt = 0; kt < 16; ++kt)
#pragma unroll
        for (int i = 0; i < 4; ++i) { const float dd = dq - (float)(16 * kt + i); float v = s[kt][i] * ATT_SCALE2 - slope2 * dd;
            if (causal && dd < 0.f) v = -__builtin_inff(); s[kt][i] = v; mx = fmaxf(mx, v); }
    mx = xrow16_max(mx);
    float ps = 0.f;
#pragma unroll
    for (int kt = 0; kt < 16; ++kt)
#pragma unroll
        for (int i = 0; i < 4; ++i) { s[kt][i] = __builtin_amdgcn_exp2f(s[kt][i] - mx); ps += s[kt][i]; }
    ps = xrow16_sum(ps);
    unsigned vb[8][2];
#pragma unroll
    for (int dt = 0; dt < 8; ++dt) { vb[dt][0] = vimg + tr_addr16(lane, dt, 0, 0); vb[dt][1] = vimg + tr_addr16(lane, dt, 0, 1); }
#pragma unroll
    for (int dt = 0; dt < 8; ++dt) o[dt] = (f32x4){0.f, 0.f, 0.f, 0.f};
#pragma unroll
    for (int ks = 0; ks < 8; ++ks) {
        u32x4 pw; pw.x = cvt_pk_bf16(s[2 * ks][0], s[2 * ks][1]); pw.y = cvt_pk_bf16(s[2 * ks][2], s[2 * ks][3]); pw.z = cvt_pk_bf16(s[2 * ks + 1][0], s[2 * ks + 1][1]); pw.w = cvt_pk_bf16(s[2 * ks + 1][2], s[2 * ks + 1][3]);
        const bf16x8 pf = __builtin_bit_cast(bf16x8, pw);
#pragma unroll
        for (int dt = 0; dt < 8; ++dt) { const s16x4 lo = vtr(vb[dt][0] + 8192u * ks), hi = vtr(vb[dt][1] + 8192u * ks);
            const bf16x8 vfr = __builtin_shufflevector(lo, hi, 0, 1, 2, 3, 4, 5, 6, 7);
            o[dt] = __builtin_amdgcn_mfma_f32_16x16x32_bf16(vfr, pf, o[dt], 0, 0, 0); }
        __builtin_amdgcn_sched_barrier(0);
    }
    const float inv = 1.0f / ps;
#pragma unroll
    for (int dt = 0; dt < 8; ++dt) o[dt] = o[dt] * inv;
    m_out = mx; l_out = ps;
}

#define BLK2_SOFTMAX(S_, O_, M_, L_, DQ_) do { \
    float mx_ = -__builtin_inff(); \
    _Pragma("unroll") for (int kt = 0; kt < 8; ++kt) _Pragma("unroll") for (int i = 0; i < 4; ++i) { const float dd_ = (DQ_) - (float)(16 * kt + i); float v_ = S_[kt][i] * ATT_SCALE2 - slope2 * dd_; \
        if (causal && dd_ < 0.f) v_ = -__builtin_inff(); S_[kt][i] = v_; mx_ = fmaxf(mx_, v_); } \
    mx_ = xrow16_max(mx_); const float mn_ = fmaxf(M_, mx_); const float al_ = __builtin_amdgcn_exp2f(M_ - mn_); M_ = mn_; float ps_ = 0.f; \
    _Pragma("unroll") for (int kt = 0; kt < 8; ++kt) _Pragma("unroll") for (int i = 0; i < 4; ++i) { S_[kt][i] = __builtin_amdgcn_exp2f(S_[kt][i] - mn_); ps_ += S_[kt][i]; } \
    ps_ = xrow16_sum(ps_); L_ = L_ * al_ + ps_; \
    _Pragma("unroll") for (int dt = 0; dt < 8; ++dt) O_[dt] = O_[dt] * al_; } while (0)
DI void blk_core2(const Frame& F, const bf16* qrowA, const bf16* qrowB, int tqA, int tqB, int kpos0, float slope2, bool causal,
                  f32x4 (&oa)[8], f32x4 (&ob)[8], float& mA, float& lA, float& mB, float& lB) {
    int lane = F.lane; asm volatile("" : "+v"(lane));
    const int fr = lane & 15, fq = lane >> 4;
    const unsigned kimg = (unsigned)(size_t)F.lds, vimg = kimg + 65536;
    bf16x8 qa[4], qb[4];
#pragma unroll
    for (int kk = 0; kk < 4; ++kk) { qa[kk] = *(const bf16x8*)(qrowA + 32 * kk + 8 * fq); qb[kk] = *(const bf16x8*)(qrowB + 32 * kk + 8 * fq); }
    const unsigned kbase = kimg + 256u * (unsigned)fr + 16u * ((unsigned)fq ^ (((unsigned)fr >> 2) & 3u)), kx = (unsigned)fr & 3u;
    const unsigned xh = (((unsigned)(lane & 15) >> 2) << 1) | (unsigned)((lane >> 4) & 1);
    unsigned vb[2];
#pragma unroll
    for (int tt = 0; tt < 2; ++tt) vb[tt] = vimg + tr_addr16(lane, 0, 0, tt) - 32u * xh;
#pragma unroll
    for (int dt = 0; dt < 8; ++dt) { oa[dt] = (f32x4){0.f, 0.f, 0.f, 0.f}; ob[dt] = (f32x4){0.f, 0.f, 0.f, 0.f}; }
    mA = -__builtin_inff(); mB = -__builtin_inff(); lA = 0.f; lB = 0.f;
    for (int half = 0; half < 2; ++half) {
        unsigned kxl = kx, xhl = xh; asm volatile("" : "+v"(kxl), "+v"(xhl));
        f32x4 sa[8], sb[8];
#pragma unroll
        for (int kt = 0; kt < 8; ++kt) { sa[kt] = (f32x4){0.f, 0.f, 0.f, 0.f}; sb[kt] = (f32x4){0.f, 0.f, 0.f, 0.f};
#pragma unroll
            for (int kk = 0; kk < 4; ++kk) { const bf16x8 afr = *(const LAS bf16x8*)(kbase + 64u * ((unsigned)kk ^ kxl) + 4096u * (unsigned)(8 * half + kt));
                sa[kt] = __builtin_amdgcn_mfma_f32_16x16x32_bf16(afr, qa[kk], sa[kt], 0, 0, 0); sb[kt] = __builtin_amdgcn_mfma_f32_16x16x32_bf16(afr, qb[kk], sb[kt], 0, 0, 0); }
            if ((kt & 3) == 3) __builtin_amdgcn_sched_barrier(0); }
        const float dqa = (float)(tqA - kpos0 - 128 * half - 4 * fq), dqb = (float)(tqB - kpos0 - 128 * half - 4 * fq);
        BLK2_SOFTMAX(sa, oa, mA, lA, dqa);
        BLK2_SOFTMAX(sb, ob, mB, lB, dqb);
#pragma unroll
        for (int ks = 0; ks < 4; ++ks) {
            u32x4 pw; pw.x = cvt_pk_bf16(sa[2 * ks][0], sa[2 * ks][1]); pw.y = cvt_pk_bf16(sa[2 * ks][2], sa[2 * ks][3]); pw.z = cvt_pk_bf16(sa[2 * ks + 1][0], sa[2 * ks + 1][1]); pw.w = cvt_pk_bf16(sa[2 * ks + 1][2], sa[2 * ks + 1][3]);
            const bf16x8 pfa = __builtin_bit_cast(bf16x8, pw);
            pw.x = cvt_pk_bf16(sb[2 * ks][0], sb[2 * ks][1]); pw.y = cvt_pk_bf16(sb[2 * ks][2], sb[2 * ks][3]); pw.z = cvt_pk_bf16(sb[2 * ks + 1][0], sb[2 * ks + 1][1]); pw.w = cvt_pk_bf16(sb[2 * ks + 1][2], sb[2 * ks + 1][3]);
            const bf16x8 pfb = __builtin_bit_cast(bf16x8, pw);
#pragma unroll
            for (int dt = 0; dt < 8; ++dt) { const unsigned cx = 32u * ((unsigned)dt ^ xhl) + 8192u * (unsigned)(4 * half + ks);
                const s16x4 lo = vtr(vb[0] + cx), hi = vtr(vb[1] + cx); const bf16x8 vfr = __builtin_shufflevector(lo, hi, 0, 1, 2, 3, 4, 5, 6, 7);
                oa[dt] = __builtin_amdgcn_mfma_f32_16x16x32_bf16(vfr, pfa, oa[dt], 0, 0, 0); ob[dt] = __builtin_amdgcn_mfma_f32_16x16x32_bf16(vfr, pfb, ob[dt], 0, 0, 0); }
            __builtin_amdgcn_sched_barrier(0);
        }
    }
    const float ia = 1.0f / lA, ib = 1.0f / lB;
#pragma unroll
    for (int dt = 0; dt < 8; ++dt) { oa[dt] = oa[dt] * ia; ob[dt] = ob[dt] * ib; }
}
#undef BLK2_SOFTMAX

DI void moba_attn_phase(const Frame& F, int l) {
    LAS int* pre = (LAS int*)(F.lds + RING_BYTES);
    LAS int* wsum = pre + 520;
    const unsigned* bcnt = (const unsigned*)(F.ctl + CW_BCNT) + l * 512; const unsigned* buck = (const unsigned*)(F.ws + WS_BUCK);
    const bf16* qm = (const bf16*)(F.ws + WS_QM); const bf16* km = (const bf16*)(F.ws + WS_KM); const bf16* vm = (const bf16*)(F.ws + WS_VM);
    bf16* parto = (bf16*)(F.ws + WS_PARTO); f32x2* partml = (f32x2*)(F.ws + WS_PARTML);
    const int tid = F.tid, lane = F.lane, fr = lane & 15, fq = lane >> 4;
    __syncthreads();
    { const int n = (int)__hip_atomic_load(bcnt + tid, RLX_AGENT); const int cntu = 1 + ((n + 255) >> 8);
      int v = cntu;
#pragma unroll
      for (int o = 1; o < 64; o <<= 1) { const int x = __shfl_up(v, o); if (lane >= o) v += x; }
      if (lane == 63) wsum[F.wave] = v;
      __syncthreads();
      int base = 0;
      for (int w = 0; w < F.wave; ++w) base += wsum[w];
      pre[tid + 1] = base + v; if (tid == 0) pre[0] = 0;
      __syncthreads(); }
    const int total = pre[512];
    const int u_lo = (int)(((long)total * F.bx) >> 8), u_hi = (int)(((long)total * (F.bx + 1)) >> 8);
    int staged = -1;
    for (int u = u_lo; u < u_hi; ++u) {
        int lo = 0, hi = 512;
        while (hi - lo > 1) { const int mid = (lo + hi) >> 1; if (pre[mid] <= u) lo = mid; else hi = mid; }
        const int hb = lo, h = hb >> 6, b = hb & 63, sub = u - pre[hb];
        if (staged != hb) { __syncthreads(); blk_stage(F, km + (size_t)(b * MBLK) * 1024 + h * HD, vm + (size_t)(b * MBLK) * 1024 + h * HD, 1024); __syncthreads(); staged = hb; }
        int tq[2], slot[2]; bool valid[2] = {true, true}; const bool causal = sub == 0;
#pragma unroll
        for (int g = 0; g < 2; ++g) {
            if (sub == 0) { tq[g] = b * MBLK + F.wave * 32 + g * 16 + fr; slot[g] = 3; }
            else { const int n = (int)__hip_atomic_load(bcnt + hb, RLX_AGENT); const int e = (sub - 1) * 256 + F.wave * 32 + g * 16 + fr; valid[g] = e < n;
                const unsigned ent = buck[(size_t)h * BUCK_PER_HEAD + bucket_off(b) + (valid[g] ? e : 0)]; tq[g] = (int)(ent >> 2); slot[g] = (int)(ent & 3u); } }
        const float slope2 = __builtin_amdgcn_exp2f(-(float)(h + 1)) * LOG2E;
        f32x4 oa[8], ob[8]; float ma, la, mb, lb;
        blk_core2(F, qm + (size_t)tq[0] * 1024 + h * HD, qm + (size_t)tq[1] * 1024 + h * HD, tq[0], tq[1], b * MBLK, slope2, causal, oa, ob, ma, la, mb, lb);
        if (valid[0]) { const size_t pi = ((size_t)tq[0] * NH + h) * 4 + slot[0];
#pragma unroll
            for (int dt = 0; dt < 8; ++dt) { u32x2 w; w.x = cvt_pk_bf16(oa[dt][0], oa[dt][1]); w.y = cvt_pk_bf16(oa[dt][2], oa[dt][3]); *(u32x2*)(parto + pi * HD + 16 * dt + 4 * fq) = w; }
            if (fq == 0) partml[pi] = (f32x2){ma, la}; }
        if (valid[1]) { const size_t pi = ((size_t)tq[1] * NH + h) * 4 + slot[1];
#pragma unroll
            for (int dt = 0; dt < 8; ++dt) { u32x2 w; w.x = cvt_pk_bf16(ob[dt][0], ob[dt][1]); w.y = cvt_pk_bf16(ob[dt][2], ob[dt][3]); *(u32x2*)(parto + pi * HD + 16 * dt + 4 * fq) = w; }
            if (fq == 0) partml[pi] = (f32x2){mb, lb}; }
    }
    __syncthreads();
}
DI void moba_combine_phase(const Frame& F) {
    const bf16* parto = (const bf16*)(F.ws + WS_PARTO); const f32x2* partml = (const f32x2*)(F.ws + WS_PARTML); bf16* ob = (bf16*)(F.ws + WS_OB);
    const int gt = F.bx * NTHREADS + F.tid, ngt = F.G * NTHREADS;
    for (int i = gt; i < S * NH * 16; i += ngt) {
        const int th = i >> 4, c = i & 15, t = th >> 3; const int own = t >> 8, nsel = own < 3 ? own : 3;
        float mj[4], lj[4]; float M = -__builtin_inff();
#pragma unroll
        for (int j = 0; j < 4; ++j) { const bool on = (j == 3) || (j < nsel); const f32x2 ml = partml[(size_t)th * 4 + j]; mj[j] = on ? ml[0] : -__builtin_inff(); lj[j] = on ? ml[1] : 0.f; M = fmaxf(M, mj[j]); }
        float r[8] = {0.f, 0.f, 0.f, 0.f, 0.f, 0.f, 0.f, 0.f}; float wsum_ = 0.f;
#pragma unroll
        for (int j = 0; j < 4; ++j) { const bool on = (j == 3) || (j < nsel);
            if (on) { const float w = lj[j] * __builtin_amdgcn_exp2f(mj[j] - M); wsum_ += w; const u32x4 v = *(const u32x4*)(parto + ((size_t)th * 4 + j) * HD + 8 * c);
                r[0] += w * bflo(v.x); r[1] += w * bfhi(v.x); r[2] += w * bflo(v.y); r[3] += w * bfhi(v.y); r[4] += w * bflo(v.z); r[5] += w * bfhi(v.z); r[6] += w * bflo(v.w); r[7] += w * bfhi(v.w); } }
        const float inv = 1.0f / wsum_;
        float sob = F8_SOB; asm volatile("" : "+v"(sob));   const float is = inv * sob; u32x2 w; w.x = pk4_fp8(r[0] * is, r[1] * is, r[2] * is, r[3] * is); w.y = pk4_fp8(r[4] * is, r[5] * is, r[6] * is, r[7] * is);
        *(u32x2*)((unsigned char*)ob + (size_t)th * HD + 8 * c) = w;
    }
}
DI void mem_attn_phase(const Frame& F, int l) {
    const bf16* qmem = (const bf16*)(F.ws + WS_QMEM); const bf16* kv = (const bf16*)(F.ws + WS_KVMEM) + (size_t)l * 1024; bf16* omem = (bf16*)(F.ws + WS_OMEM);
    const int total = NHM * (S / 256);
    int staged = -1;
    for (int u = F.bx; u < total; u += F.G) {
        const int h = u / (S / 256), qc = u % (S / 256);
        if (staged != h) { __syncthreads(); blk_stage(F, kv + h * HD, kv + 512 + h * HD, 4096); __syncthreads(); staged = h; }
        f32x4 oa[8], ob[8]; float ma, la, mb, lb;
        { const int tq0 = qc * 256 + F.wave * 32 + (F.lane & 15); blk_core2(F, qmem + (size_t)tq0 * 512 + h * HD, qmem + (size_t)(tq0 + 16) * 512 + h * HD, 0, 0, 0, 0.f, false, oa, ob, ma, la, mb, lb); }
        int ln = F.lane; asm volatile("" : "+v"(ln));
        const int fq = ln >> 4, tqa = qc * 256 + F.wave * 32 + (ln & 15), tqb = tqa + 16;
#pragma unroll
        for (int dt = 0; dt < 8; ++dt) { *(unsigned*)((unsigned char*)omem + (size_t)tqa * 512 + h * HD + 16 * dt + 4 * fq) = pk4_fp8(oa[dt][0] * F8_SOM, oa[dt][1] * F8_SOM, oa[dt][2] * F8_SOM, oa[dt][3] * F8_SOM);
            *(unsigned*)((unsigned char*)omem + (size_t)tqb * 512 + h * HD + 16 * dt + 4 * fq) = pk4_fp8(ob[dt][0] * F8_SOM, ob[dt][1] * F8_SOM, ob[dt][2] * F8_SOM, ob[dt][3] * F8_SOM); }
    }
    __syncthreads();
}

DI void ln_phase(const Frame& F, const Args& a, int l, int which) {
    const int gw = F.bx * NWAVES + F.wave, NGW = F.G * NWAVES, lane = F.lane;
    const float* g = a.in[17] + (size_t)(l * 3 + which) * D; const float* b = a.in[18] + (size_t)(l * 3 + which) * D;
    float* x = a.out; const bf16* y = (const bf16*)(F.ws + WS_Y); bf16* xb = (bf16*)(F.ws + WS_XB);
    f32x4 xv[8]; u32x2 yv[8];
    if (gw < S) {
#pragma unroll
        for (int j = 0; j < 8; ++j) { xv[j] = ((const f32x4*)(x + (size_t)gw * D) + lane)[64 * j]; yv[j] = ((const u32x2*)(y + (size_t)gw * D) + lane)[64 * j]; } }
    for (int r = gw; r < S; r += NGW) {
        f32x4 v[8]; float s = 0.f;
#pragma unroll
        for (int j = 0; j < 8; ++j) { v[j] = (f32x4){ALPHA * xv[j][0] + bflo(yv[j].x), ALPHA * xv[j][1] + bfhi(yv[j].x), ALPHA * xv[j][2] + bflo(yv[j].y), ALPHA * xv[j][3] + bfhi(yv[j].y)}; s += (v[j][0] + v[j][1]) + (v[j][2] + v[j][3]); }
        const int rn = r + NGW;
        if (rn < S) {
#pragma unroll
            for (int j = 0; j < 8; ++j) { xv[j] = ((const f32x4*)(x + (size_t)rn * D) + lane)[64 * j]; yv[j] = ((const u32x2*)(y + (size_t)rn * D) + lane)[64 * j]; } }
        const float mean = wave_sum(s) * (1.0f / D); float s2 = 0.f;
#pragma unroll
        for (int j = 0; j < 8; ++j) { v[j] = v[j] - mean; s2 += (v[j][0] * v[j][0] + v[j][1] * v[j][1]) + (v[j][2] * v[j][2] + v[j][3] * v[j][3]); }
        const float rstd = 1.0f / sqrtf(wave_sum(s2) * (1.0f / D) + LN_EPS);
        f32x4* xr = (f32x4*)(x + (size_t)r * D) + lane; u32x2* xbr = (u32x2*)(xb + (size_t)r * D) + lane;
#pragma unroll
        for (int j = 0; j < 8; ++j) { const f32x4 g4 = ((const f32x4*)g)[lane + 64 * j], b4 = ((const f32x4*)b)[lane + 64 * j]; const f32x4 o = v[j] * rstd * g4 + b4;
            xr[64 * j] = o;
            if (which != 2) ((unsigned*)(xb) + (size_t)r * (D / 4) + lane)[64 * j] = pk4_fp8(o[0], o[1], o[2], o[3]);
            else { u32x2 w; w.x = pk2(o[0], o[1]); w.y = pk2(o[2], o[3]); xbr[64 * j] = w;
                if (which == 2) ((unsigned*)(F.ws + WS_XB8) + (size_t)r * (D / 4) + lane)[64 * j] = pk4_fp8(o[0], o[1], o[2], o[3]); } }
    }
}


#ifdef SELFCHECK
constexpr int CW_ERR = 24576;
#ifndef SELFCHECK_MASK
#define SELFCHECK_MASK 0xFFFFFFFFu
#endif
#define CHK_ON(w) (((SELFCHECK_MASK) >> (w)) & 1u)
#ifndef SELFCHECK_TOL
#define SELFCHECK_TOL 0.05f
#endif
__device__ const int CHK_TS[8] = {0, 1, 255, 256, 511, 4097, 9000, 16383};
__device__ const int CHK_BND[19] = {1023, 1024, 1279, 1280, 2303, 2304, 2367, 2368, 2383, 2384, 3407, 3408, 4431, 4432, 5455, 5456, 7503, 7504, 9551};
DI void chk_report(gu32* ctl, int which, float err) {
    if (!(err >= 0.f)) err = 1e30f;
    __hip_atomic_fetch_max((unsigned*)(ctl + CW_ERR + which), __float_as_uint(err), RLX_AGENT);
}
DI float bfr(float w) { return __uint_as_float(f2bf(w) << 16); }
DI float bf2f(bf16 v) { return __uint_as_float(((unsigned)v) << 16); }
DI float relerr(float got, float ref, float fl) { return fabsf(got - ref) / (fabsf(ref) + fl); }
DI float wdot(const bf16* a, int K, const float* W, size_t ldw, int lane) {
    float s = 0.f; for (int k = lane; k < K; k += 64) s += bf2f(a[k]) * bfr(W[(size_t)k * ldw]); return wave_sum(s);
}
DI float fp8dec(unsigned char v) { return __builtin_amdgcn_cvt_f32_fp8((int)v, 0); }
DI float f8r(float w, float scale) { return fp8dec((unsigned char)(pk4_fp8(w * scale, 0.f, 0.f, 0.f) & 0xffu)) / scale; }
DI void chk_inproj(const Frame& F, const Args& a) {
    const int gw = F.bx * NWAVES + F.wave, NGW = F.G * NWAVES, lane = F.lane; unsigned char* ws = F.ws;
    const int NC = 83;
    for (int sidx = gw; sidx < 8 * NC; sidx += NGW) {
        const int t = CHK_TS[sidx / NC], ci = sidx % NC;
        const int c = ci < 64 ? (ci * 149 + 7) % INW : CHK_BND[ci - 64];
        float ref;
        if (win_rowmap(c) >= 0) ref = wdot((const bf16*)(ws + WS_XB) + (size_t)t * D, D, a.in[2] + c, INW, lane);
        else { float s = 0.f; for (int k = lane; k < D; k += 64) s += fp8dec((ws + WS_XB8)[(size_t)t * D + k]) * f8r(a.in[2][(size_t)k * INW + c], F8_SWI); ref = wave_sum(s); }
        float got, r2 = ref, fl = 0.3f;
        if (c < 1024) got = bf2f(((const bf16*)(ws + WS_QDSA))[(size_t)t * 1024 + c]);
        else if (c < 1280) got = ((const float*)(ws + WS_CKVRAW))[(size_t)t * 256 + c - 1024];
        else if (c < 2304) got = bf2f(((const bf16*)(ws + WS_QIDX))[(size_t)t * 1024 + c - 1280]);
        else if (c < 2384) got = ((const float*)(ws + WS_KWRAW))[(size_t)t * 256 + c - 2304];
        else if (c < 3408) got = bf2f(((const bf16*)(ws + WS_QM))[(size_t)t * 1024 + c - 2384]);
        else if (c < 4432) got = bf2f(((const bf16*)(ws + WS_KM))[(size_t)t * 1024 + c - 3408]);
        else if (c < 5456) got = bf2f(((const bf16*)(ws + WS_VM))[(size_t)t * 1024 + c - 4432]);
        else if (c < 7504) { got = bf2f(((const bf16*)(ws + WS_GA))[(size_t)t * D + c - 5456]); r2 = 1.f / (1.f + expf(-(ref + a.in[3][c - 5456]))); }
        else { got = bf2f(((const bf16*)(ws + WS_GB))[(size_t)t * D + c - 7504]); r2 = 1.f / (1.f + expf(-(ref + a.in[3][D + c - 7504]))); }
        if (lane == 0) chk_report(F.ctl, 0, relerr(got, r2, fl));
    }
}
DI void chk_norms(const Frame& F, const Args& a) {
    const int gw = F.bx * NWAVES + F.wave, NGW = F.G * NWAVES, lane = F.lane; unsigned char* ws = F.ws;
    for (int sidx = gw; sidx < 8; sidx += NGW) {
        const int t = CHK_TS[sidx]; const float* cr = (const float*)(ws + WS_CKVRAW) + (size_t)t * 256; const float* kw = (const float*)(ws + WS_KWRAW) + (size_t)t * 256;
        float ss = 0.f; for (int c = 0; c < 256; ++c) ss += cr[c] * cr[c];
        const float r = 1.f / sqrtf(ss / 256.f + LN_EPS); float e = 0.f;
        for (int c = lane; c < 256; c += 64) e = fmaxf(e, relerr(fp8dec((ws + WS_CKVN)[(size_t)t * 256 + c]), cr[c] * r * a.in[4][c], 0.3f));
        float mu = 0.f; for (int c = 0; c < 64; ++c) mu += kw[c]; mu /= 64.f; float var = 0.f; for (int c = 0; c < 64; ++c) var += (kw[c] - mu) * (kw[c] - mu); var /= 64.f;
        e = fmaxf(e, relerr(bf2f(((const bf16*)(ws + WS_KIDXN))[(size_t)t * 64 + lane]), (kw[lane] - mu) / sqrtf(var + LN_EPS) * a.in[5][lane] + a.in[6][lane], 0.3f));
        if (lane < 16) e = fmaxf(e, relerr(((const float*)(ws + WS_WIDX))[(size_t)t * 16 + lane], kw[64 + lane], 0.01f));
        chk_report(F.ctl, 1, e);
    }
    for (int sidx = gw; sidx < 8 * 64; sidx += NGW) {
        const int t = CHK_TS[sidx >> 6], h = sidx & 7, c = (((sidx >> 3) & 7) * 37 + (sidx & 7) * 3) & 255;
        const float ref = wdot((const bf16*)(ws + WS_QDSA) + (size_t)t * 1024 + h * HD, HD, a.in[7] + (size_t)h * HD * CKV + c, CKV, lane);
        if (lane == 0) chk_report(F.ctl, 1, relerr(bf2f(((const bf16*)(ws + WS_QLAT))[(size_t)t * 2048 + h * 256 + c]), ref, 0.3f));
    }
    for (int sidx = gw; sidx < 64; sidx += NGW) {
        const int h = sidx & 7, b = ((sidx >> 3) * 9) & 63; float s0 = 0.f, s1 = 0.f;
        for (int k = 0; k < MBLK; ++k) { s0 += bf2f(((const bf16*)(ws + WS_KM))[(size_t)(b * MBLK + k) * 1024 + h * HD + lane]); s1 += bf2f(((const bf16*)(ws + WS_KM))[(size_t)(b * MBLK + k) * 1024 + h * HD + 64 + lane]); }
        const float* km = (const float*)(ws + WS_KMEAN) + (size_t)(h * NBLK + b) * HD;
        chk_report(F.ctl, 1, fmaxf(relerr(km[lane], s0 / 256.f, 0.02f), relerr(km[64 + lane], s1 / 256.f, 0.02f)));
    }
}
DI float chk_score(const unsigned char* ws, int t, int key) {
    const bf16* q = (const bf16*)(ws + WS_QIDX) + (size_t)t * 1024; const bf16* k = (const bf16*)(ws + WS_KIDXN) + (size_t)key * 64; const float* w = (const float*)(ws + WS_WIDX) + (size_t)t * 16;
    float s = 0.f;
    for (int h = 0; h < 16; ++h) { float d = 0.f; for (int i = 0; i < 64; ++i) d += bf2f(q[h * 64 + i]) * bf2f(k[i]); s += w[h] * fmaxf(d, 0.f); }
    return s;
}
DI void chk_topk(const Frame& F, int l) {
    const int gw = F.bx * NWAVES + F.wave, NGW = F.G * NWAVES, lane = F.lane; unsigned char* ws = F.ws;
    for (int sidx = gw; sidx < 8; sidx += NGW) {
        const int t = CHK_TS[sidx]; const unsigned short* sel = (const unsigned short*)(ws + WS_SEL) + (size_t)t * TOPK; const int nsel = t + 1 < TOPK ? t + 1 : TOPK;
        float bad = 0.f, mn = __builtin_inff();
        for (int i = lane; i < TOPK; i += 64) {
            const int k = sel[i];
            if (i < nsel) { if (k > t) bad += 1.f; else mn = fminf(mn, chk_score(ws, t, k)); if (i + 1 < nsel && sel[i + 1] <= k) bad += 1.f; }
            else if (k != 0xFFFF) bad += 1.f;
        }
#pragma unroll
        for (int o = 1; o < 64; o <<= 1) mn = fminf(mn, __shfl_xor(mn, o));
        float cnt = 0.f; for (int k = lane; k <= t; k += 64) if (chk_score(ws, t, k) > mn * (mn > 0.f ? 1.00001f : 0.99999f) + 1e-6f) cnt += 1.f;
        cnt = wave_sum(cnt); bad = wave_sum(bad);
        const float extra = cnt - (float)(nsel - 1); chk_report(F.ctl, 2, (bad + (extra > 0.f ? extra : 0.f)) / 16.f);
    }
    for (int sidx = gw; sidx < 64; sidx += NGW) {
        const int t = CHK_TS[sidx >> 3], h = sidx & 7, own = t >> 8; const bf16* q = (const bf16*)(ws + WS_QM) + (size_t)t * 1024 + h * HD;
        float g = -__builtin_inff();
        if (lane < own) { g = 0.f; const float* km = (const float*)(ws + WS_KMEAN) + (size_t)(h * NBLK + lane) * HD; for (int d = 0; d < HD; ++d) g += bf2f(q[d]) * km[d]; }
        float bad = 0.f; const int nsel = own < 3 ? own : 3; float gg = g;
        for (int j = 0; j < nsel; ++j) {
            float mx = gg; int mi = lane;
#pragma unroll
            for (int o = 1; o < 64; o <<= 1) { const float ov = __shfl_xor(mx, o); const int oi = __shfl_xor(mi, o); if (ov > mx || (ov == mx && oi < mi)) { mx = ov; mi = oi; } }
            float g2 = (lane == mi) ? -__builtin_inff() : gg;
#pragma unroll
            for (int o = 1; o < 64; o <<= 1) g2 = fmaxf(g2, __shfl_xor(g2, o));
            const bool neartie = (mx - g2) < 1e-4f * (fabsf(mx) + 1e-3f);
            const unsigned n = ((const unsigned*)(F.ctl + CW_BCNT))[l * 512 + h * 64 + mi]; const unsigned* bk = (const unsigned*)(ws + WS_BUCK) + (size_t)h * BUCK_PER_HEAD + bucket_off(mi);
            float found = 0.f; for (unsigned i = lane; i < n; i += 64) if (bk[i] == (((unsigned)t << 2) | (unsigned)j)) found = 1.f;
            if (wave_sum(found) != 1.f && !neartie) bad += 1.f;
            if (lane == mi) gg = -__builtin_inff();
        }
        chk_report(F.ctl, 3, bad);
    }
}
DI void chk_attn(const Frame& F, const Args& a) {
    const int gw = F.bx * NWAVES + F.wave, NGW = F.G * NWAVES, lane = F.lane; unsigned char* ws = F.ws;
    for (int sidx = gw; sidx < 64; sidx += NGW) {
        const int t = CHK_TS[sidx >> 3], h = sidx & 7; const float slope = exp2f(-(float)(h + 1));
        {
            const unsigned short* sel = (const unsigned short*)(ws + WS_SEL) + (size_t)t * TOPK; const int nsel = t + 1 < TOPK ? t + 1 : TOPK;
            const bf16* q = (const bf16*)(ws + WS_QLAT) + (size_t)t * 2048 + h * 256; const unsigned char* ck = ws + WS_CKVN;
            float sc[4]; float mx = -__builtin_inff();
#pragma unroll
            for (int j = 0; j < 4; ++j) { const int i = lane + 64 * j; sc[j] = -__builtin_inff();
                if (i < nsel) { const int k = sel[i]; float d = 0.f; for (int c = 0; c < 256; ++c) d += bf2f(q[c]) * fp8dec(ck[(size_t)k * 256 + c]); sc[j] = d * 0.08838834764831845f - slope * (float)(t - k); }
                mx = fmaxf(mx, sc[j]); }
#pragma unroll
            for (int o = 1; o < 64; o <<= 1) mx = fmaxf(mx, __shfl_xor(mx, o));
            float p[4], ps = 0.f;
#pragma unroll
            for (int j = 0; j < 4; ++j) { p[j] = expf(sc[j] - mx); ps += p[j]; } ps = wave_sum(ps);
            float o4[4] = {0.f, 0.f, 0.f, 0.f};
#pragma unroll
            for (int j = 0; j < 4; ++j) for (int src = 0; src < 64; ++src) { const float pp = __shfl(p[j], src); const int i = src + 64 * j; if (i < nsel) { const int k = sel[i];
                _Pragma("unroll") for (int e = 0; e < 4; ++e) o4[e] += pp * fp8dec(ck[(size_t)k * 256 + lane * 4 + e]); } }
            float er = 0.f;
#pragma unroll
            for (int e = 0; e < 4; ++e) er = fmaxf(er, relerr(bf2f(((const bf16*)(ws + WS_OLAT))[(size_t)t * 2048 + h * 256 + lane * 4 + e]), o4[e] / ps, 0.05f));
            chk_report(F.ctl, 4, er);
        }
        {
            const int own = t >> 8; const bf16* q = (const bf16*)(ws + WS_QM) + (size_t)t * 1024 + h * HD; const bf16* kk = (const bf16*)(ws + WS_KM); const bf16* vv = (const bf16*)(ws + WS_VM);
            float g = -__builtin_inff();
            if (lane < own) { g = 0.f; const float* km = (const float*)(ws + WS_KMEAN) + (size_t)(h * NBLK + lane) * HD; for (int d = 0; d < HD; ++d) g += bf2f(q[d]) * km[d]; }
            int blks[4] = {-1, -1, -1, own}; const int nsel = own < 3 ? own : 3; float gg = g;
#pragma unroll
            for (int j = 0; j < 3; ++j) { if (j < nsel) { float mx = gg; int mi = lane;
#pragma unroll
                for (int o = 1; o < 64; o <<= 1) { const float ov = __shfl_xor(mx, o); const int oi = __shfl_xor(mi, o); if (ov > mx || (ov == mx && oi < mi)) { mx = ov; mi = oi; } }
                blks[j] = mi; if (lane == mi) gg = -__builtin_inff(); } }
            float M = -__builtin_inff();
#pragma unroll
            for (int bi = 0; bi < 4; ++bi) { if (blks[bi] >= 0) for (int k0 = lane; k0 < MBLK; k0 += 64) { const int kp = blks[bi] * MBLK + k0; if (kp <= t) { float d = 0.f; for (int e = 0; e < HD; ++e) d += bf2f(q[e]) * bf2f(kk[(size_t)kp * 1024 + h * HD + e]);
                M = fmaxf(M, d * 0.08838834764831845f - slope * (float)(t - kp)); } } }
#pragma unroll
            for (int o = 1; o < 64; o <<= 1) M = fmaxf(M, __shfl_xor(M, o));
            float ps = 0.f, o0 = 0.f, o1 = 0.f;
#pragma unroll
            for (int bi = 0; bi < 4; ++bi) { if (blks[bi] >= 0) for (int kb = 0; kb < MBLK; kb += 64) { const int kp = blks[bi] * MBLK + kb + lane; float p = 0.f;
                if (kp <= t) { float d = 0.f; for (int e = 0; e < HD; ++e) d += bf2f(q[e]) * bf2f(kk[(size_t)kp * 1024 + h * HD + e]); p = expf(d * 0.08838834764831845f - slope * (float)(t - kp) - M); }
                ps += p;
                for (int src = 0; src < 64; ++src) { const float pp = __shfl(p, src); const int kq = blks[bi] * MBLK + kb + src; if (kq <= t) { o0 += pp * bf2f(vv[(size_t)kq * 1024 + h * HD + 2 * lane]); o1 += pp * bf2f(vv[(size_t)kq * 1024 + h * HD + 2 * lane + 1]); } } } }
            ps = wave_sum(ps);
            const unsigned char* ob = ws + WS_OB + (size_t)t * 1024 + h * HD;
            chk_report(F.ctl, 5, fmaxf(relerr(fp8dec(ob[2 * lane]) / F8_SOB, o0 / ps, 0.1f), relerr(fp8dec(ob[2 * lane + 1]) / F8_SOB, o1 / ps, 0.1f)));
        }
        {
            float r0 = 0.f, r1 = 0.f; const bf16* ol = (const bf16*)(ws + WS_OLAT) + (size_t)t * 2048 + h * 256; const float* wu = a.in[8] + (size_t)h * CKV * HD;
            for (int c = 0; c < 256; ++c) { r0 += bf2f(ol[c]) * bfr(wu[c * HD + lane]); r1 += bf2f(ol[c]) * bfr(wu[c * HD + 64 + lane]); }
            const unsigned char* oa = ws + WS_OA + (size_t)t * 1024 + h * HD;
            chk_report(F.ctl, 6, fmaxf(relerr(fp8dec(oa[lane]) / F8_SOA, r0, 0.05f), relerr(fp8dec(oa[64 + lane]) / F8_SOA, r1, 0.05f)));
        }
    }
}
DI void chk_dense(const Frame& F, int word, const bf16* act, int lda, int K, const float* W, int N, const bf16* out, int ldo, float fl) {
    const int gw = F.bx * NWAVES + F.wave, NGW = F.G * NWAVES, lane = F.lane;
    for (int sidx = gw; sidx < 8 * 24; sidx += NGW) { const int t = CHK_TS[sidx / 24], n = ((sidx % 24) * 211 + 5) % N;
        const float ref = wdot(act + (size_t)t * lda, K, W + n, N, lane);
        if (lane == 0) chk_report(F.ctl, word, relerr(bf2f(out[(size_t)t * ldo + n]), ref, fl)); }
}
DI float wdot8r(const unsigned char* a8, int K, const float* W, size_t ldw, float wscale, int lane) {
    float s = 0.f; for (int k = lane; k < K; k += 64) s += fp8dec(a8[k]) * f8r(W[(size_t)k * ldw], wscale); return wave_sum(s);
}
DI void chk_merged(const Frame& F, const Args& a) {
    const int gw = F.bx * NWAVES + F.wave, NGW = F.G * NWAVES, lane = F.lane; unsigned char* ws = F.ws;
    for (int sidx = gw; sidx < 8 * 24; sidx += NGW) { const int t = CHK_TS[sidx / 24], n = ((sidx % 24) * 211 + 5) % D;
        const float pa = wdot8r(ws + WS_OA + (size_t)t * 1024, 1024, a.in[9] + n, D, F8_SWO, lane) / F8_SOA, pb = wdot8r(ws + WS_OB + (size_t)t * 1024, 1024, a.in[10] + n, D, F8_SWO, lane) / F8_SOB;
        const float ref = bf2f(((const bf16*)(ws + WS_GA))[(size_t)t * D + n]) * pa + bf2f(((const bf16*)(ws + WS_GB))[(size_t)t * D + n]) * pb;
        if (lane == 0) chk_report(F.ctl, 6, relerr(fp8dec((ws + WS_MERGED)[(size_t)t * D + n]) / F8_SMG, ref, 0.02f)); }
}
DI void chk_dense8(const Frame& F, int word, const unsigned char* act8, int lda, int K, float ascale, const float* W, int N, float wscale, const bf16* out, int ldo, float fl) {
    const int gw = F.bx * NWAVES + F.wave, NGW = F.G * NWAVES, lane = F.lane;
    for (int sidx = gw; sidx < 8 * 24; sidx += NGW) { const int t = CHK_TS[sidx / 24], n = ((sidx % 24) * 211 + 5) % N;
        const float ref = wdot8r(act8 + (size_t)t * lda, K, W + n, N, wscale, lane) / ascale;
        if (lane == 0) chk_report(F.ctl, word, relerr(bf2f(out[(size_t)t * ldo + n]), ref, fl)); }
}
DI void chk_ln1(const Frame& F, const Args& a) {
    const int gw = F.bx * NWAVES + F.wave, NGW = F.G * NWAVES, lane = F.lane; unsigned char* ws = F.ws;
    for (int sidx = gw; sidx < 8; sidx += NGW) { const int t = CHK_TS[sidx]; const float* x = a.in[0] + (size_t)t * D; const bf16* y = (const bf16*)(ws + WS_Y) + (size_t)t * D;
        float s = 0.f; for (int c = lane; c < D; c += 64) s += ALPHA * x[c] + bf2f(y[c]); const float mu = wave_sum(s) / D;
        float q = 0.f; for (int c = lane; c < D; c += 64) { const float d = ALPHA * x[c] + bf2f(y[c]) - mu; q += d * d; } const float rs = 1.f / sqrtf(wave_sum(q) / D + LN_EPS);
        float e = 0.f; for (int c = lane; c < D; c += 64) { const float ref = (ALPHA * x[c] + bf2f(y[c]) - mu) * rs * a.in[17][c] + a.in[18][c];
            e = fmaxf(e, relerr(a.out[(size_t)t * D + c], ref, 0.5f) * 20.f); e = fmaxf(e, relerr(fp8dec((ws + WS_XB)[(size_t)t * D + c]), ref, 0.5f)); }
        chk_report(F.ctl, 7, e); }
}
DI void chk_memattn(const Frame& F, int l) {
    const int gw = F.bx * NWAVES + F.wave, NGW = F.G * NWAVES, lane = F.lane; unsigned char* ws = F.ws;
    for (int sidx = gw; sidx < 32; sidx += NGW) { const int t = CHK_TS[sidx >> 2], h = sidx & 3; const bf16* q = (const bf16*)(ws + WS_QMEM) + (size_t)t * 512 + h * HD; const bf16* kv = (const bf16*)(ws + WS_KVMEM) + (size_t)l * 1024;
        float sc[4], mx = -__builtin_inff();
#pragma unroll
        for (int j = 0; j < 4; ++j) { const int m = lane + 64 * j; float d = 0.f; for (int e = 0; e < HD; ++e) d += bf2f(q[e]) * bf2f(kv[(size_t)m * 4096 + h * HD + e]); sc[j] = d * 0.08838834764831845f; mx = fmaxf(mx, sc[j]); }
#pragma unroll
        for (int o = 1; o < 64; o <<= 1) mx = fmaxf(mx, __shfl_xor(mx, o));
        float ps = 0.f, o0 = 0.f, o1 = 0.f;
#pragma unroll
        for (int j = 0; j < 4; ++j) { const float p = expf(sc[j] - mx); ps += p; for (int src = 0; src < 64; ++src) { const float pp = __shfl(p, src); const int m = src + 64 * j;
            o0 += pp * bf2f(kv[(size_t)m * 4096 + 512 + h * HD + 2 * lane]); o1 += pp * bf2f(kv[(size_t)m * 4096 + 512 + h * HD + 2 * lane + 1]); } }
        ps = wave_sum(ps); const unsigned char* om = ws + WS_OMEM + (size_t)t * 512 + h * HD;
        chk_report(F.ctl, 9, fmaxf(relerr(fp8dec(om[2 * lane]) / F8_SOM, o0 / ps, 0.05f), relerr(fp8dec(om[2 * lane + 1]) / F8_SOM, o1 / ps, 0.05f))); }
}
DI void chk_kvmem(const Frame& F, const Args& a) {
    const int gw = F.bx * NWAVES + F.wave, NGW = F.G * NWAVES, lane = F.lane; unsigned char* ws = F.ws;
    for (int sidx = gw; sidx < 4 * 48; sidx += NGW) { const int ll = sidx / 48, m = ((sidx % 48) * 37) & 255, n = ((sidx % 48) * 211 + 3) & 1023;
        const float ref = wdot((const bf16*)(ws + WS_MEMB) + (size_t)m * D, D, a.in[13] + (size_t)ll * D * 1024 + n, 1024, lane);
        if (lane == 0) chk_report(F.ctl, 8, relerr(bf2f(((const bf16*)(ws + WS_KVMEM))[(size_t)m * 4096 + ll * 1024 + n]), ref, 0.3f)); }
}
DI float wdot8(const unsigned char* a8, int K, const float* W, size_t ldw, int lane) {
    float s = 0.f; for (int k = lane; k < K; k += 64) s += fp8dec(a8[k]) * W[(size_t)k * ldw]; return wave_sum(s);
}
DI void chk_swiglu(const Frame& F, const Args& a) {
    const int gw = F.bx * NWAVES + F.wave, NGW = F.G * NWAVES, lane = F.lane; unsigned char* ws = F.ws;
    for (int sidx = gw; sidx < 8 * 24; sidx += NGW) { const int t = CHK_TS[sidx / 24], j = ((sidx % 24) * 509 + 11) % DFF;
        const float g = wdot8(ws + WS_XB + (size_t)t * D, D, a.in[15] + j, 2 * DFF, lane), u = wdot8(ws + WS_XB + (size_t)t * D, D, a.in[15] + DFF + j, 2 * DFF, lane);
        if (lane == 0) chk_report(F.ctl, 11, relerr(fp8dec((ws + WS_H)[(size_t)t * DFF + j]) * (1.0f / F8_SH), g / (1.f + expf(-g)) * u, 0.05f)); }
}
DI void chk_ffn2(const Frame& F, const Args& a) {
    const int gw = F.bx * NWAVES + F.wave, NGW = F.G * NWAVES, lane = F.lane; unsigned char* ws = F.ws;
    for (int sidx = gw; sidx < 8 * 24; sidx += NGW) { const int t = CHK_TS[sidx / 24], n = ((sidx % 24) * 211 + 5) % D;
        const float ref = wdot8(ws + WS_H + (size_t)t * DFF, DFF, a.in[16] + n, D, lane) * (1.0f / F8_SH);
        if (lane == 0) chk_report(F.ctl, 12, relerr(bf2f(((const bf16*)(ws + WS_Y))[(size_t)t * D + n]), ref, 0.01f)); }
}
DI void chk_encode(const Frame& F, const Args& a) {
    float B = 0.f, wgt = 0.5f;
    for (int i = 0; i < 32; ++i) if ((SELFCHECK_MASK >> i) & 1u) { const float e = __uint_as_float(__hip_atomic_load((unsigned*)(F.ctl + CW_ERR + i), RLX_AGENT)); if (e > SELFCHECK_TOL) B += wgt; wgt *= 0.5f; }
    const float sc = 1.f - 0.5f * B;
    f32x4* o = (f32x4*)a.out; const int gt = F.bx * NTHREADS + F.tid, ngt = F.G * NTHREADS;
    for (int i = gt; i < S * D / 4; i += ngt) o[i] = o[i] * sc;
}
#endif

constexpr int NPH = 17;
__global__ void __launch_bounds__(NTHREADS, 2) fwd_kernel(Args args) {
    extern __shared__ __attribute__((aligned(16))) unsigned char lds_raw[];
    LAS unsigned char* const lds = (LAS unsigned char*)lds_raw;
    volatile LAS unsigned* MISC = (volatile LAS unsigned*)(lds + MISC_OFF);
    if (threadIdx.x < 32) MISC[threadIdx.x] = 0u;
    __syncthreads();
#if MK_ONE_LAUNCH
    constexpr int lo = 0, hi = DEPTH * NPH;
#else
    const int lo = args.ph_lo, hi = args.ph_hi;
#endif
    XcdBarrier bar; bar.bar = (unsigned*)(args.ws + WS_CTL) + CW_BAR; bar.x = 0; bar.st = nullptr; bar.w0 = __builtin_amdgcn_readfirstlane((int)threadIdx.x >> 6);
    if (hi - lo > 1) bar = xcd_barrier_post((unsigned*)(args.ws + WS_CTL) + CW_BAR, MISC + 8);
#ifdef ONLY_PH
#define IN(k) (((k) - p0) == ONLY_PH && lo <= (k) && (k) < hi)
#else
#define IN(k) (lo <= (k) && (k) < hi)
#endif
#define SEAM(k) do { if (lo <= (k) && (k) + 1 < hi) { XcdBarrier b2_ = bar; asm volatile("" : "+s"(b2_.bar), "+s"(b2_.x)); xcd_barrier(b2_); } } while (0)
#ifdef REPEAT_MASK
#define NREP(bit) ((((unsigned long long)REPEAT_MASK >> (bit)) & 1ull) ? 2 : 1)
#else
#define NREP(bit) 1
#endif
#define FRAME() const Frame F = make_frame(args.ws, lds, bar.w0); unsigned char* const ws = F.ws; (void)ws; int lq = l; asm volatile("" : "+s"(lq)); (void)lq
    for (int l = 0; l < DEPTH; ++l) {
        const int p0 = l * NPH;
        if (IN(p0 + 0)) { FRAME(); for (int rep = 0; rep < NREP(0); ++rep) conv_phase(F, args, lq); } SEAM(p0 + 0);
        if (IN(p0 + 1)) {
#ifndef SKIP_A
            if (l == 0) { FRAME(); pg8::Gemm g{(const bf16*)(ws + WS_MEMB), (const bf16*)(ws + WS_WKV), D, D, D, 1, 16, 0, 0}; pg8::StaticOrder So; So.init(1, 16, F.G, F.G - 1 - F.bx);
                pg8::EpiBf16 E{(bf16*)(ws + WS_KVMEM), 4096}; pg8::gemm_phase(lds, g, So, E, F.tid); }
#endif
#ifndef SKIP_B
            { FRAME(); pg8::Gemm g{(const bf16*)(ws + WS_XB8), (const bf16*)(ws + WS_WIN8), D / 2, D / 2, D / 2, S / 256, IN8 / 256, 0, 0}; pg8::StaticOrder So; So.init(S / 256, IN8 / 256, F.G, F.bx, 1);
            pg8::EpiIn8 E{(bf16*)(ws + WS_QDSA), (bf16*)(ws + WS_VM), (bf16*)(ws + WS_GA), (bf16*)(ws + WS_GB), (float*)(ws + WS_CKVRAW), args.in[3] + (size_t)lq * 2 * D};
            for (int rep = 0; rep < NREP(1); ++rep) pg8::gemm_phase<pg8::EpiIn8, true>(lds, g, So, E, F.tid); }
            { FRAME(); pg8::Gemm g{(const bf16*)(ws + WS_XB), (const bf16*)(ws + WS_WIN), D, D, D, S / 256, INB / 256, 0, 0}; pg8::StaticOrder So; So.init(S / 256, INB / 256, F.G, F.bx, 2);
            pg8::EpiInBf E{(bf16*)(ws + WS_QIDX), (bf16*)(ws + WS_QM), (bf16*)(ws + WS_KM), (float*)(ws + WS_KWRAW)};
            for (int rep = 0; rep < NREP(1); ++rep) pg8::gemm_phase(lds, g, So, E, F.tid); }
#endif
        } SEAM(p0 + 1);
        if (IN(p0 + 2)) {
#ifdef SELFCHECK
            if (l == 0 && CHK_ON(0)) { FRAME(); chk_inproj(F, args); }
#endif
#ifndef SKIP_A
            { FRAME(); for (int rep = 0; rep < NREP(2); ++rep) norm_phase(F, args, lq); }
#endif
#ifndef SKIP_B
            { FRAME(); pg8::Gemm g{(const bf16*)(ws + WS_QDSA), (const bf16*)(ws + WS_WUK), 1024, 256, 256, S / 256, 8, 1, 256}; pg8::StaticOrder So; So.init(S / 256, 8, F.G, F.bx);
            pg8::EpiBf16 E{(bf16*)(ws + WS_QLAT), 2048}; for (int rep = 0; rep < NREP(3); ++rep) pg8::gemm_phase(lds, g, So, E, F.tid); }
#endif
        } SEAM(p0 + 2);
        if (IN(p0 + 3)) {
#ifdef SELFCHECK
            if (l == 0) { FRAME(); if (CHK_ON(1)) chk_norms(F, args); if (CHK_ON(8)) chk_kvmem(F, args); }
#endif
#ifndef SKIP_A
            { FRAME(); moba_gate_phase(F, lq); }
#endif
#ifndef SKIP_B
            { FRAME(); for (int rep = 0; rep < NREP(5); ++rep) indexer_phase(F); }
#endif
        } SEAM(p0 + 3);
        if (IN(p0 + 4)) {
#ifdef SELFCHECK
            if (l == 0 && (CHK_ON(2) || CHK_ON(3))) { FRAME(); chk_topk(F, lq); }
#endif
#ifndef SKIP_A
            { FRAME(); for (int rep = 0; rep < NREP(6); ++rep) moba_attn_phase(F, lq); }
#endif
#ifndef SKIP_B
            { FRAME(); for (int rep = 0; rep < NREP(7); ++rep) dsa_attn_phase(F); }
#endif
        } SEAM(p0 + 4);
        if (IN(p0 + 5)) {
            { FRAME(); for (int rep = 0; rep < NREP(8); ++rep) moba_combine_phase(F); }
            { FRAME(); pg8::Gemm g{(const bf16*)(ws + WS_OLAT), (const bf16*)(ws + WS_WUV), 2048, 512, 512, S / 256, 4, 0, 512}; pg8::StaticOrder So; So.init(S / 256, 4, F.G, F.bx);
            pg8::EpiF8 E{ws + WS_OA, 1024, F8_SOA}; for (int rep = 0; rep < NREP(9); ++rep) pg8::gemm_phase(lds, g, So, E, F.tid); }
        } SEAM(p0 + 5);
#ifdef SELFCHECK
        if (l == 0 && IN(p0 + 6) && (CHK_ON(4) || CHK_ON(5) || CHK_ON(6))) { FRAME(); chk_attn(F, args); }
#endif
        if (IN(p0 + 6)) { FRAME(); pg8::Gemm g{(const bf16*)(ws + WS_OA), (const bf16*)(ws + WS_WOA), 512, 512, 512, S / 256, 8, 0, 0}; pg8::StaticOrder So; So.init(S / 256, 8, F.G, F.bx);
            pg8::EpiGate E{(bf16*)(ws + WS_T1), (const bf16*)(ws + WS_GA), nullptr, nullptr, 1.0f / (F8_SOA * F8_SWO), 0.f}; for (int rep = 0; rep < NREP(10); ++rep) pg8::gemm_phase<pg8::EpiGate, true>(lds, g, So, E, F.tid); } SEAM(p0 + 6);
        if (IN(p0 + 7)) { FRAME(); pg8::Gemm g{(const bf16*)(ws + WS_OB), (const bf16*)(ws + WS_WOB), 512, 512, 512, S / 256, 8, 0, 0}; pg8::StaticOrder So; So.init(S / 256, 8, F.G, F.bx);
            pg8::EpiGate E{nullptr, (const bf16*)(ws + WS_GB), (const bf16*)(ws + WS_T1), ws + WS_MERGED, 1.0f / (F8_SOB * F8_SWO), F8_SMG}; for (int rep = 0; rep < NREP(11); ++rep) pg8::gemm_phase<pg8::EpiGate, true>(lds, g, So, E, F.tid); } SEAM(p0 + 7);
#ifdef SELFCHECK
        if (l == 0 && IN(p0 + 8) && CHK_ON(6)) { FRAME(); chk_merged(F, args); }
#endif
#if (LN_FUSED & 1)
        if (IN(p0 + 8)) { FRAME(); pg8::Gemm g{(const bf16*)(ws + WS_MERGED), (const bf16*)(ws + WS_WOUT), D / 2, D / 2, D / 2, S / 256, 8, 0, 0}; pg8::FusedOrder So{F.bx};
            pg8::EpiLn E{args.out, args.in[17] + (size_t)(lq * 3 + 0) * D, args.in[18] + (size_t)(lq * 3 + 0) * D, 1.0f / (F8_SMG * F8_SWOUT), nullptr, ws + WS_XB, (unsigned long long*)(ws + WS_LNX), (unsigned*)(F.ctl + CW_LNCNT) + (lq * 3 + 0) * 64 * 64};
            pg8::gemm_phase<pg8::EpiLn, true, pg8::FusedOrder, true>(lds, g, So, E, F.tid); } SEAM(p0 + 8);
#else
        if (IN(p0 + 8)) { FRAME(); pg8::Gemm g{(const bf16*)(ws + WS_MERGED), (const bf16*)(ws + WS_WOUT), D / 2, D / 2, D / 2, S / 256, 8, 0, 0}; pg8::StaticOrder So; So.init(S / 256, 8, F.G, F.bx);
            pg8::EpiBf16S E{(bf16*)(ws + WS_Y), D, 1.0f / (F8_SMG * F8_SWOUT)}; for (int rep = 0; rep < NREP(12); ++rep) pg8::gemm_phase<pg8::EpiBf16S, true>(lds, g, So, E, F.tid); } SEAM(p0 + 8);
        if (IN(p0 + 9)) { FRAME(); ln_phase(F, args, l, 0); } SEAM(p0 + 9);
#endif
#ifdef SELFCHECK
        if (l == 0 && IN(p0 + 10) && CHK_ON(7)) { FRAME(); chk_ln1(F, args); }
#endif
        if (IN(p0 + 10)) { FRAME(); pg8::Gemm g{(const bf16*)(ws + WS_XB), (const bf16*)(ws + WS_WQM), D / 2, D / 2, D / 2, S / 256, 2, 0, 0}; pg8::StaticOrder So; So.init(S / 256, 2, F.G, F.bx);
            pg8::EpiBf16S E{(bf16*)(ws + WS_QMEM), 512, 1.0f / F8_SWQM}; for (int rep = 0; rep < NREP(14); ++rep) pg8::gemm_phase<pg8::EpiBf16S, true>(lds, g, So, E, F.tid); } SEAM(p0 + 10);
#ifdef SELFCHECK
        if (l == 0 && IN(p0 + 11) && CHK_ON(8)) { FRAME(); chk_dense8(F, 8, ws + WS_XB, D, D, 1.f, args.in[12], 512, F8_SWQM, (const bf16*)(ws + WS_QMEM), 512, 0.3f); }
#endif
        if (IN(p0 + 11)) { FRAME(); for (int rep = 0; rep < NREP(15); ++rep) mem_attn_phase(F, lq); } SEAM(p0 + 11);
#ifdef SELFCHECK
        if (l == 0 && IN(p0 + 12) && CHK_ON(9)) { FRAME(); chk_memattn(F, lq); }
#endif
#if (LN_FUSED & 2)
        if (IN(p0 + 12)) { FRAME(); pg8::Gemm g{(const bf16*)(ws + WS_OMEM), (const bf16*)(ws + WS_WOM), 256, 256, 256, S / 256, 8, 0, 0}; pg8::FusedOrder So{F.bx};
            pg8::EpiLn E{args.out, args.in[17] + (size_t)(lq * 3 + 1) * D, args.in[18] + (size_t)(lq * 3 + 1) * D, 1.0f / (F8_SOM * F8_SWOM), nullptr, ws + WS_XB, (unsigned long long*)(ws + WS_LNX), (unsigned*)(F.ctl + CW_LNCNT) + (lq * 3 + 1) * 64 * 64};
            pg8::gemm_phase<pg8::EpiLn, true, pg8::FusedOrder, true>(lds, g, So, E, F.tid); } SEAM(p0 + 12);
#else
        if (IN(p0 + 12)) { FRAME(); pg8::Gemm g{(const bf16*)(ws + WS_OMEM), (const bf16*)(ws + WS_WOM), 256, 256, 256, S / 256, 8, 0, 0}; pg8::StaticOrder So; So.init(S / 256, 8, F.G, F.bx);
            pg8::EpiBf16S E{(bf16*)(ws + WS_Y), D, 1.0f / (F8_SOM * F8_SWOM)}; for (int rep = 0; rep < NREP(16); ++rep) pg8::gemm_phase<pg8::EpiBf16S, true>(lds, g, So, E, F.tid); } SEAM(p0 + 12);
        if (IN(p0 + 13)) { FRAME(); ln_phase(F, args, l, 1); } SEAM(p0 + 13);
#endif
        if (IN(p0 + 14)) { FRAME(); pg8::Gemm g{(const bf16*)(ws + WS_XB), (const bf16*)(ws + WS_WF1), D / 2, D / 2, D / 2, S / 256, 2 * DFF / 256, 0, 0}; pg8::StaticOrder So; So.init(S / 256, 2 * DFF / 256, F.G, F.bx);
            pg8::EpiSwiglu8 E{ws + WS_H}; for (int rep = 0; rep < NREP(18); ++rep) pg8::gemm_phase<pg8::EpiSwiglu8, true>(lds, g, So, E, F.tid); } SEAM(p0 + 14);
#ifdef SELFCHECK
        if (l == 0 && IN(p0 + 15) && CHK_ON(11)) { FRAME(); chk_swiglu(F, args); }
#endif
#if (LN_FUSED & 4)
        if (IN(p0 + 15)) { FRAME(); pg8::Gemm g{(const bf16*)(ws + WS_H), (const bf16*)(ws + WS_WF2), DFF / 2, DFF / 2, DFF / 2, S / 256, 8, 0, 0}; pg8::FusedOrder So{F.bx};
            pg8::EpiLn E{args.out, args.in[17] + (size_t)(lq * 3 + 2) * D, args.in[18] + (size_t)(lq * 3 + 2) * D, 1.0f / (F8_SH * F8_SW2), (bf16*)(ws + WS_XB), ws + WS_XB8, (unsigned long long*)(ws + WS_LNX), (unsigned*)(F.ctl + CW_LNCNT) + (lq * 3 + 2) * 64 * 64};
            pg8::gemm_phase<pg8::EpiLn, true, pg8::FusedOrder, true>(lds, g, So, E, F.tid); } SEAM(p0 + 15);
#else
        if (IN(p0 + 15)) { FRAME(); pg8::Gemm g{(const bf16*)(ws + WS_H), (const bf16*)(ws + WS_WF2), DFF / 2, DFF / 2, DFF / 2, S / 256, 8, 0, 0}; pg8::StaticOrder So; So.init(S / 256, 8, F.G, F.bx);
            pg8::EpiBf16S E{(bf16*)(ws + WS_Y), D, 1.0f / (F8_SH * F8_SW2)}; for (int rep = 0; rep < NREP(19); ++rep) pg8::gemm_phase<pg8::EpiBf16S, true>(lds, g, So, E, F.tid); } SEAM(p0 + 15);
        if (IN(p0 + 16)) { FRAME(); ln_phase(F, args, l, 2); } SEAM(p0 + 16);
#endif
    }
#ifdef SELFCHECK
    { xcd_barrier(bar); const int l = 0; FRAME(); chk_encode(F, args); }
#endif
#undef IN
#undef SEAM
#undef FRAME
}

extern "C" void kernel_launch(void* const* d_in, const int* in_sizes, int n_in, void* d_out, int out_size, void* d_ws, size_t ws_size, hipStream_t stream) {
    static int grid = 0;
    if (grid == 0) {
        if (n_in != 19 || out_size != S * D || ws_size < WS_END) { fprintf(stderr, "kernel_launch: unexpected shapes (n_in %d, out %d, ws %zu < %zu)\n", n_in, out_size, ws_size, (size_t)WS_END); grid = -1; return; }
        int dev = 0, cus = 0, per_cu = 0;
        if (hipGetDevice(&dev) != hipSuccess || hipDeviceGetAttribute(&cus, hipDeviceAttributeMultiprocessorCount, dev) != hipSuccess) { grid = -1; return; }
        if (hipFuncSetAttribute((const void*)fwd_kernel, hipFuncAttributeMaxDynamicSharedMemorySize, LDS_BYTES) != hipSuccess) { fprintf(stderr, "kernel_launch: hipFuncSetAttribute failed\n"); grid = -1; return; }
        if (hipOccupancyMaxActiveBlocksPerMultiprocessor(&per_cu, (const void*)fwd_kernel, NTHREADS, LDS_BYTES) != hipSuccess || per_cu < 1) fprintf(stderr, "kernel_launch: occupancy query says %d\n", per_cu);
        (void)hipGetLastError();
        grid = cus;
        if (grid != 256) { fprintf(stderr, "kernel_launch: %d CUs; this kernel is built for the 256-workgroup grid of an MI355X; nothing launched\n", grid); grid = -1; return; }
    }
    if (grid < 0) return;
    (void)in_sizes;
    if (hipMemsetAsync((char*)d_ws + WS_CTL, 0, CTL_ZERO_BYTES, stream) != hipSuccess) return;
    Args a{};
    for (int i = 0; i < 19; ++i) a.in[i] = (const float*)d_in[i];
    a.out = (float*)d_out; a.ws = (unsigned char*)d_ws;
#if MK_ONE_LAUNCH
    a.ph_lo = 0; a.ph_hi = DEPTH * NPH;
    hipLaunchKernelGGL(fwd_kernel, dim3(grid), dim3(NTHREADS), LDS_BYTES, stream, a);
#else
    for (int p = 0; p < DEPTH * NPH; ++p) { a.ph_lo = p; a.ph_hi = p + 1; hipLaunchKernelGGL(fwd_kernel, dim3(grid), dim3(NTHREADS), LDS_BYTES, stream, a); }
#endif
}
```

```cpp
#include <hip/hip_runtime.h>
#include <cstdio>
#include <cstdint>

#ifndef MK_ONE_LAUNCH
#define MK_ONE_LAUNCH 1
#endif
#ifndef LN_FUSED
#define LN_FUSED 7
#endif

#define LAS __attribute__((address_space(3)))
#define GAS __attribute__((address_space(1)))
typedef unsigned short bf16;
typedef short bf16x8 __attribute__((ext_vector_type(8)));
typedef short s16x4 __attribute__((ext_vector_type(4)));
typedef short v4i16_t __attribute__((ext_vector_type(4)));
typedef float f32x2 __attribute__((ext_vector_type(2)));
typedef float f32x4 __attribute__((ext_vector_type(4)));
typedef float f32x16 __attribute__((ext_vector_type(16)));
typedef unsigned u32x2 __attribute__((ext_vector_type(2)));
typedef unsigned u32x4 __attribute__((ext_vector_type(4)));
typedef int v4i __attribute__((ext_vector_type(4)));
typedef int v8i __attribute__((ext_vector_type(8)));
typedef v8i v8i_a16 __attribute__((aligned(16)));
typedef GAS unsigned gu32;
#define RLX_AGENT __ATOMIC_RELAXED, __HIP_MEMORY_SCOPE_AGENT
#define DI __device__ __forceinline__

constexpr int S = 16384, D = 2048, DEPTH = 4, NH = 8, HD = 128, CKV = 256, IH = 16, IDIM = 64, TOPK = 256, MBLK = 256, NBLK = 64, NMEM = 256, NHM = 4, DFF = 5632;
constexpr int INW = 9552, INP = 9728;
constexpr float LN_EPS = 1e-5f;
constexpr float ALPHA = 1.681792830507429f;
constexpr float LOG2E = 1.4426950408889634f;
constexpr float ATT_SCALE2 = 0.08838834764831845f * LOG2E;
constexpr int NWAVES = 8, NTHREADS = 512;
constexpr float F8_SW1 = 64.f, F8_SW2 = 128.f, F8_SH = 16.f, F8_SWI = 32.f;
constexpr float F8_SWO = 64.f, F8_SWOUT = 64.f, F8_SWQM = 32.f, F8_SWOM = 32.f;
constexpr float F8_SOA = 16.f, F8_SOB = 8.f, F8_SMG = 64.f, F8_SOM = 32.f;
constexpr int INB = 3328, IN8 = 6400;

constexpr size_t MiB = 1u << 20;
constexpr size_t WS_CTL = 0, CTL_ZERO_BYTES = 1 * MiB;
constexpr size_t WS_WIN = 1 * MiB;
constexpr size_t WS_WUK = WS_WIN + 38 * MiB;
constexpr size_t WS_WUV = WS_WUK + 1 * MiB;
constexpr size_t WS_WOA = WS_WUV + 1 * MiB;
constexpr size_t WS_WOB = WS_WOA + 4 * MiB;
constexpr size_t WS_WOUT = WS_WOB + 4 * MiB;
constexpr size_t WS_WQM = WS_WOUT + 8 * MiB;
constexpr size_t WS_WOM = WS_WQM + 2 * MiB;
constexpr size_t WS_WF1 = WS_WOM + 2 * MiB;
constexpr size_t WS_WF2 = WS_WF1 + 44 * MiB;
constexpr size_t WS_WKV = WS_WF2 + 22 * MiB;
constexpr size_t WS_MEMB = WS_WKV + 16 * MiB;
constexpr size_t WS_KVMEM = WS_MEMB + 1 * MiB;
constexpr size_t WS_XB = WS_KVMEM + 2 * MiB;
constexpr size_t WS_QDSA = WS_XB + 64 * MiB;
constexpr size_t WS_QIDX = WS_QDSA + 32 * MiB;
constexpr size_t WS_QM = WS_QIDX + 32 * MiB;
constexpr size_t WS_KM = WS_QM + 32 * MiB;
constexpr size_t WS_VM = WS_KM + 32 * MiB;
constexpr size_t WS_GA = WS_VM + 32 * MiB;
constexpr size_t WS_GB = WS_GA + 64 * MiB;
constexpr size_t WS_CKVRAW = WS_GB + 64 * MiB;
constexpr size_t WS_KWRAW = WS_CKVRAW + 16 * MiB;
constexpr size_t WS_H = WS_QDSA;
constexpr size_t WS_CKVN = WS_KWRAW + 16 * MiB;
constexpr size_t WS_KIDXN = WS_CKVN + 8 * MiB;
constexpr size_t WS_WIDX = WS_KIDXN + 2 * MiB;
constexpr size_t WS_KMEAN = WS_WIDX + 1 * MiB;
constexpr size_t WS_QLAT = WS_KMEAN + 1 * MiB;
constexpr size_t WS_SEL = WS_QLAT + 64 * MiB;
constexpr size_t WS_OLAT = WS_SEL + 8 * MiB;
constexpr size_t WS_OA = WS_OLAT + 64 * MiB;
constexpr size_t WS_OB = WS_OA + 32 * MiB;
constexpr size_t WS_BUCK = WS_OB + 32 * MiB;
constexpr size_t WS_PARTO = WS_BUCK + 16 * MiB;
constexpr size_t WS_PARTML = WS_PARTO + 128 * MiB;
constexpr size_t WS_T1 = WS_PARTML + 4 * MiB;
constexpr size_t WS_MERGED = WS_T1 + 64 * MiB;
constexpr size_t WS_Y = WS_MERGED + 64 * MiB;
constexpr size_t WS_QMEM = WS_Y + 64 * MiB;
constexpr size_t WS_OMEM = WS_QMEM + 16 * MiB;
constexpr size_t WS_XB8 = WS_OMEM + 16 * MiB;
constexpr size_t WS_LNX = WS_XB8 + 32 * MiB;
constexpr size_t WS_END = WS_LNX + 1 * MiB;
constexpr size_t WS_WIN8 = WS_WIN + 16 * MiB;
static_assert(WS_H + (size_t)S * DFF * 2 <= WS_CKVN, "h overlay");
static_assert(WS_END <= 1408 * MiB, "workspace");
constexpr int CW_BAR = 4096;
constexpr int CW_BCNT = 16384;
constexpr int CW_LNCNT = 65536;
constexpr int BUCK_PER_HEAD = 256 * 2016;
DI int bucket_off(int b) { return 256 * (63 * b - (b * (b - 1)) / 2); }

constexpr int LDS_BYTES = 147456;
constexpr int RING_BYTES = 131072;
constexpr int MISC_OFF = 143360;
constexpr int LNT_OFF = RING_BYTES;

DI unsigned f2bf(float f) { unsigned u = __builtin_bit_cast(unsigned, f); return (u + 0x7fffu + ((u >> 16) & 1u)) >> 16; }
DI unsigned pk2(float lo, float hi) { return f2bf(lo) | (f2bf(hi) << 16); }
DI unsigned cvt_pk_bf16(float lo, float hi) { unsigned r; asm volatile("v_cvt_pk_bf16_f32 %0, %1, %2" : "=v"(r) : "v"(lo), "v"(hi)); return r; }
DI float clamp448(float x) { return __builtin_amdgcn_fmed3f(x, -448.f, 448.f); }
DI unsigned pk4_fp8(float a, float b, float c, float d) {
    int w = 0; w = __builtin_amdgcn_cvt_pk_fp8_f32(clamp448(a), clamp448(b), w, false); w = __builtin_amdgcn_cvt_pk_fp8_f32(clamp448(c), clamp448(d), w, true); return (unsigned)w; }
DI float bflo(unsigned u) { return __builtin_bit_cast(float, u << 16); }
DI float bfhi(unsigned u) { return __builtin_bit_cast(float, u & 0xffff0000u); }
DI int lane_id() { int l; asm volatile("v_mbcnt_lo_u32_b32 %0, -1, 0\n\tv_mbcnt_hi_u32_b32 %0, -1, %0" : "=v"(l)); return l; }
template <int CTRL> DI int dpp_i(int x) { return __builtin_amdgcn_mov_dpp(x, CTRL, 0xf, 0xf, true); }
template <int CTRL> DI float dpp_f(float x) { return __builtin_bit_cast(float, __builtin_amdgcn_mov_dpp(__builtin_bit_cast(int, x), CTRL, 0xf, 0xf, true)); }
DI float xrow16_sum(float x);
DI float wave_sum(float v) {
    v += dpp_f<0xB1>(v); v += dpp_f<0x4E>(v); v += dpp_f<0x141>(v); v += dpp_f<0x128>(v);
    return xrow16_sum(v);
}
DI unsigned wave_umax(unsigned v) {
    { const unsigned o = (unsigned)dpp_i<0xB1>((int)v); v = o > v ? o : v; } { const unsigned o = (unsigned)dpp_i<0x4E>((int)v); v = o > v ? o : v; }
    { const unsigned o = (unsigned)dpp_i<0x141>((int)v); v = o > v ? o : v; } { const unsigned o = (unsigned)dpp_i<0x128>((int)v); v = o > v ? o : v; }
    { const auto s = __builtin_amdgcn_permlane16_swap(v, v, false, false); v = s[0] > s[1] ? s[0] : s[1]; }
    { const auto s = __builtin_amdgcn_permlane32_swap(v, v, false, false); v = s[0] > s[1] ? s[0] : s[1]; }
    return v;
}
DI unsigned wave_umin(unsigned v) { return ~wave_umax(~v); }
DI float xrow16_max(float x) {
    auto s = __builtin_amdgcn_permlane16_swap(__float_as_uint(x), __float_as_uint(x), false, false);
    x = fmaxf(__uint_as_float(s[0]), __uint_as_float(s[1]));
    auto t = __builtin_amdgcn_permlane32_swap(__float_as_uint(x), __float_as_uint(x), false, false);
    return fmaxf(__uint_as_float(t[0]), __uint_as_float(t[1]));
}
DI float xrow16_sum(float x) {
    auto s = __builtin_amdgcn_permlane16_swap(__float_as_uint(x), __float_as_uint(x), false, false);
    x = __uint_as_float(s[0]) + __uint_as_float(s[1]);
    auto t = __builtin_amdgcn_permlane32_swap(__float_as_uint(x), __float_as_uint(x), false, false);
    return __uint_as_float(t[0]) + __uint_as_float(t[1]);
}
DI float fast_sigmoid(float x) { return __builtin_amdgcn_rcpf(1.0f + __builtin_amdgcn_exp2f(-x * LOG2E)); }
DI s16x4 vtr(unsigned lds_addr) { return __builtin_bit_cast(s16x4, __builtin_amdgcn_ds_read_tr16_b64_v4i16((LAS v4i16_t*)lds_addr)); }
DI unsigned off_b(unsigned row, unsigned ch) { return 256u * row + 16u * (ch ^ (((row & 3) << 2) | ((row >> 2) & 3))); }
DI unsigned tr_addr16(unsigned lane, unsigned c, unsigned ks, unsigned t) {
    const unsigned g = lane >> 4, q = (lane & 15) >> 2, p = lane & 3;
    return off_b(32 * ks + 8 * g + 4 * t + q, 2 * c + (p >> 1)) + 8 * (p & 1);
}
DI unsigned perm32rows(unsigned k) { return (k & ~31u) | (8u * ((k >> 2) & 3u) + 4u * ((k >> 4) & 1u) + (k & 3u)); }

namespace pg8 {
constexpr int BM = 256, BK = 64, HALF = 128, HTB = HALF * BK * 2, STAGE_BYTES = 8 * HTB, NXCD = 8, WGM = 8;
__host__ __device__ __forceinline__ int lds_byte(int r, int c) { const int st = (r >> 4) * 2 + (c >> 5), rr = r & 15, cc = c & 31, ob = rr * 64 + cc * 2; return st * 1024 + (ob ^ (((ob >> 9) & 1) << 5)); }
__host__ __device__ __forceinline__ void stage_rc(int b, int& R, int& C) { const int st = b / 1024, sb = b % 1024, swz = sb ^ (((sb >> 9) & 1) << 5); R = (st >> 1) * 16 + swz / 64; C = (st & 1) * 32 + (swz % 64) / 2; }
__host__ __device__ __forceinline__ int perm32(int rho) { const int n = rho >> 4, i = rho & 15; return 8 * (i >> 2) + 4 * n + (i & 3); }
struct Unit { int pm, pn; };
struct Gemm { const bf16* A; const bf16* Bt; int lda, ldb, K, nM, nN, a_shift, a_koff; };
struct StaticOrder {
    int nM, nN, nwg, G, c, mode;
    DI void init(int nM_, int nN_, int G_, int c_, int mode_ = 0) { nM = nM_; nN = nN_; nwg = nM * nN; G = G_; c = c_; mode = mode_; }
    DI bool next(int i, Unit& u) const {
        long L = (long)i * G + c;
        if (mode == 1) { if (i == 5) L = c < 128 ? 1280 + c : (c >= 192 ? 1280 + 128 + (c - 192) : nwg); else if (i == 6) L = c < 128 ? 1472 + c : nwg; else if (i > 6) L = nwg; }
        if (mode == 2) { if (i == 3) L = (c >= 128 && c < 192) ? 768 + (c - 128) : nwg; else if (i > 3) L = nwg; }
        if (L >= nwg) return false;
        int wgid = (int)L; { const int q = nwg / NXCD, r = nwg % NXCD, xcd = wgid % NXCD, off = wgid / NXCD; wgid = (xcd < r ? xcd * (q + 1) : r * (q + 1) + (xcd - r) * q) + off; }
        const int nig = WGM * nN, gid = wgid / nig, fm = gid * WGM, gsz = (nM - fm) < WGM ? (nM - fm) : WGM;
        u.pm = fm + ((wgid % nig) % gsz); u.pn = (wgid % nig) / gsz; return true;
    }
};
struct EpiBf16 {
    bf16* O; int ldc;
    DI void operator()(const f32x4 (&acc)[2][2][4][2], const Unit& u, int wr, int wc, int fr, int fq) const {
        const int row0 = u.pm * BM + wr * 64 + fr, col0 = u.pn * BM + wc * 32 + 8 * fq;
#pragma unroll
        for (int ai = 0; ai < 2; ++ai)
#pragma unroll
            for (int m = 0; m < 4; ++m) { bf16* rowp = O + (size_t)(row0 + ai * HALF + m * 16) * ldc + col0;
#pragma unroll
                for (int bj = 0; bj < 2; ++bj) { const f32x4 v0 = acc[ai][bj][m][0], v1 = acc[ai][bj][m][1];
                    u32x4 w; w.x = cvt_pk_bf16(v0[0], v0[1]); w.y = cvt_pk_bf16(v0[2], v0[3]); w.z = cvt_pk_bf16(v1[0], v1[1]); w.w = cvt_pk_bf16(v1[2], v1[3]);
                    *(u32x4*)(rowp + bj * HALF) = w; } }
    }
};
struct EpiBf16S {
    bf16* O; int ldc; float scale;
    DI void operator()(const f32x4 (&acc)[2][2][4][2], const Unit& u, int wr, int wc, int fr, int fq) const {
        const int row0 = u.pm * BM + wr * 64 + fr, col0 = u.pn * BM + wc * 32 + 8 * fq;
#pragma unroll
        for (int ai = 0; ai < 2; ++ai)
#pragma unroll
            for (int m = 0; m < 4; ++m) { bf16* rowp = O + (size_t)(row0 + ai * HALF + m * 16) * ldc + col0;
#pragma unroll
                for (int bj = 0; bj < 2; ++bj) { const f32x4 v0 = acc[ai][bj][m][0] * scale, v1 = acc[ai][bj][m][1] * scale;
                    u32x4 w; w.x = cvt_pk_bf16(v0[0], v0[1]); w.y = cvt_pk_bf16(v0[2], v0[3]); w.z = cvt_pk_bf16(v1[0], v1[1]); w.w = cvt_pk_bf16(v1[2], v1[3]);
                    *(u32x4*)(rowp + bj * HALF) = w; } }
    }
};
struct EpiSwiglu8 {
    unsigned char* Hh;
    DI void operator()(const f32x4 (&acc)[2][2][4][2], const Unit& u, int wr, int wc, int fr, int fq) const {
        const int row0 = u.pm * BM + wr * 64 + fr, col0 = u.pn * HALF + wc * 32 + 8 * fq;
#pragma unroll
        for (int ai = 0; ai < 2; ++ai)
#pragma unroll
            for (int m = 0; m < 4; ++m) { unsigned char* rowp = Hh + (size_t)(row0 + ai * HALF + m * 16) * DFF + col0;
                float r[8];
#pragma unroll
                for (int n = 0; n < 2; ++n)
#pragma unroll
                    for (int j = 0; j < 4; ++j) { const float g = acc[ai][0][m][n][j] * (1.0f / F8_SW1), uu = acc[ai][1][m][n][j] * (F8_SH / F8_SW1); r[4 * n + j] = g * fast_sigmoid(g) * uu; }
                u32x2 w; w.x = pk4_fp8(r[0], r[1], r[2], r[3]); w.y = pk4_fp8(r[4], r[5], r[6], r[7]);
                *(u32x2*)rowp = w; }
    }
};
struct EpiF8 {
    unsigned char* O; int ldc; float scale;
    DI void operator()(const f32x4 (&acc)[2][2][4][2], const Unit& u, int wr, int wc, int fr, int fq) const {
        const int row0 = u.pm * BM + wr * 64 + fr, col0 = u.pn * BM + wc * 32 + 8 * fq;
#pragma unroll
        for (int ai = 0; ai < 2; ++ai)
#pragma unroll
            for (int m = 0; m < 4; ++m) { unsigned char* rowp = O + (size_t)(row0 + ai * HALF + m * 16) * ldc + col0;
#pragma unroll
                for (int bj = 0; bj < 2; ++bj) { const f32x4 v0 = acc[ai][bj][m][0] * scale, v1 = acc[ai][bj][m][1] * scale;
                    u32x2 w; w.x = pk4_fp8(v0[0], v0[1], v0[2], v0[3]); w.y = pk4_fp8(v1[0], v1[1], v1[2], v1[3]); *(u32x2*)(rowp + bj * HALF) = w; } }
    }
};
struct EpiGate {
    bf16* O; const bf16* gate; const bf16* add; unsigned char* O8; float ascale, oscale;
    DI void operator()(const f32x4 (&acc)[2][2][4][2], const Unit& u, int wr, int wc, int fr, int fq) const {
        const int row0 = u.pm * BM + wr * 64 + fr, col0 = u.pn * BM + wc * 32 + 8 * fq;
#pragma unroll
        for (int ai = 0; ai < 2; ++ai)
#pragma unroll
            for (int m = 0; m < 4; ++m) { const size_t ro = (size_t)(row0 + ai * HALF + m * 16) * D + col0;
#pragma unroll
                for (int bj = 0; bj < 2; ++bj) { const f32x4 v0 = acc[ai][bj][m][0] * ascale, v1 = acc[ai][bj][m][1] * ascale;
                    const u32x4 g = *(const u32x4*)(gate + ro + bj * HALF);
                    float r[8] = { v0[0] * bflo(g.x), v0[1] * bfhi(g.x), v0[2] * bflo(g.y), v0[3] * bfhi(g.y), v1[0] * bflo(g.z), v1[1] * bfhi(g.z), v1[2] * bflo(g.w), v1[3] * bfhi(g.w) };
                    if (add) { const u32x4 a = *(const u32x4*)(add + ro + bj * HALF);
                        r[0] += bflo(a.x); r[1] += bfhi(a.x); r[2] += bflo(a.y); r[3] += bfhi(a.y); r[4] += bflo(a.z); r[5] += bfhi(a.z); r[6] += bflo(a.w); r[7] += bfhi(a.w); }
                    if (O8) { u32x2 w; w.x = pk4_fp8(r[0] * oscale, r[1] * oscale, r[2] * oscale, r[3] * oscale); w.y = pk4_fp8(r[4] * oscale, r[5] * oscale, r[6] * oscale, r[7] * oscale); *(u32x2*)(O8 + ro + bj * HALF) = w; }
                    else { u32x4 w; w.x = cvt_pk_bf16(r[0], r[1]); w.y = cvt_pk_bf16(r[2], r[3]); w.z = cvt_pk_bf16(r[4], r[5]); w.w = cvt_pk_bf16(r[6], r[7]);
                        *(u32x4*)(O + ro + bj * HALF) = w; } } }
    }
};
struct EpiSwiglu {
    bf16* Hh;
    DI void operator()(const f32x4 (&acc)[2][2][4][2], const Unit& u, int wr, int wc, int fr, int fq) const {
        const int row0 = u.pm * BM + wr * 64 + fr, col0 = u.pn * HALF + wc * 32 + 8 * fq;
#pragma unroll
        for (int ai = 0; ai < 2; ++ai)
#pragma unroll
            for (int m = 0; m < 4; ++m) { bf16* rowp = Hh + (size_t)(row0 + ai * HALF + m * 16) * DFF + col0;
                float r[8];
#pragma unroll
                for (int n = 0; n < 2; ++n)
#pragma unroll
                    for (int j = 0; j < 4; ++j) { const float g = acc[ai][0][m][n][j], uu = acc[ai][1][m][n][j]; r[4 * n + j] = g * fast_sigmoid(g) * uu; }
                u32x4 w; w.x = cvt_pk_bf16(r[0], r[1]); w.y = cvt_pk_bf16(r[2], r[3]); w.z = cvt_pk_bf16(r[4], r[5]); w.w = cvt_pk_bf16(r[6], r[7]);
                *(u32x4*)rowp = w; }
    }
};
struct EpiInBf {
    bf16 *qidx, *qm, *km; float* kwraw;
    DI void operator()(const f32x4 (&acc)[2][2][4][2], const Unit& u, int wr, int wc, int fr, int fq) const {
        const int row0 = u.pm * BM + wr * 64 + fr, cl = wc * 32 + 8 * fq; const int pn = u.pn;
        if (pn == 4) {
#pragma unroll
            for (int ai = 0; ai < 2; ++ai)
#pragma unroll
                for (int m = 0; m < 4; ++m) { float* rowp = kwraw + (size_t)(row0 + ai * HALF + m * 16) * 256 + cl;
#pragma unroll
                    for (int bj = 0; bj < 2; ++bj) { *(f32x4*)(rowp + bj * HALF) = acc[ai][bj][m][0]; *(f32x4*)(rowp + bj * HALF + 4) = acc[ai][bj][m][1]; } }
            return;
        }
        bf16* O; int ct;
        if (pn < 4) { O = qidx; ct = pn; } else if (pn < 9) { O = qm; ct = pn - 5; } else { O = km; ct = pn - 9; }
        const int col0 = ct * BM + cl;
#pragma unroll
        for (int ai = 0; ai < 2; ++ai)
#pragma unroll
            for (int m = 0; m < 4; ++m) { bf16* rowp = O + (size_t)(row0 + ai * HALF + m * 16) * 1024 + col0;
#pragma unroll
                for (int bj = 0; bj < 2; ++bj) { const f32x4 v0 = acc[ai][bj][m][0], v1 = acc[ai][bj][m][1];
                    u32x4 w; w.x = cvt_pk_bf16(v0[0], v0[1]); w.y = cvt_pk_bf16(v0[2], v0[3]); w.z = cvt_pk_bf16(v1[0], v1[1]); w.w = cvt_pk_bf16(v1[2], v1[3]);
                    *(u32x4*)(rowp + bj * HALF) = w; } }
    }
};
struct EpiIn8 {
    bf16 *qdsa, *vm, *ga, *gb; float* ckvraw; const float* bgate;
    DI void operator()(const f32x4 (&acc)[2][2][4][2], const Unit& u, int wr, int wc, int fr, int fq) const {
        const int row0 = u.pm * BM + wr * 64 + fr, cl = wc * 32 + 8 * fq; const int pn = u.pn; const float sc = 1.0f / F8_SWI;
        if (pn == 4) {
#pragma unroll
            for (int ai = 0; ai < 2; ++ai)
#pragma unroll
                for (int m = 0; m < 4; ++m) { float* rowp = ckvraw + (size_t)(row0 + ai * HALF + m * 16) * 256 + cl;
#pragma unroll
                    for (int bj = 0; bj < 2; ++bj) { *(f32x4*)(rowp + bj * HALF) = acc[ai][bj][m][0] * sc; *(f32x4*)(rowp + bj * HALF + 4) = acc[ai][bj][m][1] * sc; } }
            return;
        }
        bf16* O; int ldc, ct; const float* bias = nullptr;
        if (pn < 4) { O = qdsa; ldc = 1024; ct = pn; }
        else if (pn < 9) { O = vm; ldc = 1024; ct = pn - 5; }
        else if (pn < 17) { O = ga; ldc = 2048; ct = pn - 9; bias = bgate; }
        else { O = gb; ldc = 2048; ct = pn - 17; bias = bgate + 2048; }
        const int col0 = ct * BM + cl;
#pragma unroll
        for (int ai = 0; ai < 2; ++ai)
#pragma unroll
            for (int m = 0; m < 4; ++m) { bf16* rowp = O + (size_t)(row0 + ai * HALF + m * 16) * ldc + col0;
#pragma unroll
                for (int bj = 0; bj < 2; ++bj) { f32x4 v0 = acc[ai][bj][m][0] * sc, v1 = acc[ai][bj][m][1] * sc;
                    if (bias) { const f32x4 b0 = *(const f32x4*)(bias + col0 + bj * HALF), b1 = *(const f32x4*)(bias + col0 + bj * HALF + 4);
#pragma unroll
                        for (int j = 0; j < 4; ++j) { v0[j] = fast_sigmoid(v0[j] + b0[j]); v1[j] = fast_sigmoid(v1[j] + b1[j]); } }
                    u32x4 w; w.x = cvt_pk_bf16(v0[0], v0[1]); w.y = cvt_pk_bf16(v0[2], v0[3]); w.z = cvt_pk_bf16(v1[0], v1[1]); w.w = cvt_pk_bf16(v1[2], v1[3]);
                    *(u32x4*)(rowp + bj * HALF) = w; } }
    }
};

struct FusedOrder {
    int c;
    DI bool next(int i, Unit& u) const { if (i >= 2) return false; const int xcd = c & 7, j = c >> 3; u.pm = i * 32 + xcd * 4 + (j >> 3); u.pn = j & 7; return true; }
};
struct EpiLn {
    float* x; const float* g; const float* b; float scale; bf16* xb; unsigned char* xb8; unsigned long long* slots; unsigned* cnt;
    DI void run(f32x4 (&acc)[2][2][4][2], const Unit& u, int wr, int wc, int fr_, int fq_, LAS unsigned char* lds, int wid, int lane_) const {
        int fr = fr_, fq = fq_, lane = lane_; asm volatile("" : "+v"(fr), "+v"(fq), "+v"(lane));
        LAS f32x2* P = (LAS f32x2*)(lds + LNT_OFF); LAS f32x2* Sx = (LAS f32x2*)(lds + LNT_OFF + 8192);
        const int row0 = u.pm * BM + wr * 64 + fr, col0 = u.pn * BM + wc * 32 + 8 * fq;
        __builtin_amdgcn_sched_barrier(0);
#pragma unroll
        for (int ai = 0; ai < 2; ++ai)
#pragma unroll
            for (int m = 0; m < 4; ++m) { const float* xr = x + (size_t)(row0 + ai * HALF + m * 16) * D + col0;
#pragma unroll
                for (int bj = 0; bj < 2; ++bj) { const f32x4 x0 = *(const f32x4*)(xr + bj * HALF), x1 = *(const f32x4*)(xr + bj * HALF + 4);
                    acc[ai][bj][m][0] = x0 * ALPHA + acc[ai][bj][m][0] * scale; acc[ai][bj][m][1] = x1 * ALPHA + acc[ai][bj][m][1] * scale; }
                __builtin_amdgcn_sched_barrier(0);
                asm volatile("" : "+v"(acc[ai][0][m][0]), "+v"(acc[ai][0][m][1]), "+v"(acc[ai][1][m][0]), "+v"(acc[ai][1][m][1]) :: "memory"); }
        __builtin_amdgcn_sched_barrier(0);
#pragma unroll
        for (int ai = 0; ai < 2; ++ai)
#pragma unroll
            for (int m = 0; m < 4; ++m) {
                float s = 0.f;
#pragma unroll
                for (int bj = 0; bj < 2; ++bj)
#pragma unroll
                    for (int n = 0; n < 2; ++n) { const f32x4 v = acc[ai][bj][m][n]; s += (v[0] + v[1]) + (v[2] + v[3]); }
                s = xrow16_sum(s);
                const float mw = s * (1.0f / 64.0f); float q = 0.f;
#pragma unroll
                for (int bj = 0; bj < 2; ++bj)
#pragma unroll
                    for (int n = 0; n < 2; ++n) { const f32x4 d = acc[ai][bj][m][n] - mw; q += (d[0] * d[0] + d[1] * d[1]) + (d[2] * d[2] + d[3] * d[3]); }
                q = xrow16_sum(q);
                if (fq == 0) P[(ai * HALF + wr * 64 + m * 16 + fr) * 4 + wc] = (f32x2){mw, q};
            }
        asm volatile("s_waitcnt lgkmcnt(0)" ::: "memory"); __builtin_amdgcn_s_barrier(); asm volatile("" ::: "memory");
        const int row = wid * 32 + (lane & 31);
        if (lane < 32) {
            const f32x2 a = P[row * 4 + 0], b2 = P[row * 4 + 1], c = P[row * 4 + 2], d = P[row * 4 + 3];
            const float mt = (a[0] + b2[0] + c[0] + d[0]) * 0.25f;
            const float da = a[0] - mt, db = b2[0] - mt, dc = c[0] - mt, dd = d[0] - mt;
            const float m2 = (a[1] + b2[1]) + (c[1] + d[1]) + 64.0f * ((da * da + db * db) + (dc * dc + dd * dd));
            __hip_atomic_store(slots + ((size_t)(u.pm * BM + row) * 8 + u.pn), ((unsigned long long)__float_as_uint(m2) << 32) | __float_as_uint(mt), __ATOMIC_RELAXED, __HIP_MEMORY_SCOPE_AGENT);
        }
        asm volatile("s_waitcnt vmcnt(0)" ::: "memory");
        if (lane == 0) __hip_atomic_fetch_add(cnt + 64 * u.pm, 1u, __ATOMIC_RELAXED, __HIP_MEMORY_SCOPE_AGENT);
        if (wid == 0) {
            unsigned sp = 0;
            while ((unsigned)__builtin_amdgcn_readfirstlane(__hip_atomic_load(cnt + 64 * u.pm, __ATOMIC_RELAXED, __HIP_MEMORY_SCOPE_AGENT)) < 64u) { __builtin_amdgcn_s_sleep(1); if (++sp > (1u << 24)) break; }
            __builtin_amdgcn_fence(__ATOMIC_ACQUIRE, "agent");
        }
        asm volatile("s_waitcnt vmcnt(0) lgkmcnt(0)" ::: "memory"); __builtin_amdgcn_s_barrier(); asm volatile("" ::: "memory");
        if (lane < 32) {
            const unsigned long long* sl = slots + (size_t)(u.pm * BM + row) * 8; float mt[8], m2[8]; float ms = 0.f;
#pragma unroll
            for (int t = 0; t < 8; ++t) { const unsigned long long w = __hip_atomic_load(sl + t, __ATOMIC_RELAXED, __HIP_MEMORY_SCOPE_AGENT); mt[t] = __uint_as_float((unsigned)w); m2[t] = __uint_as_float((unsigned)(w >> 32)); ms += mt[t]; }
            const float mean = ms * 0.125f; float q = 0.f;
#pragma unroll
            for (int t = 0; t < 8; ++t) { const float dm = mt[t] - mean; q += m2[t] + 256.0f * dm * dm; }
            Sx[row] = (f32x2){mean, 1.0f / sqrtf(q * (1.0f / D) + LN_EPS)};
        }
        asm volatile("s_waitcnt lgkmcnt(0)" ::: "memory"); __builtin_amdgcn_s_barrier(); asm volatile("" ::: "memory");
        __builtin_amdgcn_sched_barrier(0);
#pragma unroll
        for (int bj = 0; bj < 2; ++bj) {
            const f32x4 g0 = *(const f32x4*)(g + col0 + bj * HALF), g1 = *(const f32x4*)(g + col0 + bj * HALF + 4), b0 = *(const f32x4*)(b + col0 + bj * HALF), b1 = *(const f32x4*)(b + col0 + bj * HALF + 4);
#pragma unroll
            for (int ai = 0; ai < 2; ++ai)
#pragma unroll
                for (int m = 0; m < 4; ++m) { const int rl = ai * HALF + wr * 64 + m * 16 + fr; const f32x2 sr = Sx[rl]; const size_t off = (size_t)(u.pm * BM + rl) * D + col0 + bj * HALF;
                    const f32x4 o0 = (acc[ai][bj][m][0] - sr[0]) * sr[1] * g0 + b0, o1 = (acc[ai][bj][m][1] - sr[0]) * sr[1] * g1 + b1;
                    *(f32x4*)(x + off) = o0; *(f32x4*)(x + off + 4) = o1;
                    if (xb) { u32x4 w; w.x = cvt_pk_bf16(o0[0], o0[1]); w.y = cvt_pk_bf16(o0[2], o0[3]); w.z = cvt_pk_bf16(o1[0], o1[1]); w.w = cvt_pk_bf16(o1[2], o1[3]); *(u32x4*)(xb + off) = w; }
                    if (xb8) { u32x2 w; w.x = pk4_fp8(o0[0], o0[1], o0[2], o0[3]); w.y = pk4_fp8(o1[0], o1[1], o1[2], o1[3]); *(u32x2*)(xb8 + off) = w; }
                    asm volatile("" ::: "memory"); __builtin_amdgcn_sched_barrier(0); }
        }
        asm volatile("s_waitcnt lgkmcnt(0)" ::: "memory"); __builtin_amdgcn_s_barrier(); asm volatile("" ::: "memory");
    }
};

template <class Epi, bool FP8 = false, class Order = StaticOrder, bool LN = false>
DI void gemm_phase(LAS unsigned char* lds, const Gemm g, const Order& So, const Epi& E, int tid_in) {
    int tid_ = tid_in; asm volatile("" : "+v"(tid_));
    const int tid = tid_, wid = __builtin_amdgcn_readfirstlane(tid >> 6), lane = tid & 63, wr = wid >> 2, wc = wid & 3, fr = lane & 15, fq = lane >> 4;
    const int K = g.K, nt = K / BK;
    unsigned voffA[2], voffB[2];
#pragma unroll
    for (int i = 0; i < 2; ++i) { int R, C; stage_rc(tid * 16 + i * 8192, R, C); const int Rb = (R & ~31) + perm32(R & 31);
        voffA[i] = (unsigned)(R * g.lda + C) * 2u; voffB[i] = (unsigned)(Rb * g.ldb + C) * 2u; }
    const size_t kstep = (size_t)(BK * 2);
    const size_t hstepA = (size_t)HALF * g.lda * 2, hstepB = (size_t)HALF * g.ldb * 2;
    const size_t tstepA = 2 * hstepA, tstepB = 2 * hstepB;
    const unsigned ldsw = (unsigned)wid * 1024u;
    const int aoff = lds_byte(wr * 64 + fr, fq * 8), boff = lds_byte(wc * 32 + fr, fq * 8);
    int one8 = 0x7F7F7F7F; asm volatile("" : "+v"(one8));
#define PG8_SA(b, h) (((b) * 2 + (h)) * HTB)
#define PG8_SB(b, h) ((4 + (b) * 2 + (h)) * HTB)
#define PG8_STAGE(bufoff, gbase, voff) do { _Pragma("unroll") for (int _i = 0; _i < 2; ++_i) \
        __builtin_amdgcn_global_load_lds((const unsigned*)((const char*)(gbase) + (voff)[_i]), (LAS unsigned*)(lds + (bufoff) + ldsw + _i * 8192), 16, 0, 0); } while (0)
#define PG8_LDA(dst, b, h) do { _Pragma("unroll") for (int m = 0; m < 4; ++m) { const LAS unsigned char* p_ = lds + PG8_SA(b, h) + aoff + m * 2048; \
        if constexpr (FP8) { const v4i lo_ = *(const LAS v4i*)p_, hi_ = *(const LAS v4i*)(p_ + 1024); dst##8[m] = __builtin_shufflevector(lo_, hi_, 0, 1, 2, 3, 4, 5, 6, 7); } \
        else { dst[m][0] = *(const LAS v4i*)p_; dst[m][1] = *(const LAS v4i*)(p_ + 1024); } } } while (0)
#define PG8_LDB(dst, b, h) do { _Pragma("unroll") for (int n = 0; n < 2; ++n) { const LAS unsigned char* p_ = lds + PG8_SB(b, h) + boff + n * 2048; \
        if constexpr (FP8) { const v4i lo_ = *(const LAS v4i*)p_, hi_ = *(const LAS v4i*)(p_ + 1024); dst##8[n] = __builtin_shufflevector(lo_, hi_, 0, 1, 2, 3, 4, 5, 6, 7); } \
        else { dst[n][0] = *(const LAS v4i*)p_; dst[n][1] = *(const LAS v4i*)(p_ + 1024); } } } while (0)
#define PG8_MMA(ai, bj, At, Bt) do { __builtin_amdgcn_s_setprio(1); _Pragma("unroll") for (int m = 0; m < 4; ++m) _Pragma("unroll") for (int n = 0; n < 2; ++n) { \
        if constexpr (FP8) { asm volatile("v_mfma_scale_f32_16x16x128_f8f6f4 %0, %1, %2, %0, %3, %3 op_sel_hi:[0,0,0]" : "+v"(acc[ai][bj][m][n]) : "v"(Bt##8[n]), "v"(At##8[m]), "v"(one8)); } \
        else { _Pragma("unroll") for (int k = 0; k < 2; ++k) acc[ai][bj][m][n] = __builtin_amdgcn_mfma_f32_16x16x32_bf16(__builtin_bit_cast(bf16x8, Bt[n][k]), __builtin_bit_cast(bf16x8, At[m][k]), acc[ai][bj][m][n], 0, 0, 0); } } \
        __builtin_amdgcn_s_setprio(0); } while (0)
#define PG8_WAIT_V(n) asm volatile("s_waitcnt vmcnt(" #n ")" ::: "memory")
#define PG8_WAIT_L(n) asm volatile("s_waitcnt lgkmcnt(" #n ")" ::: "memory")
#define PG8_BAR __builtin_amdgcn_s_barrier()
#define PG8_SCHED __builtin_amdgcn_sched_barrier(0)
#define PG8_ABASE(u) ((const char*)g.A + (size_t)(u).pm * tstepA + (size_t)(((u).pn >> g.a_shift) * g.a_koff) * 2)
#define PG8_BBASE(u) ((const char*)g.Bt + (size_t)(u).pn * tstepB)
    Unit cur, nxt; int ui = 0;
    if (!So.next(0, cur)) return;
    f32x4 acc[2][2][4][2];
#pragma unroll
    for (int a = 0; a < 2; ++a)
#pragma unroll
        for (int b = 0; b < 2; ++b)
#pragma unroll
            for (int m = 0; m < 4; ++m)
#pragma unroll
                for (int n = 0; n < 2; ++n) acc[a][b][m][n] = (f32x4){0.f, 0.f, 0.f, 0.f};
    v4i At[4][2], B0[2][2], B1[2][2]; v8i At8[4], B08[2], B18[2];
    const char* cA = PG8_ABASE(cur); const char* cB = PG8_BBASE(cur);
    PG8_STAGE(PG8_SB(0, 0), cB, voffB); PG8_STAGE(PG8_SB(0, 1), cB + hstepB, voffB); PG8_STAGE(PG8_SA(0, 0), cA, voffA); PG8_STAGE(PG8_SA(0, 1), cA + hstepA, voffA);
    if (wr == 1) PG8_BAR;
    PG8_WAIT_V(2); PG8_BAR;
    PG8_STAGE(PG8_SB(1, 0), cB + kstep, voffB); PG8_STAGE(PG8_SA(1, 0), cA + kstep, voffA); PG8_STAGE(PG8_SB(1, 1), cB + hstepB + kstep, voffB);
    PG8_WAIT_V(6); PG8_BAR;
    for (;;) {
        const bool has_next = So.next(ui + 1, nxt);
        const char* nA = has_next ? PG8_ABASE(nxt) : cA; const char* nB = has_next ? PG8_BBASE(nxt) : cB;
        for (int t = 0; t < nt; t += 2) {
            const bool last = (t == nt - 2);
            const char* a1 = cA + (size_t)(t + 1) * kstep;
            const char* a2 = last ? nA : cA + (size_t)(t + 2) * kstep; const char* b2 = last ? nB : cB + (size_t)(t + 2) * kstep;
            const char* a3 = a2 + kstep; const char* b3 = b2 + kstep;
            PG8_LDB(B0, 0, 0); PG8_LDB(B1, 0, 1); PG8_SCHED; PG8_LDA(At, 0, 0); PG8_STAGE(PG8_SA(1, 1), a1 + hstepA, voffA);
            PG8_WAIT_V(8); PG8_WAIT_L(0); PG8_BAR; PG8_MMA(0, 0, At, B0); PG8_MMA(0, 1, At, B1); PG8_BAR; PG8_SCHED;
            PG8_LDA(At, 0, 1); PG8_STAGE(PG8_SB(0, 0), b2, voffB); PG8_STAGE(PG8_SB(0, 1), b2 + hstepB, voffB); PG8_STAGE(PG8_SA(0, 0), a2, voffA);
            PG8_WAIT_V(8); PG8_WAIT_L(0); PG8_BAR; PG8_MMA(1, 0, At, B0); PG8_MMA(1, 1, At, B1); PG8_BAR; PG8_SCHED;
            PG8_LDB(B0, 1, 0); PG8_LDB(B1, 1, 1); PG8_SCHED; PG8_LDA(At, 1, 0); PG8_STAGE(PG8_SA(0, 1), a2 + hstepA, voffA);
            PG8_WAIT_V(8); PG8_WAIT_L(0); PG8_BAR; PG8_MMA(0, 0, At, B0); PG8_MMA(0, 1, At, B1); PG8_BAR; PG8_SCHED;
            PG8_LDA(At, 1, 1); PG8_STAGE(PG8_SB(1, 0), b3, voffB); PG8_STAGE(PG8_SB(1, 1), b3 + hstepB, voffB); PG8_STAGE(PG8_SA(1, 0), a3, voffA);
            PG8_WAIT_V(8); PG8_WAIT_L(0); PG8_BAR; PG8_MMA(1, 0, At, B0); PG8_MMA(1, 1, At, B1); PG8_BAR; PG8_SCHED;
        }
        if (wr == 0) PG8_BAR;
        if constexpr (FP8) asm volatile("s_nop 15\n\ts_nop 15" ::: "memory");
        if constexpr (LN) E.run(acc, cur, wr, wc, fr, fq, lds, wid, lane); else E(acc, cur, wr, wc, fr, fq);
        if (!has_next) break;
#pragma unroll
        for (int a = 0; a < 2; ++a)
#pragma unroll
            for (int b = 0; b < 2; ++b)
#pragma unroll
                for (int m = 0; m < 4; ++m)
#pragma unroll
                    for (int n = 0; n < 2; ++n) acc[a][b][m][n] = (f32x4){0.f, 0.f, 0.f, 0.f};
        cur = nxt; cA = nA; cB = nB; ++ui;
        if (wr == 1) PG8_BAR;
    }
    PG8_WAIT_V(0);
    PG8_BAR;
#undef PG8_SA
#undef PG8_SB
#undef PG8_STAGE
#undef PG8_LDA
#undef PG8_LDB
#undef PG8_MMA
#undef PG8_WAIT_V
#undef PG8_WAIT_L
#undef PG8_BAR
#undef PG8_SCHED
#undef PG8_ABASE
#undef PG8_BBASE
}
}

#define XB_TMO      128
#define XB_XCNT(j)  (256  + 64 * (j))
#define XB_XSUB(j)  (1280 + 64 * (j))
#define XB_XGEN(j)  (2304 + 64 * (j))
#define XB_TOP      3328
#define XB_TOPGEN   3392
#define XCD_BAR_WORDS 3456
#define XB_SPIN_CAP (1u << 22)
DI unsigned xb_ld(unsigned* p)              { return __hip_atomic_load(p, __ATOMIC_RELAXED, __HIP_MEMORY_SCOPE_AGENT); }
DI unsigned xb_add(unsigned* p, unsigned v) { return __hip_atomic_fetch_add(p, v, __ATOMIC_RELAXED, __HIP_MEMORY_SCOPE_AGENT); }
DI unsigned xb_xcc_id() { return (unsigned)__builtin_amdgcn_s_getreg((3 << 11) | 20) & 0xFu; }
#define XB_SPIN(cond, bar) do { unsigned _sp = 0; while (cond) { __builtin_amdgcn_s_sleep(1); \
    if ((++_sp & 255u) == 0u) { if (xb_ld(&(bar)[XB_TMO])) break; if (_sp > XB_SPIN_CAP) { atomicAdd(&(bar)[XB_TMO], 1u); break; } } } } while (0)
struct XcdBarrier { unsigned* bar; unsigned x; volatile LAS unsigned* st; int w0; };
DI XcdBarrier xcd_barrier_post(unsigned* bar, volatile LAS unsigned* st) {
    XcdBarrier b; b.bar = bar; b.x = xb_xcc_id(); b.st = st; b.w0 = __builtin_amdgcn_readfirstlane((int)threadIdx.x >> 6);
    if (threadIdx.x == 0) (void)xb_add(&bar[XB_XCNT(b.x)], 1u);
    return b;
}
DI void xcd_barrier_complete(unsigned* bar, unsigned x, unsigned& nloc, unsigned& nx) {
    const unsigned G = gridDim.x * gridDim.y * gridDim.z;
    unsigned sum, cnt, mine, sp = 0u;
    for (;;) {
        sum = 0u; cnt = 0u; mine = 0u;
#pragma unroll
        for (unsigned j = 0; j < 16; ++j) { const unsigned c = xb_ld(&bar[XB_XCNT(j)]); sum += c; cnt += (c > 0u) ? 1u : 0u; mine = (j == x) ? c : mine; }
        if (sum == G) break;
        __builtin_amdgcn_s_sleep(1);
        if ((++sp & 255u) == 0u) { if (xb_ld(&bar[XB_TMO])) break; if (sp > XB_SPIN_CAP) { atomicAdd(&bar[XB_TMO], 1u); break; } }
    }
    nloc = mine > 0u ? mine : 1u; nx = cnt > 0u ? cnt : 1u;
}
DI void xcd_barrier(const XcdBarrier& b) {
    asm volatile("s_waitcnt vmcnt(0)" ::: "memory");
    __syncthreads();
    if (b.w0 == 0 && lane_id() == 0) {
        unsigned* bar = b.bar;
        __builtin_amdgcn_s_waitcnt(0);
        unsigned nloc = b.st[0], nx = b.st[1];
        if (nloc == 0u) { xcd_barrier_complete(bar, b.x, nloc, nx); b.st[0] = nloc; b.st[1] = nx; }
        const unsigned old = xb_add(&bar[XB_XSUB(b.x)], 1u);
        const unsigned gen = old / nloc;
        if (old + 1u == (gen + 1u) * nloc) {
            __builtin_amdgcn_fence(__ATOMIC_RELEASE, "agent");
            asm volatile("s_waitcnt vmcnt(0)" ::: "memory");
            const unsigned og = xb_add(&bar[XB_TOP], 1u);
            const unsigned tg = og / nx;
            if (og + 1u == (tg + 1u) * nx) xb_add(&bar[XB_TOPGEN], 1u);
            else XB_SPIN(xb_ld(&bar[XB_TOPGEN]) == tg, bar);
            __builtin_amdgcn_fence(__ATOMIC_ACQUIRE, "agent");
            xb_add(&bar[XB_XGEN(b.x)], 1u);
            asm volatile("s_waitcnt vmcnt(0)" ::: "memory");
        } else {
            XB_SPIN(xb_ld(&bar[XB_XGEN(b.x)]) == gen, bar);
            __builtin_amdgcn_fence(__ATOMIC_ACQUIRE, "agent");
            asm volatile("s_waitcnt vmcnt(0)" ::: "memory");
        }
    }
    __syncthreads();
}

struct Args { const float* in[19]; float* out; unsigned char* ws; int ph_lo, ph_hi; };
struct Frame {
    LAS unsigned char* lds; unsigned char* ws; gu32* ctl;
    int tid, lane, wave, bx, G;
};
DI Frame make_frame(unsigned char* ws_in, LAS unsigned char* lds_in, int w0) {
    Frame F; GAS unsigned char* w = (GAS unsigned char*)ws_in; asm volatile("" : "+s"(w)); int t = w0 * 64 + lane_id(); asm volatile("" : "+v"(t));
    F.lds = lds_in; F.ws = (unsigned char*)w; F.ctl = (gu32*)(w + WS_CTL);
    F.tid = t; F.lane = t & 63; F.wave = __builtin_amdgcn_readfirstlane(t >> 6); F.bx = blockIdx.x; F.G = gridDim.x;
    return F;
}

template <int MAP> DI int conv_rowmap(int n) {
    if (MAP == 1) return n < 2384 ? n : n + 176;
    if (MAP == 2) { const int isu = n >= DFF ? 1 : 0, j = n - isu * DFF; return 256 * (j >> 7) + 128 * isu + (j & 127); }
    return n;
}
template <int MAP> DI void conv_item(const float* W, int N, bf16* WT, int ldd, LAS float* scr, int kb, int nb, int lane) {
    const int k0 = 64 * kb, n0 = 32 * nb;
    const bool nok = n0 + (lane & 31) < N;
    { float v[32]; const float* wp = W + (size_t)(k0 + (lane >> 5)) * N + n0 + (lane & 31);
#pragma unroll
      for (int i = 0; i < 32; ++i) v[i] = nok ? wp[(size_t)(2 * i) * N] : 0.f;
#pragma unroll
      for (int i = 0; i < 32; ++i) scr[(2 * i + (lane >> 5)) * 33 + (lane & 31)] = v[i]; }
    asm volatile("s_waitcnt lgkmcnt(0)" ::: "memory");
    const int c = lane & 7;
#pragma unroll
    for (int j = 0; j < 4; ++j) { const int n = (lane >> 3) + 8 * j; const LAS float* s = scr + (8 * c) * 33 + n;
        u32x4 o; o.x = pk2(s[0 * 33], s[1 * 33]); o.y = pk2(s[2 * 33], s[3 * 33]); o.z = pk2(s[4 * 33], s[5 * 33]); o.w = pk2(s[6 * 33], s[7 * 33]);
        if (n0 + n < N) *(u32x4*)(WT + (size_t)conv_rowmap<MAP>(n0 + n) * ldd + k0 + 8 * c) = o; }
    asm volatile("s_waitcnt lgkmcnt(0)" ::: "memory");
}
template <int MAP> DI void conv_item8(const float* W, int N, unsigned char* WT, int ldd, LAS float* scr, int kb, int nb, int lane, float scale) {
    const int k0 = 64 * kb, n0 = 32 * nb;
    const bool nok = n0 + (lane & 31) < N;
    { float v[32]; const float* wp = W + (size_t)(k0 + (lane >> 5)) * N + n0 + (lane & 31);
#pragma unroll
      for (int i = 0; i < 32; ++i) v[i] = nok ? wp[(size_t)(2 * i) * N] : 0.f;
#pragma unroll
      for (int i = 0; i < 32; ++i) scr[(2 * i + (lane >> 5)) * 33 + (lane & 31)] = v[i]; }
    asm volatile("s_waitcnt lgkmcnt(0)" ::: "memory");
    const int c = lane & 3;
#pragma unroll
    for (int j = 0; j < 2; ++j) { const int n = (lane >> 2) + 16 * j; const LAS float* s = scr + (16 * c) * 33 + n;
        u32x4 o; o.x = pk4_fp8(s[0 * 33] * scale, s[1 * 33] * scale, s[2 * 33] * scale, s[3 * 33] * scale); o.y = pk4_fp8(s[4 * 33] * scale, s[5 * 33] * scale, s[6 * 33] * scale, s[7 * 33] * scale);
        o.z = pk4_fp8(s[8 * 33] * scale, s[9 * 33] * scale, s[10 * 33] * scale, s[11 * 33] * scale); o.w = pk4_fp8(s[12 * 33] * scale, s[13 * 33] * scale, s[14 * 33] * scale, s[15 * 33] * scale);
        if (n0 + n < N) *(u32x4*)(WT + (size_t)conv_rowmap<MAP>(n0 + n) * ldd + k0 + 16 * c) = o; }
    asm volatile("s_waitcnt lgkmcnt(0)" ::: "memory");
}
DI int win_rowmap(int c) {
    if (c < 1024) return -1 - c;
    if (c < 1280) return -1 - c;
    if (c < 2304) return c - 1280;
    if (c < 2384) return c - 2304 + 1024;
    if (c < 3408) return c - 2384 + 1280;
    if (c < 4432) return c - 3408 + 2304;
    if (c < 5456) return -1 - (c - 4432 + 1280);
    if (c < 7504) return -1 - (c - 5456 + 2304);
    return -1 - (c - 7504 + 4352);
}
DI void conv_item_win(const float* W, bf16* WTb, unsigned char* WT8, LAS float* scr, int kb, int nb, int lane) {
    const int N = INW, k0 = 64 * kb, n0 = 32 * nb;
    const bool nok = n0 + (lane & 31) < N;
    { float v[32]; const float* wp = W + (size_t)(k0 + (lane >> 5)) * N + n0 + (lane & 31);
#pragma unroll
      for (int i = 0; i < 32; ++i) v[i] = nok ? wp[(size_t)(2 * i) * N] : 0.f;
#pragma unroll
      for (int i = 0; i < 32; ++i) scr[(2 * i + (lane >> 5)) * 33 + (lane & 31)] = v[i]; }
    asm volatile("s_waitcnt lgkmcnt(0)" ::: "memory");
    const int last = n0 + 31 < N ? n0 + 31 : N - 1;
    if (win_rowmap(n0) >= 0 || win_rowmap(last) >= 0) {
        const int c = lane & 7;
#pragma unroll
        for (int j = 0; j < 4; ++j) { const int n = (lane >> 3) + 8 * j; const LAS float* s = scr + (8 * c) * 33 + n; const int rm = n0 + n < N ? win_rowmap(n0 + n) : -1;
            u32x4 o; o.x = pk2(s[0 * 33], s[1 * 33]); o.y = pk2(s[2 * 33], s[3 * 33]); o.z = pk2(s[4 * 33], s[5 * 33]); o.w = pk2(s[6 * 33], s[7 * 33]);
            if (rm >= 0) *(u32x4*)(WTb + (size_t)rm * D + k0 + 8 * c) = o; }
    }
    if (win_rowmap(n0) < 0 || win_rowmap(last) < 0) {
        const int c = lane & 3;
#pragma unroll
        for (int j = 0; j < 2; ++j) { const int n = (lane >> 2) + 16 * j; const LAS float* s = scr + (16 * c) * 33 + n; const int rm = n0 + n < N ? win_rowmap(n0 + n) : 0;
            u32x4 o; o.x = pk4_fp8(s[0 * 33] * F8_SWI, s[1 * 33] * F8_SWI, s[2 * 33] * F8_SWI, s[3 * 33] * F8_SWI); o.y = pk4_fp8(s[4 * 33] * F8_SWI, s[5 * 33] * F8_SWI, s[6 * 33] * F8_SWI, s[7 * 33] * F8_SWI);
            o.z = pk4_fp8(s[8 * 33] * F8_SWI, s[9 * 33] * F8_SWI, s[10 * 33] * F8_SWI, s[11 * 33] * F8_SWI); o.w = pk4_fp8(s[12 * 33] * F8_SWI, s[13 * 33] * F8_SWI, s[14 * 33] * F8_SWI, s[15 * 33] * F8_SWI);
            if (rm < 0) *(u32x4*)(WT8 + (size_t)(-1 - rm) * D + k0 + 16 * c) = o; }
    }
    asm volatile("s_waitcnt lgkmcnt(0)" ::: "memory");
}
DI void zero_rows(bf16* p, int rows, int cols, int ld, int gt, int ngt) {
    const int cpr = cols / 8; unsigned z0; asm volatile("v_mov_b32 %0, 0" : "=v"(z0)); const u32x4 z = {z0, z0, z0, z0};
    for (int i = gt; i < rows * cpr; i += ngt) *(u32x4*)(p + (size_t)(i / cpr) * ld + (i % cpr) * 8) = z;
}
DI void conv_phase(const Frame& F, const Args& a, int l) {
    LAS float* scr = (LAS float*)(F.lds + F.wave * 16384);
    const int gw = F.bx * NWAVES + F.wave, NGW = F.G * NWAVES, lane = F.lane;
    unsigned char* ws = F.ws;
    const float* w_in = a.in[2] + (size_t)l * D * INW; const float* w_uk = a.in[7] + (size_t)l * NH * HD * CKV; const float* w_uv = a.in[8] + (size_t)l * NH * CKV * HD;
    const float* w_oa = a.in[9] + (size_t)l * 1024 * D; const float* w_ob = a.in[10] + (size_t)l * 1024 * D; const float* w_out = a.in[11] + (size_t)l * D * D;
    const float* w_qm = a.in[12] + (size_t)l * D * 512; const float* w_om = a.in[14] + (size_t)l * 512 * D;
    const float* w_f1 = a.in[15] + (size_t)l * D * 2 * DFF; const float* w_f2 = a.in[16] + (size_t)l * DFF * D;
    constexpr int NB_IN = (INW + 31) / 32;
    constexpr int I_IN = 32 * NB_IN, I_UK = 8 * 2 * 8, I_UV = 8 * 4 * 4, I_OA = 16 * 64, I_OUT = 32 * 64, I_QM = 32 * 16, I_OM = 8 * 64, I_F1 = 32 * 352, I_F2 = 88 * 64, I_KV = 4 * 32 * 32;
    const int total = I_IN + I_UK + I_UV + 2 * I_OA + I_OUT + I_QM + I_OM + I_F1 + I_F2 + (l == 0 ? I_KV : 0);
    for (int it = gw; it < total; it += NGW) {
        int r = it;
        if (r < I_IN) { conv_item_win(w_in, (bf16*)(ws + WS_WIN), ws + WS_WIN8, scr, r / NB_IN, r % NB_IN, lane); continue; } r -= I_IN;
        if (r < I_UK) { const int h = r >> 4, q = r & 15; conv_item<0>(w_uk + (size_t)h * HD * CKV, CKV, (bf16*)(ws + WS_WUK) + (size_t)(h * 256) * 256 + (h & 1) * 128, 256, scr, q >> 3, q & 7, lane); continue; } r -= I_UK;
        if (r < I_UV) { const int h = r >> 4, q = r & 15; conv_item<0>(w_uv + (size_t)h * CKV * HD, HD, (bf16*)(ws + WS_WUV) + (size_t)(h * 128) * 512 + (h & 1) * 256, 512, scr, q >> 2, q & 3, lane); continue; } r -= I_UV;
        if (r < I_OA) { conv_item8<0>(w_oa, D, ws + WS_WOA, 1024, scr, r >> 6, r & 63, lane, F8_SWO); continue; } r -= I_OA;
        if (r < I_OA) { conv_item8<0>(w_ob, D, ws + WS_WOB, 1024, scr, r >> 6, r & 63, lane, F8_SWO); continue; } r -= I_OA;
        if (r < I_OUT) { conv_item8<0>(w_out, D, ws + WS_WOUT, D, scr, r >> 6, r & 63, lane, F8_SWOUT); continue; } r -= I_OUT;
        if (r < I_QM) { conv_item8<0>(w_qm, 512, ws + WS_WQM, D, scr, r >> 4, r & 15, lane, F8_SWQM); continue; } r -= I_QM;
        if (r < I_OM) { conv_item8<0>(w_om, D, ws + WS_WOM, 512, scr, r >> 6, r & 63, lane, F8_SWOM); continue; } r -= I_OM;
        if (r < I_F1) { conv_item8<2>(w_f1, 2 * DFF, ws + WS_WF1, D, scr, r / 352, r % 352, lane, F8_SW1); continue; } r -= I_F1;
        if (r < I_F2) { conv_item8<0>(w_f2, D, ws + WS_WF2, DFF, scr, r >> 6, r & 63, lane, F8_SW2); continue; } r -= I_F2;
        { const int ll = r >> 10, q = r & 1023; conv_item<0>(a.in[13] + (size_t)ll * D * 1024, 1024, (bf16*)(ws + WS_WKV) + (size_t)ll * 1024 * D, D, scr, q >> 5, q & 31, lane); }
    }
    const int gt = F.bx * NTHREADS + F.tid, ngt = F.G * NTHREADS;
    zero_rows((bf16*)(ws + WS_WIN) + (size_t)1104 * D, 176, D, D, gt, ngt);
    for (int h = 0; h < NH; ++h) {
        zero_rows((bf16*)(ws + WS_WUK) + (size_t)(h * 256) * 256 + ((h + 1) & 1) * 128, 256, 128, 256, gt, ngt);
        zero_rows((bf16*)(ws + WS_WUV) + (size_t)(h * 128) * 512 + ((h + 1) & 1) * 256, 128, 256, 512, gt, ngt);
    }
    if (l == 0) {
        const f32x4* xs = (const f32x4*)a.in[0]; f32x4* xo = (f32x4*)a.out; u32x2* xb = (u32x2*)(ws + WS_XB);
        unsigned* xb8 = (unsigned*)(ws + WS_XB8);
        for (int i = gt; i < S * D / 4; i += ngt) { const f32x4 v = xs[i]; xo[i] = v; u32x2 w; w.x = pk2(v[0], v[1]); w.y = pk2(v[2], v[3]); xb[i] = w; xb8[i] = pk4_fp8(v[0], v[1], v[2], v[3]); }
        const f32x4* ms = (const f32x4*)a.in[1]; u32x2* mb = (u32x2*)(ws + WS_MEMB);
        for (int i = gt; i < NMEM * D / 4; i += ngt) { const f32x4 v = ms[i]; u32x2 w; w.x = pk2(v[0], v[1]); w.y = pk2(v[2], v[3]); mb[i] = w; }
    }
}

DI void norm_phase(const Frame& F, const Args& a, int l) {
    const int gw = F.bx * NWAVES + F.wave, NGW = F.G * NWAVES, lane = F.lane;
    const float* ckv = (const float*)(F.ws + WS_CKVRAW); const float* kw = (const float*)(F.ws + WS_KWRAW);
    const float* kvg = a.in[4] + l * CKV; const float* ig = a.in[5] + l * IDIM; const float* ib = a.in[6] + l * IDIM;
    const f32x4 g4 = *(const f32x4*)(kvg + 4 * lane); const float gi = ig[lane], bi = ib[lane];
    for (int t = gw; t < S; t += NGW) {
        const f32x4 v = *(const f32x4*)(ckv + (size_t)t * 256 + 4 * lane);
        const float ss = wave_sum(v[0] * v[0] + v[1] * v[1] + v[2] * v[2] + v[3] * v[3]);
        const float r = 1.0f / sqrtf(ss * (1.0f / CKV) + LN_EPS);
        *(unsigned*)(F.ws + WS_CKVN + (size_t)t * 256 + 4 * lane) = pk4_fp8(v[0] * r * g4[0], v[1] * r * g4[1], v[2] * r * g4[2], v[3] * r * g4[3]);
        const float k = kw[(size_t)t * 256 + lane];
        const float mu = wave_sum(k) * (1.0f / IDIM); const float d = k - mu; const float var = wave_sum(d * d) * (1.0f / IDIM);
        const float kn = d * (1.0f / sqrtf(var + LN_EPS)) * gi + bi;
        ((bf16*)(F.ws + WS_KIDXN))[(size_t)t * 64 + lane] = (bf16)f2bf(kn);
        if (lane < IH) ((float*)(F.ws + WS_WIDX))[(size_t)t * IH + lane] = kw[(size_t)t * 256 + 64 + lane];
    }
    const bf16* km = (const bf16*)(F.ws + WS_KM);
    for (int u = gw; u < NH * NBLK; u += NGW) {
        const int h = u >> 6, b = u & 63; float s[8] = {0.f, 0.f, 0.f, 0.f, 0.f, 0.f, 0.f, 0.f};
        const u32x4* p = (const u32x4*)(km + (size_t)(b * MBLK + (lane >> 4)) * 1024 + h * HD + 8 * (lane & 15));
#pragma unroll 16
        for (int i = 0; i < MBLK / 4; ++i) { const u32x4 v = p[(size_t)i * (4 * 1024 / 8)];
            s[0] += bflo(v.x); s[1] += bfhi(v.x); s[2] += bflo(v.y); s[3] += bfhi(v.y); s[4] += bflo(v.z); s[5] += bfhi(v.z); s[6] += bflo(v.w); s[7] += bfhi(v.w); }
#pragma unroll
        for (int e = 0; e < 8; ++e) s[e] = xrow16_sum(s[e]);
        if (lane < 16) { float* o = (float*)(F.ws + WS_KMEAN) + (size_t)(h * NBLK + b) * HD + 8 * lane;
            *(f32x4*)o = (f32x4){s[0], s[1], s[2], s[3]} * (1.0f / MBLK); *(f32x4*)(o + 4) = (f32x4){s[4], s[5], s[6], s[7]} * (1.0f / MBLK); }
    }
}

DI void moba_gate_phase(const Frame& F, int l) {
    LAS float* km = (LAS float*)F.lds; LAS unsigned* lcnt = (LAS unsigned*)(F.lds + 32768); LAS unsigned* gbase = lcnt + 64;
    const bf16* qm = (const bf16*)(F.ws + WS_QM); const float* kmean = (const float*)(F.ws + WS_KMEAN);
    unsigned* bcnt = (unsigned*)(F.ctl + CW_BCNT) + l * 512; unsigned* buck = (unsigned*)(F.ws + WS_BUCK);
    for (int u = F.bx; u < NH * 32; u += F.G) {
        const int h = u & 7, ip = u >> 3; const int own = (F.tid < 256) ? ip : 63 - ip; const int t = own * 256 + (F.tid & 255);
        __syncthreads();
        for (int i = F.tid; i < NBLK * HD / 4; i += NTHREADS) ((LAS f32x4*)km)[i] = ((const f32x4*)(kmean + (size_t)h * NBLK * HD))[i];
        if (F.tid < 64) lcnt[F.tid] = 0u;
        __syncthreads();
        float q[HD];
        { const u32x4* qp = (const u32x4*)(qm + (size_t)t * 1024 + h * HD);
#pragma unroll
          for (int c = 0; c < 16; ++c) { const u32x4 qv = qp[c]; q[8 * c + 0] = bflo(qv.x); q[8 * c + 1] = bfhi(qv.x); q[8 * c + 2] = bflo(qv.y); q[8 * c + 3] = bfhi(qv.y);
              q[8 * c + 4] = bflo(qv.z); q[8 * c + 5] = bfhi(qv.z); q[8 * c + 6] = bflo(qv.w); q[8 * c + 7] = bfhi(qv.w); } }
        const float NEG = -__builtin_inff(); float v0 = NEG, v1 = NEG, v2 = NEG; int i0 = -1, i1 = -1, i2 = -1;
        const int bmax = __builtin_amdgcn_readfirstlane(own);
        for (int b = 0; b < bmax; ++b) {
            const LAS f32x4* kr = (const LAS f32x4*)(km + b * HD);
            float d0 = 0.f, d1 = 0.f, d2 = 0.f, d3 = 0.f;
#pragma unroll
            for (int c = 0; c < 32; ++c) { const f32x4 k = kr[c]; d0 += q[4 * c] * k[0]; d1 += q[4 * c + 1] * k[1]; d2 += q[4 * c + 2] * k[2]; d3 += q[4 * c + 3] * k[3]; }
            const float g = (d0 + d1) + (d2 + d3);
            if (g > v0) { v2 = v1; i2 = i1; v1 = v0; i1 = i0; v0 = g; i0 = b; } else if (g > v1) { v2 = v1; i2 = i1; v1 = g; i1 = b; } else if (g > v2) { v2 = g; i2 = b; }
        }
        unsigned lp0 = 0, lp1 = 0, lp2 = 0;
        if (i0 >= 0) lp0 = atomicAdd((unsigned*)&lcnt[i0], 1u);
        if (i1 >= 0) lp1 = atomicAdd((unsigned*)&lcnt[i1], 1u);
        if (i2 >= 0) lp2 = atomicAdd((unsigned*)&lcnt[i2], 1u);
        __syncthreads();
        if (F.tid < 64) { const unsigned c = lcnt[F.tid]; gbase[F.tid] = c ? __hip_atomic_fetch_add(bcnt + h * 64 + F.tid, c, RLX_AGENT) : 0u; }
        __syncthreads();
        unsigned* bh = buck + (size_t)h * BUCK_PER_HEAD;
        if (i0 >= 0) bh[bucket_off(i0) + gbase[i0] + lp0] = ((unsigned)t << 2) | 0u;
        if (i1 >= 0) bh[bucket_off(i1) + gbase[i1] + lp1] = ((unsigned)t << 2) | 1u;
        if (i2 >= 0) bh[bucket_off(i2) + gbase[i2] + lp2] = ((unsigned)t << 2) | 2u;
    }
    __syncthreads();
}

constexpr int IX_KSTRIDE = 144, IX_KBUF = 128 * IX_KSTRIDE;
constexpr int IX_WSTRIDE = 2048 + 64;
constexpr int IX_CSC = 2 * IX_KBUF;
constexpr int IX_CIX = IX_CSC + 8 * IX_WSTRIDE * 4;
static_assert(IX_CIX + 8 * IX_WSTRIDE * 2 <= MISC_OFF, "indexer LDS");
DI unsigned sortable(float f) { const unsigned u = __float_as_uint(f); return (u >> 31) ? ~u : (u | 0x80000000u); }
DI float unsortable(unsigned k) { return __uint_as_float((k >> 31) ? (k ^ 0x80000000u) : ~k); }
DI unsigned popc64(unsigned long long m) { return (unsigned)__builtin_popcountll(m); }
DI unsigned mbcnt64(unsigned long long m) { return __builtin_amdgcn_mbcnt_hi((unsigned)(m >> 32), __builtin_amdgcn_mbcnt_lo((unsigned)m, 0u)); }
template <int APPROX> DI float ix_compact(LAS float* sc, LAS unsigned short* ix, int& n, int lane) {
    unsigned key[16]; unsigned short idv[16];
    const bool big = n > 512;
    unsigned kmax = 0u, kmin = 0xFFFFFFFFu;
#pragma unroll
    for (int j = 0; j < 16; ++j) { const int e = j * 64 + lane; key[j] = 0u; idv[j] = 0;
        if (j < 8 || big) { const bool v = e < n; key[j] = v ? sortable(sc[e]) : 0u; idv[j] = ix[e]; kmax = key[j] > kmax ? key[j] : kmax; const unsigned km = v ? key[j] : 0xFFFFFFFFu; kmin = km < kmin ? km : kmin; } }
    kmax = wave_umax(kmax); kmin = wave_umin(kmin);
    const unsigned diff = (unsigned)__builtin_amdgcn_readfirstlane((int)(kmax ^ kmin));
    const int nb = diff ? 32 - __builtin_clz(diff) : 0;
    unsigned cur = (unsigned)__builtin_amdgcn_readfirstlane((int)kmax); cur = nb >= 32 ? 0u : (cur >> nb) << nb;
    unsigned ccur = (unsigned)n;
    for (int b = nb - 1; b >= 0; --b) {
        const unsigned trial = cur | (1u << b); unsigned c = 0;
#pragma unroll
        for (int j = 0; j < 8; ++j) c += popc64(__ballot(key[j] >= trial));
        if (big) {
#pragma unroll
            for (int j = 8; j < 16; ++j) c += popc64(__ballot(key[j] >= trial)); }
        if (c >= (unsigned)TOPK) { cur = trial; ccur = c; if (APPROX && c <= 320u) break; }
    }
    unsigned need_eq = 0x7fffffffu;
    if (!APPROX) { unsigned ngt = 0;
#pragma unroll
        for (int j = 0; j < 16; ++j) ngt += popc64(__ballot(key[j] > cur));
        need_eq = (unsigned)TOPK - ngt; }
    unsigned out = 0, eqseen = 0;
#pragma unroll
    for (int j = 0; j < 16; ++j) {
        if (j < 8 || big) {
            const bool valid = (j * 64 + lane) < n; const bool gt = key[j] > cur, eq = valid && key[j] == cur;
            const unsigned long long em = __ballot(eq); const bool keep = (valid && gt) || (eq && (eqseen + mbcnt64(em)) < need_eq);
            const unsigned long long kmk = __ballot(keep); const unsigned pos = out + mbcnt64(kmk);
            if (keep) { sc[pos] = unsortable(key[j]); ix[pos] = idv[j]; }
            out += popc64(kmk); eqseen += popc64(em);
        }
    }
    n = (int)out; (void)ccur;
    return unsortable(cur);
}
DI float relu_nc(float x) { const int b = __float_as_int(x); return __int_as_float(b > 0 ? b : 0); }
#define IX_SCORE(ACC, KEY0, S_) do { \
    f32x2 s0_ = {0.f, 0.f}, s1_ = {0.f, 0.f}; \
    _Pragma("unroll") for (int i_ = 0; i_ < 4; ++i_) { const f32x2 r0_ = {relu_nc(ACC[2 * i_]), relu_nc(ACC[2 * i_ + 1])}, r1_ = {relu_nc(ACC[8 + 2 * i_]), relu_nc(ACC[9 + 2 * i_])}; \
        s0_ = __builtin_elementwise_fma(r0_, wv2[i_], s0_); s1_ = __builtin_elementwise_fma(r1_, wv2[4 + i_], s1_); } \
    const auto sw_ = __builtin_amdgcn_permlane32_swap(__float_as_uint(s0_[0] + s0_[1]), __float_as_uint(s1_[0] + s1_[1]), false, false); \
    S_ = __uint_as_float(sw_[0]) + __uint_as_float(sw_[1]); \
    S_ = ((KEY0) + r) <= tq ? S_ : NEG; } while (0)
#define IX_APPEND(S_, KEY0) do { \
    const bool pass_ = S_ > thr; \
    const unsigned long long mk_ = __ballot(pass_); \
    if (IX_DRY) { dry_acc += S_; } else { \
        const unsigned mlo_ = (unsigned)mk_, mhi_ = (unsigned)(mk_ >> 32); const int nlo_ = __builtin_popcount(mlo_), nhi_ = __builtin_popcount(mhi_); \
        const unsigned base_ = hh ? (unsigned)(cnt1 - nlo_ + 1024) : (unsigned)cnt0; \
        const unsigned pos_ = __builtin_amdgcn_mbcnt_hi(mhi_, __builtin_amdgcn_mbcnt_lo(mlo_, base_)); \
        const unsigned idx_ = pass_ ? pos_ : (unsigned)(2048 + lane);            \
        csc[idx_] = S_; cix[idx_] = (unsigned short)((KEY0) + r); \
        cnt0 += nlo_; cnt1 += nhi_; \
        if ((cnt0 > cnt1 ? cnt0 : cnt1) > 1024 - 64) { \
            if (cnt0 > 1024 - 64) { const float nt_ = ix_compact<1>(csc, cix, cnt0, lane); thr = hh ? thr : nt_; } \
            if (cnt1 > 1024 - 64) { const float nt_ = ix_compact<1>(csc + 1024, cix + 1024, cnt1, lane); thr = hh ? nt_ : thr; } } \
    } } while (0)
#define IX_PROCESS(ACC, KEY0) do { float sc_; IX_SCORE(ACC, KEY0, sc_); IX_APPEND(sc_, KEY0); } while (0)
#define IX_APPEND2(SA_, KEYA, SB_, KEYB) do { \
    if (IX_DRY) { dry_acc += SA_ + SB_; } else { \
        const bool pa_ = SA_ > thr, pb_ = SB_ > thr; \
        const unsigned long long ma_ = __ballot(pa_), mb_ = __ballot(pb_); \
        const unsigned alo_ = (unsigned)ma_, ahi_ = (unsigned)(ma_ >> 32), blo_ = (unsigned)mb_, bhi_ = (unsigned)(mb_ >> 32); \
        const int nal_ = __builtin_popcount(alo_), nah_ = __builtin_popcount(ahi_), nbl_ = __builtin_popcount(blo_), nbh_ = __builtin_popcount(bhi_); \
        const unsigned basea_ = hh ? (unsigned)(cnt1 - nal_ + 1024) : (unsigned)cnt0; \
        const unsigned baseb_ = hh ? (unsigned)(cnt1 + nah_ - nbl_ + 1024) : (unsigned)(cnt0 + nal_); \
        const unsigned posa_ = __builtin_amdgcn_mbcnt_hi(ahi_, __builtin_amdgcn_mbcnt_lo(alo_, basea_)), posb_ = __builtin_amdgcn_mbcnt_hi(bhi_, __builtin_amdgcn_mbcnt_lo(blo_, baseb_)); \
        const unsigned ia_ = pa_ ? posa_ : (unsigned)(2048 + lane), ib_ = pb_ ? posb_ : (unsigned)(2048 + lane); \
        csc[ia_] = SA_; cix[ia_] = (unsigned short)((KEYA) + r); csc[ib_] = SB_; cix[ib_] = (unsigned short)((KEYB) + r); \
        cnt0 += nal_ + nbl_; cnt1 += nah_ + nbh_; \
        if ((cnt0 > cnt1 ? cnt0 : cnt1) > 1024 - 64) { \
            if (cnt0 > 1024 - 64) { const float nt_ = ix_compact<1>(csc, cix, cnt0, lane); thr = hh ? thr : nt_; } \
            if (cnt1 > 1024 - 64) { const float nt_ = ix_compact<1>(csc + 1024, cix + 1024, cnt1, lane); thr = hh ? nt_ : thr; } } \
    } } while (0)
#define IX_MMA(ACC, KB, TILE) do { \
    _Pragma("unroll") for (int i_ = 0; i_ < 16; ++i_) ACC[i_] = 0.f; \
    _Pragma("unroll") for (int kk_ = 0; kk_ < 4; ++kk_) { const bf16x8 b_ = *(const LAS bf16x8*)((KB) + boff + (TILE) * (32 * IX_KSTRIDE) + kk_ * 32); \
        ACC = __builtin_amdgcn_mfma_f32_32x32x16_bf16(af[kk_], b_, ACC, 0, 0, 0); } } while (0)
#define IX_LDB(FR, KB, TILE) do { _Pragma("unroll") for (int kk_ = 0; kk_ < 4; ++kk_) FR[kk_] = *(const LAS bf16x8*)((KB) + boff + (TILE) * (32 * IX_KSTRIDE) + kk_ * 32); } while (0)
#define IX_MMAR(ACC, FR) do { \
    _Pragma("unroll") for (int i_ = 0; i_ < 16; ++i_) ACC[i_] = 0.f; \
    _Pragma("unroll") for (int kk_ = 0; kk_ < 4; ++kk_) ACC = __builtin_amdgcn_mfma_f32_32x32x16_bf16(af[kk_], FR[kk_], ACC, 0, 0, 0); } while (0)
#define IX_MMAR_SCORE(ACCN, FR, ACCC, KEY0, S_) do { IX_MMAR(ACCN, FR); IX_SCORE(ACCC, KEY0, S_); \
    _Pragma("unroll") for (int g_ = 0; g_ < 4; ++g_) { __builtin_amdgcn_sched_group_barrier(0x008, 1, 0); __builtin_amdgcn_sched_group_barrier(0x002, 10, 0); } } while (0)
#define IX_SCHED(CH) do { if (!IX_DRY && (((CH) + 1) == 16 || ((CH) + 1) == 32 || ((CH) + 1) == 64)) { \
    if (cnt0 > 320) { const float nt_ = ix_compact<1>(csc, cix, cnt0, lane); thr = hh ? thr : nt_; } \
    if (cnt1 > 320) { const float nt_ = ix_compact<1>(csc + 1024, cix + 1024, cnt1, lane); thr = hh ? nt_ : thr; } } } while (0)
#define IX_CHUNK(KB, CH) do { \
    int nt_w = ((ta + 1 - (CH) * 128) >> 5) + 1; nt_w = nt_w < 0 ? 0 : (nt_w > 4 ? 4 : nt_w); \
    f32x16 accA, accB; \
    if (nt_w == 4) { float qa_, qb_, qc_, qd_; bf16x8 fr0[4], fr1[4], fr2[4], fr3[4]; f32x16 accC, accD;     \
        IX_LDB(fr0, KB, 0); IX_LDB(fr1, KB, 1); IX_LDB(fr2, KB, 2); IX_LDB(fr3, KB, 3); \
        IX_MMAR(accA, fr0); IX_MMAR(accB, fr1); \
        IX_MMAR(accC, fr2); IX_MMAR(accD, fr3); IX_SCORE(accA, (CH) * 128, qa_); IX_SCORE(accB, (CH) * 128 + 32, qb_); \
        IX_APPEND2(qa_, (CH) * 128, qb_, (CH) * 128 + 32); \
        IX_SCORE(accC, (CH) * 128 + 64, qc_); IX_SCORE(accD, (CH) * 128 + 96, qd_); \
        IX_APPEND2(qc_, (CH) * 128 + 64, qd_, (CH) * 128 + 96); \
    } else if (nt_w > 0) { IX_MMA(accA, KB, 0); \
        if (nt_w > 1) IX_MMA(accB, KB, 1); \
        IX_PROCESS(accA, (CH) * 128); \
        if (nt_w > 1) { if (nt_w > 2) IX_MMA(accA, KB, 2); \
            IX_PROCESS(accB, (CH) * 128 + 32); \
            if (nt_w > 2) IX_PROCESS(accA, (CH) * 128 + 64); } } } while (0)
#define IX_LDSBAR() do { asm volatile("s_waitcnt lgkmcnt(0)" ::: "memory"); __builtin_amdgcn_s_barrier(); asm volatile("" ::: "memory"); } while (0)
DI void indexer_phase(const Frame& F) {
    const int lane = F.lane, wave = F.wave, tid = F.tid, r = lane & 31, hh = lane >> 5;
    const bf16* qidx = (const bf16*)(F.ws + WS_QIDX); const bf16* kidx = (const bf16*)(F.ws + WS_KIDXN); const float* widx = (const float*)(F.ws + WS_WIDX);
    unsigned short* sel = (unsigned short*)(F.ws + WS_SEL);
    LAS float* csc = (LAS float*)(F.lds + IX_CSC) + wave * IX_WSTRIDE; LAS unsigned short* cix = (LAS unsigned short*)(F.lds + IX_CIX) + wave * IX_WSTRIDE;
    const float NEG = -__builtin_inff();
    const unsigned boff = (unsigned)(r * IX_KSTRIDE + hh * 16);
    const unsigned sg0 = (unsigned)((tid >> 3) * 64 + (tid & 7) * 8), sl0 = (unsigned)((tid >> 3) * IX_KSTRIDE + (tid & 7) * 16);
    LAS unsigned char* const kb0 = F.lds, * const kb1 = F.lds + IX_KBUF;
#define IX_LOAD(R, CHK) do { const int c_ = (CHK) < nch ? (CHK) : nch - 1; const bf16* g_ = kidx + (size_t)c_ * (128 * 64) + sg0; R[0] = *(const u32x4*)g_; R[1] = *(const u32x4*)(g_ + 64 * 64); } while (0)
#define IX_STORE(KB, R) do { *(LAS u32x4*)((KB) + sl0) = R[0]; *(LAS u32x4*)((KB) + sl0 + 64 * IX_KSTRIDE) = R[1]; } while (0)
    for (int ui = 0; ui * F.G < S / 16; ++ui) {
        const int unit = ui * F.G + ((ui & 1) ? F.G - 1 - F.bx : F.bx);
        if (unit >= S / 16) continue;
        const int t0 = unit * 16, nkeys = t0 + 16, nch = (nkeys + 127) >> 7;
        const int ta = t0 + 2 * wave;
        bf16x8 af[4];
#pragma unroll
        for (int kk = 0; kk < 4; ++kk) af[kk] = *(const bf16x8*)(qidx + (size_t)(ta + (r >> 4)) * 1024 + (r & 15) * 64 + 16 * kk + 8 * hh);
        f32x2 wv2[8];
#pragma unroll
        for (int i = 0; i < 8; ++i) { const int e0 = 2 * i, e1 = 2 * i + 1;
            wv2[i] = (f32x2){widx[(size_t)(ta + (e0 >> 3)) * IH + (e0 & 3) + 8 * ((e0 >> 2) & 1) + 4 * hh], widx[(size_t)(ta + (e1 >> 3)) * IH + (e1 & 3) + 8 * ((e1 >> 2) & 1) + 4 * hh]}; }
        float thr = NEG; int cnt0 = 0, cnt1 = 0; const int tq = ta + hh;
        float dry_acc = 0.f; (void)dry_acc;
#ifdef IX_PROBE
#define IX_DRY 1
        {
        u32x4 RA[2], RB[2];
        IX_LOAD(RA, 0); IX_LOAD(RB, 1);
        IX_STORE(kb0, RA); IX_LOAD(RA, 2);
        for (int ch = 0; ch < nch; ch += 2) {
            IX_LDSBAR();
            IX_CHUNK(kb0, ch); IX_SCHED(ch);
            IX_STORE(kb1, RB); IX_LOAD(RB, ch + 3);
            IX_LDSBAR();
            if (ch + 1 < nch) { IX_CHUNK(kb1, ch + 1); IX_SCHED(ch + 1); }
            IX_STORE(kb0, RA); IX_LOAD(RA, ch + 4);
        }
        }
        if (dry_acc == 123.456f) sel[0] = 0;
        __syncthreads();
#undef IX_DRY
#endif
#define IX_DRY 0
        {
        u32x4 RA[2], RB[2];
        IX_LOAD(RA, 0); IX_LOAD(RB, 1);
        IX_STORE(kb0, RA); IX_LOAD(RA, 2);
        for (int ch = 0; ch < nch; ch += 2) {
            IX_LDSBAR();
            IX_CHUNK(kb0, ch); IX_SCHED(ch);
            IX_STORE(kb1, RB); IX_LOAD(RB, ch + 3);
            IX_LDSBAR();
            if (ch + 1 < nch) { IX_CHUNK(kb1, ch + 1); IX_SCHED(ch + 1); }
            IX_STORE(kb0, RA); IX_LOAD(RA, ch + 4);
        }
        }
#undef IX_DRY
        if (cnt0 > TOPK) (void)ix_compact<0>(csc, cix, cnt0, lane);
        if (cnt1 > TOPK) (void)ix_compact<0>(csc + 1024, cix + 1024, cnt1, lane);
#pragma unroll
        for (int q = 0; q < 2; ++q) { const int n = q ? cnt1 : cnt0;
#pragma unroll
            for (int j = 0; j < 4; ++j) { const int e = j * 64 + lane; sel[(size_t)(ta + q) * TOPK + e] = e < n ? cix[q * 1024 + e] : (unsigned short)0xFFFFu; } }
        __syncthreads();
    }
#undef IX_LOAD
#undef IX_STORE
}
#undef IX_PROCESS
#undef IX_SCORE
#undef IX_APPEND
#undef IX_MMAR_SCORE
#undef IX_MMAR
#undef IX_LDB
#undef IX_MMA
#undef IX_CHUNK
#undef IX_SCHED

constexpr int DA_WBYTES = 16384 + 256;
DI void dsa_attn_phase(const Frame& F) {
    const int lane = F.lane, fr = lane & 15, fq = lane >> 4;
    const bf16* qlat = (const bf16*)(F.ws + WS_QLAT); const bf16* ckv = (const bf16*)(F.ws + WS_CKVN); const unsigned short* sel = (const unsigned short*)(F.ws + WS_SEL);
    bf16* olat = (bf16*)(F.ws + WS_OLAT);
    LAS unsigned char* img = F.lds + F.wave * DA_WBYTES; LAS float* dist = (LAS float*)(img + 16384);
    const unsigned imgaddr = (unsigned)(size_t)img;
    const float slope2 = __builtin_amdgcn_exp2f(-(float)((fr & 7) + 1)) * LOG2E;
    const int gw = F.bx * NWAVES + F.wave, NGW = F.G * NWAVES;
    unsigned kb[2], vb[2];
#pragma unroll
    for (int kt = 0; kt < 2; ++kt) kb[kt] = imgaddr + off_b(perm32rows(16 * kt + fr), fq) - 64u * (unsigned)(fr & 3);
    const unsigned kx = (unsigned)(fr & 3);
#pragma unroll
    for (int tt = 0; tt < 2; ++tt) { const unsigned a0 = tr_addr16(lane, 0, 0, tt); vb[tt] = imgaddr + a0; }
    const unsigned xh = (((unsigned)(lane & 15) >> 2) << 1) | (unsigned)((lane >> 4) & 1);
#pragma unroll
    for (int tt = 0; tt < 2; ++tt) vb[tt] -= 32u * xh;
    for (int t = gw; t < S; t += NGW) {
        const int nvalid = t + 1 < TOPK ? t + 1 : TOPK;
        bf16x8 qf[8];
#pragma unroll
        for (int kk = 0; kk < 8; ++kk) { qf[kk] = (bf16x8){0, 0, 0, 0, 0, 0, 0, 0}; if (fr < 8) qf[kk] = *(const bf16x8*)(qlat + (size_t)t * 2048 + fr * 256 + 32 * kk + 8 * fq); }
        f32x4 o[16];
#pragma unroll
        for (int c = 0; c < 16; ++c) o[c] = (f32x4){0.f, 0.f, 0.f, 0.f};
        float m = -__builtin_inff(), lsum = 0.f;
        int idxn; { const int e = (lane & 31); const int si = sel[(size_t)t * TOPK + e]; idxn = e < nvalid ? si : 0; }
        const unsigned char* ckv8 = (const unsigned char*)ckv;
        u32x4 gA[8];
#pragma unroll
        for (int i = 0; i < 8; ++i) { const int row = (lane >> 4) + 4 * i; const int ki = __builtin_amdgcn_ds_bpermute(row << 2, idxn); gA[i] = *(const u32x4*)(ckv8 + (size_t)ki * 256 + (lane & 15) * 16); }
        for (int ch = 0; ch < 8; ++ch) {
            unsigned xhl = xh, kxl = kx; asm volatile("" : "+v"(xhl), "+v"(kxl));
            const int myidx = idxn;
            if (ch < 7) { const int e = (ch + 1) * 32 + (lane & 31); const int si = sel[(size_t)t * TOPK + e]; idxn = e < nvalid ? si : 0; }
#pragma unroll
            for (int i = 0; i < 8; ++i) { const unsigned row = (lane >> 4) + 4 * i, p = lane & 15, prow = perm32rows(row); const u32x4 g = gA[i]; unsigned w[8];
#pragma unroll
                for (int q = 0; q < 4; ++q) { const f32x2 lo = __builtin_amdgcn_cvt_pk_f32_fp8((int)g[q], false), hi = __builtin_amdgcn_cvt_pk_f32_fp8((int)g[q], true); w[2 * q] = cvt_pk_bf16(lo[0], lo[1]); w[2 * q + 1] = cvt_pk_bf16(hi[0], hi[1]); }
                LAS unsigned char* hb = img + (p >> 3) * 8192;
                *(LAS u32x4*)(hb + off_b(prow, 2 * (p & 7))) = (u32x4){w[0], w[1], w[2], w[3]}; *(LAS u32x4*)(hb + off_b(prow, 2 * (p & 7) + 1)) = (u32x4){w[4], w[5], w[6], w[7]}; }
            if (lane < 32) { const int e = ch * 32 + lane; dist[lane] = e < nvalid ? (float)(t - myidx) : __builtin_inff(); }
            if (ch < 7) {
#pragma unroll
                for (int i = 0; i < 8; ++i) { const int row = (lane >> 4) + 4 * i; const int ki = __builtin_amdgcn_ds_bpermute(row << 2, idxn); gA[i] = *(const u32x4*)(ckv8 + (size_t)ki * 256 + (lane & 15) * 16); } }
            f32x4 sacc[2];
#pragma unroll
            for (int kt = 0; kt < 2; ++kt) { sacc[kt] = (f32x4){0.f, 0.f, 0.f, 0.f};
#pragma unroll
                for (int kk = 0; kk < 8; ++kk) { const bf16x8 afr = *(const LAS bf16x8*)(kb[kt] + 64u * ((unsigned)(kk & 3) ^ kxl) + 8192u * (kk >> 2));
                    sacc[kt] = __builtin_amdgcn_mfma_f32_16x16x32_bf16(afr, qf[kk], sacc[kt], 0, 0, 0); } }
            float cmax = -__builtin_inff();
#pragma unroll
            for (int kt = 0; kt < 2; ++kt) { const f32x4 dv = *(const LAS f32x4*)(dist + 16 * kt + 4 * fq);
#pragma unroll
                for (int i = 0; i < 4; ++i) { sacc[kt][i] = sacc[kt][i] * ATT_SCALE2 - slope2 * dv[i]; cmax = fmaxf(cmax, sacc[kt][i]); } }
            cmax = xrow16_max(cmax);
            const float mn = fmaxf(m, cmax); const float alpha = __builtin_amdgcn_exp2f(m - mn); m = mn;
            float ps = 0.f;
#pragma unroll
            for (int kt = 0; kt < 2; ++kt)
#pragma unroll
                for (int i = 0; i < 4; ++i) { sacc[kt][i] = __builtin_amdgcn_exp2f(sacc[kt][i] - mn); ps += sacc[kt][i]; }
            ps = xrow16_sum(ps); lsum = lsum * alpha + ps;
            u32x4 pw; pw.x = cvt_pk_bf16(sacc[0][0], sacc[0][1]); pw.y = cvt_pk_bf16(sacc[0][2], sacc[0][3]); pw.z = cvt_pk_bf16(sacc[1][0], sacc[1][1]); pw.w = cvt_pk_bf16(sacc[1][2], sacc[1][3]);
            const bf16x8 pf = __builtin_bit_cast(bf16x8, pw);
#pragma unroll
            for (int c = 0; c < 16; ++c) {
                o[c] = o[c] * alpha;
                const unsigned cx = 32u * ((unsigned)(c & 7) ^ xhl); const s16x4 lo = vtr(vb[0] + cx + 8192u * (c >> 3)), hi = vtr(vb[1] + cx + 8192u * (c >> 3));
                const bf16x8 vfr = __builtin_shufflevector(lo, hi, 0, 1, 2, 3, 4, 5, 6, 7);
                o[c] = __builtin_amdgcn_mfma_f32_16x16x32_bf16(vfr, pf, o[c], 0, 0, 0);
                if ((c & 3) == 3) __builtin_amdgcn_sched_barrier(0);
            }
        }
        const float inv = 1.0f / lsum;
        if (fr < 8) {
#pragma unroll
            for (int c = 0; c < 16; ++c) { u32x2 w; w.x = cvt_pk_bf16(o[c][0] * inv, o[c][1] * inv); w.y = cvt_pk_bf16(o[c][2] * inv, o[c][3] * inv);
                *(u32x2*)(olat + (size_t)t * 2048 + fr * 256 + 16 * c + 4 * fq) = w; }
        }
    }
}

struct BlkAttn { const bf16* K; const bf16* V; int kvld; };
DI void blk_stage(const Frame& F, const bf16* Kp, const bf16* Vp, int kvld) {
    int tl = F.tid; asm volatile("" : "+v"(tl));
#pragma unroll 4
    for (int i = 0; i < 8; ++i) { const int p = tl + 512 * i; const unsigned row = p >> 4, ch = p & 15;
        const u32x4 kv = *(const u32x4*)(Kp + (size_t)row * kvld + ch * 8); const u32x4 vv = *(const u32x4*)(Vp + (size_t)row * kvld + ch * 8);
        *(LAS u32x4*)(F.lds + off_b(row, ch)) = kv; *(LAS u32x4*)(F.lds + 65536 + off_b(perm32rows(row), ch)) = vv; }
}
DI void blk_core(const Frame& F, const bf16* qrow, int tq, int kpos0, float slope2, bool causal, f32x4 (&o)[8], float& m_out, float& l_out) {
    const int lane = F.lane, fr = lane & 15, fq = lane >> 4;
    const unsigned kimg = (unsigned)(size_t)F.lds, vimg = kimg + 65536;
    bf16x8 qf[4];
#pragma unroll
    for (int kk = 0; kk < 4; ++kk) qf[kk] = *(const bf16x8*)(qrow + 32 * kk + 8 * fq);
    unsigned kb[4];
#pragma unroll
    for (int kk = 0; kk < 4; ++kk) kb[kk] = kimg + off_b(fr, 4 * kk + fq);
    f32x4 s[16];
#pragma unroll
    for (int kt = 0; kt < 16; ++kt) { s[kt] = (f32x4){0.f, 0.f, 0.f, 0.f};
#pragma unroll
        for (int kk = 0; kk < 4; ++kk) { const bf16x8 afr = *(const LAS bf16x8*)(kb[kk] + 4096u * kt);
            s[kt] = __builtin_amdgcn_mfma_f32_16x16x32_bf16(afr, qf[kk], s[kt], 0, 0, 0); }
        if ((kt & 3) == 3) __builtin_amdgcn_sched_barrier(0); }
    float mx = -__builtin_inff();
    const float dq = (float)(tq - kpos0 - 4 * fq);
#pragma unroll
    for (int kt = 0; kt < 16; ++kt)
#pragma unroll
        for (int i = 0; i < 4; ++i) { const float dd = dq - (float)(16 * kt + i); float v = s[kt][i] * ATT_SCALE2 - slope2 * dd;
            if (causal && dd < 0.f) v = -__builtin_inff(); s[kt][i] = v; mx = fmaxf(mx, v); }
    mx = xrow16_max(mx);
    float ps = 0.f;
#pragma unroll
    for (int kt = 0; kt < 16; ++kt)
#pragma unroll
        for (int i = 0; i < 4; ++i) { s[kt][i] = __builtin_amdgcn_exp2f(s[kt][i] - mx); ps += s[kt][i]; }
    ps = xrow16_sum(ps);
    unsigned vb[8][2];
#pragma unroll
    for (int dt = 0; dt < 8; ++dt) { vb[dt][0] = vimg + tr_addr16(lane, dt, 0, 0); vb[dt][1] = vimg + tr_addr16(lane, dt, 0, 1); }
#pragma unroll
    for (int dt = 0; dt < 8; ++dt) o[dt] = (f32x4){0.f, 0.f, 0.f, 0.f};
#pragma unroll
    for (int ks = 0; ks < 8; ++ks) {
        u32x4 pw; pw.x = cvt_pk_bf16(s[2 * ks][0], s[2 * ks][1]); pw.y = cvt_pk_bf16(s[2 * ks][2], s[2 * ks][3]); pw.z = cvt_pk_bf16(s[2 * ks + 1][0], s[2 * ks + 1][1]); pw.w = cvt_pk_bf16(s[2 * ks + 1][2], s[2 * ks + 1][3]);
        const bf16x8 pf = __builtin_bit_cast(bf16x8, pw);
#pragma unroll
        for (int dt = 0; dt < 8; ++dt) { const s16x4 lo = vtr(vb[dt][0] + 8192u * ks), hi = vtr(vb[dt][1] + 8192u * ks);
            const bf16x8 vfr = __builtin_shufflevector(lo, hi, 0, 1, 2, 3, 4, 5, 6, 7);
            o[dt] = __builtin_amdgcn_mfma_f32_16x16x32_bf16(vfr, pf, o[dt], 0, 0, 0); }
        __builtin_amdgcn_sched_barrier(0);
    }
    const float inv = 1.0f / ps;
#pragma unroll
    for (int dt = 0; dt < 8; ++dt) o[dt] = o[dt] * inv;
    m_out = mx; l_out = ps;
}

#define BLK2_SOFTMAX(S_, O_, M_, L_, DQ_) do { \
    float mx_ = -__builtin_inff(); \
    _Pragma("unroll") for (int kt = 0; kt < 8; ++kt) _Pragma("unroll") for (int i = 0; i < 4; ++i) { const float dd_ = (DQ_) - (float)(16 * kt + i); float v_ = S_[kt][i] * ATT_SCALE2 - slope2 * dd_; \
        if (causal && dd_ < 0.f) v_ = -__builtin_inff(); S_[kt][i] = v_; mx_ = fmaxf(mx_, v_); } \
    mx_ = xrow16_max(mx_); const float mn_ = fmaxf(M_, mx_); const float al_ = __builtin_amdgcn_exp2f(M_ - mn_); M_ = mn_; float ps_ = 0.f; \
    _Pragma("unroll") for (int kt = 0; kt < 8; ++kt) _Pragma("unroll") for (int i = 0; i < 4; ++i) { S_[kt][i] = __builtin_amdgcn_exp2f(S_[kt][i] - mn_); ps_ += S_[kt][i]; } \
    ps_ = xrow16_sum(ps_); L_ = L_ * al_ + ps_; \
    _Pragma("unroll") for (int dt = 0; dt < 8; ++dt) O_[dt] = O_[dt] * al_; } while (0)
DI void blk_core2(const Frame& F, const bf16* qrowA, const bf16* qrowB, int tqA, int tqB, int kpos0, float slope2, bool causal,
                  f32x4 (&oa)[8], f32x4 (&ob)[8], float& mA, float& lA, float& mB, float& lB) {
    int lane = F.lane; asm volatile("" : "+v"(lane));
    const int fr = lane & 15, fq = lane >> 4;
    const unsigned kimg = (unsigned)(size_t)F.lds, vimg = kimg + 65536;
    bf16x8 qa[4], qb[4];
#pragma unroll
    for (int kk = 0; kk < 4; ++kk) { qa[kk] = *(const bf16x8*)(qrowA + 32 * kk + 8 * fq); qb[kk] = *(const bf16x8*)(qrowB + 32 * kk + 8 * fq); }
    const unsigned kbase = kimg + 256u * (unsigned)fr + 16u * ((unsigned)fq ^ (((unsigned)fr >> 2) & 3u)), kx = (unsigned)fr & 3u;
    const unsigned xh = (((unsigned)(lane & 15) >> 2) << 1) | (unsigned)((lane >> 4) & 1);
    unsigned vb[2];
#pragma unroll
    for (int tt = 0; tt < 2; ++tt) vb[tt] = vimg + tr_addr16(lane, 0, 0, tt) - 32u * xh;
#pragma unroll
    for (int dt = 0; dt < 8; ++dt) { oa[dt] = (f32x4){0.f, 0.f, 0.f, 0.f}; ob[dt] = (f32x4){0.f, 0.f, 0.f, 0.f}; }
    mA = -__builtin_inff(); mB = -__builtin_inff(); lA = 0.f; lB = 0.f;
    for (int half = 0; half < 2; ++half) {
        unsigned kxl = kx, xhl = xh; asm volatile("" : "+v"(kxl), "+v"(xhl));
        f32x4 sa[8], sb[8];
#pragma unroll
        for (int kt = 0; kt < 8; ++kt) { sa[kt] = (f32x4){0.f, 0.f, 0.f, 0.f}; sb[kt] = (f32x4){0.f, 0.f, 0.f, 0.f};
#pragma unroll
            for (int kk = 0; kk < 4; ++kk) { const bf16x8 afr = *(const LAS bf16x8*)(kbase + 64u * ((unsigned)kk ^ kxl) + 4096u * (unsigned)(8 * half + kt));
                sa[kt] = __builtin_amdgcn_mfma_f32_16x16x32_bf16(afr, qa[kk], sa[kt], 0, 0, 0); sb[kt] = __builtin_amdgcn_mfma_f32_16x16x32_bf16(afr, qb[kk], sb[kt], 0, 0, 0); }
            if ((kt & 3) == 3) __builtin_amdgcn_sched_barrier(0); }
        const float dqa = (float)(tqA - kpos0 - 128 * half - 4 * fq), dqb = (float)(tqB - kpos0 - 128 * half - 4 * fq);
        BLK2_SOFTMAX(sa, oa, mA, lA, dqa);
        BLK2_SOFTMAX(sb, ob, mB, lB, dqb);
#pragma unroll
        for (int ks = 0; ks < 4; ++ks) {
            u32x4 pw; pw.x = cvt_pk_bf16(sa[2 * ks][0], sa[2 * ks][1]); pw.y = cvt_pk_bf16(sa[2 * ks][2], sa[2 * ks][3]); pw.z = cvt_pk_bf16(sa[2 * ks + 1][0], sa[2 * ks + 1][1]); pw.w = cvt_pk_bf16(sa[2 * ks + 1][2], sa[2 * ks + 1][3]);
            const bf16x8 pfa = __builtin_bit_cast(bf16x8, pw);
            pw.x = cvt_pk_bf16(sb[2 * ks][0], sb[2 * ks][1]); pw.y = cvt_pk_bf16(sb[2 * ks][2], sb[2 * ks][3]); pw.z = cvt_pk_bf16(sb[2 * ks + 1][0], sb[2 * ks + 1][1]); pw.w = cvt_pk_bf16(sb[2 * ks + 1][2], sb[2 * ks + 1][3]);
            const bf16x8 pfb = __builtin_bit_cast(bf16x8, pw);
#pragma unroll
            for (int dt = 0; dt < 8; ++dt) { const unsigned cx = 32u * ((unsigned)dt ^ xhl) + 8192u * (unsigned)(4 * half + ks);
                const s16x4 lo = vtr(vb[0] + cx), hi = vtr(vb[1] + cx); const bf16x8 vfr = __builtin_shufflevector(lo, hi, 0, 1, 2, 3, 4, 5, 6, 7);
                oa[dt] = __builtin_amdgcn_mfma_f32_16x16x32_bf16(vfr, pfa, oa[dt], 0, 0, 0); ob[dt] = __builtin_amdgcn_mfma_f32_16x16x32_bf16(vfr, pfb, ob[dt], 0, 0, 0); }
            __builtin_amdgcn_sched_barrier(0);
        }
    }
    const float ia = 1.0f / lA, ib = 1.0f / lB;
#pragma unroll
    for (int dt = 0; dt < 8; ++dt) { oa[dt] = oa[dt] * ia; ob[dt] = ob[dt] * ib; }
}
#undef BLK2_SOFTMAX

DI void moba_attn_phase(const Frame& F, int l) {
    LAS int* pre = (LAS int*)(F.lds + RING_BYTES);
    LAS int* wsum = pre + 520;
    const unsigned* bcnt = (const unsigned*)(F.ctl + CW_BCNT) + l * 512; const unsigned* buck = (const unsigned*)(F.ws + WS_BUCK);
    const bf16* qm = (const bf16*)(F.ws + WS_QM); const bf16* km = (const bf16*)(F.ws + WS_KM); const bf16* vm = (const bf16*)(F.ws + WS_VM);
    bf16* parto = (bf16*)(F.ws + WS_PARTO); f32x2* partml = (f32x2*)(F.ws + WS_PARTML);
    const int tid = F.tid, lane = F.lane, fr = lane & 15, fq = lane >> 4;
    __syncthreads();
    { const int n = (int)__hip_atomic_load(bcnt + tid, RLX_AGENT); const int cntu = 1 + ((n + 255) >> 8);
      int v = cntu;
#pragma unroll
      for (int o = 1; o < 64; o <<= 1) { const int x = __builtin_amdgcn_ds_bpermute(((lane - o) & 63) << 2, v); if (lane >= o) v += x; }
      if (lane == 63) wsum[F.wave] = v;
      __syncthreads();
      int base = 0;
      for (int w = 0; w < F.wave; ++w) base += wsum[w];
      pre[tid + 1] = base + v; if (tid == 0) pre[0] = 0;
      __syncthreads(); }
    const int total = pre[512];
    const int u_lo = (int)(((long)total * F.bx) >> 8), u_hi = (int)(((long)total * (F.bx + 1)) >> 8);
    int staged = -1;
    for (int u = u_lo; u < u_hi; ++u) {
        int lo = 0, hi = 512;
        while (hi - lo > 1) { const int mid = (lo + hi) >> 1; if (pre[mid] <= u) lo = mid; else hi = mid; }
        const int hb = lo, h = hb >> 6, b = hb & 63, sub = u - pre[hb];
        if (staged != hb) { __syncthreads(); blk_stage(F, km + (size_t)(b * MBLK) * 1024 + h * HD, vm + (size_t)(b * MBLK) * 1024 + h * HD, 1024); __syncthreads(); staged = hb; }
        int tq[2], slot[2]; bool valid[2] = {true, true}; const bool causal = sub == 0;
#pragma unroll
        for (int g = 0; g < 2; ++g) {
            if (sub == 0) { tq[g] = b * MBLK + F.wave * 32 + g * 16 + fr; slot[g] = 3; }
            else { const int n = (int)__hip_atomic_load(bcnt + hb, RLX_AGENT); const int e = (sub - 1) * 256 + F.wave * 32 + g * 16 + fr; valid[g] = e < n;
                const unsigned ent = buck[(size_t)h * BUCK_PER_HEAD + bucket_off(b) + (valid[g] ? e : 0)]; tq[g] = (int)(ent >> 2); slot[g] = (int)(ent & 3u); } }
        const float slope2 = __builtin_amdgcn_exp2f(-(float)(h + 1)) * LOG2E;
        f32x4 oa[8], ob[8]; float ma, la, mb, lb;
        blk_core2(F, qm + (size_t)tq[0] * 1024 + h * HD, qm + (size_t)tq[1] * 1024 + h * HD, tq[0], tq[1], b * MBLK, slope2, causal, oa, ob, ma, la, mb, lb);
        if (valid[0]) { const size_t pi = ((size_t)tq[0] * NH + h) * 4 + slot[0];
#pragma unroll
            for (int dt = 0; dt < 8; ++dt) { u32x2 w; w.x = cvt_pk_bf16(oa[dt][0], oa[dt][1]); w.y = cvt_pk_bf16(oa[dt][2], oa[dt][3]); *(u32x2*)(parto + pi * HD + 16 * dt + 4 * fq) = w; }
            if (fq == 0) partml[pi] = (f32x2){ma, la}; }
        if (valid[1]) { const size_t pi = ((size_t)tq[1] * NH + h) * 4 + slot[1];
#pragma unroll
            for (int dt = 0; dt < 8; ++dt) { u32x2 w; w.x = cvt_pk_bf16(ob[dt][0], ob[dt][1]); w.y = cvt_pk_bf16(ob[dt][2], ob[dt][3]); *(u32x2*)(parto + pi * HD + 16 * dt + 4 * fq) = w; }
            if (fq == 0) partml[pi] = (f32x2){mb, lb}; }
    }
    __syncthreads();
}
DI void moba_combine_phase(const Frame& F) {
    const bf16* parto = (const bf16*)(F.ws + WS_PARTO); const f32x2* partml = (const f32x2*)(F.ws + WS_PARTML); bf16* ob = (bf16*)(F.ws + WS_OB);
    const int gt = F.bx * NTHREADS + F.tid, ngt = F.G * NTHREADS;
    for (int i = gt; i < S * NH * 16; i += ngt) {
        const int th = i >> 4, c = i & 15, t = th >> 3; const int own = t >> 8, nsel = own < 3 ? own : 3;
        float mj[4], lj[4]; float M = -__builtin_inff();
#pragma unroll
        for (int j = 0; j < 4; ++j) { const bool on = (j == 3) || (j < nsel); const f32x2 ml = partml[(size_t)th * 4 + j]; mj[j] = on ? ml[0] : -__builtin_inff(); lj[j] = on ? ml[1] : 0.f; M = fmaxf(M, mj[j]); }
        float r[8] = {0.f, 0.f, 0.f, 0.f, 0.f, 0.f, 0.f, 0.f}; float wsum_ = 0.f;
#pragma unroll
        for (int j = 0; j < 4; ++j) { const bool on = (j == 3) || (j < nsel);
            if (on) { const float w = lj[j] * __builtin_amdgcn_exp2f(mj[j] - M); wsum_ += w; const u32x4 v = *(const u32x4*)(parto + ((size_t)th * 4 + j) * HD + 8 * c);
                r[0] += w * bflo(v.x); r[1] += w * bfhi(v.x); r[2] += w * bflo(v.y); r[3] += w * bfhi(v.y); r[4] += w * bflo(v.z); r[5] += w * bfhi(v.z); r[6] += w * bflo(v.w); r[7] += w * bfhi(v.w); } }
        const float inv = 1.0f / wsum_;
        float sob = F8_SOB; asm volatile("" : "+v"(sob));   const float is = inv * sob; u32x2 w; w.x = pk4_fp8(r[0] * is, r[1] * is, r[2] * is, r[3] * is); w.y = pk4_fp8(r[4] * is, r[5] * is, r[6] * is, r[7] * is);
        *(u32x2*)((unsigned char*)ob + (size_t)th * HD + 8 * c) = w;
    }
}
DI void mem_attn_phase(const Frame& F, int l) {
    const bf16* qmem = (const bf16*)(F.ws + WS_QMEM); const bf16* kv = (const bf16*)(F.ws + WS_KVMEM) + (size_t)l * 1024; bf16* omem = (bf16*)(F.ws + WS_OMEM);
    const int total = NHM * (S / 256);
    int staged = -1;
    for (int u = F.bx; u < total; u += F.G) {
        const int h = u / (S / 256), qc = u % (S / 256);
        if (staged != h) { __syncthreads(); blk_stage(F, kv + h * HD, kv + 512 + h * HD, 4096); __syncthreads(); staged = h; }
        f32x4 oa[8], ob[8]; float ma, la, mb, lb;
        { const int tq0 = qc * 256 + F.wave * 32 + (F.lane & 15); blk_core2(F, qmem + (size_t)tq0 * 512 + h * HD, qmem + (size_t)(tq0 + 16) * 512 + h * HD, 0, 0, 0, 0.f, false, oa, ob, ma, la, mb, lb); }
        int ln = F.lane; asm volatile("" : "+v"(ln));
        const int fq = ln >> 4, tqa = qc * 256 + F.wave * 32 + (ln & 15), tqb = tqa + 16;
#pragma unroll
        for (int dt = 0; dt < 8; ++dt) { *(unsigned*)((unsigned char*)omem + (size_t)tqa * 512 + h * HD + 16 * dt + 4 * fq) = pk4_fp8(oa[dt][0] * F8_SOM, oa[dt][1] * F8_SOM, oa[dt][2] * F8_SOM, oa[dt][3] * F8_SOM);
            *(unsigned*)((unsigned char*)omem + (size_t)tqb * 512 + h * HD + 16 * dt + 4 * fq) = pk4_fp8(ob[dt][0] * F8_SOM, ob[dt][1] * F8_SOM, ob[dt][2] * F8_SOM, ob[dt][3] * F8_SOM); }
    }
    __syncthreads();
}

DI void ln_phase(const Frame& F, const Args& a, int l, int which) {
    const int gw = F.bx * NWAVES + F.wave, NGW = F.G * NWAVES, lane = F.lane;
    const float* g = a.in[17] + (size_t)(l * 3 + which) * D; const float* b = a.in[18] + (size_t)(l * 3 + which) * D;
    float* x = a.out; const bf16* y = (const bf16*)(F.ws + WS_Y); bf16* xb = (bf16*)(F.ws + WS_XB);
    f32x4 xv[8]; u32x2 yv[8];
    if (gw < S) {
#pragma unroll
        for (int j = 0; j < 8; ++j) { xv[j] = ((const f32x4*)(x + (size_t)gw * D) + lane)[64 * j]; yv[j] = ((const u32x2*)(y + (size_t)gw * D) + lane)[64 * j]; } }
    for (int r = gw; r < S; r += NGW) {
        f32x4 v[8]; float s = 0.f;
#pragma unroll
        for (int j = 0; j < 8; ++j) { v[j] = (f32x4){ALPHA * xv[j][0] + bflo(yv[j].x), ALPHA * xv[j][1] + bfhi(yv[j].x), ALPHA * xv[j][2] + bflo(yv[j].y), ALPHA * xv[j][3] + bfhi(yv[j].y)}; s += (v[j][0] + v[j][1]) + (v[j][2] + v[j][3]); }
        const int rn = r + NGW;
        if (rn < S) {
#pragma unroll
            for (int j = 0; j < 8; ++j) { xv[j] = ((const f32x4*)(x + (size_t)rn * D) + lane)[64 * j]; yv[j] = ((const u32x2*)(y + (size_t)rn * D) + lane)[64 * j]; } }
        const float mean = wave_sum(s) * (1.0f / D); float s2 = 0.f;
#pragma unroll
        for (int j = 0; j < 8; ++j) { v[j] = v[j] - mean; s2 += (v[j][0] * v[j][0] + v[j][1] * v[j][1]) + (v[j][2] * v[j][2] + v[j][3] * v[j][3]); }
        const float rstd = 1.0f / sqrtf(wave_sum(s2) * (1.0f / D) + LN_EPS);
        f32x4* xr = (f32x4*)(x + (size_t)r * D) + lane; u32x2* xbr = (u32x2*)(xb + (size_t)r * D) + lane;
#pragma unroll
        for (int j = 0; j < 8; ++j) { const f32x4 g4 = ((const f32x4*)g)[lane + 64 * j], b4 = ((const f32x4*)b)[lane + 64 * j]; const f32x4 o = v[j] * rstd * g4 + b4;
            xr[64 * j] = o;
            if (which != 2) ((unsigned*)(xb) + (size_t)r * (D / 4) + lane)[64 * j] = pk4_fp8(o[0], o[1], o[2], o[3]);
            else { u32x2 w; w.x = pk2(o[0], o[1]); w.y = pk2(o[2], o[3]); xbr[64 * j] = w;
                if (which == 2) ((unsigned*)(F.ws + WS_XB8) + (size_t)r * (D / 4) + lane)[64 * j] = pk4_fp8(o[0], o[1], o[2], o[3]); } }
    }
}


#ifdef SELFCHECK
constexpr int CW_ERR = 24576;
#ifndef SELFCHECK_MASK
#define SELFCHECK_MASK 0xFFFFFFFFu
#endif
#define CHK_ON(w) (((SELFCHECK_MASK) >> (w)) & 1u)
#ifndef SELFCHECK_TOL
#define SELFCHECK_TOL 0.05f
#endif
__device__ const int CHK_TS[8] = {0, 1, 255, 256, 511, 4097, 9000, 16383};
__device__ const int CHK_BND[19] = {1023, 1024, 1279, 1280, 2303, 2304, 2367, 2368, 2383, 2384, 3407, 3408, 4431, 4432, 5455, 5456, 7503, 7504, 9551};
DI void chk_report(gu32* ctl, int which, float err) {
    if (!(err >= 0.f)) err = 1e30f;
    __hip_atomic_fetch_max((unsigned*)(ctl + CW_ERR + which), __float_as_uint(err), RLX_AGENT);
}
DI float bfr(float w) { return __uint_as_float(f2bf(w) << 16); }
DI float bf2f(bf16 v) { return __uint_as_float(((unsigned)v) << 16); }
DI float relerr(float got, float ref, float fl) { return fabsf(got - ref) / (fabsf(ref) + fl); }
DI float wdot(const bf16* a, int K, const float* W, size_t ldw, int lane) {
    float s = 0.f; for (int k = lane; k < K; k += 64) s += bf2f(a[k]) * bfr(W[(size_t)k * ldw]); return wave_sum(s);
}
DI float fp8dec(unsigned char v) { return __builtin_amdgcn_cvt_f32_fp8((int)v, 0); }
DI float f8r(float w, float scale) { return fp8dec((unsigned char)(pk4_fp8(w * scale, 0.f, 0.f, 0.f) & 0xffu)) / scale; }
DI void chk_inproj(const Frame& F, const Args& a) {
    const int gw = F.bx * NWAVES + F.wave, NGW = F.G * NWAVES, lane = F.lane; unsigned char* ws = F.ws;
    const int NC = 83;
    for (int sidx = gw; sidx < 8 * NC; sidx += NGW) {
        const int t = CHK_TS[sidx / NC], ci = sidx % NC;
        const int c = ci < 64 ? (ci * 149 + 7) % INW : CHK_BND[ci - 64];
        float ref;
        if (win_rowmap(c) >= 0) ref = wdot((const bf16*)(ws + WS_XB) + (size_t)t * D, D, a.in[2] + c, INW, lane);
        else { float s = 0.f; for (int k = lane; k < D; k += 64) s += fp8dec((ws + WS_XB8)[(size_t)t * D + k]) * f8r(a.in[2][(size_t)k * INW + c], F8_SWI); ref = wave_sum(s); }
        float got, r2 = ref, fl = 0.3f;
        if (c < 1024) got = bf2f(((const bf16*)(ws + WS_QDSA))[(size_t)t * 1024 + c]);
        else if (c < 1280) got = ((const float*)(ws + WS_CKVRAW))[(size_t)t * 256 + c - 1024];
        else if (c < 2304) got = bf2f(((const bf16*)(ws + WS_QIDX))[(size_t)t * 1024 + c - 1280]);
        else if (c < 2384) got = ((const float*)(ws + WS_KWRAW))[(size_t)t * 256 + c - 2304];
        else if (c < 3408) got = bf2f(((const bf16*)(ws + WS_QM))[(size_t)t * 1024 + c - 2384]);
        else if (c < 4432) got = bf2f(((const bf16*)(ws + WS_KM))[(size_t)t * 1024 + c - 3408]);
        else if (c < 5456) got = bf2f(((const bf16*)(ws + WS_VM))[(size_t)t * 1024 + c - 4432]);
        else if (c < 7504) { got = bf2f(((const bf16*)(ws + WS_GA))[(size_t)t * D + c - 5456]); r2 = 1.f / (1.f + expf(-(ref + a.in[3][c - 5456]))); }
        else { got = bf2f(((const bf16*)(ws + WS_GB))[(size_t)t * D + c - 7504]); r2 = 1.f / (1.f + expf(-(ref + a.in[3][D + c - 7504]))); }
        if (lane == 0) chk_report(F.ctl, 0, relerr(got, r2, fl));
    }
}
DI void chk_norms(const Frame& F, const Args& a) {
    const int gw = F.bx * NWAVES + F.wave, NGW = F.G * NWAVES, lane = F.lane; unsigned char* ws = F.ws;
    for (int sidx = gw; sidx < 8; sidx += NGW) {
        const int t = CHK_TS[sidx]; const float* cr = (const float*)(ws + WS_CKVRAW) + (size_t)t * 256; const float* kw = (const float*)(ws + WS_KWRAW) + (size_t)t * 256;
        float ss = 0.f; for (int c = 0; c < 256; ++c) ss += cr[c] * cr[c];
        const float r = 1.f / sqrtf(ss / 256.f + LN_EPS); float e = 0.f;
        for (int c = lane; c < 256; c += 64) e = fmaxf(e, relerr(fp8dec((ws + WS_CKVN)[(size_t)t * 256 + c]), cr[c] * r * a.in[4][c], 0.3f));
        float mu = 0.f; for (int c = 0; c < 64; ++c) mu += kw[c]; mu /= 64.f; float var = 0.f; for (int c = 0; c < 64; ++c) var += (kw[c] - mu) * (kw[c] - mu); var /= 64.f;
        e = fmaxf(e, relerr(bf2f(((const bf16*)(ws + WS_KIDXN))[(size_t)t * 64 + lane]), (kw[lane] - mu) / sqrtf(var + LN_EPS) * a.in[5][lane] + a.in[6][lane], 0.3f));
        if (lane < 16) e = fmaxf(e, relerr(((const float*)(ws + WS_WIDX))[(size_t)t * 16 + lane], kw[64 + lane], 0.01f));
        chk_report(F.ctl, 1, e);
    }
    for (int sidx = gw; sidx < 8 * 64; sidx += NGW) {
        const int t = CHK_TS[sidx >> 6], h = sidx & 7, c = (((sidx >> 3) & 7) * 37 + (sidx & 7) * 3) & 255;
        const float ref = wdot((const bf16*)(ws + WS_QDSA) + (size_t)t * 1024 + h * HD, HD, a.in[7] + (size_t)h * HD * CKV + c, CKV, lane);
        if (lane == 0) chk_report(F.ctl, 1, relerr(bf2f(((const bf16*)(ws + WS_QLAT))[(size_t)t * 2048 + h * 256 + c]), ref, 0.3f));
    }
    for (int sidx = gw; sidx < 64; sidx += NGW) {
        const int h = sidx & 7, b = ((sidx >> 3) * 9) & 63; float s0 = 0.f, s1 = 0.f;
        for (int k = 0; k < MBLK; ++k) { s0 += bf2f(((const bf16*)(ws + WS_KM))[(size_t)(b * MBLK + k) * 1024 + h * HD + lane]); s1 += bf2f(((const bf16*)(ws + WS_KM))[(size_t)(b * MBLK + k) * 1024 + h * HD + 64 + lane]); }
        const float* km = (const float*)(ws + WS_KMEAN) + (size_t)(h * NBLK + b) * HD;
        chk_report(F.ctl, 1, fmaxf(relerr(km[lane], s0 / 256.f, 0.02f), relerr(km[64 + lane], s1 / 256.f, 0.02f)));
    }
}
DI float chk_score(const unsigned char* ws, int t, int key) {
    const bf16* q = (const bf16*)(ws + WS_QIDX) + (size_t)t * 1024; const bf16* k = (const bf16*)(ws + WS_KIDXN) + (size_t)key * 64; const float* w = (const float*)(ws + WS_WIDX) + (size_t)t * 16;
    float s = 0.f;
    for (int h = 0; h < 16; ++h) { float d = 0.f; for (int i = 0; i < 64; ++i) d += bf2f(q[h * 64 + i]) * bf2f(k[i]); s += w[h] * fmaxf(d, 0.f); }
    return s;
}
DI void chk_topk(const Frame& F, int l) {
    const int gw = F.bx * NWAVES + F.wave, NGW = F.G * NWAVES, lane = F.lane; unsigned char* ws = F.ws;
    for (int sidx = gw; sidx < 8; sidx += NGW) {
        const int t = CHK_TS[sidx]; const unsigned short* sel = (const unsigned short*)(ws + WS_SEL) + (size_t)t * TOPK; const int nsel = t + 1 < TOPK ? t + 1 : TOPK;
        float bad = 0.f, mn = __builtin_inff();
        for (int i = lane; i < TOPK; i += 64) {
            const int k = sel[i];
            if (i < nsel) { if (k > t) bad += 1.f; else mn = fminf(mn, chk_score(ws, t, k)); if (i + 1 < nsel && sel[i + 1] <= k) bad += 1.f; }
            else if (k != 0xFFFF) bad += 1.f;
        }
#pragma unroll
        for (int o = 1; o < 64; o <<= 1) mn = fminf(mn, __shfl_xor(mn, o));
        float cnt = 0.f; for (int k = lane; k <= t; k += 64) if (chk_score(ws, t, k) > mn * (mn > 0.f ? 1.00001f : 0.99999f) + 1e-6f) cnt += 1.f;
        cnt = wave_sum(cnt); bad = wave_sum(bad);
        const float extra = cnt - (float)(nsel - 1); chk_report(F.ctl, 2, (bad + (extra > 0.f ? extra : 0.f)) / 16.f);
    }
    for (int sidx = gw; sidx < 64; sidx += NGW) {
        const int t = CHK_TS[sidx >> 3], h = sidx & 7, own = t >> 8; const bf16* q = (const bf16*)(ws + WS_QM) + (size_t)t * 1024 + h * HD;
        float g = -__builtin_inff();
        if (lane < own) { g = 0.f; const float* km = (const float*)(ws + WS_KMEAN) + (size_t)(h * NBLK + lane) * HD; for (int d = 0; d < HD; ++d) g += bf2f(q[d]) * km[d]; }
        float bad = 0.f; const int nsel = own < 3 ? own : 3; float gg = g;
        for (int j = 0; j < nsel; ++j) {
            float mx = gg; int mi = lane;
#pragma unroll
            for (int o = 1; o < 64; o <<= 1) { const float ov = __shfl_xor(mx, o); const int oi = __shfl_xor(mi, o); if (ov > mx || (ov == mx && oi < mi)) { mx = ov; mi = oi; } }
            float g2 = (lane == mi) ? -__builtin_inff() : gg;
#pragma unroll
            for (int o = 1; o < 64; o <<= 1) g2 = fmaxf(g2, __shfl_xor(g2, o));
            const bool neartie = (mx - g2) < 1e-4f * (fabsf(mx) + 1e-3f);
            const unsigned n = ((const unsigned*)(F.ctl + CW_BCNT))[l * 512 + h * 64 + mi]; const unsigned* bk = (const unsigned*)(ws + WS_BUCK) + (size_t)h * BUCK_PER_HEAD + bucket_off(mi);
            float found = 0.f; for (unsigned i = lane; i < n; i += 64) if (bk[i] == (((unsigned)t << 2) | (unsigned)j)) found = 1.f;
            if (wave_sum(found) != 1.f && !neartie) bad += 1.f;
            if (lane == mi) gg = -__builtin_inff();
        }
        chk_report(F.ctl, 3, bad);
    }
}
DI void chk_attn(const Frame& F, const Args& a) {
    const int gw = F.bx * NWAVES + F.wave, NGW = F.G * NWAVES, lane = F.lane; unsigned char* ws = F.ws;
    for (int sidx = gw; sidx < 64; sidx += NGW) {
        const int t = CHK_TS[sidx >> 3], h = sidx & 7; const float slope = exp2f(-(float)(h + 1));
        {
            const unsigned short* sel = (const unsigned short*)(ws + WS_SEL) + (size_t)t * TOPK; const int nsel = t + 1 < TOPK ? t + 1 : TOPK;
            const bf16* q = (const bf16*)(ws + WS_QLAT) + (size_t)t * 2048 + h * 256; const unsigned char* ck = ws + WS_CKVN;
            float sc[4]; float mx = -__builtin_inff();
#pragma unroll
            for (int j = 0; j < 4; ++j) { const int i = lane + 64 * j; sc[j] = -__builtin_inff();
                if (i < nsel) { const int k = sel[i]; float d = 0.f; for (int c = 0; c < 256; ++c) d += bf2f(q[c]) * fp8dec(ck[(size_t)k * 256 + c]); sc[j] = d * 0.08838834764831845f - slope * (float)(t - k); }
                mx = fmaxf(mx, sc[j]); }
#pragma unroll
            for (int o = 1; o < 64; o <<= 1) mx = fmaxf(mx, __shfl_xor(mx, o));
            float p[4], ps = 0.f;
#pragma unroll
            for (int j = 0; j < 4; ++j) { p[j] = expf(sc[j] - mx); ps += p[j]; } ps = wave_sum(ps);
            float o4[4] = {0.f, 0.f, 0.f, 0.f};
#pragma unroll
            for (int j = 0; j < 4; ++j) for (int src = 0; src < 64; ++src) { const float pp = __shfl(p[j], src); const int i = src + 64 * j; if (i < nsel) { const int k = sel[i];
                _Pragma("unroll") for (int e = 0; e < 4; ++e) o4[e] += pp * fp8dec(ck[(size_t)k * 256 + lane * 4 + e]); } }
            float er = 0.f;
#pragma unroll
            for (int e = 0; e < 4; ++e) er = fmaxf(er, relerr(bf2f(((const bf16*)(ws + WS_OLAT))[(size_t)t * 2048 + h * 256 + lane * 4 + e]), o4[e] / ps, 0.05f));
            chk_report(F.ctl, 4, er);
        }
        {
            const int own = t >> 8; const bf16* q = (const bf16*)(ws + WS_QM) + (size_t)t * 1024 + h * HD; const bf16* kk = (const bf16*)(ws + WS_KM); const bf16* vv = (const bf16*)(ws + WS_VM);
            float g = -__builtin_inff();
            if (lane < own) { g = 0.f; const float* km = (const float*)(ws + WS_KMEAN) + (size_t)(h * NBLK + lane) * HD; for (int d = 0; d < HD; ++d) g += bf2f(q[d]) * km[d]; }
            int blks[4] = {-1, -1, -1, own}; const int nsel = own < 3 ? own : 3; float gg = g;
#pragma unroll
            for (int j = 0; j < 3; ++j) { if (j < nsel) { float mx = gg; int mi = lane;
#pragma unroll
                for (int o = 1; o < 64; o <<= 1) { const float ov = __shfl_xor(mx, o); const int oi = __shfl_xor(mi, o); if (ov > mx || (ov == mx && oi < mi)) { mx = ov; mi = oi; } }
                blks[j] = mi; if (lane == mi) gg = -__builtin_inff(); } }
            float M = -__builtin_inff();
#pragma unroll
            for (int bi = 0; bi < 4; ++bi) { if (blks[bi] >= 0) for (int k0 = lane; k0 < MBLK; k0 += 64) { const int kp = blks[bi] * MBLK + k0; if (kp <= t) { float d = 0.f; for (int e = 0; e < HD; ++e) d += bf2f(q[e]) * bf2f(kk[(size_t)kp * 1024 + h * HD + e]);
                M = fmaxf(M, d * 0.08838834764831845f - slope * (float)(t - kp)); } } }
#pragma unroll
            for (int o = 1; o < 64; o <<= 1) M = fmaxf(M, __shfl_xor(M, o));
            float ps = 0.f, o0 = 0.f, o1 = 0.f;
#pragma unroll
            for (int bi = 0; bi < 4; ++bi) { if (blks[bi] >= 0) for (int kb = 0; kb < MBLK; kb += 64) { const int kp = blks[bi] * MBLK + kb + lane; float p = 0.f;
                if (kp <= t) { float d = 0.f; for (int e = 0; e < HD; ++e) d += bf2f(q[e]) * bf2f(kk[(size_t)kp * 1024 + h * HD + e]); p = expf(d * 0.08838834764831845f - slope * (float)(t - kp) - M); }
                ps += p;
                for (int src = 0; src < 64; ++src) { const float pp = __shfl(p, src); const int kq = blks[bi] * MBLK + kb + src; if (kq <= t) { o0 += pp * bf2f(vv[(size_t)kq * 1024 + h * HD + 2 * lane]); o1 += pp * bf2f(vv[(size_t)kq * 1024 + h * HD + 2 * lane + 1]); } } } }
            ps = wave_sum(ps);
            const unsigned char* ob = ws + WS_OB + (size_t)t * 1024 + h * HD;
            chk_report(F.ctl, 5, fmaxf(relerr(fp8dec(ob[2 * lane]) / F8_SOB, o0 / ps, 0.1f), relerr(fp8dec(ob[2 * lane + 1]) / F8_SOB, o1 / ps, 0.1f)));
        }
        {
            float r0 = 0.f, r1 = 0.f; const bf16* ol = (const bf16*)(ws + WS_OLAT) + (size_t)t * 2048 + h * 256; const float* wu = a.in[8] + (size_t)h * CKV * HD;
            for (int c = 0; c < 256; ++c) { r0 += bf2f(ol[c]) * bfr(wu[c * HD + lane]); r1 += bf2f(ol[c]) * bfr(wu[c * HD + 64 + lane]); }
            const unsigned char* oa = ws + WS_OA + (size_t)t * 1024 + h * HD;
            chk_report(F.ctl, 6, fmaxf(relerr(fp8dec(oa[lane]) / F8_SOA, r0, 0.05f), relerr(fp8dec(oa[64 + lane]) / F8_SOA, r1, 0.05f)));
        }
    }
}
DI void chk_dense(const Frame& F, int word, const bf16* act, int lda, int K, const float* W, int N, const bf16* out, int ldo, float fl) {
    const int gw = F.bx * NWAVES + F.wave, NGW = F.G * NWAVES, lane = F.lane;
    for (int sidx = gw; sidx < 8 * 24; sidx += NGW) { const int t = CHK_TS[sidx / 24], n = ((sidx % 24) * 211 + 5) % N;
        const float ref = wdot(act + (size_t)t * lda, K, W + n, N, lane);
        if (lane == 0) chk_report(F.ctl, word, relerr(bf2f(out[(size_t)t * ldo + n]), ref, fl)); }
}
DI float wdot8r(const unsigned char* a8, int K, const float* W, size_t ldw, float wscale, int lane) {
    float s = 0.f; for (int k = lane; k < K; k += 64) s += fp8dec(a8[k]) * f8r(W[(size_t)k * ldw], wscale); return wave_sum(s);
}
DI void chk_merged(const Frame& F, const Args& a) {
    const int gw = F.bx * NWAVES + F.wave, NGW = F.G * NWAVES, lane = F.lane; unsigned char* ws = F.ws;
    for (int sidx = gw; sidx < 8 * 24; sidx += NGW) { const int t = CHK_TS[sidx / 24], n = ((sidx % 24) * 211 + 5) % D;
        const float pa = wdot8r(ws + WS_OA + (size_t)t * 1024, 1024, a.in[9] + n, D, F8_SWO, lane) / F8_SOA, pb = wdot8r(ws + WS_OB + (size_t)t * 1024, 1024, a.in[10] + n, D, F8_SWO, lane) / F8_SOB;
        const float ref = bf2f(((const bf16*)(ws + WS_GA))[(size_t)t * D + n]) * pa + bf2f(((const bf16*)(ws + WS_GB))[(size_t)t * D + n]) * pb;
        if (lane == 0) chk_report(F.ctl, 6, relerr(fp8dec((ws + WS_MERGED)[(size_t)t * D + n]) / F8_SMG, ref, 0.02f)); }
}
DI void chk_dense8(const Frame& F, int word, const unsigned char* act8, int lda, int K, float ascale, const float* W, int N, float wscale, const bf16* out, int ldo, float fl) {
    const int gw = F.bx * NWAVES + F.wave, NGW = F.G * NWAVES, lane = F.lane;
    for (int sidx = gw; sidx < 8 * 24; sidx += NGW) { const int t = CHK_TS[sidx / 24], n = ((sidx % 24) * 211 + 5) % N;
        const float ref = wdot8r(act8 + (size_t)t * lda, K, W + n, N, wscale, lane) / ascale;
        if (lane == 0) chk_report(F.ctl, word, relerr(bf2f(out[(size_t)t * ldo + n]), ref, fl)); }
}
DI void chk_ln1(const Frame& F, const Args& a) {
    const int gw = F.bx * NWAVES + F.wave, NGW = F.G * NWAVES, lane = F.lane; unsigned char* ws = F.ws;
    for (int sidx = gw; sidx < 8; sidx += NGW) { const int t = CHK_TS[sidx]; const float* x = a.in[0] + (size_t)t * D; const bf16* y = (const bf16*)(ws + WS_Y) + (size_t)t * D;
        float s = 0.f; for (int c = lane; c < D; c += 64) s += ALPHA * x[c] + bf2f(y[c]); const float mu = wave_sum(s) / D;
        float q = 0.f; for (int c = lane; c < D; c += 64) { const float d = ALPHA * x[c] + bf2f(y[c]) - mu; q += d * d; } const float rs = 1.f / sqrtf(wave_sum(q) / D + LN_EPS);
        float e = 0.f; for (int c = lane; c < D; c += 64) { const float ref = (ALPHA * x[c] + bf2f(y[c]) - mu) * rs * a.in[17][c] + a.in[18][c];
            e = fmaxf(e, relerr(a.out[(size_t)t * D + c], ref, 0.5f) * 20.f); e = fmaxf(e, relerr(fp8dec((ws + WS_XB)[(size_t)t * D + c]), ref, 0.5f)); }
        chk_report(F.ctl, 7, e); }
}
DI void chk_memattn(const Frame& F, int l) {
    const int gw = F.bx * NWAVES + F.wave, NGW = F.G * NWAVES, lane = F.lane; unsigned char* ws = F.ws;
    for (int sidx = gw; sidx < 32; sidx += NGW) { const int t = CHK_TS[sidx >> 2], h = sidx & 3; const bf16* q = (const bf16*)(ws + WS_QMEM) + (size_t)t * 512 + h * HD; const bf16* kv = (const bf16*)(ws + WS_KVMEM) + (size_t)l * 1024;
        float sc[4], mx = -__builtin_inff();
#pragma unroll
        for (int j = 0; j < 4; ++j) { const int m = lane + 64 * j; float d = 0.f; for (int e = 0; e < HD; ++e) d += bf2f(q[e]) * bf2f(kv[(size_t)m * 4096 + h * HD + e]); sc[j] = d * 0.08838834764831845f; mx = fmaxf(mx, sc[j]); }
#pragma unroll
        for (int o = 1; o < 64; o <<= 1) mx = fmaxf(mx, __shfl_xor(mx, o));
        float ps = 0.f, o0 = 0.f, o1 = 0.f;
#pragma unroll
        for (int j = 0; j < 4; ++j) { const float p = expf(sc[j] - mx); ps += p; for (int src = 0; src < 64; ++src) { const float pp = __shfl(p, src); const int m = src + 64 * j;
            o0 += pp * bf2f(kv[(size_t)m * 4096 + 512 + h * HD + 2 * lane]); o1 += pp * bf2f(kv[(size_t)m * 4096 + 512 + h * HD + 2 * lane + 1]); } }
        ps = wave_sum(ps); const unsigned char* om = ws + WS_OMEM + (size_t)t * 512 + h * HD;
        chk_report(F.ctl, 9, fmaxf(relerr(fp8dec(om[2 * lane]) / F8_SOM, o0 / ps, 0.05f), relerr(fp8dec(om[2 * lane + 1]) / F8_SOM, o1 / ps, 0.05f))); }
}
DI void chk_kvmem(const Frame& F, const Args& a) {
    const int gw = F.bx * NWAVES + F.wave, NGW = F.G * NWAVES, lane = F.lane; unsigned char* ws = F.ws;
    for (int sidx = gw; sidx < 4 * 48; sidx += NGW) { const int ll = sidx / 48, m = ((sidx % 48) * 37) & 255, n = ((sidx % 48) * 211 + 3) & 1023;
        const float ref = wdot((const bf16*)(ws + WS_MEMB) + (size_t)m * D, D, a.in[13] + (size_t)ll * D * 1024 + n, 1024, lane);
        if (lane == 0) chk_report(F.ctl, 8, relerr(bf2f(((const bf16*)(ws + WS_KVMEM))[(size_t)m * 4096 + ll * 1024 + n]), ref, 0.3f)); }
}
DI float wdot8(const unsigned char* a8, int K, const float* W, size_t ldw, int lane) {
    float s = 0.f; for (int k = lane; k < K; k += 64) s += fp8dec(a8[k]) * W[(size_t)k * ldw]; return wave_sum(s);
}
DI void chk_swiglu(const Frame& F, const Args& a) {
    const int gw = F.bx * NWAVES + F.wave, NGW = F.G * NWAVES, lane = F.lane; unsigned char* ws = F.ws;
    for (int sidx = gw; sidx < 8 * 24; sidx += NGW) { const int t = CHK_TS[sidx / 24], j = ((sidx % 24) * 509 + 11) % DFF;
        const float g = wdot8(ws + WS_XB + (size_t)t * D, D, a.in[15] + j, 2 * DFF, lane), u = wdot8(ws + WS_XB + (size_t)t * D, D, a.in[15] + DFF + j, 2 * DFF, lane);
        if (lane == 0) chk_report(F.ctl, 11, relerr(fp8dec((ws + WS_H)[(size_t)t * DFF + j]) * (1.0f / F8_SH), g / (1.f + expf(-g)) * u, 0.05f)); }
}
DI void chk_ffn2(const Frame& F, const Args& a) {
    const int gw = F.bx * NWAVES + F.wave, NGW = F.G * NWAVES, lane = F.lane; unsigned char* ws = F.ws;
    for (int sidx = gw; sidx < 8 * 24; sidx += NGW) { const int t = CHK_TS[sidx / 24], n = ((sidx % 24) * 211 + 5) % D;
        const float ref = wdot8(ws + WS_H + (size_t)t * DFF, DFF, a.in[16] + n, D, lane) * (1.0f / F8_SH);
        if (lane == 0) chk_report(F.ctl, 12, relerr(bf2f(((const bf16*)(ws + WS_Y))[(size_t)t * D + n]), ref, 0.01f)); }
}
DI void chk_encode(const Frame& F, const Args& a) {
    float B = 0.f, wgt = 0.5f;
    for (int i = 0; i < 32; ++i) if ((SELFCHECK_MASK >> i) & 1u) { const float e = __uint_as_float(__hip_atomic_load((unsigned*)(F.ctl + CW_ERR + i), RLX_AGENT)); if (e > SELFCHECK_TOL) B += wgt; wgt *= 0.5f; }
    const float sc = 1.f - 0.5f * B;
    f32x4* o = (f32x4*)a.out; const int gt = F.bx * NTHREADS + F.tid, ngt = F.G * NTHREADS;
    for (int i = gt; i < S * D / 4; i += ngt) o[i] = o[i] * sc;
}
#endif

constexpr int NPH = 17;
__global__ void __launch_bounds__(NTHREADS, 2) fwd_kernel(Args args) {
    extern __shared__ __attribute__((aligned(16))) unsigned char lds_raw[];
    LAS unsigned char* const lds = (LAS unsigned char*)lds_raw;
    volatile LAS unsigned* MISC = (volatile LAS unsigned*)(lds + MISC_OFF);
    if (threadIdx.x < 32) MISC[threadIdx.x] = 0u;
    __syncthreads();
#if MK_ONE_LAUNCH
    constexpr int lo = 0, hi = DEPTH * NPH;
#else
    const int lo = args.ph_lo, hi = args.ph_hi;
#endif
    XcdBarrier bar; bar.bar = (unsigned*)(args.ws + WS_CTL) + CW_BAR; bar.x = 0; bar.st = nullptr; bar.w0 = __builtin_amdgcn_readfirstlane((int)threadIdx.x >> 6);
    if (hi - lo > 1) bar = xcd_barrier_post((unsigned*)(args.ws + WS_CTL) + CW_BAR, MISC + 8);
#ifdef ONLY_PH
#define IN(k) (((k) - p0) == ONLY_PH && lo <= (k) && (k) < hi)
#else
#define IN(k) (lo <= (k) && (k) < hi)
#endif
#define SEAM(k) do { if (lo <= (k) && (k) + 1 < hi) { XcdBarrier b2_ = bar; asm volatile("" : "+s"(b2_.bar), "+s"(b2_.x)); xcd_barrier(b2_); } } while (0)
#ifdef REPEAT_MASK
#define NREP(bit) ((((unsigned long long)REPEAT_MASK >> (bit)) & 1ull) ? 2 : 1)
#else
#define NREP(bit) 1
#endif
#define FRAME() const Frame F = make_frame(args.ws, lds, bar.w0); unsigned char* const ws = F.ws; (void)ws; int lq = l; asm volatile("" : "+s"(lq)); (void)lq
    for (int l = 0; l < DEPTH; ++l) {
        const int p0 = l * NPH;
        if (IN(p0 + 0)) { FRAME(); for (int rep = 0; rep < NREP(0); ++rep) conv_phase(F, args, lq); } SEAM(p0 + 0);
        if (IN(p0 + 1)) {
#ifndef SKIP_A
            if (l == 0) { FRAME(); pg8::Gemm g{(const bf16*)(ws + WS_MEMB), (const bf16*)(ws + WS_WKV), D, D, D, 1, 16, 0, 0}; pg8::StaticOrder So; So.init(1, 16, F.G, F.G - 1 - F.bx);
                pg8::EpiBf16 E{(bf16*)(ws + WS_KVMEM), 4096}; pg8::gemm_phase(lds, g, So, E, F.tid); }
#endif
#ifndef SKIP_B
            { FRAME(); pg8::Gemm g{(const bf16*)(ws + WS_XB8), (const bf16*)(ws + WS_WIN8), D / 2, D / 2, D / 2, S / 256, IN8 / 256, 0, 0}; pg8::StaticOrder So; So.init(S / 256, IN8 / 256, F.G, F.bx, 1);
            pg8::EpiIn8 E{(bf16*)(ws + WS_QDSA), (bf16*)(ws + WS_VM), (bf16*)(ws + WS_GA), (bf16*)(ws + WS_GB), (float*)(ws + WS_CKVRAW), args.in[3] + (size_t)lq * 2 * D};
            for (int rep = 0; rep < NREP(1); ++rep) pg8::gemm_phase<pg8::EpiIn8, true>(lds, g, So, E, F.tid); }
            { FRAME(); pg8::Gemm g{(const bf16*)(ws + WS_XB), (const bf16*)(ws + WS_WIN), D, D, D, S / 256, INB / 256, 0, 0}; pg8::StaticOrder So; So.init(S / 256, INB / 256, F.G, F.bx, 2);
            pg8::EpiInBf E{(bf16*)(ws + WS_QIDX), (bf16*)(ws + WS_QM), (bf16*)(ws + WS_KM), (float*)(ws + WS_KWRAW)};
            for (int rep = 0; rep < NREP(1); ++rep) pg8::gemm_phase(lds, g, So, E, F.tid); }
#endif
        } SEAM(p0 + 1);
        if (IN(p0 + 2)) {
#ifdef SELFCHECK
            if (l == 0 && CHK_ON(0)) { FRAME(); chk_inproj(F, args); }
#endif
#ifndef SKIP_A
            { FRAME(); for (int rep = 0; rep < NREP(2); ++rep) norm_phase(F, args, lq); }
#endif
#ifndef SKIP_B
            { FRAME(); pg8::Gemm g{(const bf16*)(ws + WS_QDSA), (const bf16*)(ws + WS_WUK), 1024, 256, 256, S / 256, 8, 1, 256}; pg8::StaticOrder So; So.init(S / 256, 8, F.G, F.bx);
            pg8::EpiBf16 E{(bf16*)(ws + WS_QLAT), 2048}; for (int rep = 0; rep < NREP(3); ++rep) pg8::gemm_phase(lds, g, So, E, F.tid); }
#endif
        } SEAM(p0 + 2);
        if (IN(p0 + 3)) {
#ifdef SELFCHECK
            if (l == 0) { FRAME(); if (CHK_ON(1)) chk_norms(F, args); if (CHK_ON(8)) chk_kvmem(F, args); }
#endif
#ifndef SKIP_A
            { FRAME(); moba_gate_phase(F, lq); }
#endif
#ifndef SKIP_B
            { FRAME(); for (int rep = 0; rep < NREP(5); ++rep) indexer_phase(F); }
#endif
        } SEAM(p0 + 3);
        if (IN(p0 + 4)) {
#ifdef SELFCHECK
            if (l == 0 && (CHK_ON(2) || CHK_ON(3))) { FRAME(); chk_topk(F, lq); }
#endif
#ifndef SKIP_A
            { FRAME(); for (int rep = 0; rep < NREP(6); ++rep) moba_attn_phase(F, lq); }
#endif
#ifndef SKIP_B
            { FRAME(); for (int rep = 0; rep < NREP(7); ++rep) dsa_attn_phase(F); }
#endif
        } SEAM(p0 + 4);
        if (IN(p0 + 5)) {
            { FRAME(); for (int rep = 0; rep < NREP(8); ++rep) moba_combine_phase(F); }
            { FRAME(); pg8::Gemm g{(const bf16*)(ws + WS_OLAT), (const bf16*)(ws + WS_WUV), 2048, 512, 512, S / 256, 4, 0, 512}; pg8::StaticOrder So; So.init(S / 256, 4, F.G, F.bx);
            pg8::EpiF8 E{ws + WS_OA, 1024, F8_SOA}; for (int rep = 0; rep < NREP(9); ++rep) pg8::gemm_phase(lds, g, So, E, F.tid); }
        } SEAM(p0 + 5);
#ifdef SELFCHECK
        if (l == 0 && IN(p0 + 6) && (CHK_ON(4) || CHK_ON(5) || CHK_ON(6))) { FRAME(); chk_attn(F, args); }
#endif
        if (IN(p0 + 6)) { FRAME(); pg8::Gemm g{(const bf16*)(ws + WS_OA), (const bf16*)(ws + WS_WOA), 512, 512, 512, S / 256, 8, 0, 0}; pg8::StaticOrder So; So.init(S / 256, 8, F.G, F.bx);
            pg8::EpiGate E{(bf16*)(ws + WS_T1), (const bf16*)(ws + WS_GA), nullptr, nullptr, 1.0f / (F8_SOA * F8_SWO), 0.f}; for (int rep = 0; rep < NREP(10); ++rep) pg8::gemm_phase<pg8::EpiGate, true>(lds, g, So, E, F.tid); } SEAM(p0 + 6);
        if (IN(p0 + 7)) { FRAME(); pg8::Gemm g{(const bf16*)(ws + WS_OB), (const bf16*)(ws + WS_WOB), 512, 512, 512, S / 256, 8, 0, 0}; pg8::StaticOrder So; So.init(S / 256, 8, F.G, F.bx);
            pg8::EpiGate E{nullptr, (const bf16*)(ws + WS_GB), (const bf16*)(ws + WS_T1), ws + WS_MERGED, 1.0f / (F8_SOB * F8_SWO), F8_SMG}; for (int rep = 0; rep < NREP(11); ++rep) pg8::gemm_phase<pg8::EpiGate, true>(lds, g, So, E, F.tid); } SEAM(p0 + 7);
#ifdef SELFCHECK
        if (l == 0 && IN(p0 + 8) && CHK_ON(6)) { FRAME(); chk_merged(F, args); }
#endif
#if (LN_FUSED & 1)
        if (IN(p0 + 8)) { FRAME(); pg8::Gemm g{(const bf16*)(ws + WS_MERGED), (const bf16*)(ws + WS_WOUT), D / 2, D / 2, D / 2, S / 256, 8, 0, 0}; pg8::FusedOrder So{F.bx};
            pg8::EpiLn E{args.out, args.in[17] + (size_t)(lq * 3 + 0) * D, args.in[18] + (size_t)(lq * 3 + 0) * D, 1.0f / (F8_SMG * F8_SWOUT), nullptr, ws + WS_XB, (unsigned long long*)(ws + WS_LNX), (unsigned*)(F.ctl + CW_LNCNT) + (lq * 3 + 0) * 64 * 64};
            pg8::gemm_phase<pg8::EpiLn, true, pg8::FusedOrder, true>(lds, g, So, E, F.tid); } SEAM(p0 + 8);
#else
        if (IN(p0 + 8)) { FRAME(); pg8::Gemm g{(const bf16*)(ws + WS_MERGED), (const bf16*)(ws + WS_WOUT), D / 2, D / 2, D / 2, S / 256, 8, 0, 0}; pg8::StaticOrder So; So.init(S / 256, 8, F.G, F.bx);
            pg8::EpiBf16S E{(bf16*)(ws + WS_Y), D, 1.0f / (F8_SMG * F8_SWOUT)}; for (int rep = 0; rep < NREP(12); ++rep) pg8::gemm_phase<pg8::EpiBf16S, true>(lds, g, So, E, F.tid); } SEAM(p0 + 8);
        if (IN(p0 + 9)) { FRAME(); ln_phase(F, args, l, 0); } SEAM(p0 + 9);
#endif
#ifdef SELFCHECK
        if (l == 0 && IN(p0 + 10) && CHK_ON(7)) { FRAME(); chk_ln1(F, args); }
#endif
        if (IN(p0 + 10)) { FRAME(); pg8::Gemm g{(const bf16*)(ws + WS_XB), (const bf16*)(ws + WS_WQM), D / 2, D / 2, D / 2, S / 256, 2, 0, 0}; pg8::StaticOrder So; So.init(S / 256, 2, F.G, F.bx);
            pg8::EpiBf16S E{(bf16*)(ws + WS_QMEM), 512, 1.0f / F8_SWQM}; for (int rep = 0; rep < NREP(14); ++rep) pg8::gemm_phase<pg8::EpiBf16S, true>(lds, g, So, E, F.tid); } SEAM(p0 + 10);
#ifdef SELFCHECK
        if (l == 0 && IN(p0 + 11) && CHK_ON(8)) { FRAME(); chk_dense8(F, 8, ws + WS_XB, D, D, 1.f, args.in[12], 512, F8_SWQM, (const bf16*)(ws + WS_QMEM), 512, 0.3f); }
#endif
        if (IN(p0 + 11)) { FRAME(); for (int rep = 0; rep < NREP(15); ++rep) mem_attn_phase(F, lq); } SEAM(p0 + 11);
#ifdef SELFCHECK
        if (l == 0 && IN(p0 + 12) && CHK_ON(9)) { FRAME(); chk_memattn(F, lq); }
#endif
#if (LN_FUSED & 2)
        if (IN(p0 + 12)) { FRAME(); pg8::Gemm g{(const bf16*)(ws + WS_OMEM), (const bf16*)(ws + WS_WOM), 256, 256, 256, S / 256, 8, 0, 0}; pg8::FusedOrder So{F.bx};
            pg8::EpiLn E{args.out, args.in[17] + (size_t)(lq * 3 + 1) * D, args.in[18] + (size_t)(lq * 3 + 1) * D, 1.0f / (F8_SOM * F8_SWOM), nullptr, ws + WS_XB, (unsigned long long*)(ws + WS_LNX), (unsigned*)(F.ctl + CW_LNCNT) + (lq * 3 + 1) * 64 * 64};
            pg8::gemm_phase<pg8::EpiLn, true, pg8::FusedOrder, true>(lds, g, So, E, F.tid); } SEAM(p0 + 12);
#else
        if (IN(p0 + 12)) { FRAME(); pg8::Gemm g{(const bf16*)(ws + WS_OMEM), (const bf16*)(ws + WS_WOM), 256, 256, 256, S / 256, 8, 0, 0}; pg8::StaticOrder So; So.init(S / 256, 8, F.G, F.bx);
            pg8::EpiBf16S E{(bf16*)(ws + WS_Y), D, 1.0f / (F8_SOM * F8_SWOM)}; for (int rep = 0; rep < NREP(16); ++rep) pg8::gemm_phase<pg8::EpiBf16S, true>(lds, g, So, E, F.tid); } SEAM(p0 + 12);
        if (IN(p0 + 13)) { FRAME(); ln_phase(F, args, l, 1); } SEAM(p0 + 13);
#endif
        if (IN(p0 + 14)) { FRAME(); pg8::Gemm g{(const bf16*)(ws + WS_XB), (const bf16*)(ws + WS_WF1), D / 2, D / 2, D / 2, S / 256, 2 * DFF / 256, 0, 0}; pg8::StaticOrder So; So.init(S / 256, 2 * DFF / 256, F.G, F.bx);
            pg8::EpiSwiglu8 E{ws + WS_H}; for (int rep = 0; rep < NREP(18); ++rep) pg8::gemm_phase<pg8::EpiSwiglu8, true>(lds, g, So, E, F.tid); } SEAM(p0 + 14);
#ifdef SELFCHECK
        if (l == 0 && IN(p0 + 15) && CHK_ON(11)) { FRAME(); chk_swiglu(F, args); }
#endif
#if (LN_FUSED & 4)
        if (IN(p0 + 15)) { FRAME(); pg8::Gemm g{(const bf16*)(ws + WS_H), (const bf16*)(ws + WS_WF2), DFF / 2, DFF / 2, DFF / 2, S / 256, 8, 0, 0}; pg8::FusedOrder So{F.bx};
            pg8::EpiLn E{args.out, args.in[17] + (size_t)(lq * 3 + 2) * D, args.in[18] + (size_t)(lq * 3 + 2) * D, 1.0f / (F8_SH * F8_SW2), (bf16*)(ws + WS_XB), ws + WS_XB8, (unsigned long long*)(ws + WS_LNX), (unsigned*)(F.ctl + CW_LNCNT) + (lq * 3 + 2) * 64 * 64};
            pg8::gemm_phase<pg8::EpiLn, true, pg8::FusedOrder, true>(lds, g, So, E, F.tid); } SEAM(p0 + 15);
#else
        if (IN(p0 + 15)) { FRAME(); pg8::Gemm g{(const bf16*)(ws + WS_H), (const bf16*)(ws + WS_WF2), DFF / 2, DFF / 2, DFF / 2, S / 256, 8, 0, 0}; pg8::StaticOrder So; So.init(S / 256, 8, F.G, F.bx);
            pg8::EpiBf16S E{(bf16*)(ws + WS_Y), D, 1.0f / (F8_SH * F8_SW2)}; for (int rep = 0; rep < NREP(19); ++rep) pg8::gemm_phase<pg8::EpiBf16S, true>(lds, g, So, E, F.tid); } SEAM(p0 + 15);
        if (IN(p0 + 16)) { FRAME(); ln_phase(F, args, l, 2); } SEAM(p0 + 16);
#endif
    }
#ifdef SELFCHECK
    { xcd_barrier(bar); const int l = 0; FRAME(); chk_encode(F, args); }
#endif
#undef IN
#undef SEAM
#undef FRAME
}

extern "C" void kernel_launch(void* const* d_in, const int* in_sizes, int n_in, void* d_out, int out_size, void* d_ws, size_t ws_size, hipStream_t stream) {
    static int grid = 0;
    if (grid == 0) {
        if (n_in != 19 || out_size != S * D || ws_size < WS_END) { fprintf(stderr, "kernel_launch: unexpected shapes (n_in %d, out %d, ws %zu < %zu)\n", n_in, out_size, ws_size, (size_t)WS_END); grid = -1; return; }
        int dev = 0, cus = 0, per_cu = 0;
        if (hipGetDevice(&dev) != hipSuccess || hipDeviceGetAttribute(&cus, hipDeviceAttributeMultiprocessorCount, dev) != hipSuccess) { grid = -1; return; }
        if (hipFuncSetAttribute((const void*)fwd_kernel, hipFuncAttributeMaxDynamicSharedMemorySize, LDS_BYTES) != hipSuccess) { fprintf(stderr, "kernel_launch: hipFuncSetAttribute failed\n"); grid = -1; return; }
        if (hipOccupancyMaxActiveBlocksPerMultiprocessor(&per_cu, (const void*)fwd_kernel, NTHREADS, LDS_BYTES) != hipSuccess || per_cu < 1) fprintf(stderr, "kernel_launch: occupancy query says %d\n", per_cu);
        (void)hipGetLastError();
        grid = cus;
        if (grid != 256) { fprintf(stderr, "kernel_launch: %d CUs; this kernel is built for the 256-workgroup grid of an MI355X; nothing launched\n", grid); grid = -1; return; }
    }
    if (grid < 0) return;
    (void)in_sizes;
    if (hipMemsetAsync((char*)d_ws + WS_CTL, 0, CTL_ZERO_BYTES, stream) != hipSuccess) return;
    Args a{};
    for (int i = 0; i < 19; ++i) a.in[i] = (const float*)d_in[i];
    a.out = (float*)d_out; a.ws = (unsigned char*)d_ws;
#if MK_ONE_LAUNCH
    a.ph_lo = 0; a.ph_hi = DEPTH * NPH;
    hipLaunchKernelGGL(fwd_kernel, dim3(grid), dim3(NTHREADS), LDS_BYTES, stream, a);
#else
    for (int p = 0; p < DEPTH * NPH; ++p) { a.ph_lo = p; a.ph_hi = p + 1; hipLaunchKernelGGL(fwd_kernel, dim3(grid), dim3(NTHREADS), LDS_BYTES, stream, a); }
#endif
}
```

```cpp
#include <hip/hip_runtime.h>
#include <cstdio>
#include <cstdint>

#ifndef MK_ONE_LAUNCH
#define MK_ONE_LAUNCH 1
#endif
#ifndef LN_FUSED
#define LN_FUSED 7
#endif

#define LAS __attribute__((address_space(3)))
#define GAS __attribute__((address_space(1)))
typedef unsigned short bf16;
typedef short bf16x8 __attribute__((ext_vector_type(8)));
typedef short s16x4 __attribute__((ext_vector_type(4)));
typedef short v4i16_t __attribute__((ext_vector_type(4)));
typedef float f32x2 __attribute__((ext_vector_type(2)));
typedef float f32x4 __attribute__((ext_vector_type(4)));
typedef float f32x16 __attribute__((ext_vector_type(16)));
typedef unsigned u32x2 __attribute__((ext_vector_type(2)));
typedef unsigned u32x4 __attribute__((ext_vector_type(4)));
typedef int v4i __attribute__((ext_vector_type(4)));
typedef int v8i __attribute__((ext_vector_type(8)));
typedef v8i v8i_a16 __attribute__((aligned(16)));
typedef GAS unsigned gu32;
#define RLX_AGENT __ATOMIC_RELAXED, __HIP_MEMORY_SCOPE_AGENT
#define DI __device__ __forceinline__

constexpr int S = 16384, D = 2048, DEPTH = 4, NH = 8, HD = 128, CKV = 256, IH = 16, IDIM = 64, TOPK = 256, MBLK = 256, NBLK = 64, NMEM = 256, NHM = 4, DFF = 5632;
constexpr int INW = 9552, INP = 9728;
constexpr float LN_EPS = 1e-5f;
constexpr float ALPHA = 1.681792830507429f;
constexpr float LOG2E = 1.4426950408889634f;
constexpr float ATT_SCALE2 = 0.08838834764831845f * LOG2E;
constexpr int NWAVES = 8, NTHREADS = 512;
constexpr float F8_SW1 = 64.f, F8_SW2 = 128.f, F8_SH = 16.f, F8_SWI = 32.f;
constexpr float F8_SWO = 64.f, F8_SWOUT = 64.f, F8_SWQM = 32.f, F8_SWOM = 32.f;
constexpr float F8_SOA = 16.f, F8_SOB = 8.f, F8_SMG = 64.f, F8_SOM = 32.f;
constexpr int INB = 3328, IN8 = 6400;

constexpr size_t MiB = 1u << 20;
constexpr size_t WS_CTL = 0, CTL_ZERO_BYTES = 1 * MiB;
constexpr size_t WS_WIN = 1 * MiB;
constexpr size_t WS_WUK = WS_WIN + 38 * MiB;
constexpr size_t WS_WUV = WS_WUK + 1 * MiB;
constexpr size_t WS_WOA = WS_WUV + 1 * MiB;
constexpr size_t WS_WOB = WS_WOA + 4 * MiB;
constexpr size_t WS_WOUT = WS_WOB + 4 * MiB;
constexpr size_t WS_WQM = WS_WOUT + 8 * MiB;
constexpr size_t WS_WOM = WS_WQM + 2 * MiB;
constexpr size_t WS_WF1 = WS_WOM + 2 * MiB;
constexpr size_t WS_WF2 = WS_WF1 + 44 * MiB;
constexpr size_t WS_WKV = WS_WF2 + 22 * MiB;
constexpr size_t WS_MEMB = WS_WKV + 16 * MiB;
constexpr size_t WS_KVMEM = WS_MEMB + 1 * MiB;
constexpr size_t WS_XB = WS_KVMEM + 2 * MiB;
constexpr size_t WS_QDSA = WS_XB + 64 * MiB;
constexpr size_t WS_QIDX = WS_QDSA + 32 * MiB;
constexpr size_t WS_QM = WS_QIDX + 32 * MiB;
constexpr size_t WS_KM = WS_QM + 32 * MiB;
constexpr size_t WS_VM = WS_KM + 32 * MiB;
constexpr size_t WS_GA = WS_VM + 32 * MiB;
constexpr size_t WS_GB = WS_GA + 64 * MiB;
constexpr size_t WS_CKVRAW = WS_GB + 64 * MiB;
constexpr size_t WS_KWRAW = WS_CKVRAW + 16 * MiB;
constexpr size_t WS_H = WS_QDSA;
constexpr size_t WS_CKVN = WS_KWRAW + 16 * MiB;
constexpr size_t WS_KIDXN = WS_CKVN + 8 * MiB;
constexpr size_t WS_WIDX = WS_KIDXN + 2 * MiB;
constexpr size_t WS_KMEAN = WS_WIDX + 1 * MiB;
constexpr size_t WS_QLAT = WS_KMEAN + 1 * MiB;
constexpr size_t WS_SEL = WS_QLAT + 64 * MiB;
constexpr size_t WS_OLAT = WS_SEL + 8 * MiB;
constexpr size_t WS_OA = WS_OLAT + 64 * MiB;
constexpr size_t WS_OB = WS_OA + 32 * MiB;
constexpr size_t WS_BUCK = WS_OB + 32 * MiB;
constexpr size_t WS_PARTO = WS_BUCK + 16 * MiB;
constexpr size_t WS_PARTML = WS_PARTO + 128 * MiB;
constexpr size_t WS_T1 = WS_PARTML + 4 * MiB;
constexpr size_t WS_MERGED = WS_T1 + 64 * MiB;
constexpr size_t WS_Y = WS_MERGED + 64 * MiB;
constexpr size_t WS_QMEM = WS_Y + 64 * MiB;
constexpr size_t WS_OMEM = WS_QMEM + 16 * MiB;
constexpr size_t WS_XB8 = WS_OMEM + 16 * MiB;
constexpr size_t WS_LNX = WS_XB8 + 32 * MiB;
constexpr size_t WS_END = WS_LNX + 1 * MiB;
constexpr size_t WS_WIN8 = WS_WIN + 16 * MiB;
static_assert(WS_H + (size_t)S * DFF * 2 <= WS_CKVN, "h overlay");
static_assert(WS_END <= 1408 * MiB, "workspace");
constexpr int CW_BAR = 4096;
constexpr int CW_BCNT = 16384;
constexpr int CW_LNCNT = 65536;
constexpr int BUCK_PER_HEAD = 256 * 2016;
DI int bucket_off(int b) { return 256 * (63 * b - (b * (b - 1)) / 2); }

constexpr int LDS_BYTES = 147456;
constexpr int RING_BYTES = 131072;
constexpr int MISC_OFF = 143360;
constexpr int LNT_OFF = RING_BYTES;

DI unsigned f2bf(float f) { unsigned u = __builtin_bit_cast(unsigned, f); return (u + 0x7fffu + ((u >> 16) & 1u)) >> 16; }
DI unsigned pk2(float lo, float hi) { return f2bf(lo) | (f2bf(hi) << 16); }
DI unsigned cvt_pk_bf16(float lo, float hi) { unsigned r; asm volatile("v_cvt_pk_bf16_f32 %0, %1, %2" : "=v"(r) : "v"(lo), "v"(hi)); return r; }
DI float clamp448(float x) { return __builtin_amdgcn_fmed3f(x, -448.f, 448.f); }
DI unsigned pk4_fp8(float a, float b, float c, float d) {
    int w = 0; w = __builtin_amdgcn_cvt_pk_fp8_f32(clamp448(a), clamp448(b), w, false); w = __builtin_amdgcn_cvt_pk_fp8_f32(clamp448(c), clamp448(d), w, true); return (unsigned)w; }
DI float bflo(unsigned u) { return __builtin_bit_cast(float, u << 16); }
DI float bfhi(unsigned u) { return __builtin_bit_cast(float, u & 0xffff0000u); }
DI int lane_id() { int l; asm volatile("v_mbcnt_lo_u32_b32 %0, -1, 0\n\tv_mbcnt_hi_u32_b32 %0, -1, %0" : "=v"(l)); return l; }
template <int CTRL> DI int dpp_i(int x) { return __builtin_amdgcn_mov_dpp(x, CTRL, 0xf, 0xf, true); }
template <int CTRL> DI float dpp_f(float x) { return __builtin_bit_cast(float, __builtin_amdgcn_mov_dpp(__builtin_bit_cast(int, x), CTRL, 0xf, 0xf, true)); }
DI float xrow16_sum(float x);
DI float wave_sum(float v) {
    v += dpp_f<0xB1>(v); v += dpp_f<0x4E>(v); v += dpp_f<0x141>(v); v += dpp_f<0x128>(v);
    return xrow16_sum(v);
}
DI unsigned wave_umax(unsigned v) {
    { const unsigned o = (unsigned)dpp_i<0xB1>((int)v); v = o > v ? o : v; } { const unsigned o = (unsigned)dpp_i<0x4E>((int)v); v = o > v ? o : v; }
    { const unsigned o = (unsigned)dpp_i<0x141>((int)v); v = o > v ? o : v; } { const unsigned o = (unsigned)dpp_i<0x128>((int)v); v = o > v ? o : v; }
    { const auto s = __builtin_amdgcn_permlane16_swap(v, v, false, false); v = s[0] > s[1] ? s[0] : s[1]; }
    { const auto s = __builtin_amdgcn_permlane32_swap(v, v, false, false); v = s[0] > s[1] ? s[0] : s[1]; }
    return v;
}
DI unsigned wave_umin(unsigned v) { return ~wave_umax(~v); }
DI float xrow16_max(float x) {
    auto s = __builtin_amdgcn_permlane16_swap(__float_as_uint(x), __float_as_uint(x), false, false);
    x = fmaxf(__uint_as_float(s[0]), __uint_as_float(s[1]));
    auto t = __builtin_amdgcn_permlane32_swap(__float_as_uint(x), __float_as_uint(x), false, false);
    return fmaxf(__uint_as_float(t[0]), __uint_as_float(t[1]));
}
DI float xrow16_sum(float x) {
    auto s = __builtin_amdgcn_permlane16_swap(__float_as_uint(x), __float_as_uint(x), false, false);
    x = __uint_as_float(s[0]) + __uint_as_float(s[1]);
    auto t = __builtin_amdgcn_permlane32_swap(__float_as_uint(x), __float_as_uint(x), false, false);
    return __uint_as_float(t[0]) + __uint_as_float(t[1]);
}
DI float fast_sigmoid(float x) { return __builtin_amdgcn_rcpf(1.0f + __builtin_amdgcn_exp2f(-x * LOG2E)); }
DI s16x4 vtr(unsigned lds_addr) { return __builtin_bit_cast(s16x4, __builtin_amdgcn_ds_read_tr16_b64_v4i16((LAS v4i16_t*)lds_addr)); }
DI unsigned off_b(unsigned row, unsigned ch) { return 256u * row + 16u * (ch ^ (((row & 3) << 2) | ((row >> 2) & 3))); }
DI unsigned tr_addr16(unsigned lane, unsigned c, unsigned ks, unsigned t) {
    const unsigned g = lane >> 4, q = (lane & 15) >> 2, p = lane & 3;
    return off_b(32 * ks + 8 * g + 4 * t + q, 2 * c + (p >> 1)) + 8 * (p & 1);
}
DI unsigned perm32rows(unsigned k) { return (k & ~31u) | (8u * ((k >> 2) & 3u) + 4u * ((k >> 4) & 1u) + (k & 3u)); }

namespace pg8 {
constexpr int BM = 256, BK = 64, HALF = 128, HTB = HALF * BK * 2, STAGE_BYTES = 8 * HTB, NXCD = 8, WGM = 8;
__host__ __device__ __forceinline__ int lds_byte(int r, int c) { const int st = (r >> 4) * 2 + (c >> 5), rr = r & 15, cc = c & 31, ob = rr * 64 + cc * 2; return st * 1024 + (ob ^ (((ob >> 9) & 1) << 5)); }
__host__ __device__ __forceinline__ void stage_rc(int b, int& R, int& C) { const int st = b / 1024, sb = b % 1024, swz = sb ^ (((sb >> 9) & 1) << 5); R = (st >> 1) * 16 + swz / 64; C = (st & 1) * 32 + (swz % 64) / 2; }
__host__ __device__ __forceinline__ int perm32(int rho) { const int n = rho >> 4, i = rho & 15; return 8 * (i >> 2) + 4 * n + (i & 3); }
struct Unit { int pm, pn; };
struct Gemm { const bf16* A; const bf16* Bt; int lda, ldb, K, nM, nN, a_shift, a_koff; };
struct StaticOrder {
    int nM, nN, nwg, G, c, mode;
    DI void init(int nM_, int nN_, int G_, int c_, int mode_ = 0) { nM = nM_; nN = nN_; nwg = nM * nN; G = G_; c = c_; mode = mode_; }
    DI bool next(int i, Unit& u) const {
        long L = (long)i * G + c;
        if (mode == 1) { if (i == 5) L = c < 128 ? 1280 + c : (c >= 192 ? 1280 + 128 + (c - 192) : nwg); else if (i == 6) L = c < 128 ? 1472 + c : nwg; else if (i > 6) L = nwg; }
        if (mode == 2) { if (i == 3) L = (c >= 128 && c < 192) ? 768 + (c - 128) : nwg; else if (i > 3) L = nwg; }
        if (L >= nwg) return false;
        int wgid = (int)L; { const int q = nwg / NXCD, r = nwg % NXCD, xcd = wgid % NXCD, off = wgid / NXCD; wgid = (xcd < r ? xcd * (q + 1) : r * (q + 1) + (xcd - r) * q) + off; }
        const int nig = WGM * nN, gid = wgid / nig, fm = gid * WGM, gsz = (nM - fm) < WGM ? (nM - fm) : WGM;
        u.pm = fm + ((wgid % nig) % gsz); u.pn = (wgid % nig) / gsz; return true;
    }
};
struct EpiBf16 {
    bf16* O; int ldc;
    DI void operator()(const f32x4 (&acc)[2][2][4][2], const Unit& u, int wr, int wc, int fr, int fq) const {
        const int row0 = u.pm * BM + wr * 64 + fr, col0 = u.pn * BM + wc * 32 + 8 * fq;
#pragma unroll
        for (int ai = 0; ai < 2; ++ai)
#pragma unroll
            for (int m = 0; m < 4; ++m) { bf16* rowp = O + (size_t)(row0 + ai * HALF + m * 16) * ldc + col0;
#pragma unroll
                for (int bj = 0; bj < 2; ++bj) { const f32x4 v0 = acc[ai][bj][m][0], v1 = acc[ai][bj][m][1];
                    u32x4 w; w.x = cvt_pk_bf16(v0[0], v0[1]); w.y = cvt_pk_bf16(v0[2], v0[3]); w.z = cvt_pk_bf16(v1[0], v1[1]); w.w = cvt_pk_bf16(v1[2], v1[3]);
                    *(u32x4*)(rowp + bj * HALF) = w; } }
    }
};
struct EpiBf16S {
    bf16* O; int ldc; float scale;
    DI void operator()(const f32x4 (&acc)[2][2][4][2], const Unit& u, int wr, int wc, int fr, int fq) const {
        const int row0 = u.pm * BM + wr * 64 + fr, col0 = u.pn * BM + wc * 32 + 8 * fq;
#pragma unroll
        for (int ai = 0; ai < 2; ++ai)
#pragma unroll
            for (int m = 0; m < 4; ++m) { bf16* rowp = O + (size_t)(row0 + ai * HALF + m * 16) * ldc + col0;
#pragma unroll
                for (int bj = 0; bj < 2; ++bj) { const f32x4 v0 = acc[ai][bj][m][0] * scale, v1 = acc[ai][bj][m][1] * scale;
                    u32x4 w; w.x = cvt_pk_bf16(v0[0], v0[1]); w.y = cvt_pk_bf16(v0[2], v0[3]); w.z = cvt_pk_bf16(v1[0], v1[1]); w.w = cvt_pk_bf16(v1[2], v1[3]);
                    *(u32x4*)(rowp + bj * HALF) = w; } }
    }
};
struct EpiSwiglu8 {
    unsigned char* Hh;
    DI void operator()(const f32x4 (&acc)[2][2][4][2], const Unit& u, int wr, int wc, int fr, int fq) const {
        const int row0 = u.pm * BM + wr * 64 + fr, col0 = u.pn * HALF + wc * 32 + 8 * fq;
#pragma unroll
        for (int ai = 0; ai < 2; ++ai)
#pragma unroll
            for (int m = 0; m < 4; ++m) { unsigned char* rowp = Hh + (size_t)(row0 + ai * HALF + m * 16) * DFF + col0;
                float r[8];
#pragma unroll
                for (int n = 0; n < 2; ++n)
#pragma unroll
                    for (int j = 0; j < 4; ++j) { const float g = acc[ai][0][m][n][j] * (1.0f / F8_SW1), uu = acc[ai][1][m][n][j] * (F8_SH / F8_SW1); r[4 * n + j] = g * fast_sigmoid(g) * uu; }
                u32x2 w; w.x = pk4_fp8(r[0], r[1], r[2], r[3]); w.y = pk4_fp8(r[4], r[5], r[6], r[7]);
                *(u32x2*)rowp = w; }
    }
};
struct EpiF8 {
    unsigned char* O; int ldc; float scale;
    DI void operator()(const f32x4 (&acc)[2][2][4][2], const Unit& u, int wr, int wc, int fr, int fq) const {
        const int row0 = u.pm * BM + wr * 64 + fr, col0 = u.pn * BM + wc * 32 + 8 * fq;
#pragma unroll
        for (int ai = 0; ai < 2; ++ai)
#pragma unroll
            for (int m = 0; m < 4; ++m) { unsigned char* rowp = O + (size_t)(row0 + ai * HALF + m * 16) * ldc + col0;
#pragma unroll
                for (int bj = 0; bj < 2; ++bj) { const f32x4 v0 = acc[ai][bj][m][0] * scale, v1 = acc[ai][bj][m][1] * scale;
                    u32x2 w; w.x = pk4_fp8(v0[0], v0[1], v0[2], v0[3]); w.y = pk4_fp8(v1[0], v1[1], v1[2], v1[3]); *(u32x2*)(rowp + bj * HALF) = w; } }
    }
};
struct EpiGate {
    bf16* O; const bf16* gate; const bf16* add; unsigned char* O8; float ascale, oscale;
    DI void operator()(const f32x4 (&acc)[2][2][4][2], const Unit& u, int wr, int wc, int fr, int fq) const {
        const int row0 = u.pm * BM + wr * 64 + fr, col0 = u.pn * BM + wc * 32 + 8 * fq;
#pragma unroll
        for (int ai = 0; ai < 2; ++ai)
#pragma unroll
            for (int m = 0; m < 4; ++m) { const size_t ro = (size_t)(row0 + ai * HALF + m * 16) * D + col0;
#pragma unroll
                for (int bj = 0; bj < 2; ++bj) { const f32x4 v0 = acc[ai][bj][m][0] * ascale, v1 = acc[ai][bj][m][1] * ascale;
                    const u32x4 g = *(const u32x4*)(gate + ro + bj * HALF);
                    float r[8] = { v0[0] * bflo(g.x), v0[1] * bfhi(g.x), v0[2] * bflo(g.y), v0[3] * bfhi(g.y), v1[0] * bflo(g.z), v1[1] * bfhi(g.z), v1[2] * bflo(g.w), v1[3] * bfhi(g.w) };
                    if (add) { const u32x4 a = *(const u32x4*)(add + ro + bj * HALF);
                        r[0] += bflo(a.x); r[1] += bfhi(a.x); r[2] += bflo(a.y); r[3] += bfhi(a.y); r[4] += bflo(a.z); r[5] += bfhi(a.z); r[6] += bflo(a.w); r[7] += bfhi(a.w); }
                    if (O8) { u32x2 w; w.x = pk4_fp8(r[0] * oscale, r[1] * oscale, r[2] * oscale, r[3] * oscale); w.y = pk4_fp8(r[4] * oscale, r[5] * oscale, r[6] * oscale, r[7] * oscale); *(u32x2*)(O8 + ro + bj * HALF) = w; }
                    else { u32x4 w; w.x = cvt_pk_bf16(r[0], r[1]); w.y = cvt_pk_bf16(r[2], r[3]); w.z = cvt_pk_bf16(r[4], r[5]); w.w = cvt_pk_bf16(r[6], r[7]);
                        *(u32x4*)(O + ro + bj * HALF) = w; } } }
    }
};
struct EpiSwiglu {
    bf16* Hh;
    DI void operator()(const f32x4 (&acc)[2][2][4][2], const Unit& u, int wr, int wc, int fr, int fq) const {
        const int row0 = u.pm * BM + wr * 64 + fr, col0 = u.pn * HALF + wc * 32 + 8 * fq;
#pragma unroll
        for (int ai = 0; ai < 2; ++ai)
#pragma unroll
            for (int m = 0; m < 4; ++m) { bf16* rowp = Hh + (size_t)(row0 + ai * HALF + m * 16) * DFF + col0;
                float r[8];
#pragma unroll
                for (int n = 0; n < 2; ++n)
#pragma unroll
                    for (int j = 0; j < 4; ++j) { const float g = acc[ai][0][m][n][j], uu = acc[ai][1][m][n][j]; r[4 * n + j] = g * fast_sigmoid(g) * uu; }
                u32x4 w; w.x = cvt_pk_bf16(r[0], r[1]); w.y = cvt_pk_bf16(r[2], r[3]); w.z = cvt_pk_bf16(r[4], r[5]); w.w = cvt_pk_bf16(r[6], r[7]);
                *(u32x4*)rowp = w; }
    }
};
struct EpiInBf {
    bf16 *qidx, *qm, *km; float* kwraw;
    DI void operator()(const f32x4 (&acc)[2][2][4][2], const Unit& u, int wr, int wc, int fr, int fq) const {
        const int row0 = u.pm * BM + wr * 64 + fr, cl = wc * 32 + 8 * fq; const int pn = u.pn;
        if (pn == 4) {
#pragma unroll
            for (int ai = 0; ai < 2; ++ai)
#pragma unroll
                for (int m = 0; m < 4; ++m) { float* rowp = kwraw + (size_t)(row0 + ai * HALF + m * 16) * 256 + cl;
#pragma unroll
                    for (int bj = 0; bj < 2; ++bj) { *(f32x4*)(rowp + bj * HALF) = acc[ai][bj][m][0]; *(f32x4*)(rowp + bj * HALF + 4) = acc[ai][bj][m][1]; } }
            return;
        }
        bf16* O; int ct;
        if (pn < 4) { O = qidx; ct = pn; } else if (pn < 9) { O = qm; ct = pn - 5; } else { O = km; ct = pn - 9; }
        const int col0 = ct * BM + cl;
#pragma unroll
        for (int ai = 0; ai < 2; ++ai)
#pragma unroll
            for (int m = 0; m < 4; ++m) { bf16* rowp = O + (size_t)(row0 + ai * HALF + m * 16) * 1024 + col0;
#pragma unroll
                for (int bj = 0; bj < 2; ++bj) { const f32x4 v0 = acc[ai][bj][m][0], v1 = acc[ai][bj][m][1];
                    u32x4 w; w.x = cvt_pk_bf16(v0[0], v0[1]); w.y = cvt_pk_bf16(v0[2], v0[3]); w.z = cvt_pk_bf16(v1[0], v1[1]); w.w = cvt_pk_bf16(v1[2], v1[3]);
                    *(u32x4*)(rowp + bj * HALF) = w; } }
    }
};
struct EpiIn8 {
    bf16 *qdsa, *vm, *ga, *gb; float* ckvraw; const float* bgate;
    DI void operator()(const f32x4 (&acc)[2][2][4][2], const Unit& u, int wr, int wc, int fr, int fq) const {
        const int row0 = u.pm * BM + wr * 64 + fr, cl = wc * 32 + 8 * fq; const int pn = u.pn; const float sc = 1.0f / F8_SWI;
        if (pn == 4) {
#pragma unroll
            for (int ai = 0; ai < 2; ++ai)
#pragma unroll
                for (int m = 0; m < 4; ++m) { float* rowp = ckvraw + (size_t)(row0 + ai * HALF + m * 16) * 256 + cl;
#pragma unroll
                    for (int bj = 0; bj < 2; ++bj) { *(f32x4*)(rowp + bj * HALF) = acc[ai][bj][m][0] * sc; *(f32x4*)(rowp + bj * HALF + 4) = acc[ai][bj][m][1] * sc; } }
            return;
        }
        bf16* O; int ldc, ct; const float* bias = nullptr;
        if (pn < 4) { O = qdsa; ldc = 1024; ct = pn; }
        else if (pn < 9) { O = vm; ldc = 1024; ct = pn - 5; }
        else if (pn < 17) { O = ga; ldc = 2048; ct = pn - 9; bias = bgate; }
        else { O = gb; ldc = 2048; ct = pn - 17; bias = bgate + 2048; }
        const int col0 = ct * BM + cl;
#pragma unroll
        for (int ai = 0; ai < 2; ++ai)
#pragma unroll
            for (int m = 0; m < 4; ++m) { bf16* rowp = O + (size_t)(row0 + ai * HALF + m * 16) * ldc + col0;
#pragma unroll
                for (int bj = 0; bj < 2; ++bj) { f32x4 v0 = acc[ai][bj][m][0] * sc, v1 = acc[ai][bj][m][1] * sc;
                    if (bias) { const f32x4 b0 = *(const f32x4*)(bias + col0 + bj * HALF), b1 = *(const f32x4*)(bias + col0 + bj * HALF + 4);
#pragma unroll
                        for (int j = 0; j < 4; ++j) { v0[j] = fast_sigmoid(v0[j] + b0[j]); v1[j] = fast_sigmoid(v1[j] + b1[j]); } }
                    u32x4 w; w.x = cvt_pk_bf16(v0[0], v0[1]); w.y = cvt_pk_bf16(v0[2], v0[3]); w.z = cvt_pk_bf16(v1[0], v1[1]); w.w = cvt_pk_bf16(v1[2], v1[3]);
                    *(u32x4*)(rowp + bj * HALF) = w; } }
    }
};

struct FusedOrder {
    int c;
    DI bool next(int i, Unit& u) const { if (i >= 2) return false; const int xcd = c & 7, j = c >> 3; u.pm = xcd * 8 + i * 4 + (j >> 3); u.pn = j & 7; return true; }
};
struct EpiLn {
    float* x; const float* g; const float* b; float scale; bf16* xb; unsigned char* xb8; unsigned long long* slots; unsigned* cnt;
    DI void run(f32x4 (&acc)[2][2][4][2], const Unit& u, int wr, int wc, int fr_, int fq_, LAS unsigned char* lds, int wid, int lane_) const {
        int fr = fr_, fq = fq_, lane = lane_; asm volatile("" : "+v"(fr), "+v"(fq), "+v"(lane));
        LAS f32x2* P = (LAS f32x2*)(lds + LNT_OFF); LAS f32x2* Sx = (LAS f32x2*)(lds + LNT_OFF + 8192);
        const int row0 = u.pm * BM + wr * 64 + fr, col0 = u.pn * BM + wc * 32 + 8 * fq;
        __builtin_amdgcn_sched_barrier(0);
#pragma unroll
        for (int ai = 0; ai < 2; ++ai)
#pragma unroll
            for (int m = 0; m < 4; ++m) { const float* xr = x + (size_t)(row0 + ai * HALF + m * 16) * D + col0;
#pragma unroll
                for (int bj = 0; bj < 2; ++bj) { const f32x4 x0 = *(const f32x4*)(xr + bj * HALF), x1 = *(const f32x4*)(xr + bj * HALF + 4);
                    acc[ai][bj][m][0] = x0 * ALPHA + acc[ai][bj][m][0] * scale; acc[ai][bj][m][1] = x1 * ALPHA + acc[ai][bj][m][1] * scale; }
                __builtin_amdgcn_sched_barrier(0);
                asm volatile("" : "+v"(acc[ai][0][m][0]), "+v"(acc[ai][0][m][1]), "+v"(acc[ai][1][m][0]), "+v"(acc[ai][1][m][1]) :: "memory"); }
        __builtin_amdgcn_sched_barrier(0);
#pragma unroll
        for (int ai = 0; ai < 2; ++ai)
#pragma unroll
            for (int m = 0; m < 4; ++m) {
                float s = 0.f;
#pragma unroll
                for (int bj = 0; bj < 2; ++bj)
#pragma unroll
                    for (int n = 0; n < 2; ++n) { const f32x4 v = acc[ai][bj][m][n]; s += (v[0] + v[1]) + (v[2] + v[3]); }
                s = xrow16_sum(s);
                const float mw = s * (1.0f / 64.0f); float q = 0.f;
#pragma unroll
                for (int bj = 0; bj < 2; ++bj)
#pragma unroll
                    for (int n = 0; n < 2; ++n) { const f32x4 d = acc[ai][bj][m][n] - mw; q += (d[0] * d[0] + d[1] * d[1]) + (d[2] * d[2] + d[3] * d[3]); }
                q = xrow16_sum(q);
                if (fq == 0) P[(ai * HALF + wr * 64 + m * 16 + fr) * 4 + wc] = (f32x2){mw, q};
            }
        asm volatile("s_waitcnt lgkmcnt(0)" ::: "memory"); __builtin_amdgcn_s_barrier(); asm volatile("" ::: "memory");
        const int row = wid * 32 + (lane & 31);
        if (lane < 32) {
            const f32x2 a = P[row * 4 + 0], b2 = P[row * 4 + 1], c = P[row * 4 + 2], d = P[row * 4 + 3];
            const float mt = (a[0] + b2[0] + c[0] + d[0]) * 0.25f;
            const float da = a[0] - mt, db = b2[0] - mt, dc = c[0] - mt, dd = d[0] - mt;
            const float m2 = (a[1] + b2[1]) + (c[1] + d[1]) + 64.0f * ((da * da + db * db) + (dc * dc + dd * dd));
            __hip_atomic_store(slots + ((size_t)(u.pm * BM + row) * 8 + u.pn), ((unsigned long long)__float_as_uint(m2) << 32) | __float_as_uint(mt), __ATOMIC_RELAXED, __HIP_MEMORY_SCOPE_AGENT);
        }
        asm volatile("s_waitcnt vmcnt(0)" ::: "memory");
        if (lane == 0) __hip_atomic_fetch_add(cnt + 64 * u.pm, 1u, __ATOMIC_RELAXED, __HIP_MEMORY_SCOPE_AGENT);
        if (wid == 0) {
            unsigned sp = 0;
            while ((unsigned)__builtin_amdgcn_readfirstlane(__hip_atomic_load(cnt + 64 * u.pm, __ATOMIC_RELAXED, __HIP_MEMORY_SCOPE_AGENT)) < 64u) { __builtin_amdgcn_s_sleep(1); if (++sp > (1u << 24)) break; }
            __builtin_amdgcn_fence(__ATOMIC_ACQUIRE, "agent");
        }
        asm volatile("s_waitcnt vmcnt(0) lgkmcnt(0)" ::: "memory"); __builtin_amdgcn_s_barrier(); asm volatile("" ::: "memory");
        if (lane < 32) {
            const unsigned long long* sl = slots + (size_t)(u.pm * BM + row) * 8; float mt[8], m2[8]; float ms = 0.f;
#pragma unroll
            for (int t = 0; t < 8; ++t) { const unsigned long long w = __hip_atomic_load(sl + t, __ATOMIC_RELAXED, __HIP_MEMORY_SCOPE_AGENT); mt[t] = __uint_as_float((unsigned)w); m2[t] = __uint_as_float((unsigned)(w >> 32)); ms += mt[t]; }
            const float mean = ms * 0.125f; float q = 0.f;
#pragma unroll
            for (int t = 0; t < 8; ++t) { const float dm = mt[t] - mean; q += m2[t] + 256.0f * dm * dm; }
            Sx[row] = (f32x2){mean, 1.0f / sqrtf(q * (1.0f / D) + LN_EPS)};
        }
        asm volatile("s_waitcnt lgkmcnt(0)" ::: "memory"); __builtin_amdgcn_s_barrier(); asm volatile("" ::: "memory");
        __builtin_amdgcn_sched_barrier(0);
#pragma unroll
        for (int bj = 0; bj < 2; ++bj) {
            const f32x4 g0 = *(const f32x4*)(g + col0 + bj * HALF), g1 = *(const f32x4*)(g + col0 + bj * HALF + 4), b0 = *(const f32x4*)(b + col0 + bj * HALF), b1 = *(const f32x4*)(b + col0 + bj * HALF + 4);
#pragma unroll
            for (int ai = 0; ai < 2; ++ai)
#pragma unroll
                for (int m = 0; m < 4; ++m) { const int rl = ai * HALF + wr * 64 + m * 16 + fr; const f32x2 sr = Sx[rl]; const size_t off = (size_t)(u.pm * BM + rl) * D + col0 + bj * HALF;
                    const f32x4 o0 = (acc[ai][bj][m][0] - sr[0]) * sr[1] * g0 + b0, o1 = (acc[ai][bj][m][1] - sr[0]) * sr[1] * g1 + b1;
                    *(f32x4*)(x + off) = o0; *(f32x4*)(x + off + 4) = o1;
                    if (xb) { u32x4 w; w.x = cvt_pk_bf16(o0[0], o0[1]); w.y = cvt_pk_bf16(o0[2], o0[3]); w.z = cvt_pk_bf16(o1[0], o1[1]); w.w = cvt_pk_bf16(o1[2], o1[3]); *(u32x4*)(xb + off) = w; }
                    if (xb8) { u32x2 w; w.x = pk4_fp8(o0[0], o0[1], o0[2], o0[3]); w.y = pk4_fp8(o1[0], o1[1], o1[2], o1[3]); *(u32x2*)(xb8 + off) = w; }
                    asm volatile("" ::: "memory"); __builtin_amdgcn_sched_barrier(0); }
        }
        asm volatile("s_waitcnt lgkmcnt(0)" ::: "memory"); __builtin_amdgcn_s_barrier(); asm volatile("" ::: "memory");
    }
};

template <class Epi, bool FP8 = false, class Order = StaticOrder, bool LN = false>
DI void gemm_phase(LAS unsigned char* lds, const Gemm g, const Order& So, const Epi& E, int tid_in) {
    int tid_ = tid_in; asm volatile("" : "+v"(tid_));
    const int tid = tid_, wid = __builtin_amdgcn_readfirstlane(tid >> 6), lane = tid & 63, wr = wid >> 2, wc = wid & 3, fr = lane & 15, fq = lane >> 4;
    const int K = g.K, nt = K / BK;
    unsigned voffA[2], voffB[2];
#pragma unroll
    for (int i = 0; i < 2; ++i) { int R, C; stage_rc(tid * 16 + i * 8192, R, C); const int Rb = (R & ~31) + perm32(R & 31);
        voffA[i] = (unsigned)(R * g.lda + C) * 2u; voffB[i] = (unsigned)(Rb * g.ldb + C) * 2u; }
    const size_t kstep = (size_t)(BK * 2);
    const size_t hstepA = (size_t)HALF * g.lda * 2, hstepB = (size_t)HALF * g.ldb * 2;
    const size_t tstepA = 2 * hstepA, tstepB = 2 * hstepB;
    const unsigned ldsw = (unsigned)wid * 1024u;
    const int aoff = lds_byte(wr * 64 + fr, fq * 8), boff = lds_byte(wc * 32 + fr, fq * 8);
    int one8 = 0x7F7F7F7F; asm volatile("" : "+v"(one8));
#define PG8_SA(b, h) (((b) * 2 + (h)) * HTB)
#define PG8_SB(b, h) ((4 + (b) * 2 + (h)) * HTB)
#define PG8_STAGE(bufoff, gbase, voff) do { _Pragma("unroll") for (int _i = 0; _i < 2; ++_i) \
        __builtin_amdgcn_global_load_lds((const unsigned*)((const char*)(gbase) + (voff)[_i]), (LAS unsigned*)(lds + (bufoff) + ldsw + _i * 8192), 16, 0, 0); } while (0)
#define PG8_LDA(dst, b, h) do { _Pragma("unroll") for (int m = 0; m < 4; ++m) { const LAS unsigned char* p_ = lds + PG8_SA(b, h) + aoff + m * 2048; \
        if constexpr (FP8) { const v4i lo_ = *(const LAS v4i*)p_, hi_ = *(const LAS v4i*)(p_ + 1024); dst##8[m] = __builtin_shufflevector(lo_, hi_, 0, 1, 2, 3, 4, 5, 6, 7); } \
        else { dst[m][0] = *(const LAS v4i*)p_; dst[m][1] = *(const LAS v4i*)(p_ + 1024); } } } while (0)
#define PG8_LDB(dst, b, h) do { _Pragma("unroll") for (int n = 0; n < 2; ++n) { const LAS unsigned char* p_ = lds + PG8_SB(b, h) + boff + n * 2048; \
        if constexpr (FP8) { const v4i lo_ = *(const LAS v4i*)p_, hi_ = *(const LAS v4i*)(p_ + 1024); dst##8[n] = __builtin_shufflevector(lo_, hi_, 0, 1, 2, 3, 4, 5, 6, 7); } \
        else { dst[n][0] = *(const LAS v4i*)p_; dst[n][1] = *(const LAS v4i*)(p_ + 1024); } } } while (0)
#define PG8_MMA(ai, bj, At, Bt) do { __builtin_amdgcn_s_setprio(1); _Pragma("unroll") for (int m = 0; m < 4; ++m) _Pragma("unroll") for (int n = 0; n < 2; ++n) { \
        if constexpr (FP8) { asm volatile("v_mfma_scale_f32_16x16x128_f8f6f4 %0, %1, %2, %0, %3, %3 op_sel_hi:[0,0,0]" : "+v"(acc[ai][bj][m][n]) : "v"(Bt##8[n]), "v"(At##8[m]), "v"(one8)); } \
        else { _Pragma("unroll") for (int k = 0; k < 2; ++k) acc[ai][bj][m][n] = __builtin_amdgcn_mfma_f32_16x16x32_bf16(__builtin_bit_cast(bf16x8, Bt[n][k]), __builtin_bit_cast(bf16x8, At[m][k]), acc[ai][bj][m][n], 0, 0, 0); } } \
        __builtin_amdgcn_s_setprio(0); } while (0)
#define PG8_WAIT_V(n) asm volatile("s_waitcnt vmcnt(" #n ")" ::: "memory")
#define PG8_WAIT_L(n) asm volatile("s_waitcnt lgkmcnt(" #n ")" ::: "memory")
#define PG8_BAR __builtin_amdgcn_s_barrier()
#define PG8_SCHED __builtin_amdgcn_sched_barrier(0)
#define PG8_ABASE(u) ((const char*)g.A + (size_t)(u).pm * tstepA + (size_t)(((u).pn >> g.a_shift) * g.a_koff) * 2)
#define PG8_BBASE(u) ((const char*)g.Bt + (size_t)(u).pn * tstepB)
    Unit cur, nxt; int ui = 0;
    if (!So.next(0, cur)) return;
    f32x4 acc[2][2][4][2];
#pragma unroll
    for (int a = 0; a < 2; ++a)
#pragma unroll
        for (int b = 0; b < 2; ++b)
#pragma unroll
            for (int m = 0; m < 4; ++m)
#pragma unroll
                for (int n = 0; n < 2; ++n) acc[a][b][m][n] = (f32x4){0.f, 0.f, 0.f, 0.f};
    v4i At[4][2], B0[2][2], B1[2][2]; v8i At8[4], B08[2], B18[2];
    const char* cA = PG8_ABASE(cur); const char* cB = PG8_BBASE(cur);
    PG8_STAGE(PG8_SB(0, 0), cB, voffB); PG8_STAGE(PG8_SB(0, 1), cB + hstepB, voffB); PG8_STAGE(PG8_SA(0, 0), cA, voffA); PG8_STAGE(PG8_SA(0, 1), cA + hstepA, voffA);
    if (wr == 1) PG8_BAR;
    PG8_WAIT_V(2); PG8_BAR;
    PG8_STAGE(PG8_SB(1, 0), cB + kstep, voffB); PG8_STAGE(PG8_SA(1, 0), cA + kstep, voffA); PG8_STAGE(PG8_SB(1, 1), cB + hstepB + kstep, voffB);
    PG8_WAIT_V(6); PG8_BAR;
    for (;;) {
        const bool has_next = So.next(ui + 1, nxt);
        const char* nA = has_next ? PG8_ABASE(nxt) : cA; const char* nB = has_next ? PG8_BBASE(nxt) : cB;
        for (int t = 0; t < nt; t += 2) {
            const bool last = (t == nt - 2);
            const char* a1 = cA + (size_t)(t + 1) * kstep;
            const char* a2 = last ? nA : cA + (size_t)(t + 2) * kstep; const char* b2 = last ? nB : cB + (size_t)(t + 2) * kstep;
            const char* a3 = a2 + kstep; const char* b3 = b2 + kstep;
            PG8_LDB(B0, 0, 0); PG8_LDB(B1, 0, 1); PG8_SCHED; PG8_LDA(At, 0, 0); PG8_STAGE(PG8_SA(1, 1), a1 + hstepA, voffA);
            PG8_WAIT_V(8); PG8_WAIT_L(0); PG8_BAR; PG8_MMA(0, 0, At, B0); PG8_MMA(0, 1, At, B1); PG8_BAR; PG8_SCHED;
            PG8_LDA(At, 0, 1); PG8_STAGE(PG8_SB(0, 0), b2, voffB); PG8_STAGE(PG8_SB(0, 1), b2 + hstepB, voffB); PG8_STAGE(PG8_SA(0, 0), a2, voffA);
            PG8_WAIT_V(8); PG8_WAIT_L(0); PG8_BAR; PG8_MMA(1, 0, At, B0); PG8_MMA(1, 1, At, B1); PG8_BAR; PG8_SCHED;
            PG8_LDB(B0, 1, 0); PG8_LDB(B1, 1, 1); PG8_SCHED; PG8_LDA(At, 1, 0); PG8_STAGE(PG8_SA(0, 1), a2 + hstepA, voffA);
            PG8_WAIT_V(8); PG8_WAIT_L(0); PG8_BAR; PG8_MMA(0, 0, At, B0); PG8_MMA(0, 1, At, B1); PG8_BAR; PG8_SCHED;
            PG8_LDA(At, 1, 1); PG8_STAGE(PG8_SB(1, 0), b3, voffB); PG8_STAGE(PG8_SB(1, 1), b3 + hstepB, voffB); PG8_STAGE(PG8_SA(1, 0), a3, voffA);
            PG8_WAIT_V(8); PG8_WAIT_L(0); PG8_BAR; PG8_MMA(1, 0, At, B0); PG8_MMA(1, 1, At, B1); PG8_BAR; PG8_SCHED;
        }
        if (wr == 0) PG8_BAR;
        if constexpr (FP8) asm volatile("s_nop 15\n\ts_nop 15" ::: "memory");
        if constexpr (LN) E.run(acc, cur, wr, wc, fr, fq, lds, wid, lane); else E(acc, cur, wr, wc, fr, fq);
        if (!has_next) break;
#pragma unroll
        for (int a = 0; a < 2; ++a)
#pragma unroll
            for (int b = 0; b < 2; ++b)
#pragma unroll
                for (int m = 0; m < 4; ++m)
#pragma unroll
                    for (int n = 0; n < 2; ++n) acc[a][b][m][n] = (f32x4){0.f, 0.f, 0.f, 0.f};
        cur = nxt; cA = nA; cB = nB; ++ui;
        if (wr == 1) PG8_BAR;
    }
    PG8_WAIT_V(0);
    PG8_BAR;
#undef PG8_SA
#undef PG8_SB
#undef PG8_STAGE
#undef PG8_LDA
#undef PG8_LDB
#undef PG8_MMA
#undef PG8_WAIT_V
#undef PG8_WAIT_L
#undef PG8_BAR
#undef PG8_SCHED
#undef PG8_ABASE
#undef PG8_BBASE
}
}

#define XB_TMO      128
#define XB_XCNT(j)  (256  + 64 * (j))
#define XB_XSUB(j)  (1280 + 64 * (j))
#define XB_XGEN(j)  (2304 + 64 * (j))
#define XB_TOP      3328
#define XB_TOPGEN   3392
#define XCD_BAR_WORDS 3456
#define XB_SPIN_CAP (1u << 22)
DI unsigned xb_ld(unsigned* p)              { return __hip_atomic_load(p, __ATOMIC_RELAXED, __HIP_MEMORY_SCOPE_AGENT); }
DI unsigned xb_add(unsigned* p, unsigned v) { return __hip_atomic_fetch_add(p, v, __ATOMIC_RELAXED, __HIP_MEMORY_SCOPE_AGENT); }
DI unsigned xb_xcc_id() { return (unsigned)__builtin_amdgcn_s_getreg((3 << 11) | 20) & 0xFu; }
#define XB_SPIN(cond, bar) do { unsigned _sp = 0; while (cond) { __builtin_amdgcn_s_sleep(1); \
    if ((++_sp & 255u) == 0u) { if (xb_ld(&(bar)[XB_TMO])) break; if (_sp > XB_SPIN_CAP) { atomicAdd(&(bar)[XB_TMO], 1u); break; } } } } while (0)
struct XcdBarrier { unsigned* bar; unsigned x; volatile LAS unsigned* st; int w0; };
DI XcdBarrier xcd_barrier_post(unsigned* bar, volatile LAS unsigned* st) {
    XcdBarrier b; b.bar = bar; b.x = xb_xcc_id(); b.st = st; b.w0 = __builtin_amdgcn_readfirstlane((int)threadIdx.x >> 6);
    if (threadIdx.x == 0) (void)xb_add(&bar[XB_XCNT(b.x)], 1u);
    return b;
}
DI void xcd_barrier_complete(unsigned* bar, unsigned x, unsigned& nloc, unsigned& nx) {
    const unsigned G = gridDim.x * gridDim.y * gridDim.z;
    unsigned sum, cnt, mine, sp = 0u;
    for (;;) {
        sum = 0u; cnt = 0u; mine = 0u;
#pragma unroll
        for (unsigned j = 0; j < 16; ++j) { const unsigned c = xb_ld(&bar[XB_XCNT(j)]); sum += c; cnt += (c > 0u) ? 1u : 0u; mine = (j == x) ? c : mine; }
        if (sum == G) break;
        __builtin_amdgcn_s_sleep(1);
        if ((++sp & 255u) == 0u) { if (xb_ld(&bar[XB_TMO])) break; if (sp > XB_SPIN_CAP) { atomicAdd(&bar[XB_TMO], 1u); break; } }
    }
    nloc = mine > 0u ? mine : 1u; nx = cnt > 0u ? cnt : 1u;
}
DI void xcd_barrier(const XcdBarrier& b) {
    asm volatile("s_waitcnt vmcnt(0)" ::: "memory");
    __syncthreads();
    if (b.w0 == 0 && lane_id() == 0) {
        unsigned* bar = b.bar;
        __builtin_amdgcn_s_waitcnt(0);
        unsigned nloc = b.st[0], nx = b.st[1];
        if (nloc == 0u) { xcd_barrier_complete(bar, b.x, nloc, nx); b.st[0] = nloc; b.st[1] = nx; }
        const unsigned old = xb_add(&bar[XB_XSUB(b.x)], 1u);
        const unsigned gen = old / nloc;
        if (old + 1u == (gen + 1u) * nloc) {
            __builtin_amdgcn_fence(__ATOMIC_RELEASE, "agent");
            asm volatile("s_waitcnt vmcnt(0)" ::: "memory");
            const unsigned og = xb_add(&bar[XB_TOP], 1u);
            const unsigned tg = og / nx;
            if (og + 1u == (tg + 1u) * nx) xb_add(&bar[XB_TOPGEN], 1u);
            else XB_SPIN(xb_ld(&bar[XB_TOPGEN]) == tg, bar);
            __builtin_amdgcn_fence(__ATOMIC_ACQUIRE, "agent");
            xb_add(&bar[XB_XGEN(b.x)], 1u);
            asm volatile("s_waitcnt vmcnt(0)" ::: "memory");
        } else {
            XB_SPIN(xb_ld(&bar[XB_XGEN(b.x)]) == gen, bar);
            __builtin_amdgcn_fence(__ATOMIC_ACQUIRE, "agent");
            asm volatile("s_waitcnt vmcnt(0)" ::: "memory");
        }
    }
    __syncthreads();
}

struct Args { const float* in[19]; float* out; unsigned char* ws; int ph_lo, ph_hi; };
struct Frame {
    LAS unsigned char* lds; unsigned char* ws; gu32* ctl;
    int tid, lane, wave, bx, G;
};
DI Frame make_frame(unsigned char* ws_in, LAS unsigned char* lds_in, int w0) {
    Frame F; GAS unsigned char* w = (GAS unsigned char*)ws_in; asm volatile("" : "+s"(w)); int t = w0 * 64 + lane_id(); asm volatile("" : "+v"(t));
    F.lds = lds_in; F.ws = (unsigned char*)w; F.ctl = (gu32*)(w + WS_CTL);
    F.tid = t; F.lane = t & 63; F.wave = __builtin_amdgcn_readfirstlane(t >> 6); F.bx = blockIdx.x; F.G = gridDim.x;
    return F;
}

template <int MAP> DI int conv_rowmap(int n) {
    if (MAP == 1) return n < 2384 ? n : n + 176;
    if (MAP == 2) { const int isu = n >= DFF ? 1 : 0, j = n - isu * DFF; return 256 * (j >> 7) + 128 * isu + (j & 127); }
    return n;
}
template <int MAP> DI void conv_item(const float* W, int N, bf16* WT, int ldd, LAS float* scr, int kb, int nb, int lane) {
    const int k0 = 64 * kb, n0 = 32 * nb;
    const bool nok = n0 + (lane & 31) < N;
    { float v[32]; const float* wp = W + (size_t)(k0 + (lane >> 5)) * N + n0 + (lane & 31);
#pragma unroll
      for (int i = 0; i < 32; ++i) v[i] = nok ? __builtin_nontemporal_load(wp + (size_t)(2 * i) * N) : 0.f;
#pragma unroll
      for (int i = 0; i < 32; ++i) scr[(2 * i + (lane >> 5)) * 33 + (lane & 31)] = v[i]; }
    asm volatile("s_waitcnt lgkmcnt(0)" ::: "memory");
    const int c = lane & 7;
#pragma unroll
    for (int j = 0; j < 4; ++j) { const int n = (lane >> 3) + 8 * j; const LAS float* s = scr + (8 * c) * 33 + n;
        u32x4 o; o.x = pk2(s[0 * 33], s[1 * 33]); o.y = pk2(s[2 * 33], s[3 * 33]); o.z = pk2(s[4 * 33], s[5 * 33]); o.w = pk2(s[6 * 33], s[7 * 33]);
        if (n0 + n < N) *(u32x4*)(WT + (size_t)conv_rowmap<MAP>(n0 + n) * ldd + k0 + 8 * c) = o; }
    asm volatile("s_waitcnt lgkmcnt(0)" ::: "memory");
}
template <int MAP> DI void conv_item8(const float* W, int N, unsigned char* WT, int ldd, LAS float* scr, int kb, int nb, int lane, float scale) {
    const int k0 = 64 * kb, n0 = 32 * nb;
    const bool nok = n0 + (lane & 31) < N;
    { float v[32]; const float* wp = W + (size_t)(k0 + (lane >> 5)) * N + n0 + (lane & 31);
#pragma unroll
      for (int i = 0; i < 32; ++i) v[i] = nok ? __builtin_nontemporal_load(wp + (size_t)(2 * i) * N) : 0.f;
#pragma unroll
      for (int i = 0; i < 32; ++i) scr[(2 * i + (lane >> 5)) * 33 + (lane & 31)] = v[i]; }
    asm volatile("s_waitcnt lgkmcnt(0)" ::: "memory");
    const int c = lane & 3;
#pragma unroll
    for (int j = 0; j < 2; ++j) { const int n = (lane >> 2) + 16 * j; const LAS float* s = scr + (16 * c) * 33 + n;
        u32x4 o; o.x = pk4_fp8(s[0 * 33] * scale, s[1 * 33] * scale, s[2 * 33] * scale, s[3 * 33] * scale); o.y = pk4_fp8(s[4 * 33] * scale, s[5 * 33] * scale, s[6 * 33] * scale, s[7 * 33] * scale);
        o.z = pk4_fp8(s[8 * 33] * scale, s[9 * 33] * scale, s[10 * 33] * scale, s[11 * 33] * scale); o.w = pk4_fp8(s[12 * 33] * scale, s[13 * 33] * scale, s[14 * 33] * scale, s[15 * 33] * scale);
        if (n0 + n < N) *(u32x4*)(WT + (size_t)conv_rowmap<MAP>(n0 + n) * ldd + k0 + 16 * c) = o; }
    asm volatile("s_waitcnt lgkmcnt(0)" ::: "memory");
}
DI int win_rowmap(int c) {
    if (c < 1024) return -1 - c;
    if (c < 1280) return -1 - c;
    if (c < 2304) return c - 1280;
    if (c < 2384) return c - 2304 + 1024;
    if (c < 3408) return c - 2384 + 1280;
    if (c < 4432) return c - 3408 + 2304;
    if (c < 5456) return -1 - (c - 4432 + 1280);
    if (c < 7504) return -1 - (c - 5456 + 2304);
    return -1 - (c - 7504 + 4352);
}
DI void conv_item_win(const float* W, bf16* WTb, unsigned char* WT8, LAS float* scr, int kb, int nb, int lane) {
    const int N = INW, k0 = 64 * kb, n0 = 32 * nb;
    const bool nok = n0 + (lane & 31) < N;
    { float v[32]; const float* wp = W + (size_t)(k0 + (lane >> 5)) * N + n0 + (lane & 31);
#pragma unroll
      for (int i = 0; i < 32; ++i) v[i] = nok ? __builtin_nontemporal_load(wp + (size_t)(2 * i) * N) : 0.f;
#pragma unroll
      for (int i = 0; i < 32; ++i) scr[(2 * i + (lane >> 5)) * 33 + (lane & 31)] = v[i]; }
    asm volatile("s_waitcnt lgkmcnt(0)" ::: "memory");
    const int last = n0 + 31 < N ? n0 + 31 : N - 1;
    if (win_rowmap(n0) >= 0 || win_rowmap(last) >= 0) {
        const int c = lane & 7;
#pragma unroll
        for (int j = 0; j < 4; ++j) { const int n = (lane >> 3) + 8 * j; const LAS float* s = scr + (8 * c) * 33 + n; const int rm = n0 + n < N ? win_rowmap(n0 + n) : -1;
            u32x4 o; o.x = pk2(s[0 * 33], s[1 * 33]); o.y = pk2(s[2 * 33], s[3 * 33]); o.z = pk2(s[4 * 33], s[5 * 33]); o.w = pk2(s[6 * 33], s[7 * 33]);
            if (rm >= 0) *(u32x4*)(WTb + (size_t)rm * D + k0 + 8 * c) = o; }
    }
    if (win_rowmap(n0) < 0 || win_rowmap(last) < 0) {
        const int c = lane & 3;
#pragma unroll
        for (int j = 0; j < 2; ++j) { const int n = (lane >> 2) + 16 * j; const LAS float* s = scr + (16 * c) * 33 + n; const int rm = n0 + n < N ? win_rowmap(n0 + n) : 0;
            u32x4 o; o.x = pk4_fp8(s[0 * 33] * F8_SWI, s[1 * 33] * F8_SWI, s[2 * 33] * F8_SWI, s[3 * 33] * F8_SWI); o.y = pk4_fp8(s[4 * 33] * F8_SWI, s[5 * 33] * F8_SWI, s[6 * 33] * F8_SWI, s[7 * 33] * F8_SWI);
            o.z = pk4_fp8(s[8 * 33] * F8_SWI, s[9 * 33] * F8_SWI, s[10 * 33] * F8_SWI, s[11 * 33] * F8_SWI); o.w = pk4_fp8(s[12 * 33] * F8_SWI, s[13 * 33] * F8_SWI, s[14 * 33] * F8_SWI, s[15 * 33] * F8_SWI);
            if (rm < 0) *(u32x4*)(WT8 + (size_t)(-1 - rm) * D + k0 + 16 * c) = o; }
    }
    asm volatile("s_waitcnt lgkmcnt(0)" ::: "memory");
}
DI void zero_rows(bf16* p, int rows, int cols, int ld, int gt, int ngt) {
    const int cpr = cols / 8; unsigned z0; asm volatile("v_mov_b32 %0, 0" : "=v"(z0)); const u32x4 z = {z0, z0, z0, z0};
    for (int i = gt; i < rows * cpr; i += ngt) *(u32x4*)(p + (size_t)(i / cpr) * ld + (i % cpr) * 8) = z;
}
DI void conv_phase(const Frame& F, const Args& a, int l) {
    LAS float* scr = (LAS float*)(F.lds + F.wave * 16384);
    const int gw = F.bx * NWAVES + F.wave, NGW = F.G * NWAVES, lane = F.lane;
    unsigned char* ws = F.ws;
    const float* w_in = a.in[2] + (size_t)l * D * INW; const float* w_uk = a.in[7] + (size_t)l * NH * HD * CKV; const float* w_uv = a.in[8] + (size_t)l * NH * CKV * HD;
    const float* w_oa = a.in[9] + (size_t)l * 1024 * D; const float* w_ob = a.in[10] + (size_t)l * 1024 * D; const float* w_out = a.in[11] + (size_t)l * D * D;
    const float* w_qm = a.in[12] + (size_t)l * D * 512; const float* w_om = a.in[14] + (size_t)l * 512 * D;
    const float* w_f1 = a.in[15] + (size_t)l * D * 2 * DFF; const float* w_f2 = a.in[16] + (size_t)l * DFF * D;
    constexpr int NB_IN = (INW + 31) / 32;
    constexpr int I_IN = 32 * NB_IN, I_UK = 8 * 2 * 8, I_UV = 8 * 4 * 4, I_OA = 16 * 64, I_OUT = 32 * 64, I_QM = 32 * 16, I_OM = 8 * 64, I_F1 = 32 * 352, I_F2 = 88 * 64, I_KV = 4 * 32 * 32;
    const int total = I_IN + I_UK + I_UV + 2 * I_OA + I_OUT + I_QM + I_OM + I_F1 + I_F2 + (l == 0 ? I_KV : 0);
    for (int it = gw; it < total; it += NGW) {
        int r = it;
        if (r < I_IN) { conv_item_win(w_in, (bf16*)(ws + WS_WIN), ws + WS_WIN8, scr, r / NB_IN, r % NB_IN, lane); continue; } r -= I_IN;
        if (r < I_UK) { const int h = r >> 4, q = r & 15; conv_item<0>(w_uk + (size_t)h * HD * CKV, CKV, (bf16*)(ws + WS_WUK) + (size_t)(h * 256) * 256 + (h & 1) * 128, 256, scr, q >> 3, q & 7, lane); continue; } r -= I_UK;
        if (r < I_UV) { const int h = r >> 4, q = r & 15; conv_item<0>(w_uv + (size_t)h * CKV * HD, HD, (bf16*)(ws + WS_WUV) + (size_t)(h * 128) * 512 + (h & 1) * 256, 512, scr, q >> 2, q & 3, lane); continue; } r -= I_UV;
        if (r < I_OA) { conv_item8<0>(w_oa, D, ws + WS_WOA, 1024, scr, r >> 6, r & 63, lane, F8_SWO); continue; } r -= I_OA;
        if (r < I_OA) { conv_item8<0>(w_ob, D, ws + WS_WOB, 1024, scr, r >> 6, r & 63, lane, F8_SWO); continue; } r -= I_OA;
        if (r < I_OUT) { conv_item8<0>(w_out, D, ws + WS_WOUT, D, scr, r >> 6, r & 63, lane, F8_SWOUT); continue; } r -= I_OUT;
        if (r < I_QM) { conv_item8<0>(w_qm, 512, ws + WS_WQM, D, scr, r >> 4, r & 15, lane, F8_SWQM); continue; } r -= I_QM;
        if (r < I_OM) { conv_item8<0>(w_om, D, ws + WS_WOM, 512, scr, r >> 6, r & 63, lane, F8_SWOM); continue; } r -= I_OM;
        if (r < I_F1) { conv_item8<2>(w_f1, 2 * DFF, ws + WS_WF1, D, scr, r / 352, r % 352, lane, F8_SW1); continue; } r -= I_F1;
        if (r < I_F2) { conv_item8<0>(w_f2, D, ws + WS_WF2, DFF, scr, r >> 6, r & 63, lane, F8_SW2); continue; } r -= I_F2;
        { const int ll = r >> 10, q = r & 1023; conv_item<0>(a.in[13] + (size_t)ll * D * 1024, 1024, (bf16*)(ws + WS_WKV) + (size_t)ll * 1024 * D, D, scr, q >> 5, q & 31, lane); }
    }
    const int gt = F.bx * NTHREADS + F.tid, ngt = F.G * NTHREADS;
    zero_rows((bf16*)(ws + WS_WIN) + (size_t)1104 * D, 176, D, D, gt, ngt);
    for (int h = 0; h < NH; ++h) {
        zero_rows((bf16*)(ws + WS_WUK) + (size_t)(h * 256) * 256 + ((h + 1) & 1) * 128, 256, 128, 256, gt, ngt);
        zero_rows((bf16*)(ws + WS_WUV) + (size_t)(h * 128) * 512 + ((h + 1) & 1) * 256, 128, 256, 512, gt, ngt);
    }
    if (l == 0) {
        const f32x4* xs = (const f32x4*)a.in[0]; f32x4* xo = (f32x4*)a.out; u32x2* xb = (u32x2*)(ws + WS_XB);
        unsigned* xb8 = (unsigned*)(ws + WS_XB8);
        for (int i = gt; i < S * D / 4; i += ngt) { const f32x4 v = __builtin_nontemporal_load(xs + i); xo[i] = v; u32x2 w; w.x = pk2(v[0], v[1]); w.y = pk2(v[2], v[3]); xb[i] = w; xb8[i] = pk4_fp8(v[0], v[1], v[2], v[3]); }
        const f32x4* ms = (const f32x4*)a.in[1]; u32x2* mb = (u32x2*)(ws + WS_MEMB);
        for (int i = gt; i < NMEM * D / 4; i += ngt) { const f32x4 v = ms[i]; u32x2 w; w.x = pk2(v[0], v[1]); w.y = pk2(v[2], v[3]); mb[i] = w; }
    }
}

DI void norm_phase(const Frame& F, const Args& a, int l) {
    const int gw = F.bx * NWAVES + F.wave, NGW = F.G * NWAVES, lane = F.lane;
    const float* ckv = (const float*)(F.ws + WS_CKVRAW); const float* kw = (const float*)(F.ws + WS_KWRAW);
    const float* kvg = a.in[4] + l * CKV; const float* ig = a.in[5] + l * IDIM; const float* ib = a.in[6] + l * IDIM;
    const f32x4 g4 = *(const f32x4*)(kvg + 4 * lane); const float gi = ig[lane], bi = ib[lane];
    for (int t = gw; t < S; t += NGW) {
        const f32x4 v = *(const f32x4*)(ckv + (size_t)t * 256 + 4 * lane);
        const float ss = wave_sum(v[0] * v[0] + v[1] * v[1] + v[2] * v[2] + v[3] * v[3]);
        const float r = 1.0f / sqrtf(ss * (1.0f / CKV) + LN_EPS);
        *(unsigned*)(F.ws + WS_CKVN + (size_t)t * 256 + 4 * lane) = pk4_fp8(v[0] * r * g4[0], v[1] * r * g4[1], v[2] * r * g4[2], v[3] * r * g4[3]);
        const float k = kw[(size_t)t * 256 + lane];
        const float mu = wave_sum(k) * (1.0f / IDIM); const float d = k - mu; const float var = wave_sum(d * d) * (1.0f / IDIM);
        const float kn = d * (1.0f / sqrtf(var + LN_EPS)) * gi + bi;
        ((bf16*)(F.ws + WS_KIDXN))[(size_t)t * 64 + lane] = (bf16)f2bf(kn);
        if (lane < IH) ((float*)(F.ws + WS_WIDX))[(size_t)t * IH + lane] = kw[(size_t)t * 256 + 64 + lane];
    }
    const bf16* km = (const bf16*)(F.ws + WS_KM);
    for (int u = gw; u < NH * NBLK; u += NGW) {
        const int h = u >> 6, b = u & 63; float s[8] = {0.f, 0.f, 0.f, 0.f, 0.f, 0.f, 0.f, 0.f};
        const u32x4* p = (const u32x4*)(km + (size_t)(b * MBLK + (lane >> 4)) * 1024 + h * HD + 8 * (lane & 15));
#pragma unroll 16
        for (int i = 0; i < MBLK / 4; ++i) { const u32x4 v = p[(size_t)i * (4 * 1024 / 8)];
            s[0] += bflo(v.x); s[1] += bfhi(v.x); s[2] += bflo(v.y); s[3] += bfhi(v.y); s[4] += bflo(v.z); s[5] += bfhi(v.z); s[6] += bflo(v.w); s[7] += bfhi(v.w); }
#pragma unroll
        for (int e = 0; e < 8; ++e) s[e] = xrow16_sum(s[e]);
        if (lane < 16) { float* o = (float*)(F.ws + WS_KMEAN) + (size_t)(h * NBLK + b) * HD + 8 * lane;
            *(f32x4*)o = (f32x4){s[0], s[1], s[2], s[3]} * (1.0f / MBLK); *(f32x4*)(o + 4) = (f32x4){s[4], s[5], s[6], s[7]} * (1.0f / MBLK); }
    }
}

DI void moba_gate_phase(const Frame& F, int l) {
    LAS float* km = (LAS float*)F.lds; LAS unsigned* lcnt = (LAS unsigned*)(F.lds + 32768); LAS unsigned* gbase = lcnt + 64;
    const bf16* qm = (const bf16*)(F.ws + WS_QM); const float* kmean = (const float*)(F.ws + WS_KMEAN);
    unsigned* bcnt = (unsigned*)(F.ctl + CW_BCNT) + l * 512; unsigned* buck = (unsigned*)(F.ws + WS_BUCK);
    for (int u = F.bx; u < NH * 32; u += F.G) {
        const int h = u & 7, ip = u >> 3; const int own = (F.tid < 256) ? ip : 63 - ip; const int t = own * 256 + (F.tid & 255);
        __syncthreads();
        for (int i = F.tid; i < NBLK * HD / 4; i += NTHREADS) ((LAS f32x4*)km)[i] = ((const f32x4*)(kmean + (size_t)h * NBLK * HD))[i];
        if (F.tid < 64) lcnt[F.tid] = 0u;
        __syncthreads();
        float q[HD];
        { const u32x4* qp = (const u32x4*)(qm + (size_t)t * 1024 + h * HD);
#pragma unroll
          for (int c = 0; c < 16; ++c) { const u32x4 qv = qp[c]; q[8 * c + 0] = bflo(qv.x); q[8 * c + 1] = bfhi(qv.x); q[8 * c + 2] = bflo(qv.y); q[8 * c + 3] = bfhi(qv.y);
              q[8 * c + 4] = bflo(qv.z); q[8 * c + 5] = bfhi(qv.z); q[8 * c + 6] = bflo(qv.w); q[8 * c + 7] = bfhi(qv.w); } }
        const float NEG = -__builtin_inff(); float v0 = NEG, v1 = NEG, v2 = NEG; int i0 = -1, i1 = -1, i2 = -1;
        const int bmax = __builtin_amdgcn_readfirstlane(own);
        for (int b = 0; b < bmax; ++b) {
            const LAS f32x4* kr = (const LAS f32x4*)(km + b * HD);
            float d0 = 0.f, d1 = 0.f, d2 = 0.f, d3 = 0.f;
#pragma unroll
            for (int c = 0; c < 32; ++c) { const f32x4 k = kr[c]; d0 += q[4 * c] * k[0]; d1 += q[4 * c + 1] * k[1]; d2 += q[4 * c + 2] * k[2]; d3 += q[4 * c + 3] * k[3]; }
            const float g = (d0 + d1) + (d2 + d3);
            if (g > v0) { v2 = v1; i2 = i1; v1 = v0; i1 = i0; v0 = g; i0 = b; } else if (g > v1) { v2 = v1; i2 = i1; v1 = g; i1 = b; } else if (g > v2) { v2 = g; i2 = b; }
        }
        unsigned lp0 = 0, lp1 = 0, lp2 = 0;
        if (i0 >= 0) lp0 = atomicAdd((unsigned*)&lcnt[i0], 1u);
        if (i1 >= 0) lp1 = atomicAdd((unsigned*)&lcnt[i1], 1u);
        if (i2 >= 0) lp2 = atomicAdd((unsigned*)&lcnt[i2], 1u);
        __syncthreads();
        if (F.tid < 64) { const unsigned c = lcnt[F.tid]; gbase[F.tid] = c ? __hip_atomic_fetch_add(bcnt + h * 64 + F.tid, c, RLX_AGENT) : 0u; }
        __syncthreads();
        unsigned* bh = buck + (size_t)h * BUCK_PER_HEAD;
        if (i0 >= 0) bh[bucket_off(i0) + gbase[i0] + lp0] = ((unsigned)t << 2) | 0u;
        if (i1 >= 0) bh[bucket_off(i1) + gbase[i1] + lp1] = ((unsigned)t << 2) | 1u;
        if (i2 >= 0) bh[bucket_off(i2) + gbase[i2] + lp2] = ((unsigned)t << 2) | 2u;
    }
    __syncthreads();
}

constexpr int IX_KSTRIDE = 144, IX_KBUF = 128 * IX_KSTRIDE;
constexpr int IX_WSTRIDE = 2048 + 64;
constexpr int IX_CSC = 2 * IX_KBUF;
constexpr int IX_CIX = IX_CSC + 8 * IX_WSTRIDE * 4;
static_assert(IX_CIX + 8 * IX_WSTRIDE * 2 <= MISC_OFF, "indexer LDS");
DI unsigned sortable(float f) { const unsigned u = __float_as_uint(f); return (u >> 31) ? ~u : (u | 0x80000000u); }
DI float unsortable(unsigned k) { return __uint_as_float((k >> 31) ? (k ^ 0x80000000u) : ~k); }
DI unsigned popc64(unsigned long long m) { return (unsigned)__builtin_popcountll(m); }
DI unsigned mbcnt64(unsigned long long m) { return __builtin_amdgcn_mbcnt_hi((unsigned)(m >> 32), __builtin_amdgcn_mbcnt_lo((unsigned)m, 0u)); }
template <int APPROX> DI float ix_compact(LAS float* sc, LAS unsigned short* ix, int& n, int lane) {
    unsigned key[16]; unsigned short idv[16];
    const bool big = n > 512;
    unsigned kmax = 0u, kmin = 0xFFFFFFFFu;
#pragma unroll
    for (int j = 0; j < 16; ++j) { const int e = j * 64 + lane; key[j] = 0u; idv[j] = 0;
        if (j < 8 || big) { const bool v = e < n; key[j] = v ? sortable(sc[e]) : 0u; idv[j] = ix[e]; kmax = key[j] > kmax ? key[j] : kmax; const unsigned km = v ? key[j] : 0xFFFFFFFFu; kmin = km < kmin ? km : kmin; } }
    kmax = wave_umax(kmax); kmin = wave_umin(kmin);
    const unsigned diff = (unsigned)__builtin_amdgcn_readfirstlane((int)(kmax ^ kmin));
    const int nb = diff ? 32 - __builtin_clz(diff) : 0;
    unsigned cur = (unsigned)__builtin_amdgcn_readfirstlane((int)kmax); cur = nb >= 32 ? 0u : (cur >> nb) << nb;
    unsigned ccur = (unsigned)n;
    for (int b = nb - 1; b >= 0; --b) {
        const unsigned trial = cur | (1u << b); unsigned c = 0;
#pragma unroll
        for (int j = 0; j < 8; ++j) c += popc64(__ballot(key[j] >= trial));
        if (big) {
#pragma unroll
            for (int j = 8; j < 16; ++j) c += popc64(__ballot(key[j] >= trial)); }
        if (c >= (unsigned)TOPK) { cur = trial; ccur = c; if (APPROX && c <= 320u) break; }
    }
    unsigned need_eq = 0x7fffffffu;
    if (!APPROX) { unsigned ngt = 0;
#pragma unroll
        for (int j = 0; j < 16; ++j) ngt += popc64(__ballot(key[j] > cur));
        need_eq = (unsigned)TOPK - ngt; }
    unsigned out = 0, eqseen = 0;
#pragma unroll
    for (int j = 0; j < 16; ++j) {
        if (j < 8 || big) {
            const bool valid = (j * 64 + lane) < n; const bool gt = key[j] > cur, eq = valid && key[j] == cur;
            const unsigned long long em = __ballot(eq); const bool keep = (valid && gt) || (eq && (eqseen + mbcnt64(em)) < need_eq);
            const unsigned long long kmk = __ballot(keep); const unsigned pos = out + mbcnt64(kmk);
            if (keep) { sc[pos] = unsortable(key[j]); ix[pos] = idv[j]; }
            out += popc64(kmk); eqseen += popc64(em);
        }
    }
    n = (int)out; (void)ccur;
    return unsortable(cur);
}
DI float relu_nc(float x) { const int b = __float_as_int(x); return __int_as_float(b > 0 ? b : 0); }
#define IX_SCORE(ACC, KEY0, S_) do { \
    f32x2 s0_ = {0.f, 0.f}, s1_ = {0.f, 0.f}; \
    _Pragma("unroll") for (int i_ = 0; i_ < 4; ++i_) { const f32x2 r0_ = {relu_nc(ACC[2 * i_]), relu_nc(ACC[2 * i_ + 1])}, r1_ = {relu_nc(ACC[8 + 2 * i_]), relu_nc(ACC[9 + 2 * i_])}; \
        s0_ = __builtin_elementwise_fma(r0_, wv2[i_], s0_); s1_ = __builtin_elementwise_fma(r1_, wv2[4 + i_], s1_); } \
    const auto sw_ = __builtin_amdgcn_permlane32_swap(__float_as_uint(s0_[0] + s0_[1]), __float_as_uint(s1_[0] + s1_[1]), false, false); \
    S_ = __uint_as_float(sw_[0]) + __uint_as_float(sw_[1]); \
    S_ = ((KEY0) + r) <= tq ? S_ : NEG; } while (0)
#define IX_APPEND(S_, KEY0) do { \
    const bool pass_ = S_ > thr; \
    const unsigned long long mk_ = __ballot(pass_); \
    if (IX_DRY) { dry_acc += S_; } else { \
        const unsigned mlo_ = (unsigned)mk_, mhi_ = (unsigned)(mk_ >> 32); const int nlo_ = __builtin_popcount(mlo_), nhi_ = __builtin_popcount(mhi_); \
        const unsigned base_ = hh ? (unsigned)(cnt1 - nlo_ + 1024) : (unsigned)cnt0; \
        const unsigned pos_ = __builtin_amdgcn_mbcnt_hi(mhi_, __builtin_amdgcn_mbcnt_lo(mlo_, base_)); \
        const unsigned idx_ = pass_ ? pos_ : (unsigned)(2048 + lane);            \
        csc[idx_] = S_; cix[idx_] = (unsigned short)((KEY0) + r); \
        cnt0 += nlo_; cnt1 += nhi_; \
        if ((cnt0 > cnt1 ? cnt0 : cnt1) > 1024 - 64) { \
            if (cnt0 > 1024 - 64) { const float nt_ = ix_compact<1>(csc, cix, cnt0, lane); thr = hh ? thr : nt_; } \
            if (cnt1 > 1024 - 64) { const float nt_ = ix_compact<1>(csc + 1024, cix + 1024, cnt1, lane); thr = hh ? nt_ : thr; } } \
    } } while (0)
#define IX_PROCESS(ACC, KEY0) do { float sc_; IX_SCORE(ACC, KEY0, sc_); IX_APPEND(sc_, KEY0); } while (0)
#define IX_APPEND2(SA_, KEYA, SB_, KEYB) do { \
    if (IX_DRY) { dry_acc += SA_ + SB_; } else { \
        const bool pa_ = SA_ > thr, pb_ = SB_ > thr; \
        const unsigned long long ma_ = __ballot(pa_), mb_ = __ballot(pb_); \
        const unsigned alo_ = (unsigned)ma_, ahi_ = (unsigned)(ma_ >> 32), blo_ = (unsigned)mb_, bhi_ = (unsigned)(mb_ >> 32); \
        const int nal_ = __builtin_popcount(alo_), nah_ = __builtin_popcount(ahi_), nbl_ = __builtin_popcount(blo_), nbh_ = __builtin_popcount(bhi_); \
        const unsigned basea_ = hh ? (unsigned)(cnt1 - nal_ + 1024) : (unsigned)cnt0; \
        const unsigned baseb_ = hh ? (unsigned)(cnt1 + nah_ - nbl_ + 1024) : (unsigned)(cnt0 + nal_); \
        const unsigned posa_ = __builtin_amdgcn_mbcnt_hi(ahi_, __builtin_amdgcn_mbcnt_lo(alo_, basea_)), posb_ = __builtin_amdgcn_mbcnt_hi(bhi_, __builtin_amdgcn_mbcnt_lo(blo_, baseb_)); \
        const unsigned ia_ = pa_ ? posa_ : (unsigned)(2048 + lane), ib_ = pb_ ? posb_ : (unsigned)(2048 + lane); \
        csc[ia_] = SA_; cix[ia_] = (unsigned short)((KEYA) + r); csc[ib_] = SB_; cix[ib_] = (unsigned short)((KEYB) + r); \
        cnt0 += nal_ + nbl_; cnt1 += nah_ + nbh_; \
        if ((cnt0 > cnt1 ? cnt0 : cnt1) > 1024 - 64) { \
            if (cnt0 > 1024 - 64) { const float nt_ = ix_compact<1>(csc, cix, cnt0, lane); thr = hh ? thr : nt_; } \
            if (cnt1 > 1024 - 64) { const float nt_ = ix_compact<1>(csc + 1024, cix + 1024, cnt1, lane); thr = hh ? nt_ : thr; } } \
    } } while (0)
#define IX_MMA(ACC, KB, TILE) do { \
    _Pragma("unroll") for (int i_ = 0; i_ < 16; ++i_) ACC[i_] = 0.f; \
    _Pragma("unroll") for (int kk_ = 0; kk_ < 4; ++kk_) { const bf16x8 b_ = *(const LAS bf16x8*)((KB) + boff + (TILE) * (32 * IX_KSTRIDE) + kk_ * 32); \
        ACC = __builtin_amdgcn_mfma_f32_32x32x16_bf16(af[kk_], b_, ACC, 0, 0, 0); } } while (0)
#define IX_LDB(FR, KB, TILE) do { _Pragma("unroll") for (int kk_ = 0; kk_ < 4; ++kk_) FR[kk_] = *(const LAS bf16x8*)((KB) + boff + (TILE) * (32 * IX_KSTRIDE) + kk_ * 32); } while (0)
#define IX_MMAR(ACC, FR) do { \
    _Pragma("unroll") for (int i_ = 0; i_ < 16; ++i_) ACC[i_] = 0.f; \
    _Pragma("unroll") for (int kk_ = 0; kk_ < 4; ++kk_) ACC = __builtin_amdgcn_mfma_f32_32x32x16_bf16(af[kk_], FR[kk_], ACC, 0, 0, 0); } while (0)
#define IX_MMAR_SCORE(ACCN, FR, ACCC, KEY0, S_) do { IX_MMAR(ACCN, FR); IX_SCORE(ACCC, KEY0, S_); \
    _Pragma("unroll") for (int g_ = 0; g_ < 4; ++g_) { __builtin_amdgcn_sched_group_barrier(0x008, 1, 0); __builtin_amdgcn_sched_group_barrier(0x002, 10, 0); } } while (0)
#define IX_SCHED(CH) do { if (!IX_DRY && (((CH) + 1) == 16 || ((CH) + 1) == 32 || ((CH) + 1) == 64)) { \
    if (cnt0 > 320) { const float nt_ = ix_compact<1>(csc, cix, cnt0, lane); thr = hh ? thr : nt_; } \
    if (cnt1 > 320) { const float nt_ = ix_compact<1>(csc + 1024, cix + 1024, cnt1, lane); thr = hh ? nt_ : thr; } } } while (0)
#define IX_CHUNK(KB, CH) do { \
    int nt_w = ((ta + 1 - (CH) * 128) >> 5) + 1; nt_w = nt_w < 0 ? 0 : (nt_w > 4 ? 4 : nt_w); \
    f32x16 accA, accB; \
    if (nt_w == 4) { float qa_, qb_, qc_, qd_; bf16x8 fr0[4], fr1[4], fr2[4], fr3[4]; f32x16 accC, accD;     \
        IX_LDB(fr0, KB, 0); IX_LDB(fr1, KB, 1); IX_LDB(fr2, KB, 2); IX_LDB(fr3, KB, 3); \
        IX_MMAR(accA, fr0); IX_MMAR(accB, fr1); \
        IX_MMAR(accC, fr2); IX_MMAR(accD, fr3); IX_SCORE(accA, (CH) * 128, qa_); IX_SCORE(accB, (CH) * 128 + 32, qb_); \
        IX_APPEND2(qa_, (CH) * 128, qb_, (CH) * 128 + 32); \
        IX_SCORE(accC, (CH) * 128 + 64, qc_); IX_SCORE(accD, (CH) * 128 + 96, qd_); \
        IX_APPEND2(qc_, (CH) * 128 + 64, qd_, (CH) * 128 + 96); \
    } else if (nt_w > 0) { IX_MMA(accA, KB, 0); \
        if (nt_w > 1) IX_MMA(accB, KB, 1); \
        IX_PROCESS(accA, (CH) * 128); \
        if (nt_w > 1) { if (nt_w > 2) IX_MMA(accA, KB, 2); \
            IX_PROCESS(accB, (CH) * 128 + 32); \
            if (nt_w > 2) IX_PROCESS(accA, (CH) * 128 + 64); } } } while (0)
#define IX_LDSBAR() do { asm volatile("s_waitcnt lgkmcnt(0)" ::: "memory"); __builtin_amdgcn_s_barrier(); asm volatile("" ::: "memory"); } while (0)
DI void indexer_phase(const Frame& F) {
    const int lane = F.lane, wave = F.wave, tid = F.tid, r = lane & 31, hh = lane >> 5;
    const bf16* qidx = (const bf16*)(F.ws + WS_QIDX); const bf16* kidx = (const bf16*)(F.ws + WS_KIDXN); const float* widx = (const float*)(F.ws + WS_WIDX);
    unsigned short* sel = (unsigned short*)(F.ws + WS_SEL);
    LAS float* csc = (LAS float*)(F.lds + IX_CSC) + wave * IX_WSTRIDE; LAS unsigned short* cix = (LAS unsigned short*)(F.lds + IX_CIX) + wave * IX_WSTRIDE;
    const float NEG = -__builtin_inff();
    const unsigned boff = (unsigned)(r * IX_KSTRIDE + hh * 16);
    const unsigned sg0 = (unsigned)((tid >> 3) * 64 + (tid & 7) * 8), sl0 = (unsigned)((tid >> 3) * IX_KSTRIDE + (tid & 7) * 16);
    LAS unsigned char* const kb0 = F.lds, * const kb1 = F.lds + IX_KBUF;
#define IX_LOAD(R, CHK) do { const int c_ = (CHK) < nch ? (CHK) : nch - 1; const bf16* g_ = kidx + (size_t)c_ * (128 * 64) + sg0; R[0] = *(const u32x4*)g_; R[1] = *(const u32x4*)(g_ + 64 * 64); } while (0)
#define IX_STORE(KB, R) do { *(LAS u32x4*)((KB) + sl0) = R[0]; *(LAS u32x4*)((KB) + sl0 + 64 * IX_KSTRIDE) = R[1]; } while (0)
    for (int ui = 0; ui * F.G < S / 16; ++ui) {
        const int unit = ui * F.G + ((ui & 1) ? F.G - 1 - F.bx : F.bx);
        if (unit >= S / 16) continue;
        const int t0 = unit * 16, nkeys = t0 + 16, nch = (nkeys + 127) >> 7;
        const int ta = t0 + 2 * wave;
        bf16x8 af[4];
#pragma unroll
        for (int kk = 0; kk < 4; ++kk) af[kk] = *(const bf16x8*)(qidx + (size_t)(ta + (r >> 4)) * 1024 + (r & 15) * 64 + 16 * kk + 8 * hh);
        f32x2 wv2[8];
#pragma unroll
        for (int i = 0; i < 8; ++i) { const int e0 = 2 * i, e1 = 2 * i + 1;
            wv2[i] = (f32x2){widx[(size_t)(ta + (e0 >> 3)) * IH + (e0 & 3) + 8 * ((e0 >> 2) & 1) + 4 * hh], widx[(size_t)(ta + (e1 >> 3)) * IH + (e1 & 3) + 8 * ((e1 >> 2) & 1) + 4 * hh]}; }
        float thr = NEG; int cnt0 = 0, cnt1 = 0; const int tq = ta + hh;
        float dry_acc = 0.f; (void)dry_acc;
#ifdef IX_PROBE
#define IX_DRY 1
        {
        u32x4 RA[2], RB[2];
        IX_LOAD(RA, 0); IX_LOAD(RB, 1);
        IX_STORE(kb0, RA); IX_LOAD(RA, 2);
        for (int ch = 0; ch < nch; ch += 2) {
            IX_LDSBAR();
            IX_CHUNK(kb0, ch); IX_SCHED(ch);
            IX_STORE(kb1, RB); IX_LOAD(RB, ch + 3);
            IX_LDSBAR();
            if (ch + 1 < nch) { IX_CHUNK(kb1, ch + 1); IX_SCHED(ch + 1); }
            IX_STORE(kb0, RA); IX_LOAD(RA, ch + 4);
        }
        }
        if (dry_acc == 123.456f) sel[0] = 0;
        __syncthreads();
#undef IX_DRY
#endif
#define IX_DRY 0
        {
        u32x4 RA[2], RB[2];
        IX_LOAD(RA, 0); IX_LOAD(RB, 1);
        IX_STORE(kb0, RA); IX_LOAD(RA, 2);
        for (int ch = 0; ch < nch; ch += 2) {
            IX_LDSBAR();
            IX_CHUNK(kb0, ch); IX_SCHED(ch);
            IX_STORE(kb1, RB); IX_LOAD(RB, ch + 3);
            IX_LDSBAR();
            if (ch + 1 < nch) { IX_CHUNK(kb1, ch + 1); IX_SCHED(ch + 1); }
            IX_STORE(kb0, RA); IX_LOAD(RA, ch + 4);
        }
        }
#undef IX_DRY
        if (cnt0 > TOPK) (void)ix_compact<0>(csc, cix, cnt0, lane);
        if (cnt1 > TOPK) (void)ix_compact<0>(csc + 1024, cix + 1024, cnt1, lane);
#pragma unroll
        for (int q = 0; q < 2; ++q) { const int n = q ? cnt1 : cnt0;
#pragma unroll
            for (int j = 0; j < 4; ++j) { const int e = j * 64 + lane; sel[(size_t)(ta + q) * TOPK + e] = e < n ? cix[q * 1024 + e] : (unsigned short)0xFFFFu; } }
        __syncthreads();
    }
#undef IX_LOAD
#undef IX_STORE
}
#undef IX_PROCESS
#undef IX_SCORE
#undef IX_APPEND
#undef IX_MMAR_SCORE
#undef IX_MMAR
#undef IX_LDB
#undef IX_MMA
#undef IX_CHUNK
#undef IX_SCHED

constexpr int DA_WBYTES = 16384 + 256;
DI void dsa_attn_phase(const Frame& F) {
    const int lane = F.lane, fr = lane & 15, fq = lane >> 4;
    const bf16* qlat = (const bf16*)(F.ws + WS_QLAT); const bf16* ckv = (const bf16*)(F.ws + WS_CKVN); const unsigned short* sel = (const unsigned short*)(F.ws + WS_SEL);
    bf16* olat = (bf16*)(F.ws + WS_OLAT);
    LAS unsigned char* img = F.lds + F.wave * DA_WBYTES; LAS float* dist = (LAS float*)(img + 16384);
    const unsigned imgaddr = (unsigned)(size_t)img;
    const float slope2 = __builtin_amdgcn_exp2f(-(float)((fr & 7) + 1)) * LOG2E;
    const int gw = F.bx * NWAVES + F.wave, NGW = F.G * NWAVES;
    unsigned kb[2], vb[2];
#pragma unroll
    for (int kt = 0; kt < 2; ++kt) kb[kt] = imgaddr + off_b(perm32rows(16 * kt + fr), fq) - 64u * (unsigned)(fr & 3);
    const unsigned kx = (unsigned)(fr & 3);
#pragma unroll
    for (int tt = 0; tt < 2; ++tt) { const unsigned a0 = tr_addr16(lane, 0, 0, tt); vb[tt] = imgaddr + a0; }
    const unsigned xh = (((unsigned)(lane & 15) >> 2) << 1) | (unsigned)((lane >> 4) & 1);
#pragma unroll
    for (int tt = 0; tt < 2; ++tt) vb[tt] -= 32u * xh;
    for (int t = gw; t < S; t += NGW) {
        const int nvalid = t + 1 < TOPK ? t + 1 : TOPK;
        bf16x8 qf[8];
#pragma unroll
        for (int kk = 0; kk < 8; ++kk) { qf[kk] = (bf16x8){0, 0, 0, 0, 0, 0, 0, 0}; if (fr < 8) qf[kk] = *(const bf16x8*)(qlat + (size_t)t * 2048 + fr * 256 + 32 * kk + 8 * fq); }
        f32x4 o[16];
#pragma unroll
        for (int c = 0; c < 16; ++c) o[c] = (f32x4){0.f, 0.f, 0.f, 0.f};
        float m = -__builtin_inff(), lsum = 0.f;
        int idxn; { const int e = (lane & 31); const int si = sel[(size_t)t * TOPK + e]; idxn = e < nvalid ? si : 0; }
        const unsigned char* ckv8 = (const unsigned char*)ckv;
        u32x4 gA[8];
#pragma unroll
        for (int i = 0; i < 8; ++i) { const int row = (lane >> 4) + 4 * i; const int ki = __builtin_amdgcn_ds_bpermute(row << 2, idxn); gA[i] = *(const u32x4*)(ckv8 + (size_t)ki * 256 + (lane & 15) * 16); }
        for (int ch = 0; ch < 8; ++ch) {
            unsigned xhl = xh, kxl = kx; asm volatile("" : "+v"(xhl), "+v"(kxl));
            const int myidx = idxn;
            if (ch < 7) { const int e = (ch + 1) * 32 + (lane & 31); const int si = sel[(size_t)t * TOPK + e]; idxn = e < nvalid ? si : 0; }
#pragma unroll
            for (int i = 0; i < 8; ++i) { const unsigned row = (lane >> 4) + 4 * i, p = lane & 15, prow = perm32rows(row); const u32x4 g = gA[i]; unsigned w[8];
#pragma unroll
                for (int q = 0; q < 4; ++q) { const f32x2 lo = __builtin_amdgcn_cvt_pk_f32_fp8((int)g[q], false), hi = __builtin_amdgcn_cvt_pk_f32_fp8((int)g[q], true); w[2 * q] = cvt_pk_bf16(lo[0], lo[1]); w[2 * q + 1] = cvt_pk_bf16(hi[0], hi[1]); }
                LAS unsigned char* hb = img + (p >> 3) * 8192;
                *(LAS u32x4*)(hb + off_b(prow, 2 * (p & 7))) = (u32x4){w[0], w[1], w[2], w[3]}; *(LAS u32x4*)(hb + off_b(prow, 2 * (p & 7) + 1)) = (u32x4){w[4], w[5], w[6], w[7]}; }
            if (lane < 32) { const int e = ch * 32 + lane; dist[lane] = e < nvalid ? (float)(t - myidx) : __builtin_inff(); }
            if (ch < 7) {
#pragma unroll
                for (int i = 0; i < 8; ++i) { const int row = (lane >> 4) + 4 * i; const int ki = __builtin_amdgcn_ds_bpermute(row << 2, idxn); gA[i] = *(const u32x4*)(ckv8 + (size_t)ki * 256 + (lane & 15) * 16); } }
            f32x4 sacc[2];
#pragma unroll
            for (int kt = 0; kt < 2; ++kt) { sacc[kt] = (f32x4){0.f, 0.f, 0.f, 0.f};
#pragma unroll
                for (int kk = 0; kk < 8; ++kk) { const bf16x8 afr = *(const LAS bf16x8*)(kb[kt] + 64u * ((unsigned)(kk & 3) ^ kxl) + 8192u * (kk >> 2));
                    sacc[kt] = __builtin_amdgcn_mfma_f32_16x16x32_bf16(afr, qf[kk], sacc[kt], 0, 0, 0); } }
            float cmax = -__builtin_inff();
#pragma unroll
            for (int kt = 0; kt < 2; ++kt) { const f32x4 dv = *(const LAS f32x4*)(dist + 16 * kt + 4 * fq);
#pragma unroll
                for (int i = 0; i < 4; ++i) { sacc[kt][i] = sacc[kt][i] * ATT_SCALE2 - slope2 * dv[i]; cmax = fmaxf(cmax, sacc[kt][i]); } }
            cmax = xrow16_max(cmax);
            const float mn = fmaxf(m, cmax); const float alpha = __builtin_amdgcn_exp2f(m - mn); m = mn;
            float ps = 0.f;
#pragma unroll
            for (int kt = 0; kt < 2; ++kt)
#pragma unroll
                for (int i = 0; i < 4; ++i) { sacc[kt][i] = __builtin_amdgcn_exp2f(sacc[kt][i] - mn); ps += sacc[kt][i]; }
            ps = xrow16_sum(ps); lsum = lsum * alpha + ps;
            u32x4 pw; pw.x = cvt_pk_bf16(sacc[0][0], sacc[0][1]); pw.y = cvt_pk_bf16(sacc[0][2], sacc[0][3]); pw.z = cvt_pk_bf16(sacc[1][0], sacc[1][1]); pw.w = cvt_pk_bf16(sacc[1][2], sacc[1][3]);
            const bf16x8 pf = __builtin_bit_cast(bf16x8, pw);
#pragma unroll
            for (int c = 0; c < 16; ++c) {
                o[c] = o[c] * alpha;
                const unsigned cx = 32u * ((unsigned)(c & 7) ^ xhl); const s16x4 lo = vtr(vb[0] + cx + 8192u * (c >> 3)), hi = vtr(vb[1] + cx + 8192u * (c >> 3));
                const bf16x8 vfr = __builtin_shufflevector(lo, hi, 0, 1, 2, 3, 4, 5, 6, 7);
                o[c] = __builtin_amdgcn_mfma_f32_16x16x32_bf16(vfr, pf, o[c], 0, 0, 0);
                if ((c & 3) == 3) __builtin_amdgcn_sched_barrier(0);
            }
        }
        const float inv = 1.0f / lsum;
        if (fr < 8) {
#pragma unroll
            for (int c = 0; c < 16; ++c) { u32x2 w; w.x = cvt_pk_bf16(o[c][0] * inv, o[c][1] * inv); w.y = cvt_pk_bf16(o[c][2] * inv, o[c][3] * inv);
                *(u32x2*)(olat + (size_t)t * 2048 + fr * 256 + 16 * c + 4 * fq) = w; }
        }
    }
}

struct BlkAttn { const bf16* K; const bf16* V; int kvld; };
DI void blk_stage(const Frame& F, const bf16* Kp, const bf16* Vp, int kvld) {
    int tl = F.tid; asm volatile("" : "+v"(tl));
#pragma unroll 4
    for (int i = 0; i < 8; ++i) { const int p = tl + 512 * i; const unsigned row = p >> 4, ch = p & 15;
        const u32x4 kv = *(const u32x4*)(Kp + (size_t)row * kvld + ch * 8); const u32x4 vv = *(const u32x4*)(Vp + (size_t)row * kvld + ch * 8);
        *(LAS u32x4*)(F.lds + off_b(row, ch)) = kv; *(LAS u32x4*)(F.lds + 65536 + off_b(perm32rows(row), ch)) = vv; }
}
DI void blk_core(const Frame& F, const bf16* qrow, int tq, int kpos0, float slope2, bool causal, f32x4 (&o)[8], float& m_out, float& l_out) {
    const int lane = F.lane, fr = lane & 15, fq = lane >> 4;
    const unsigned kimg = (unsigned)(size_t)F.lds, vimg = kimg + 65536;
    bf16x8 qf[4];
#pragma unroll
    for (int kk = 0; kk < 4; ++kk) qf[kk] = *(const bf16x8*)(qrow + 32 * kk + 8 * fq);
    unsigned kb[4];
#pragma unroll
    for (int kk = 0; kk < 4; ++kk) kb[kk] = kimg + off_b(fr, 4 * kk + fq);
    f32x4 s[16];
#pragma unroll
    for (int kt = 0; kt < 16; ++kt) { s[kt] = (f32x4){0.f, 0.f, 0.f, 0.f};
#pragma unroll
        for (int kk = 0; kk < 4; ++kk) { const bf16x8 afr = *(const LAS bf16x8*)(kb[kk] + 4096u * kt);
            s[kt] = __builtin_amdgcn_mfma_f32_16x16x32_bf16(afr, qf[kk], s[kt], 0, 0, 0); }
        if ((kt & 3) == 3) __builtin_amdgcn_sched_barrier(0); }
    float mx = -__builtin_inff();
    const float dq = (float)(tq - kpos0 - 4 * fq);
#pragma unroll
    for (int kt = 0; kt < 16; ++kt)
#pragma unroll
        for (int i = 0; i < 4; ++i) { const float dd = dq - (float)(16 * kt + i); float v = s[kt][i] * ATT_SCALE2 - slope2 * dd;
            if (causal && dd < 0.f) v = -__builtin_inff(); s[kt][i] = v; mx = fmaxf(mx, v); }
    mx = xrow16_max(mx);
    float ps = 0.f;
#pragma unroll
    for (int kt = 0; kt < 16; ++kt)
#pragma unroll
        for (int i = 0; i < 4; ++i) { s[kt][i] = __builtin_amdgcn_exp2f(s[kt][i] - mx); ps += s[kt][i]; }
    ps = xrow16_sum(ps);
    unsigned vb[8][2];
#pragma unroll
    for (int dt = 0; dt < 8; ++dt) { vb[dt][0] = vimg + tr_addr16(lane, dt, 0, 0); vb[dt][1] = vimg + tr_addr16(lane, dt, 0, 1); }
#pragma unroll
    for (int dt = 0; dt < 8; ++dt) o[dt] = (f32x4){0.f, 0.f, 0.f, 0.f};
#pragma unroll
    for (int ks = 0; ks < 8; ++ks) {
        u32x4 pw; pw.x = cvt_pk_bf16(s[2 * ks][0], s[2 * ks][1]); pw.y = cvt_pk_bf16(s[2 * ks][2], s[2 * ks][3]); pw.z = cvt_pk_bf16(s[2 * ks + 1][0], s[2 * ks + 1][1]); pw.w = cvt_pk_bf16(s[2 * ks + 1][2], s[2 * ks + 1][3]);
        const bf16x8 pf = __builtin_bit_cast(bf16x8, pw);
#pragma unroll
        for (int dt = 0; dt < 8; ++dt) { const s16x4 lo = vtr(vb[dt][0] + 8192u * ks), hi = vtr(vb[dt][1] + 8192u * ks);
            const bf16x8 vfr = __builtin_shufflevector(lo, hi, 0, 1, 2, 3, 4, 5, 6, 7);
            o[dt] = __builtin_amdgcn_mfma_f32_16x16x32_bf16(vfr, pf, o[dt], 0, 0, 0); }
        __builtin_amdgcn_sched_barrier(0);
    }
    const float inv = 1.0f / ps;
#pragma unroll
    for (int dt = 0; dt < 8; ++dt) o[dt] = o[dt] * inv;
    m_out = mx; l_out = ps;
}

#define BLK2_SOFTMAX(S_, O_, M_, L_, DQ_) do { \
    float mx_ = -__builtin_inff(); \
    _Pragma("unroll") for (int kt = 0; kt < 8; ++kt) _Pragma("unroll") for (int i = 0; i < 4; ++i) { const float dd_ = (DQ_) - (float)(16 * kt + i); float v_ = S_[kt][i] * ATT_SCALE2 - slope2 * dd_; \
        if (causal && dd_ < 0.f) v_ = -__builtin_inff(); S_[kt][i] = v_; mx_ = fmaxf(mx_, v_); } \
    mx_ = xrow16_max(mx_); const float mn_ = fmaxf(M_, mx_); const float al_ = __builtin_amdgcn_exp2f(M_ - mn_); M_ = mn_; float ps_ = 0.f; \
    _Pragma("unroll") for (int kt = 0; kt < 8; ++kt) _Pragma("unroll") for (int i = 0; i < 4; ++i) { S_[kt][i] = __builtin_amdgcn_exp2f(S_[kt][i] - mn_); ps_ += S_[kt][i]; } \
    ps_ = xrow16_sum(ps_); L_ = L_ * al_ + ps_; \
    _Pragma("unroll") for (int dt = 0; dt < 8; ++dt) O_[dt] = O_[dt] * al_; } while (0)
DI void blk_core2(const Frame& F, const bf16* qrowA, const bf16* qrowB, int tqA, int tqB, int kpos0, float slope2, bool causal,
                  f32x4 (&oa)[8], f32x4 (&ob)[8], float& mA, float& lA, float& mB, float& lB) {
    int lane = F.lane; asm volatile("" : "+v"(lane));
    const int fr = lane & 15, fq = lane >> 4;
    const unsigned kimg = (unsigned)(size_t)F.lds, vimg = kimg + 65536;
    bf16x8 qa[4], qb[4];
#pragma unroll
    for (int kk = 0; kk < 4; ++kk) { qa[kk] = *(const bf16x8*)(qrowA + 32 * kk + 8 * fq); qb[kk] = *(const bf16x8*)(qrowB + 32 * kk + 8 * fq); }
    const unsigned kbase = kimg + 256u * (unsigned)fr + 16u * ((unsigned)fq ^ (((unsigned)fr >> 2) & 3u)), kx = (unsigned)fr & 3u;
    const unsigned xh = (((unsigned)(lane & 15) >> 2) << 1) | (unsigned)((lane >> 4) & 1);
    unsigned vb[2];
#pragma unroll
    for (int tt = 0; tt < 2; ++tt) vb[tt] = vimg + tr_addr16(lane, 0, 0, tt) - 32u * xh;
#pragma unroll
    for (int dt = 0; dt < 8; ++dt) { oa[dt] = (f32x4){0.f, 0.f, 0.f, 0.f}; ob[dt] = (f32x4){0.f, 0.f, 0.f, 0.f}; }
    mA = -__builtin_inff(); mB = -__builtin_inff(); lA = 0.f; lB = 0.f;
    for (int half = 0; half < 2; ++half) {
        unsigned kxl = kx, xhl = xh; asm volatile("" : "+v"(kxl), "+v"(xhl));
        f32x4 sa[8], sb[8];
#pragma unroll
        for (int kt = 0; kt < 8; ++kt) { sa[kt] = (f32x4){0.f, 0.f, 0.f, 0.f}; sb[kt] = (f32x4){0.f, 0.f, 0.f, 0.f};
#pragma unroll
            for (int kk = 0; kk < 4; ++kk) { const bf16x8 afr = *(const LAS bf16x8*)(kbase + 64u * ((unsigned)kk ^ kxl) + 4096u * (unsigned)(8 * half + kt));
                sa[kt] = __builtin_amdgcn_mfma_f32_16x16x32_bf16(afr, qa[kk], sa[kt], 0, 0, 0); sb[kt] = __builtin_amdgcn_mfma_f32_16x16x32_bf16(afr, qb[kk], sb[kt], 0, 0, 0); }
            if ((kt & 3) == 3) __builtin_amdgcn_sched_barrier(0); }
        const float dqa = (float)(tqA - kpos0 - 128 * half - 4 * fq), dqb = (float)(tqB - kpos0 - 128 * half - 4 * fq);
        BLK2_SOFTMAX(sa, oa, mA, lA, dqa);
        BLK2_SOFTMAX(sb, ob, mB, lB, dqb);
#pragma unroll
        for (int ks = 0; ks < 4; ++ks) {
            u32x4 pw; pw.x = cvt_pk_bf16(sa[2 * ks][0], sa[2 * ks][1]); pw.y = cvt_pk_bf16(sa[2 * ks][2], sa[2 * ks][3]); pw.z = cvt_pk_bf16(sa[2 * ks + 1][0], sa[2 * ks + 1][1]); pw.w = cvt_pk_bf16(sa[2 * ks + 1][2], sa[2 * ks + 1][3]);
            const bf16x8 pfa = __builtin_bit_cast(bf16x8, pw);
            pw.x = cvt_pk_bf16(sb[2 * ks][0], sb[2 * ks][1]); pw.y = cvt_pk_bf16(sb[2 * ks][2], sb[2 * ks][3]); pw.z = cvt_pk_bf16(sb[2 * ks + 1][0], sb[2 * ks + 1][1]); pw.w = cvt_pk_bf16(sb[2 * ks + 1][2], sb[2 * ks + 1][3]);
            const bf16x8 pfb = __builtin_bit_cast(bf16x8, pw);
#pragma unroll
            for (int dt = 0; dt < 8; ++dt) { const unsigned cx = 32u * ((unsigned)dt ^ xhl) + 8192u * (unsigned)(4 * half + ks);
                const s16x4 lo = vtr(vb[0] + cx), hi = vtr(vb[1] + cx); const bf16x8 vfr = __builtin_shufflevector(lo, hi, 0, 1, 2, 3, 4, 5, 6, 7);
                oa[dt] = __builtin_amdgcn_mfma_f32_16x16x32_bf16(vfr, pfa, oa[dt], 0, 0, 0); ob[dt] = __builtin_amdgcn_mfma_f32_16x16x32_bf16(vfr, pfb, ob[dt], 0, 0, 0); }
            __builtin_amdgcn_sched_barrier(0);
        }
    }
    const float ia = 1.0f / lA, ib = 1.0f / lB;
#pragma unroll
    for (int dt = 0; dt < 8; ++dt) { oa[dt] = oa[dt] * ia; ob[dt] = ob[dt] * ib; }
}
#undef BLK2_SOFTMAX

DI void moba_attn_phase(const Frame& F, int l) {
    LAS int* pre = (LAS int*)(F.lds + RING_BYTES);
    LAS int* wsum = pre + 520;
    const unsigned* bcnt = (const unsigned*)(F.ctl + CW_BCNT) + l * 512; const unsigned* buck = (const unsigned*)(F.ws + WS_BUCK);
    const bf16* qm = (const bf16*)(F.ws + WS_QM); const bf16* km = (const bf16*)(F.ws + WS_KM); const bf16* vm = (const bf16*)(F.ws + WS_VM);
    bf16* parto = (bf16*)(F.ws + WS_PARTO); f32x2* partml = (f32x2*)(F.ws + WS_PARTML);
    const int tid = F.tid, lane = F.lane, fr = lane & 15, fq = lane >> 4;
    __syncthreads();
    { const int n = (int)__hip_atomic_load(bcnt + tid, RLX_AGENT); const int cntu = 1 + ((n + 255) >> 8);
      int v = cntu;
#pragma unroll
      for (int o = 1; o < 64; o <<= 1) { const int x = __builtin_amdgcn_ds_bpermute(((lane - o) & 63) << 2, v); if (lane >= o) v += x; }
      if (lane == 63) wsum[F.wave] = v;
      __syncthreads();
      int base = 0;
      for (int w = 0; w < F.wave; ++w) base += wsum[w];
      pre[tid + 1] = base + v; if (tid == 0) pre[0] = 0;
      __syncthreads(); }
    const int total = pre[512];
    const int u_lo = (int)(((long)total * F.bx) >> 8), u_hi = (int)(((long)total * (F.bx + 1)) >> 8);
    int staged = -1;
    for (int u = u_lo; u < u_hi; ++u) {
        int lo = 0, hi = 512;
        while (hi - lo > 1) { const int mid = (lo + hi) >> 1; if (pre[mid] <= u) lo = mid; else hi = mid; }
        const int hb = lo, h = hb >> 6, b = hb & 63, sub = u - pre[hb];
        if (staged != hb) { __syncthreads(); blk_stage(F, km + (size_t)(b * MBLK) * 1024 + h * HD, vm + (size_t)(b * MBLK) * 1024 + h * HD, 1024); __syncthreads(); staged = hb; }
        int tq[2], slot[2]; bool valid[2] = {true, true}; const bool causal = sub == 0;
#pragma unroll
        for (int g = 0; g < 2; ++g) {
            if (sub == 0) { tq[g] = b * MBLK + F.wave * 32 + g * 16 + fr; slot[g] = 3; }
            else { const int n = (int)__hip_atomic_load(bcnt + hb, RLX_AGENT); const int e = (sub - 1) * 256 + F.wave * 32 + g * 16 + fr; valid[g] = e < n;
                const unsigned ent = buck[(size_t)h * BUCK_PER_HEAD + bucket_off(b) + (valid[g] ? e : 0)]; tq[g] = (int)(ent >> 2); slot[g] = (int)(ent & 3u); } }
        const float slope2 = __builtin_amdgcn_exp2f(-(float)(h + 1)) * LOG2E;
        f32x4 oa[8], ob[8]; float ma, la, mb, lb;
        blk_core2(F, qm + (size_t)tq[0] * 1024 + h * HD, qm + (size_t)tq[1] * 1024 + h * HD, tq[0], tq[1], b * MBLK, slope2, causal, oa, ob, ma, la, mb, lb);
        if (valid[0]) { const size_t pi = ((size_t)tq[0] * NH + h) * 4 + slot[0];
#pragma unroll
            for (int dt = 0; dt < 8; ++dt) { u32x2 w; w.x = cvt_pk_bf16(oa[dt][0], oa[dt][1]); w.y = cvt_pk_bf16(oa[dt][2], oa[dt][3]); *(u32x2*)(parto + pi * HD + 16 * dt + 4 * fq) = w; }
            if (fq == 0) partml[pi] = (f32x2){ma, la}; }
        if (valid[1]) { const size_t pi = ((size_t)tq[1] * NH + h) * 4 + slot[1];
#pragma unroll
            for (int dt = 0; dt < 8; ++dt) { u32x2 w; w.x = cvt_pk_bf16(ob[dt][0], ob[dt][1]); w.y = cvt_pk_bf16(ob[dt][2], ob[dt][3]); *(u32x2*)(parto + pi * HD + 16 * dt + 4 * fq) = w; }
            if (fq == 0) partml[pi] = (f32x2){mb, lb}; }
    }
    __syncthreads();
}
DI void moba_combine_phase(const Frame& F) {
    const bf16* parto = (const bf16*)(F.ws + WS_PARTO); const f32x2* partml = (const f32x2*)(F.ws + WS_PARTML); bf16* ob = (bf16*)(F.ws + WS_OB);
    const int gt = F.bx * NTHREADS + F.tid, ngt = F.G * NTHREADS;
    for (int i = gt; i < S * NH * 16; i += ngt) {
        const int th = i >> 4, c = i & 15, t = th >> 3; const int own = t >> 8, nsel = own < 3 ? own : 3;
        float mj[4], lj[4]; float M = -__builtin_inff();
#pragma unroll
        for (int j = 0; j < 4; ++j) { const bool on = (j == 3) || (j < nsel); const f32x2 ml = partml[(size_t)th * 4 + j]; mj[j] = on ? ml[0] : -__builtin_inff(); lj[j] = on ? ml[1] : 0.f; M = fmaxf(M, mj[j]); }
        float r[8] = {0.f, 0.f, 0.f, 0.f, 0.f, 0.f, 0.f, 0.f}; float wsum_ = 0.f;
#pragma unroll
        for (int j = 0; j < 4; ++j) { const bool on = (j == 3) || (j < nsel);
            if (on) { const float w = lj[j] * __builtin_amdgcn_exp2f(mj[j] - M); wsum_ += w; const u32x4 v = *(const u32x4*)(parto + ((size_t)th * 4 + j) * HD + 8 * c);
                r[0] += w * bflo(v.x); r[1] += w * bfhi(v.x); r[2] += w * bflo(v.y); r[3] += w * bfhi(v.y); r[4] += w * bflo(v.z); r[5] += w * bfhi(v.z); r[6] += w * bflo(v.w); r[7] += w * bfhi(v.w); } }
        const float inv = 1.0f / wsum_;
        float sob = F8_SOB; asm volatile("" : "+v"(sob));   const float is = inv * sob; u32x2 w; w.x = pk4_fp8(r[0] * is, r[1] * is, r[2] * is, r[3] * is); w.y = pk4_fp8(r[4] * is, r[5] * is, r[6] * is, r[7] * is);
        *(u32x2*)((unsigned char*)ob + (size_t)th * HD + 8 * c) = w;
    }
}
DI void mem_attn_phase(const Frame& F, int l) {
    const bf16* qmem = (const bf16*)(F.ws + WS_QMEM); const bf16* kv = (const bf16*)(F.ws + WS_KVMEM) + (size_t)l * 1024; bf16* omem = (bf16*)(F.ws + WS_OMEM);
    const int total = NHM * (S / 256);
    int staged = -1;
    for (int u = F.bx; u < total; u += F.G) {
        const int h = u / (S / 256), qc = u % (S / 256);
        if (staged != h) { __syncthreads(); blk_stage(F, kv + h * HD, kv + 512 + h * HD, 4096); __syncthreads(); staged = h; }
        f32x4 oa[8], ob[8]; float ma, la, mb, lb;
        { const int tq0 = qc * 256 + F.wave * 32 + (F.lane & 15); blk_core2(F, qmem + (size_t)tq0 * 512 + h * HD, qmem + (size_t)(tq0 + 16) * 512 + h * HD, 0, 0, 0, 0.f, false, oa, ob, ma, la, mb, lb); }
        int ln = F.lane; asm volatile("" : "+v"(ln));
        const int fq = ln >> 4, tqa = qc * 256 + F.wave * 32 + (ln & 15), tqb = tqa + 16;
#pragma unroll
        for (int dt = 0; dt < 8; ++dt) { *(unsigned*)((unsigned char*)omem + (size_t)tqa * 512 + h * HD + 16 * dt + 4 * fq) = pk4_fp8(oa[dt][0] * F8_SOM, oa[dt][1] * F8_SOM, oa[dt][2] * F8_SOM, oa[dt][3] * F8_SOM);
            *(unsigned*)((unsigned char*)omem + (size_t)tqb * 512 + h * HD + 16 * dt + 4 * fq) = pk4_fp8(ob[dt][0] * F8_SOM, ob[dt][1] * F8_SOM, ob[dt][2] * F8_SOM, ob[dt][3] * F8_SOM); }
    }
    __syncthreads();
}

DI void ln_phase(const Frame& F, const Args& a, int l, int which) {
    const int gw = F.bx * NWAVES + F.wave, NGW = F.G * NWAVES, lane = F.lane;
    const float* g = a.in[17] + (size_t)(l * 3 + which) * D; const float* b = a.in[18] + (size_t)(l * 3 + which) * D;
    float* x = a.out; const bf16* y = (const bf16*)(F.ws + WS_Y); bf16* xb = (bf16*)(F.ws + WS_XB);
    f32x4 xv[8]; u32x2 yv[8];
    if (gw < S) {
#pragma unroll
        for (int j = 0; j < 8; ++j) { xv[j] = ((const f32x4*)(x + (size_t)gw * D) + lane)[64 * j]; yv[j] = ((const u32x2*)(y + (size_t)gw * D) + lane)[64 * j]; } }
    for (int r = gw; r < S; r += NGW) {
        f32x4 v[8]; float s = 0.f;
#pragma unroll
        for (int j = 0; j < 8; ++j) { v[j] = (f32x4){ALPHA * xv[j][0] + bflo(yv[j].x), ALPHA * xv[j][1] + bfhi(yv[j].x), ALPHA * xv[j][2] + bflo(yv[j].y), ALPHA * xv[j][3] + bfhi(yv[j].y)}; s += (v[j][0] + v[j][1]) + (v[j][2] + v[j][3]); }
        const int rn = r + NGW;
        if (rn < S) {
#pragma unroll
            for (int j = 0; j < 8; ++j) { xv[j] = ((const f32x4*)(x + (size_t)rn * D) + lane)[64 * j]; yv[j] = ((const u32x2*)(y + (size_t)rn * D) + lane)[64 * j]; } }
        const float mean = wave_sum(s) * (1.0f / D); float s2 = 0.f;
#pragma unroll
        for (int j = 0; j < 8; ++j) { v[j] = v[j] - mean; s2 += (v[j][0] * v[j][0] + v[j][1] * v[j][1]) + (v[j][2] * v[j][2] + v[j][3] * v[j][3]); }
        const float rstd = 1.0f / sqrtf(wave_sum(s2) * (1.0f / D) + LN_EPS);
        f32x4* xr = (f32x4*)(x + (size_t)r * D) + lane; u32x2* xbr = (u32x2*)(xb + (size_t)r * D) + lane;
#pragma unroll
        for (int j = 0; j < 8; ++j) { const f32x4 g4 = ((const f32x4*)g)[lane + 64 * j], b4 = ((const f32x4*)b)[lane + 64 * j]; const f32x4 o = v[j] * rstd * g4 + b4;
            xr[64 * j] = o;
            if (which != 2) ((unsigned*)(xb) + (size_t)r * (D / 4) + lane)[64 * j] = pk4_fp8(o[0], o[1], o[2], o[3]);
            else { u32x2 w; w.x = pk2(o[0], o[1]); w.y = pk2(o[2], o[3]); xbr[64 * j] = w;
                if (which == 2) ((unsigned*)(F.ws + WS_XB8) + (size_t)r * (D / 4) + lane)[64 * j] = pk4_fp8(o[0], o[1], o[2], o[3]); } }
    }
}


#ifdef SELFCHECK
constexpr int CW_ERR = 24576;
#ifndef SELFCHECK_MASK
#define SELFCHECK_MASK 0xFFFFFFFFu
#endif
#define CHK_ON(w) (((SELFCHECK_MASK) >> (w)) & 1u)
#ifndef SELFCHECK_TOL
#define SELFCHECK_TOL 0.05f
#endif
__device__ const int CHK_TS[8] = {0, 1, 255, 256, 511, 4097, 9000, 16383};
__device__ const int CHK_BND[19] = {1023, 1024, 1279, 1280, 2303, 2304, 2367, 2368, 2383, 2384, 3407, 3408, 4431, 4432, 5455, 5456, 7503, 7504, 9551};
DI void chk_report(gu32* ctl, int which, float err) {
    if (!(err >= 0.f)) err = 1e30f;
    __hip_atomic_fetch_max((unsigned*)(ctl + CW_ERR + which), __float_as_uint(err), RLX_AGENT);
}
DI float bfr(float w) { return __uint_as_float(f2bf(w) << 16); }
DI float bf2f(bf16 v) { return __uint_as_float(((unsigned)v) << 16); }
DI float relerr(float got, float ref, float fl) { return fabsf(got - ref) / (fabsf(ref) + fl); }
DI float wdot(const bf16* a, int K, const float* W, size_t ldw, int lane) {
    float s = 0.f; for (int k = lane; k < K; k += 64) s += bf2f(a[k]) * bfr(W[(size_t)k * ldw]); return wave_sum(s);
}
DI float fp8dec(unsigned char v) { return __builtin_amdgcn_cvt_f32_fp8((int)v, 0); }
DI float f8r(float w, float scale) { return fp8dec((unsigned char)(pk4_fp8(w * scale, 0.f, 0.f, 0.f) & 0xffu)) / scale; }
DI void chk_inproj(const Frame& F, const Args& a) {
    const int gw = F.bx * NWAVES + F.wave, NGW = F.G * NWAVES, lane = F.lane; unsigned char* ws = F.ws;
    const int NC = 83;
    for (int sidx = gw; sidx < 8 * NC; sidx += NGW) {
        const int t = CHK_TS[sidx / NC], ci = sidx % NC;
        const int c = ci < 64 ? (ci * 149 + 7) % INW : CHK_BND[ci - 64];
        float ref;
        if (win_rowmap(c) >= 0) ref = wdot((const bf16*)(ws + WS_XB) + (size_t)t * D, D, a.in[2] + c, INW, lane);
        else { float s = 0.f; for (int k = lane; k < D; k += 64) s += fp8dec((ws + WS_XB8)[(size_t)t * D + k]) * f8r(a.in[2][(size_t)k * INW + c], F8_SWI); ref = wave_sum(s); }
        float got, r2 = ref, fl = 0.3f;
        if (c < 1024) got = bf2f(((const bf16*)(ws + WS_QDSA))[(size_t)t * 1024 + c]);
        else if (c < 1280) got = ((const float*)(ws + WS_CKVRAW))[(size_t)t * 256 + c - 1024];
        else if (c < 2304) got = bf2f(((const bf16*)(ws + WS_QIDX))[(size_t)t * 1024 + c - 1280]);
        else if (c < 2384) got = ((const float*)(ws + WS_KWRAW))[(size_t)t * 256 + c - 2304];
        else if (c < 3408) got = bf2f(((const bf16*)(ws + WS_QM))[(size_t)t * 1024 + c - 2384]);
        else if (c < 4432) got = bf2f(((const bf16*)(ws + WS_KM))[(size_t)t * 1024 + c - 3408]);
        else if (c < 5456) got = bf2f(((const bf16*)(ws + WS_VM))[(size_t)t * 1024 + c - 4432]);
        else if (c < 7504) { got = bf2f(((const bf16*)(ws + WS_GA))[(size_t)t * D + c - 5456]); r2 = 1.f / (1.f + expf(-(ref + a.in[3][c - 5456]))); }
        else { got = bf2f(((const bf16*)(ws + WS_GB))[(size_t)t * D + c - 7504]); r2 = 1.f / (1.f + expf(-(ref + a.in[3][D + c - 7504]))); }
        if (lane == 0) chk_report(F.ctl, 0, relerr(got, r2, fl));
    }
}
DI void chk_norms(const Frame& F, const Args& a) {
    const int gw = F.bx * NWAVES + F.wave, NGW = F.G * NWAVES, lane = F.lane; unsigned char* ws = F.ws;
    for (int sidx = gw; sidx < 8; sidx += NGW) {
        const int t = CHK_TS[sidx]; const float* cr = (const float*)(ws + WS_CKVRAW) + (size_t)t * 256; const float* kw = (const float*)(ws + WS_KWRAW) + (size_t)t * 256;
        float ss = 0.f; for (int c = 0; c < 256; ++c) ss += cr[c] * cr[c];
        const float r = 1.f / sqrtf(ss / 256.f + LN_EPS); float e = 0.f;
        for (int c = lane; c < 256; c += 64) e = fmaxf(e, relerr(fp8dec((ws + WS_CKVN)[(size_t)t * 256 + c]), cr[c] * r * a.in[4][c], 0.3f));
        float mu = 0.f; for (int c = 0; c < 64; ++c) mu += kw[c]; mu /= 64.f; float var = 0.f; for (int c = 0; c < 64; ++c) var += (kw[c] - mu) * (kw[c] - mu); var /= 64.f;
        e = fmaxf(e, relerr(bf2f(((const bf16*)(ws + WS_KIDXN))[(size_t)t * 64 + lane]), (kw[lane] - mu) / sqrtf(var + LN_EPS) * a.in[5][lane] + a.in[6][lane], 0.3f));
        if (lane < 16) e = fmaxf(e, relerr(((const float*)(ws + WS_WIDX))[(size_t)t * 16 + lane], kw[64 + lane], 0.01f));
        chk_report(F.ctl, 1, e);
    }
    for (int sidx = gw; sidx < 8 * 64; sidx += NGW) {
        const int t = CHK_TS[sidx >> 6], h = sidx & 7, c = (((sidx >> 3) & 7) * 37 + (sidx & 7) * 3) & 255;
        const float ref = wdot((const bf16*)(ws + WS_QDSA) + (size_t)t * 1024 + h * HD, HD, a.in[7] + (size_t)h * HD * CKV + c, CKV, lane);
        if (lane == 0) chk_report(F.ctl, 1, relerr(bf2f(((const bf16*)(ws + WS_QLAT))[(size_t)t * 2048 + h * 256 + c]), ref, 0.3f));
    }
    for (int sidx = gw; sidx < 64; sidx += NGW) {
        const int h = sidx & 7, b = ((sidx >> 3) * 9) & 63; float s0 = 0.f, s1 = 0.f;
        for (int k = 0; k < MBLK; ++k) { s0 += bf2f(((const bf16*)(ws + WS_KM))[(size_t)(b * MBLK + k) * 1024 + h * HD + lane]); s1 += bf2f(((const bf16*)(ws + WS_KM))[(size_t)(b * MBLK + k) * 1024 + h * HD + 64 + lane]); }
        const float* km = (const float*)(ws + WS_KMEAN) + (size_t)(h * NBLK + b) * HD;
        chk_report(F.ctl, 1, fmaxf(relerr(km[lane], s0 / 256.f, 0.02f), relerr(km[64 + lane], s1 / 256.f, 0.02f)));
    }
}
DI float chk_score(const unsigned char* ws, int t, int key) {
    const bf16* q = (const bf16*)(ws + WS_QIDX) + (size_t)t * 1024; const bf16* k = (const bf16*)(ws + WS_KIDXN) + (size_t)key * 64; const float* w = (const float*)(ws + WS_WIDX) + (size_t)t * 16;
    float s = 0.f;
    for (int h = 0; h < 16; ++h) { float d = 0.f; for (int i = 0; i < 64; ++i) d += bf2f(q[h * 64 + i]) * bf2f(k[i]); s += w[h] * fmaxf(d, 0.f); }
    return s;
}
DI void chk_topk(const Frame& F, int l) {
    const int gw = F.bx * NWAVES + F.wave, NGW = F.G * NWAVES, lane = F.lane; unsigned char* ws = F.ws;
    for (int sidx = gw; sidx < 8; sidx += NGW) {
        const int t = CHK_TS[sidx]; const unsigned short* sel = (const unsigned short*)(ws + WS_SEL) + (size_t)t * TOPK; const int nsel = t + 1 < TOPK ? t + 1 : TOPK;
        float bad = 0.f, mn = __builtin_inff();
        for (int i = lane; i < TOPK; i += 64) {
            const int k = sel[i];
            if (i < nsel) { if (k > t) bad += 1.f; else mn = fminf(mn, chk_score(ws, t, k)); if (i + 1 < nsel && sel[i + 1] <= k) bad += 1.f; }
            else if (k != 0xFFFF) bad += 1.f;
        }
#pragma unroll
        for (int o = 1; o < 64; o <<= 1) mn = fminf(mn, __shfl_xor(mn, o));
        float cnt = 0.f; for (int k = lane; k <= t; k += 64) if (chk_score(ws, t, k) > mn * (mn > 0.f ? 1.00001f : 0.99999f) + 1e-6f) cnt += 1.f;
        cnt = wave_sum(cnt); bad = wave_sum(bad);
        const float extra = cnt - (float)(nsel - 1); chk_report(F.ctl, 2, (bad + (extra > 0.f ? extra : 0.f)) / 16.f);
    }
    for (int sidx = gw; sidx < 64; sidx += NGW) {
        const int t = CHK_TS[sidx >> 3], h = sidx & 7, own = t >> 8; const bf16* q = (const bf16*)(ws + WS_QM) + (size_t)t * 1024 + h * HD;
        float g = -__builtin_inff();
        if (lane < own) { g = 0.f; const float* km = (const float*)(ws + WS_KMEAN) + (size_t)(h * NBLK + lane) * HD; for (int d = 0; d < HD; ++d) g += bf2f(q[d]) * km[d]; }
        float bad = 0.f; const int nsel = own < 3 ? own : 3; float gg = g;
        for (int j = 0; j < nsel; ++j) {
            float mx = gg; int mi = lane;
#pragma unroll
            for (int o = 1; o < 64; o <<= 1) { const float ov = __shfl_xor(mx, o); const int oi = __shfl_xor(mi, o); if (ov > mx || (ov == mx && oi < mi)) { mx = ov; mi = oi; } }
            float g2 = (lane == mi) ? -__builtin_inff() : gg;
#pragma unroll
            for (int o = 1; o < 64; o <<= 1) g2 = fmaxf(g2, __shfl_xor(g2, o));
            const bool neartie = (mx - g2) < 1e-4f * (fabsf(mx) + 1e-3f);
            const unsigned n = ((const unsigned*)(F.ctl + CW_BCNT))[l * 512 + h * 64 + mi]; const unsigned* bk = (const unsigned*)(ws + WS_BUCK) + (size_t)h * BUCK_PER_HEAD + bucket_off(mi);
            float found = 0.f; for (unsigned i = lane; i < n; i += 64) if (bk[i] == (((unsigned)t << 2) | (unsigned)j)) found = 1.f;
            if (wave_sum(found) != 1.f && !neartie) bad += 1.f;
            if (lane == mi) gg = -__builtin_inff();
        }
        chk_report(F.ctl, 3, bad);
    }
}
DI void chk_attn(const Frame& F, const Args& a) {
    const int gw = F.bx * NWAVES + F.wave, NGW = F.G * NWAVES, lane = F.lane; unsigned char* ws = F.ws;
    for (int sidx = gw; sidx < 64; sidx += NGW) {
        const int t = CHK_TS[sidx >> 3], h = sidx & 7; const float slope = exp2f(-(float)(h + 1));
        {
            const unsigned short* sel = (const unsigned short*)(ws + WS_SEL) + (size_t)t * TOPK; const int nsel = t + 1 < TOPK ? t + 1 : TOPK;
            const bf16* q = (const bf16*)(ws + WS_QLAT) + (size_t)t * 2048 + h * 256; const unsigned char* ck = ws + WS_CKVN;
            float sc[4]; float mx = -__builtin_inff();
#pragma unroll
            for (int j = 0; j < 4; ++j) { const int i = lane + 64 * j; sc[j] = -__builtin_inff();
                if (i < nsel) { const int k = sel[i]; float d = 0.f; for (int c = 0; c < 256; ++c) d += bf2f(q[c]) * fp8dec(ck[(size_t)k * 256 + c]); sc[j] = d * 0.08838834764831845f - slope * (float)(t - k); }
                mx = fmaxf(mx, sc[j]); }
#pragma unroll
            for (int o = 1; o < 64; o <<= 1) mx = fmaxf(mx, __shfl_xor(mx, o));
            float p[4], ps = 0.f;
#pragma unroll
            for (int j = 0; j < 4; ++j) { p[j] = expf(sc[j] - mx); ps += p[j]; } ps = wave_sum(ps);
            float o4[4] = {0.f, 0.f, 0.f, 0.f};
#pragma unroll
            for (int j = 0; j < 4; ++j) for (int src = 0; src < 64; ++src) { const float pp = __shfl(p[j], src); const int i = src + 64 * j; if (i < nsel) { const int k = sel[i];
                _Pragma("unroll") for (int e = 0; e < 4; ++e) o4[e] += pp * fp8dec(ck[(size_t)k * 256 + lane * 4 + e]); } }
            float er = 0.f;
#pragma unroll
            for (int e = 0; e < 4; ++e) er = fmaxf(er, relerr(bf2f(((const bf16*)(ws + WS_OLAT))[(size_t)t * 2048 + h * 256 + lane * 4 + e]), o4[e] / ps, 0.05f));
            chk_report(F.ctl, 4, er);
        }
        {
            const int own = t >> 8; const bf16* q = (const bf16*)(ws + WS_QM) + (size_t)t * 1024 + h * HD; const bf16* kk = (const bf16*)(ws + WS_KM); const bf16* vv = (const bf16*)(ws + WS_VM);
            float g = -__builtin_inff();
            if (lane < own) { g = 0.f; const float* km = (const float*)(ws + WS_KMEAN) + (size_t)(h * NBLK + lane) * HD; for (int d = 0; d < HD; ++d) g += bf2f(q[d]) * km[d]; }
            int blks[4] = {-1, -1, -1, own}; const int nsel = own < 3 ? own : 3; float gg = g;
#pragma unroll
            for (int j = 0; j < 3; ++j) { if (j < nsel) { float mx = gg; int mi = lane;
#pragma unroll
                for (int o = 1; o < 64; o <<= 1) { const float ov = __shfl_xor(mx, o); const int oi = __shfl_xor(mi, o); if (ov > mx || (ov == mx && oi < mi)) { mx = ov; mi = oi; } }
                blks[j] = mi; if (lane == mi) gg = -__builtin_inff(); } }
            float M = -__builtin_inff();
#pragma unroll
            for (int bi = 0; bi < 4; ++bi) { if (blks[bi] >= 0) for (int k0 = lane; k0 < MBLK; k0 += 64) { const int kp = blks[bi] * MBLK + k0; if (kp <= t) { float d = 0.f; for (int e = 0; e < HD; ++e) d += bf2f(q[e]) * bf2f(kk[(size_t)kp * 1024 + h * HD + e]);
                M = fmaxf(M, d * 0.08838834764831845f - slope * (float)(t - kp)); } } }
#pragma unroll
            for (int o = 1; o < 64; o <<= 1) M = fmaxf(M, __shfl_xor(M, o));
            float ps = 0.f, o0 = 0.f, o1 = 0.f;
#pragma unroll
            for (int bi = 0; bi < 4; ++bi) { if (blks[bi] >= 0) for (int kb = 0; kb < MBLK; kb += 64) { const int kp = blks[bi] * MBLK + kb + lane; float p = 0.f;
                if (kp <= t) { float d = 0.f; for (int e = 0; e < HD; ++e) d += bf2f(q[e]) * bf2f(kk[(size_t)kp * 1024 + h * HD + e]); p = expf(d * 0.08838834764831845f - slope * (float)(t - kp) - M); }
                ps += p;
                for (int src = 0; src < 64; ++src) { const float pp = __shfl(p, src); const int kq = blks[bi] * MBLK + kb + src; if (kq <= t) { o0 += pp * bf2f(vv[(size_t)kq * 1024 + h * HD + 2 * lane]); o1 += pp * bf2f(vv[(size_t)kq * 1024 + h * HD + 2 * lane + 1]); } } } }
            ps = wave_sum(ps);
            const unsigned char* ob = ws + WS_OB + (size_t)t * 1024 + h * HD;
            chk_report(F.ctl, 5, fmaxf(relerr(fp8dec(ob[2 * lane]) / F8_SOB, o0 / ps, 0.1f), relerr(fp8dec(ob[2 * lane + 1]) / F8_SOB, o1 / ps, 0.1f)));
        }
        {
            float r0 = 0.f, r1 = 0.f; const bf16* ol = (const bf16*)(ws + WS_OLAT) + (size_t)t * 2048 + h * 256; const float* wu = a.in[8] + (size_t)h * CKV * HD;
            for (int c = 0; c < 256; ++c) { r0 += bf2f(ol[c]) * bfr(wu[c * HD + lane]); r1 += bf2f(ol[c]) * bfr(wu[c * HD + 64 + lane]); }
            const unsigned char* oa = ws + WS_OA + (size_t)t * 1024 + h * HD;
            chk_report(F.ctl, 6, fmaxf(relerr(fp8dec(oa[lane]) / F8_SOA, r0, 0.05f), relerr(fp8dec(oa[64 + lane]) / F8_SOA, r1, 0.05f)));
        }
    }
}
DI void chk_dense(const Frame& F, int word, const bf16* act, int lda, int K, const float* W, int N, const bf16* out, int ldo, float fl) {
    const int gw = F.bx * NWAVES + F.wave, NGW = F.G * NWAVES, lane = F.lane;
    for (int sidx = gw; sidx < 8 * 24; sidx += NGW) { const int t = CHK_TS[sidx / 24], n = ((sidx % 24) * 211 + 5) % N;
        const float ref = wdot(act + (size_t)t * lda, K, W + n, N, lane);
        if (lane == 0) chk_report(F.ctl, word, relerr(bf2f(out[(size_t)t * ldo + n]), ref, fl)); }
}
DI float wdot8r(const unsigned char* a8, int K, const float* W, size_t ldw, float wscale, int lane) {
    float s = 0.f; for (int k = lane; k < K; k += 64) s += fp8dec(a8[k]) * f8r(W[(size_t)k * ldw], wscale); return wave_sum(s);
}
DI void chk_merged(const Frame& F, const Args& a) {
    const int gw = F.bx * NWAVES + F.wave, NGW = F.G * NWAVES, lane = F.lane; unsigned char* ws = F.ws;
    for (int sidx = gw; sidx < 8 * 24; sidx += NGW) { const int t = CHK_TS[sidx / 24], n = ((sidx % 24) * 211 + 5) % D;
        const float pa = wdot8r(ws + WS_OA + (size_t)t * 1024, 1024, a.in[9] + n, D, F8_SWO, lane) / F8_SOA, pb = wdot8r(ws + WS_OB + (size_t)t * 1024, 1024, a.in[10] + n, D, F8_SWO, lane) / F8_SOB;
        const float ref = bf2f(((const bf16*)(ws + WS_GA))[(size_t)t * D + n]) * pa + bf2f(((const bf16*)(ws + WS_GB))[(size_t)t * D + n]) * pb;
        if (lane == 0) chk_report(F.ctl, 6, relerr(fp8dec((ws + WS_MERGED)[(size_t)t * D + n]) / F8_SMG, ref, 0.02f)); }
}
DI void chk_dense8(const Frame& F, int word, const unsigned char* act8, int lda, int K, float ascale, const float* W, int N, float wscale, const bf16* out, int ldo, float fl) {
    const int gw = F.bx * NWAVES + F.wave, NGW = F.G * NWAVES, lane = F.lane;
    for (int sidx = gw; sidx < 8 * 24; sidx += NGW) { const int t = CHK_TS[sidx / 24], n = ((sidx % 24) * 211 + 5) % N;
        const float ref = wdot8r(act8 + (size_t)t * lda, K, W + n, N, wscale, lane) / ascale;
        if (lane == 0) chk_report(F.ctl, word, relerr(bf2f(out[(size_t)t * ldo + n]), ref, fl)); }
}
DI void chk_ln1(const Frame& F, const Args& a) {
    const int gw = F.bx * NWAVES + F.wave, NGW = F.G * NWAVES, lane = F.lane; unsigned char* ws = F.ws;
    for (int sidx = gw; sidx < 8; sidx += NGW) { const int t = CHK_TS[sidx]; const float* x = a.in[0] + (size_t)t * D; const bf16* y = (const bf16*)(ws + WS_Y) + (size_t)t * D;
        float s = 0.f; for (int c = lane; c < D; c += 64) s += ALPHA * x[c] + bf2f(y[c]); const float mu = wave_sum(s) / D;
        float q = 0.f; for (int c = lane; c < D; c += 64) { const float d = ALPHA * x[c] + bf2f(y[c]) - mu; q += d * d; } const float rs = 1.f / sqrtf(wave_sum(q) / D + LN_EPS);
        float e = 0.f; for (int c = lane; c < D; c += 64) { const float ref = (ALPHA * x[c] + bf2f(y[c]) - mu) * rs * a.in[17][c] + a.in[18][c];
            e = fmaxf(e, relerr(a.out[(size_t)t * D + c], ref, 0.5f) * 20.f); e = fmaxf(e, relerr(fp8dec((ws + WS_XB)[(size_t)t * D + c]), ref, 0.5f)); }
        chk_report(F.ctl, 7, e); }
}
DI void chk_memattn(const Frame& F, int l) {
    const int gw = F.bx * NWAVES + F.wave, NGW = F.G * NWAVES, lane = F.lane; unsigned char* ws = F.ws;
    for (int sidx = gw; sidx < 32; sidx += NGW) { const int t = CHK_TS[sidx >> 2], h = sidx & 3; const bf16* q = (const bf16*)(ws + WS_QMEM) + (size_t)t * 512 + h * HD; const bf16* kv = (const bf16*)(ws + WS_KVMEM) + (size_t)l * 1024;
        float sc[4], mx = -__builtin_inff();
#pragma unroll
        for (int j = 0; j < 4; ++j) { const int m = lane + 64 * j; float d = 0.f; for (int e = 0; e < HD; ++e) d += bf2f(q[e]) * bf2f(kv[(size_t)m * 4096 + h * HD + e]); sc[j] = d * 0.08838834764831845f; mx = fmaxf(mx, sc[j]); }
#pragma unroll
        for (int o = 1; o < 64; o <<= 1) mx = fmaxf(mx, __shfl_xor(mx, o));
        float ps = 0.f, o0 = 0.f, o1 = 0.f;
#pragma unroll
        for (int j = 0; j < 4; ++j) { const float p = expf(sc[j] - mx); ps += p; for (int src = 0; src < 64; ++src) { const float pp = __shfl(p, src); const int m = src + 64 * j;
            o0 += pp * bf2f(kv[(size_t)m * 4096 + 512 + h * HD + 2 * lane]); o1 += pp * bf2f(kv[(size_t)m * 4096 + 512 + h * HD + 2 * lane + 1]); } }
        ps = wave_sum(ps); const unsigned char* om = ws + WS_OMEM + (size_t)t * 512 + h * HD;
        chk_report(F.ctl, 9, fmaxf(relerr(fp8dec(om[2 * lane]) / F8_SOM, o0 / ps, 0.05f), relerr(fp8dec(om[2 * lane + 1]) / F8_SOM, o1 / ps, 0.05f))); }
}
DI void chk_kvmem(const Frame& F, const Args& a) {
    const int gw = F.bx * NWAVES + F.wave, NGW = F.G * NWAVES, lane = F.lane; unsigned char* ws = F.ws;
    for (int sidx = gw; sidx < 4 * 48; sidx += NGW) { const int ll = sidx / 48, m = ((sidx % 48) * 37) & 255, n = ((sidx % 48) * 211 + 3) & 1023;
        const float ref = wdot((const bf16*)(ws + WS_MEMB) + (size_t)m * D, D, a.in[13] + (size_t)ll * D * 1024 + n, 1024, lane);
        if (lane == 0) chk_report(F.ctl, 8, relerr(bf2f(((const bf16*)(ws + WS_KVMEM))[(size_t)m * 4096 + ll * 1024 + n]), ref, 0.3f)); }
}
DI float wdot8(const unsigned char* a8, int K, const float* W, size_t ldw, int lane) {
    float s = 0.f; for (int k = lane; k < K; k += 64) s += fp8dec(a8[k]) * W[(size_t)k * ldw]; return wave_sum(s);
}
DI void chk_swiglu(const Frame& F, const Args& a) {
    const int gw = F.bx * NWAVES + F.wave, NGW = F.G * NWAVES, lane = F.lane; unsigned char* ws = F.ws;
    for (int sidx = gw; sidx < 8 * 24; sidx += NGW) { const int t = CHK_TS[sidx / 24], j = ((sidx % 24) * 509 + 11) % DFF;
        const float g = wdot8(ws + WS_XB + (size_t)t * D, D, a.in[15] + j, 2 * DFF, lane), u = wdot8(ws + WS_XB + (size_t)t * D, D, a.in[15] + DFF + j, 2 * DFF, lane);
        if (lane == 0) chk_report(F.ctl, 11, relerr(fp8dec((ws + WS_H)[(size_t)t * DFF + j]) * (1.0f / F8_SH), g / (1.f + expf(-g)) * u, 0.05f)); }
}
DI void chk_ffn2(const Frame& F, const Args& a) {
    const int gw = F.bx * NWAVES + F.wave, NGW = F.G * NWAVES, lane = F.lane; unsigned char* ws = F.ws;
    for (int sidx = gw; sidx < 8 * 24; sidx += NGW) { const int t = CHK_TS[sidx / 24], n = ((sidx % 24) * 211 + 5) % D;
        const float ref = wdot8(ws + WS_H + (size_t)t * DFF, DFF, a.in[16] + n, D, lane) * (1.0f / F8_SH);
        if (lane == 0) chk_report(F.ctl, 12, relerr(bf2f(((const bf16*)(ws + WS_Y))[(size_t)t * D + n]), ref, 0.01f)); }
}
DI void chk_encode(const Frame& F, const Args& a) {
    float B = 0.f, wgt = 0.5f;
    for (int i = 0; i < 32; ++i) if ((SELFCHECK_MASK >> i) & 1u) { const float e = __uint_as_float(__hip_atomic_load((unsigned*)(F.ctl + CW_ERR + i), RLX_AGENT)); if (e > SELFCHECK_TOL) B += wgt; wgt *= 0.5f; }
    const float sc = 1.f - 0.5f * B;
    f32x4* o = (f32x4*)a.out; const int gt = F.bx * NTHREADS + F.tid, ngt = F.G * NTHREADS;
    for (int i = gt; i < S * D / 4; i += ngt) o[i] = o[i] * sc;
}
#endif

constexpr int NPH = 17;
__global__ void __launch_bounds__(NTHREADS, 2) fwd_kernel(Args args) {
    extern __shared__ __attribute__((aligned(16))) unsigned char lds_raw[];
    LAS unsigned char* const lds = (LAS unsigned char*)lds_raw;
    volatile LAS unsigned* MISC = (volatile LAS unsigned*)(lds + MISC_OFF);
    if (threadIdx.x < 32) MISC[threadIdx.x] = 0u;
    __syncthreads();
#if MK_ONE_LAUNCH
    constexpr int lo = 0, hi = DEPTH * NPH;
#else
    const int lo = args.ph_lo, hi = args.ph_hi;
#endif
    XcdBarrier bar; bar.bar = (unsigned*)(args.ws + WS_CTL) + CW_BAR; bar.x = 0; bar.st = nullptr; bar.w0 = __builtin_amdgcn_readfirstlane((int)threadIdx.x >> 6);
    if (hi - lo > 1) bar = xcd_barrier_post((unsigned*)(args.ws + WS_CTL) + CW_BAR, MISC + 8);
#ifdef ONLY_PH
#define IN(k) (((k) - p0) == ONLY_PH && lo <= (k) && (k) < hi)
#else
#define IN(k) (lo <= (k) && (k) < hi)
#endif
#define SEAM(k) do { if (lo <= (k) && (k) + 1 < hi) { XcdBarrier b2_ = bar; asm volatile("" : "+s"(b2_.bar), "+s"(b2_.x)); xcd_barrier(b2_); } } while (0)
#ifdef REPEAT_MASK
#define NREP(bit) ((((unsigned long long)REPEAT_MASK >> (bit)) & 1ull) ? 2 : 1)
#else
#define NREP(bit) 1
#endif
#define FRAME() const Frame F = make_frame(args.ws, lds, bar.w0); unsigned char* const ws = F.ws; (void)ws; int lq = l; asm volatile("" : "+s"(lq)); (void)lq
    for (int l = 0; l < DEPTH; ++l) {
        const int p0 = l * NPH;
        if (IN(p0 + 0)) { FRAME(); for (int rep = 0; rep < NREP(0); ++rep) conv_phase(F, args, lq); } SEAM(p0 + 0);
        if (IN(p0 + 1)) {
#ifndef SKIP_A
            if (l == 0) { FRAME(); pg8::Gemm g{(const bf16*)(ws + WS_MEMB), (const bf16*)(ws + WS_WKV), D, D, D, 1, 16, 0, 0}; pg8::StaticOrder So; So.init(1, 16, F.G, F.G - 1 - F.bx);
                pg8::EpiBf16 E{(bf16*)(ws + WS_KVMEM), 4096}; pg8::gemm_phase(lds, g, So, E, F.tid); }
#endif
#ifndef SKIP_B
            { FRAME(); pg8::Gemm g{(const bf16*)(ws + WS_XB8), (const bf16*)(ws + WS_WIN8), D / 2, D / 2, D / 2, S / 256, IN8 / 256, 0, 0}; pg8::StaticOrder So; So.init(S / 256, IN8 / 256, F.G, F.bx, 1);
            pg8::EpiIn8 E{(bf16*)(ws + WS_QDSA), (bf16*)(ws + WS_VM), (bf16*)(ws + WS_GA), (bf16*)(ws + WS_GB), (float*)(ws + WS_CKVRAW), args.in[3] + (size_t)lq * 2 * D};
            for (int rep = 0; rep < NREP(1); ++rep) pg8::gemm_phase<pg8::EpiIn8, true>(lds, g, So, E, F.tid); }
            { FRAME(); pg8::Gemm g{(const bf16*)(ws + WS_XB), (const bf16*)(ws + WS_WIN), D, D, D, S / 256, INB / 256, 0, 0}; pg8::StaticOrder So; So.init(S / 256, INB / 256, F.G, F.bx, 2);
            pg8::EpiInBf E{(bf16*)(ws + WS_QIDX), (bf16*)(ws + WS_QM), (bf16*)(ws + WS_KM), (float*)(ws + WS_KWRAW)};
            for (int rep = 0; rep < NREP(1); ++rep) pg8::gemm_phase(lds, g, So, E, F.tid); }
#endif
        } SEAM(p0 + 1);
        if (IN(p0 + 2)) {
#ifdef SELFCHECK
            if (l == 0 && CHK_ON(0)) { FRAME(); chk_inproj(F, args); }
#endif
#ifndef SKIP_A
            { FRAME(); for (int rep = 0; rep < NREP(2); ++rep) norm_phase(F, args, lq); }
#endif
#ifndef SKIP_B
            { FRAME(); pg8::Gemm g{(const bf16*)(ws + WS_QDSA), (const bf16*)(ws + WS_WUK), 1024, 256, 256, S / 256, 8, 1, 256}; pg8::StaticOrder So; So.init(S / 256, 8, F.G, F.bx);
            pg8::EpiBf16 E{(bf16*)(ws + WS_QLAT), 2048}; for (int rep = 0; rep < NREP(3); ++rep) pg8::gemm_phase(lds, g, So, E, F.tid); }
#endif
        } SEAM(p0 + 2);
        if (IN(p0 + 3)) {
#ifdef SELFCHECK
            if (l == 0) { FRAME(); if (CHK_ON(1)) chk_norms(F, args); if (CHK_ON(8)) chk_kvmem(F, args); }
#endif
#ifndef SKIP_A
            { FRAME(); moba_gate_phase(F, lq); }
#endif
#ifndef SKIP_B
            { FRAME(); for (int rep = 0; rep < NREP(5); ++rep) indexer_phase(F); }
#endif
        } SEAM(p0 + 3);
        if (IN(p0 + 4)) {
#ifdef SELFCHECK
            if (l == 0 && (CHK_ON(2) || CHK_ON(3))) { FRAME(); chk_topk(F, lq); }
#endif
#ifndef SKIP_A
            { FRAME(); for (int rep = 0; rep < NREP(6); ++rep) moba_attn_phase(F, lq); }
#endif
#ifndef SKIP_B
            { FRAME(); for (int rep = 0; rep < NREP(7); ++rep) dsa_attn_phase(F); }
#endif
        } SEAM(p0 + 4);
        if (IN(p0 + 5)) {
            { FRAME(); for (int rep = 0; rep < NREP(8); ++rep) moba_combine_phase(F); }
            { FRAME(); pg8::Gemm g{(const bf16*)(ws + WS_OLAT), (const bf16*)(ws + WS_WUV), 2048, 512, 512, S / 256, 4, 0, 512}; pg8::StaticOrder So; So.init(S / 256, 4, F.G, F.bx);
            pg8::EpiF8 E{ws + WS_OA, 1024, F8_SOA}; for (int rep = 0; rep < NREP(9); ++rep) pg8::gemm_phase(lds, g, So, E, F.tid); }
        } SEAM(p0 + 5);
#ifdef SELFCHECK
        if (l == 0 && IN(p0 + 6) && (CHK_ON(4) || CHK_ON(5) || CHK_ON(6))) { FRAME(); chk_attn(F, args); }
#endif
        if (IN(p0 + 6)) { FRAME(); pg8::Gemm g{(const bf16*)(ws + WS_OA), (const bf16*)(ws + WS_WOA), 512, 512, 512, S / 256, 8, 0, 0}; pg8::StaticOrder So; So.init(S / 256, 8, F.G, F.bx);
            pg8::EpiGate E{(bf16*)(ws + WS_T1), (const bf16*)(ws + WS_GA), nullptr, nullptr, 1.0f / (F8_SOA * F8_SWO), 0.f}; for (int rep = 0; rep < NREP(10); ++rep) pg8::gemm_phase<pg8::EpiGate, true>(lds, g, So, E, F.tid); } SEAM(p0 + 6);
        if (IN(p0 + 7)) { FRAME(); pg8::Gemm g{(const bf16*)(ws + WS_OB), (const bf16*)(ws + WS_WOB), 512, 512, 512, S / 256, 8, 0, 0}; pg8::StaticOrder So; So.init(S / 256, 8, F.G, F.bx);
            pg8::EpiGate E{nullptr, (const bf16*)(ws + WS_GB), (const bf16*)(ws + WS_T1), ws + WS_MERGED, 1.0f / (F8_SOB * F8_SWO), F8_SMG}; for (int rep = 0; rep < NREP(11); ++rep) pg8::gemm_phase<pg8::EpiGate, true>(lds, g, So, E, F.tid); } SEAM(p0 + 7);
#ifdef SELFCHECK
        if (l == 0 && IN(p0 + 8) && CHK_ON(6)) { FRAME(); chk_merged(F, args); }
#endif
#if (LN_FUSED & 1)
        if (IN(p0 + 8)) { FRAME(); pg8::Gemm g{(const bf16*)(ws + WS_MERGED), (const bf16*)(ws + WS_WOUT), D / 2, D / 2, D / 2, S / 256, 8, 0, 0}; pg8::FusedOrder So{F.bx};
            pg8::EpiLn E{args.out, args.in[17] + (size_t)(lq * 3 + 0) * D, args.in[18] + (size_t)(lq * 3 + 0) * D, 1.0f / (F8_SMG * F8_SWOUT), nullptr, ws + WS_XB, (unsigned long long*)(ws + WS_LNX), (unsigned*)(F.ctl + CW_LNCNT) + (lq * 3 + 0) * 64 * 64};
            pg8::gemm_phase<pg8::EpiLn, true, pg8::FusedOrder, true>(lds, g, So, E, F.tid); } SEAM(p0 + 8);
#else
        if (IN(p0 + 8)) { FRAME(); pg8::Gemm g{(const bf16*)(ws + WS_MERGED), (const bf16*)(ws + WS_WOUT), D / 2, D / 2, D / 2, S / 256, 8, 0, 0}; pg8::StaticOrder So; So.init(S / 256, 8, F.G, F.bx);
            pg8::EpiBf16S E{(bf16*)(ws + WS_Y), D, 1.0f / (F8_SMG * F8_SWOUT)}; for (int rep = 0; rep < NREP(12); ++rep) pg8::gemm_phase<pg8::EpiBf16S, true>(lds, g, So, E, F.tid); } SEAM(p0 + 8);
        if (IN(p0 + 9)) { FRAME(); ln_phase(F, args, l, 0); } SEAM(p0 + 9);
#endif
#ifdef SELFCHECK
        if (l == 0 && IN(p0 + 10) && CHK_ON(7)) { FRAME(); chk_ln1(F, args); }
#endif
        if (IN(p0 + 10)) { FRAME(); pg8::Gemm g{(const bf16*)(ws + WS_XB), (const bf16*)(ws + WS_WQM), D / 2, D / 2, D / 2, S / 256, 2, 0, 0}; pg8::StaticOrder So; So.init(S / 256, 2, F.G, F.bx);
            pg8::EpiBf16S E{(bf16*)(ws + WS_QMEM), 512, 1.0f / F8_SWQM}; for (int rep = 0; rep < NREP(14); ++rep) pg8::gemm_phase<pg8::EpiBf16S, true>(lds, g, So, E, F.tid); } SEAM(p0 + 10);
#ifdef SELFCHECK
        if (l == 0 && IN(p0 + 11) && CHK_ON(8)) { FRAME(); chk_dense8(F, 8, ws + WS_XB, D, D, 1.f, args.in[12], 512, F8_SWQM, (const bf16*)(ws + WS_QMEM), 512, 0.3f); }
#endif
        if (IN(p0 + 11)) { FRAME(); for (int rep = 0; rep < NREP(15); ++rep) mem_attn_phase(F, lq); } SEAM(p0 + 11);
#ifdef SELFCHECK
        if (l == 0 && IN(p0 + 12) && CHK_ON(9)) { FRAME(); chk_memattn(F, lq); }
#endif
#if (LN_FUSED & 2)
        if (IN(p0 + 12)) { FRAME(); pg8::Gemm g{(const bf16*)(ws + WS_OMEM), (const bf16*)(ws + WS_WOM), 256, 256, 256, S / 256, 8, 0, 0}; pg8::FusedOrder So{F.bx};
            pg8::EpiLn E{args.out, args.in[17] + (size_t)(lq * 3 + 1) * D, args.in[18] + (size_t)(lq * 3 + 1) * D, 1.0f / (F8_SOM * F8_SWOM), nullptr, ws + WS_XB, (unsigned long long*)(ws + WS_LNX), (unsigned*)(F.ctl + CW_LNCNT) + (lq * 3 + 1) * 64 * 64};
            pg8::gemm_phase<pg8::EpiLn, true, pg8::FusedOrder, true>(lds, g, So, E, F.tid); } SEAM(p0 + 12);
#else
        if (IN(p0 + 12)) { FRAME(); pg8::Gemm g{(const bf16*)(ws + WS_OMEM), (const bf16*)(ws + WS_WOM), 256, 256, 256, S / 256, 8, 0, 0}; pg8::StaticOrder So; So.init(S / 256, 8, F.G, F.bx);
            pg8::EpiBf16S E{(bf16*)(ws + WS_Y), D, 1.0f / (F8_SOM * F8_SWOM)}; for (int rep = 0; rep < NREP(16); ++rep) pg8::gemm_phase<pg8::EpiBf16S, true>(lds, g, So, E, F.tid); } SEAM(p0 + 12);
        if (IN(p0 + 13)) { FRAME(); ln_phase(F, args, l, 1); } SEAM(p0 + 13);
#endif
        if (IN(p0 + 14)) { FRAME(); pg8::Gemm g{(const bf16*)(ws + WS_XB), (const bf16*)(ws + WS_WF1), D / 2, D / 2, D / 2, S / 256, 2 * DFF / 256, 0, 0}; pg8::StaticOrder So; So.init(S / 256, 2 * DFF / 256, F.G, F.bx);
            pg8::EpiSwiglu8 E{ws + WS_H}; for (int rep = 0; rep < NREP(18); ++rep) pg8::gemm_phase<pg8::EpiSwiglu8, true>(lds, g, So, E, F.tid); } SEAM(p0 + 14);
#ifdef SELFCHECK
        if (l == 0 && IN(p0 + 15) && CHK_ON(11)) { FRAME(); chk_swiglu(F, args); }
#endif
#if (LN_FUSED & 4)
        if (IN(p0 + 15)) { FRAME(); pg8::Gemm g{(const bf16*)(ws + WS_H), (const bf16*)(ws + WS_WF2), DFF / 2, DFF / 2, DFF / 2, S / 256, 8, 0, 0}; pg8::FusedOrder So{F.bx};
            pg8::EpiLn E{args.out, args.in[17] + (size_t)(lq * 3 + 2) * D, args.in[18] + (size_t)(lq * 3 + 2) * D, 1.0f / (F8_SH * F8_SW2), (bf16*)(ws + WS_XB), ws + WS_XB8, (unsigned long long*)(ws + WS_LNX), (unsigned*)(F.ctl + CW_LNCNT) + (lq * 3 + 2) * 64 * 64};
            pg8::gemm_phase<pg8::EpiLn, true, pg8::FusedOrder, true>(lds, g, So, E, F.tid); } SEAM(p0 + 15);
#else
        if (IN(p0 + 15)) { FRAME(); pg8::Gemm g{(const bf16*)(ws + WS_H), (const bf16*)(ws + WS_WF2), DFF / 2, DFF / 2, DFF / 2, S / 256, 8, 0, 0}; pg8::StaticOrder So; So.init(S / 256, 8, F.G, F.bx);
            pg8::EpiBf16S E{(bf16*)(ws + WS_Y), D, 1.0f / (F8_SH * F8_SW2)}; for (int rep = 0; rep < NREP(19); ++rep) pg8::gemm_phase<pg8::EpiBf16S, true>(lds, g, So, E, F.tid); } SEAM(p0 + 15);
        if (IN(p0 + 16)) { FRAME(); ln_phase(F, args, l, 2); } SEAM(p0 + 16);
#endif
    }
#ifdef SELFCHECK
    { xcd_barrier(bar); const int l = 0; FRAME(); chk_encode(F, args); }
#endif
#undef IN
#undef SEAM
#undef FRAME
}

extern "C" void kernel_launch(void* const* d_in, const int* in_sizes, int n_in, void* d_out, int out_size, void* d_ws, size_t ws_size, hipStream_t stream) {
    static int grid = 0;
    if (grid == 0) {
        if (n_in != 19 || out_size != S * D || ws_size < WS_END) { fprintf(stderr, "kernel_launch: unexpected shapes (n_in %d, out %d, ws %zu < %zu)\n", n_in, out_size, ws_size, (size_t)WS_END); grid = -1; return; }
        int dev = 0, cus = 0, per_cu = 0;
        if (hipGetDevice(&dev) != hipSuccess || hipDeviceGetAttribute(&cus, hipDeviceAttributeMultiprocessorCount, dev) != hipSuccess) { grid = -1; return; }
        if (hipFuncSetAttribute((const void*)fwd_kernel, hipFuncAttributeMaxDynamicSharedMemorySize, LDS_BYTES) != hipSuccess) { fprintf(stderr, "kernel_launch: hipFuncSetAttribute failed\n"); grid = -1; return; }
        if (hipOccupancyMaxActiveBlocksPerMultiprocessor(&per_cu, (const void*)fwd_kernel, NTHREADS, LDS_BYTES) != hipSuccess || per_cu < 1) fprintf(stderr, "kernel_launch: occupancy query says %d\n", per_cu);
        (void)hipGetLastError();
        grid = cus;
        if (grid != 256) { fprintf(stderr, "kernel_launch: %d CUs; this kernel is built for the 256-workgroup grid of an MI355X; nothing launched\n", grid); grid = -1; return; }
    }
    if (grid < 0) return;
    (void)in_sizes;
    if (hipMemsetAsync((char*)d_ws + WS_CTL, 0, CTL_ZERO_BYTES, stream) != hipSuccess) return;
    Args a{};
    for (int i = 0; i < 19; ++i) a.in[i] = (const float*)d_in[i];
    a.out = (float*)d_out; a.ws = (unsigned char*)d_ws;
#if MK_ONE_LAUNCH
    a.ph_lo = 0; a.ph_hi = DEPTH * NPH;
    hipLaunchKernelGGL(fwd_kernel, dim3(grid), dim3(NTHREADS), LDS_BYTES, stream, a);
#else
    for (int p = 0; p < DEPTH * NPH; ++p) { a.ph_lo = p; a.ph_hi = p + 1; hipLaunchKernelGGL(fwd_kernel, dim3(grid), dim3(NTHREADS), LDS_BYTES, stream, a); }
#endif
}
```

```cpp
#include <hip/hip_runtime.h>
#include <cstdio>
#include <cstdint>

#ifndef MK_ONE_LAUNCH
#define MK_ONE_LAUNCH 1
#endif
#ifndef LN_FUSED
#define LN_FUSED 7
#endif
#if LN_FUSED != 7
#error "the bf16 residual stream lives in the fused LayerNorm epilogues only"
#endif

#ifndef MOBA_QK_FP8
#define MOBA_QK_FP8 1
#endif
#define LAS __attribute__((address_space(3)))
#define GAS __attribute__((address_space(1)))
typedef unsigned short bf16;
typedef short bf16x8 __attribute__((ext_vector_type(8)));
typedef short s16x4 __attribute__((ext_vector_type(4)));
typedef short v4i16_t __attribute__((ext_vector_type(4)));
typedef float f32x2 __attribute__((ext_vector_type(2)));
typedef float f32x4 __attribute__((ext_vector_type(4)));
typedef float f32x16 __attribute__((ext_vector_type(16)));
typedef unsigned u32x2 __attribute__((ext_vector_type(2)));
typedef unsigned u32x4 __attribute__((ext_vector_type(4)));
typedef int v4i __attribute__((ext_vector_type(4)));
typedef int v8i __attribute__((ext_vector_type(8)));
typedef v8i v8i_a16 __attribute__((aligned(16)));
typedef GAS unsigned gu32;
#define RLX_AGENT __ATOMIC_RELAXED, __HIP_MEMORY_SCOPE_AGENT
#define DI __device__ __forceinline__

constexpr int S = 16384, D = 2048, DEPTH = 4, NH = 8, HD = 128, CKV = 256, IH = 16, IDIM = 64, TOPK = 256, MBLK = 256, NBLK = 64, NMEM = 256, NHM = 4, DFF = 5632;
constexpr int INW = 9552, INP = 9728;
constexpr float LN_EPS = 1e-5f;
constexpr float ALPHA = 1.681792830507429f;
constexpr float LOG2E = 1.4426950408889634f;
constexpr float ATT_SCALE2 = 0.08838834764831845f * LOG2E;
constexpr int NWAVES = 8, NTHREADS = 512;
constexpr float F8_SW1 = 64.f, F8_SW2 = 128.f, F8_SH = 16.f, F8_SWI = 32.f;
constexpr float F8_SWO = 64.f, F8_SWOUT = 64.f, F8_SWQM = 32.f, F8_SWOM = 32.f;
constexpr float F8_SGT = 256.f;
constexpr float F8_SOA = 16.f, F8_SOB = 8.f, F8_SMG = 64.f, F8_SOM = 32.f;
constexpr int INB = MOBA_QK_FP8 ? 1280 : 3328, IN8 = MOBA_QK_FP8 ? 8448 : 6400;

constexpr size_t MiB = 1u << 20;
constexpr size_t WS_CTL = 0, CTL_ZERO_BYTES = 512 * 1024;
constexpr size_t WS_WIN = 1 * MiB;
constexpr size_t WS_WUK = WS_WIN + 38 * MiB;
constexpr size_t WS_WUV = WS_WUK + 1 * MiB;
constexpr size_t WS_WOA = WS_WUV + 1 * MiB;
constexpr size_t WS_WOB = WS_WOA + 4 * MiB;
constexpr size_t WS_WOUT = WS_WOB + 4 * MiB;
constexpr size_t WS_WQM = WS_WOUT + 8 * MiB;
constexpr size_t WS_WOM = WS_WQM + 2 * MiB;
constexpr size_t WS_WF1 = WS_WOM + 2 * MiB;
constexpr size_t WS_WF2 = WS_WF1 + 44 * MiB;
constexpr size_t WS_WKV = WS_WF2 + 22 * MiB;
constexpr size_t WS_MEMB = WS_WKV + 16 * MiB;
constexpr size_t WS_KVMEM = WS_MEMB + 1 * MiB;
constexpr size_t WS_XB = WS_KVMEM + 2 * MiB;
constexpr size_t WS_QDSA = WS_XB + 64 * MiB;
constexpr size_t WS_QIDX = WS_QDSA + 32 * MiB;
constexpr size_t WS_QM = WS_QIDX + 32 * MiB;
constexpr size_t WS_KM = WS_QM + 32 * MiB;
constexpr size_t WS_VM = WS_KM + 32 * MiB;
constexpr size_t WS_GA = WS_VM + 32 * MiB;
constexpr size_t WS_GB = WS_GA + 64 * MiB;
constexpr size_t WS_CKVRAW = WS_GB + 64 * MiB;
constexpr size_t WS_KWRAW = WS_CKVRAW + 16 * MiB;
constexpr size_t WS_H = WS_QDSA;
constexpr size_t WS_CKVN = WS_KWRAW + 16 * MiB;
constexpr size_t WS_KIDXN = WS_CKVN + 8 * MiB;
constexpr size_t WS_WIDX = WS_KIDXN + 2 * MiB;
constexpr size_t WS_KMEAN = WS_WIDX + 1 * MiB;
constexpr size_t WS_QLAT = WS_KMEAN + 1 * MiB;
constexpr size_t WS_SEL = WS_QLAT + 64 * MiB;
constexpr size_t WS_OLAT = WS_SEL + 8 * MiB;
constexpr size_t WS_OA = WS_OLAT + 64 * MiB;
constexpr size_t WS_OB = WS_OA + 32 * MiB;
constexpr size_t WS_BUCK = WS_OB + 32 * MiB;
constexpr size_t WS_PARTO = WS_BUCK + 16 * MiB;
constexpr size_t WS_PARTML = WS_PARTO + 128 * MiB;
constexpr size_t WS_T1 = WS_PARTML + 4 * MiB;
constexpr size_t WS_MERGED = WS_T1 + 64 * MiB;
constexpr size_t WS_Y = WS_MERGED + 64 * MiB;
constexpr size_t WS_QMEM = WS_Y + 64 * MiB;
constexpr size_t WS_OMEM = WS_QMEM + 16 * MiB;
constexpr size_t WS_XB8 = WS_OMEM + 16 * MiB;
constexpr size_t WS_LNX = WS_XB8 + 32 * MiB;
constexpr size_t WS_END = WS_LNX + 1 * MiB;
constexpr size_t WS_WIN8 = WS_WIN + 16 * MiB;
static_assert(WS_H + (size_t)S * DFF * 2 <= WS_CKVN, "h overlay");
static_assert(WS_END <= 1408 * MiB, "workspace");
constexpr int CW_BAR = 4096;
constexpr int CW_BCNT = 16384;
constexpr int CW_LNCNT = 65536;
constexpr int BUCK_PER_HEAD = 256 * 2016;
DI int bucket_off(int b) { return 256 * (63 * b - (b * (b - 1)) / 2); }

constexpr int LDS_BYTES = 147456;
constexpr int RING_BYTES = 131072;
constexpr int MISC_OFF = 143360;
constexpr int LNT_OFF = RING_BYTES;

DI unsigned f2bf(float f) { unsigned u = __builtin_bit_cast(unsigned, f); return (u + 0x7fffu + ((u >> 16) & 1u)) >> 16; }
DI unsigned pk2(float lo, float hi) { return f2bf(lo) | (f2bf(hi) << 16); }
DI unsigned cvt_pk_bf16(float lo, float hi) { unsigned r; asm volatile("v_cvt_pk_bf16_f32 %0, %1, %2" : "=v"(r) : "v"(lo), "v"(hi)); return r; }
DI float clamp448(float x) { return __builtin_amdgcn_fmed3f(x, -448.f, 448.f); }
DI unsigned pk4_fp8(float a, float b, float c, float d) {
    int w = 0; w = __builtin_amdgcn_cvt_pk_fp8_f32(clamp448(a), clamp448(b), w, false); w = __builtin_amdgcn_cvt_pk_fp8_f32(clamp448(c), clamp448(d), w, true); return (unsigned)w; }
DI float bflo(unsigned u) { return __builtin_bit_cast(float, u << 16); }
DI float bfhi(unsigned u) { return __builtin_bit_cast(float, u & 0xffff0000u); }
DI int lane_id() { int l; asm volatile("v_mbcnt_lo_u32_b32 %0, -1, 0\n\tv_mbcnt_hi_u32_b32 %0, -1, %0" : "=v"(l)); return l; }
template <int CTRL> DI int dpp_i(int x) { return __builtin_amdgcn_mov_dpp(x, CTRL, 0xf, 0xf, true); }
template <int CTRL> DI float dpp_f(float x) { return __builtin_bit_cast(float, __builtin_amdgcn_mov_dpp(__builtin_bit_cast(int, x), CTRL, 0xf, 0xf, true)); }
DI float xrow16_sum(float x);
DI float wave_sum(float v) {
    v += dpp_f<0xB1>(v); v += dpp_f<0x4E>(v); v += dpp_f<0x141>(v); v += dpp_f<0x128>(v);
    return xrow16_sum(v);
}
DI unsigned wave_umax(unsigned v) {
    { const unsigned o = (unsigned)dpp_i<0xB1>((int)v); v = o > v ? o : v; } { const unsigned o = (unsigned)dpp_i<0x4E>((int)v); v = o > v ? o : v; }
    { const unsigned o = (unsigned)dpp_i<0x141>((int)v); v = o > v ? o : v; } { const unsigned o = (unsigned)dpp_i<0x128>((int)v); v = o > v ? o : v; }
    { const auto s = __builtin_amdgcn_permlane16_swap(v, v, false, false); v = s[0] > s[1] ? s[0] : s[1]; }
    { const auto s = __builtin_amdgcn_permlane32_swap(v, v, false, false); v = s[0] > s[1] ? s[0] : s[1]; }
    return v;
}
DI unsigned wave_umin(unsigned v) { return ~wave_umax(~v); }
DI float xrow16_max(float x) {
    auto s = __builtin_amdgcn_permlane16_swap(__float_as_uint(x), __float_as_uint(x), false, false);
    x = fmaxf(__uint_as_float(s[0]), __uint_as_float(s[1]));
    auto t = __builtin_amdgcn_permlane32_swap(__float_as_uint(x), __float_as_uint(x), false, false);
    return fmaxf(__uint_as_float(t[0]), __uint_as_float(t[1]));
}
DI float xrow16_sum(float x) {
    auto s = __builtin_amdgcn_permlane16_swap(__float_as_uint(x), __float_as_uint(x), false, false);
    x = __uint_as_float(s[0]) + __uint_as_float(s[1]);
    auto t = __builtin_amdgcn_permlane32_swap(__float_as_uint(x), __float_as_uint(x), false, false);
    return __uint_as_float(t[0]) + __uint_as_float(t[1]);
}
DI float fast_sigmoid(float x) { return __builtin_amdgcn_rcpf(1.0f + __builtin_amdgcn_exp2f(-x * LOG2E)); }
DI s16x4 vtr(unsigned lds_addr) { return __builtin_bit_cast(s16x4, __builtin_amdgcn_ds_read_tr16_b64_v4i16((LAS v4i16_t*)lds_addr)); }
DI unsigned off_b(unsigned row, unsigned ch) { return 256u * row + 16u * (ch ^ (((row & 3) << 2) | ((row >> 2) & 3))); }
DI unsigned tr_addr16(unsigned lane, unsigned c, unsigned ks, unsigned t) {
    const unsigned g = lane >> 4, q = (lane & 15) >> 2, p = lane & 3;
    return off_b(32 * ks + 8 * g + 4 * t + q, 2 * c + (p >> 1)) + 8 * (p & 1);
}
DI unsigned perm32rows(unsigned k) { return (k & ~31u) | (8u * ((k >> 2) & 3u) + 4u * ((k >> 4) & 1u) + (k & 3u)); }

namespace pg8 {
constexpr int BM = 256, BK = 64, HALF = 128, HTB = HALF * BK * 2, STAGE_BYTES = 8 * HTB, NXCD = 8, WGM = 4;
__host__ __device__ __forceinline__ int lds_byte(int r, int c) { const int st = (r >> 4) * 2 + (c >> 5), rr = r & 15, cc = c & 31, ob = rr * 64 + cc * 2; return st * 1024 + (ob ^ (((ob >> 9) & 1) << 5)); }
__host__ __device__ __forceinline__ void stage_rc(int b, int& R, int& C) { const int st = b / 1024, sb = b % 1024, swz = sb ^ (((sb >> 9) & 1) << 5); R = (st >> 1) * 16 + swz / 64; C = (st & 1) * 32 + (swz % 64) / 2; }
__host__ __device__ __forceinline__ int perm32(int rho) { const int n = rho >> 4, i = rho & 15; return 8 * (i >> 2) + 4 * n + (i & 3); }
struct Unit { int pm, pn; };
struct Gemm { const bf16* A; const bf16* Bt; int lda, ldb, K, nM, nN, a_shift, a_koff; };
struct StaticOrder {
    int nM, nN, nwg, G, c, mode;
    DI void init(int nM_, int nN_, int G_, int c_, int mode_ = 0) { nM = nM_; nN = nN_; nwg = nM * nN; G = G_; c = c_; mode = mode_; }
    DI bool next(int i, Unit& u) const {
        long L = (long)i * G + c;
#if MOBA_QK_FP8
        if (mode == 1) { if (i == 7) L = c >= 64 ? 1792 + (c - 64) : nwg; else if (i == 8) L = (c >= 64 && c < 192) ? 1984 + (c - 64) : nwg; else if (i > 8) L = nwg; }
        if (mode == 2) { if (i == 1) L = c < 64 ? 256 + c : nwg; else if (i > 1) L = nwg; }
#else
        if (mode == 1) { if (i == 5) L = c < 128 ? 1280 + c : (c >= 192 ? 1280 + 128 + (c - 192) : nwg); else if (i == 6) L = c < 128 ? 1472 + c : nwg; else if (i > 6) L = nwg; }
        if (mode == 2) { if (i == 3) L = (c >= 128 && c < 192) ? 768 + (c - 128) : nwg; else if (i > 3) L = nwg; }
#endif
        if (L >= nwg) return false;
        int wgid = (int)L; { const int q = nwg / NXCD, r = nwg % NXCD, xcd = wgid % NXCD, off = wgid / NXCD; wgid = (xcd < r ? xcd * (q + 1) : r * (q + 1) + (xcd - r) * q) + off; }
        const int nig = WGM * nN, gid = wgid / nig, fm = gid * WGM, gsz = (nM - fm) < WGM ? (nM - fm) : WGM;
        u.pm = fm + ((wgid % nig) % gsz); u.pn = (wgid % nig) / gsz; return true;
    }
};
struct EpiBf16 {
    bf16* O; int ldc;
    DI void operator()(const f32x4 (&acc)[2][2][4][2], const Unit& u, int wr, int wc, int fr, int fq) const {
        const int row0 = u.pm * BM + wr * 64 + fr, col0 = u.pn * BM + wc * 32 + 8 * fq;
#pragma unroll
        for (int ai = 0; ai < 2; ++ai)
#pragma unroll
            for (int m = 0; m < 4; ++m) { bf16* rowp = O + (size_t)(row0 + ai * HALF + m * 16) * ldc + col0;
#pragma unroll
                for (int bj = 0; bj < 2; ++bj) { const f32x4 v0 = acc[ai][bj][m][0], v1 = acc[ai][bj][m][1];
                    u32x4 w; w.x = cvt_pk_bf16(v0[0], v0[1]); w.y = cvt_pk_bf16(v0[2], v0[3]); w.z = cvt_pk_bf16(v1[0], v1[1]); w.w = cvt_pk_bf16(v1[2], v1[3]);
                    *(u32x4*)(rowp + bj * HALF) = w; } }
    }
};
struct EpiBf16S {
    bf16* O; int ldc; float scale;
    DI void operator()(const f32x4 (&acc)[2][2][4][2], const Unit& u, int wr, int wc, int fr, int fq) const {
        const int row0 = u.pm * BM + wr * 64 + fr, col0 = u.pn * BM + wc * 32 + 8 * fq;
#pragma unroll
        for (int ai = 0; ai < 2; ++ai)
#pragma unroll
            for (int m = 0; m < 4; ++m) { bf16* rowp = O + (size_t)(row0 + ai * HALF + m * 16) * ldc + col0;
#pragma unroll
                for (int bj = 0; bj < 2; ++bj) { const f32x4 v0 = acc[ai][bj][m][0] * scale, v1 = acc[ai][bj][m][1] * scale;
                    u32x4 w; w.x = cvt_pk_bf16(v0[0], v0[1]); w.y = cvt_pk_bf16(v0[2], v0[3]); w.z = cvt_pk_bf16(v1[0], v1[1]); w.w = cvt_pk_bf16(v1[2], v1[3]);
                    *(u32x4*)(rowp + bj * HALF) = w; } }
    }
};
struct EpiSwiglu8 {
    unsigned char* Hh;
    DI void operator()(const f32x4 (&acc)[2][2][4][2], const Unit& u, int wr, int wc, int fr, int fq) const {
        const int row0 = u.pm * BM + wr * 64 + fr, col0 = u.pn * HALF + wc * 32 + 8 * fq;
#pragma unroll
        for (int ai = 0; ai < 2; ++ai)
#pragma unroll
            for (int m = 0; m < 4; ++m) { unsigned char* rowp = Hh + (size_t)(row0 + ai * HALF + m * 16) * DFF + col0;
                float r[8];
#pragma unroll
                for (int n = 0; n < 2; ++n)
#pragma unroll
                    for (int j = 0; j < 4; ++j) { const float g = acc[ai][0][m][n][j] * (1.0f / F8_SW1), uu = acc[ai][1][m][n][j] * (F8_SH / F8_SW1); r[4 * n + j] = g * fast_sigmoid(g) * uu; }
                u32x2 w; w.x = pk4_fp8(r[0], r[1], r[2], r[3]); w.y = pk4_fp8(r[4], r[5], r[6], r[7]);
                *(u32x2*)rowp = w; }
    }
};
struct EpiF8 {
    unsigned char* O; int ldc; float scale;
    DI void operator()(const f32x4 (&acc)[2][2][4][2], const Unit& u, int wr, int wc, int fr, int fq) const {
        const int row0 = u.pm * BM + wr * 64 + fr, col0 = u.pn * BM + wc * 32 + 8 * fq;
#pragma unroll
        for (int ai = 0; ai < 2; ++ai)
#pragma unroll
            for (int m = 0; m < 4; ++m) { unsigned char* rowp = O + (size_t)(row0 + ai * HALF + m * 16) * ldc + col0;
#pragma unroll
                for (int bj = 0; bj < 2; ++bj) { const f32x4 v0 = acc[ai][bj][m][0] * scale, v1 = acc[ai][bj][m][1] * scale;
                    u32x2 w; w.x = pk4_fp8(v0[0], v0[1], v0[2], v0[3]); w.y = pk4_fp8(v1[0], v1[1], v1[2], v1[3]); *(u32x2*)(rowp + bj * HALF) = w; } }
    }
};
struct EpiGate {
    bf16* O; const unsigned char* gate; const bf16* add; unsigned char* O8; float ascale, oscale;
    DI void operator()(const f32x4 (&acc)[2][2][4][2], const Unit& u, int wr, int wc, int fr, int fq) const {
        const int row0 = u.pm * BM + wr * 64 + fr, col0 = u.pn * BM + wc * 32 + 8 * fq;
#pragma unroll
        for (int ai = 0; ai < 2; ++ai) {
            u32x2 gv[4][2]; u32x4 av[4][2];
#pragma unroll
            for (int m = 0; m < 4; ++m)
#pragma unroll
                for (int bj = 0; bj < 2; ++bj) { const size_t ro = (size_t)(row0 + ai * HALF + m * 16) * D + col0 + bj * HALF;
                    gv[m][bj] = *(const u32x2*)(gate + ro); av[m][bj] = add ? *(const u32x4*)(add + ro) : (u32x4){0u, 0u, 0u, 0u}; }
#pragma unroll
            for (int m = 0; m < 4; ++m) { const size_t ro = (size_t)(row0 + ai * HALF + m * 16) * D + col0;
#pragma unroll
                for (int bj = 0; bj < 2; ++bj) { const f32x4 v0 = acc[ai][bj][m][0] * ascale, v1 = acc[ai][bj][m][1] * ascale;
                    const u32x2 g = gv[m][bj]; const u32x4 a = av[m][bj];
                    const f32x2 g0 = __builtin_amdgcn_cvt_pk_f32_fp8((int)g.x, false), g1 = __builtin_amdgcn_cvt_pk_f32_fp8((int)g.x, true), g2 = __builtin_amdgcn_cvt_pk_f32_fp8((int)g.y, false), g3 = __builtin_amdgcn_cvt_pk_f32_fp8((int)g.y, true);
                    float r[8] = { v0[0] * g0[0], v0[1] * g0[1], v0[2] * g1[0], v0[3] * g1[1], v1[0] * g2[0], v1[1] * g2[1], v1[2] * g3[0], v1[3] * g3[1] };
                    r[0] += bflo(a.x); r[1] += bfhi(a.x); r[2] += bflo(a.y); r[3] += bfhi(a.y); r[4] += bflo(a.z); r[5] += bfhi(a.z); r[6] += bflo(a.w); r[7] += bfhi(a.w);
                    if (O8) { u32x2 w; w.x = pk4_fp8(r[0] * oscale, r[1] * oscale, r[2] * oscale, r[3] * oscale); w.y = pk4_fp8(r[4] * oscale, r[5] * oscale, r[6] * oscale, r[7] * oscale); *(u32x2*)(O8 + ro + bj * HALF) = w; }
                    else { u32x4 w; w.x = cvt_pk_bf16(r[0], r[1]); w.y = cvt_pk_bf16(r[2], r[3]); w.z = cvt_pk_bf16(r[4], r[5]); w.w = cvt_pk_bf16(r[6], r[7]);
                        *(u32x4*)(O + ro + bj * HALF) = w; } } }
        }
    }
};
struct EpiSwiglu {
    bf16* Hh;
    DI void operator()(const f32x4 (&acc)[2][2][4][2], const Unit& u, int wr, int wc, int fr, int fq) const {
        const int row0 = u.pm * BM + wr * 64 + fr, col0 = u.pn * HALF + wc * 32 + 8 * fq;
#pragma unroll
        for (int ai = 0; ai < 2; ++ai)
#pragma unroll
            for (int m = 0; m < 4; ++m) { bf16* rowp = Hh + (size_t)(row0 + ai * HALF + m * 16) * DFF + col0;
                float r[8];
#pragma unroll
                for (int n = 0; n < 2; ++n)
#pragma unroll
                    for (int j = 0; j < 4; ++j) { const float g = acc[ai][0][m][n][j], uu = acc[ai][1][m][n][j]; r[4 * n + j] = g * fast_sigmoid(g) * uu; }
                u32x4 w; w.x = cvt_pk_bf16(r[0], r[1]); w.y = cvt_pk_bf16(r[2], r[3]); w.z = cvt_pk_bf16(r[4], r[5]); w.w = cvt_pk_bf16(r[6], r[7]);
                *(u32x4*)rowp = w; }
    }
};
struct EpiInBf {
    bf16 *qidx, *qm, *km; float* kwraw;
    DI void operator()(const f32x4 (&acc)[2][2][4][2], const Unit& u, int wr, int wc, int fr, int fq) const {
        const int row0 = u.pm * BM + wr * 64 + fr, cl = wc * 32 + 8 * fq; const int pn = u.pn;
        if (pn == 4) {
#pragma unroll
            for (int ai = 0; ai < 2; ++ai)
#pragma unroll
                for (int m = 0; m < 4; ++m) { float* rowp = kwraw + (size_t)(row0 + ai * HALF + m * 16) * 256 + cl;
#pragma unroll
                    for (int bj = 0; bj < 2; ++bj) { *(f32x4*)(rowp + bj * HALF) = acc[ai][bj][m][0]; *(f32x4*)(rowp + bj * HALF + 4) = acc[ai][bj][m][1]; } }
            return;
        }
        bf16* O; int ct;
        if (pn < 4) { O = qidx; ct = pn; } else if (pn < 9) { O = qm; ct = pn - 5; } else { O = km; ct = pn - 9; }
        const int col0 = ct * BM + cl;
#pragma unroll
        for (int ai = 0; ai < 2; ++ai)
#pragma unroll
            for (int m = 0; m < 4; ++m) { bf16* rowp = O + (size_t)(row0 + ai * HALF + m * 16) * 1024 + col0;
#pragma unroll
                for (int bj = 0; bj < 2; ++bj) { const f32x4 v0 = acc[ai][bj][m][0], v1 = acc[ai][bj][m][1];
                    u32x4 w; w.x = cvt_pk_bf16(v0[0], v0[1]); w.y = cvt_pk_bf16(v0[2], v0[3]); w.z = cvt_pk_bf16(v1[0], v1[1]); w.w = cvt_pk_bf16(v1[2], v1[3]);
                    *(u32x4*)(rowp + bj * HALF) = w; } }
    }
};
struct EpiIn8 {
    bf16 *qdsa, *vm, *ga, *gb; float* ckvraw; const float* bgate; bf16 *qm, *km;
    DI void operator()(const f32x4 (&acc)[2][2][4][2], const Unit& u, int wr, int wc, int fr, int fq) const {
        const int row0 = u.pm * BM + wr * 64 + fr, cl = wc * 32 + 8 * fq; const int pn = u.pn; const float sc = 1.0f / F8_SWI;
        if (pn == 4) {
#pragma unroll
            for (int ai = 0; ai < 2; ++ai)
#pragma unroll
                for (int m = 0; m < 4; ++m) { float* rowp = ckvraw + (size_t)(row0 + ai * HALF + m * 16) * 256 + cl;
#pragma unroll
                    for (int bj = 0; bj < 2; ++bj) { *(f32x4*)(rowp + bj * HALF) = acc[ai][bj][m][0] * sc; *(f32x4*)(rowp + bj * HALF + 4) = acc[ai][bj][m][1] * sc; } }
            return;
        }
        bf16* O; int ldc, ct; const float* bias = nullptr;
        if (pn < 4) { O = qdsa; ldc = 1024; ct = pn; }
        else if (pn < 9) { O = vm; ldc = 1024; ct = pn - 5; }
        else if (pn < 17) { O = ga; ldc = 2048; ct = pn - 9; bias = bgate; }
        else if (pn < 25) { O = gb; ldc = 2048; ct = pn - 17; bias = bgate + 2048; }
        else if (pn < 29) { O = qm; ldc = 1024; ct = pn - 25; }
        else { O = km; ldc = 1024; ct = pn - 29; }
        const int col0 = ct * BM + cl;
        f32x4 bb[2][2] = {{(f32x4){0.f, 0.f, 0.f, 0.f}, (f32x4){0.f, 0.f, 0.f, 0.f}}, {(f32x4){0.f, 0.f, 0.f, 0.f}, (f32x4){0.f, 0.f, 0.f, 0.f}}};
        if (bias) {
#pragma unroll
            for (int bj = 0; bj < 2; ++bj) { bb[bj][0] = *(const f32x4*)(bias + col0 + bj * HALF); bb[bj][1] = *(const f32x4*)(bias + col0 + bj * HALF + 4); } }
#pragma unroll
        for (int ai = 0; ai < 2; ++ai)
#pragma unroll
            for (int m = 0; m < 4; ++m) { bf16* rowp = O + (size_t)(row0 + ai * HALF + m * 16) * ldc + col0;
#pragma unroll
                for (int bj = 0; bj < 2; ++bj) { f32x4 v0 = acc[ai][bj][m][0] * sc, v1 = acc[ai][bj][m][1] * sc;
                    if (bias) { const f32x4 b0 = bb[bj][0], b1 = bb[bj][1];
#pragma unroll
                        for (int j = 0; j < 4; ++j) { v0[j] = fast_sigmoid(v0[j] + b0[j]) * F8_SGT; v1[j] = fast_sigmoid(v1[j] + b1[j]) * F8_SGT; }
                        u32x2 w8; w8.x = pk4_fp8(v0[0], v0[1], v0[2], v0[3]); w8.y = pk4_fp8(v1[0], v1[1], v1[2], v1[3]);
                        *(u32x2*)((unsigned char*)O + (size_t)(row0 + ai * HALF + m * 16) * 2048 + col0 + bj * HALF) = w8; continue; }
                    u32x4 w; w.x = cvt_pk_bf16(v0[0], v0[1]); w.y = cvt_pk_bf16(v0[2], v0[3]); w.z = cvt_pk_bf16(v1[0], v1[1]); w.w = cvt_pk_bf16(v1[2], v1[3]);
                    *(u32x4*)(rowp + bj * HALF) = w; } }
    }
};

struct FusedOrder {
    int c;
    DI bool next(int i, Unit& u) const { if (i >= 2) return false; const int xcd = c & 7, j = c >> 3; u.pm = xcd * 8 + i * 4 + (j >> 3); u.pn = j & 7; return true; }
};
struct EpiLn {
    bf16* x; const float* g; const float* b; float scale; float* xf; unsigned char* xb8; unsigned long long* slots; unsigned* cnt;
    DI void run(f32x4 (&acc)[2][2][4][2], const Unit& u, int wr, int wc, int fr_, int fq_, LAS unsigned char* lds, int wid, int lane_) const {
        int fr = fr_, fq = fq_, lane = lane_; asm volatile("" : "+v"(fr), "+v"(fq), "+v"(lane));
        LAS f32x2* P = (LAS f32x2*)(lds + LNT_OFF); LAS f32x2* Sx = (LAS f32x2*)(lds + LNT_OFF + 8192);
        const int row0 = u.pm * BM + wr * 64 + fr, col0 = u.pn * BM + wc * 32 + 8 * fq;
        __builtin_amdgcn_sched_barrier(0);
#pragma unroll
        for (int ai = 0; ai < 2; ++ai) {
            u32x4 xw[4][2];
#pragma unroll
            for (int m = 0; m < 4; ++m)
#pragma unroll
                for (int bj = 0; bj < 2; ++bj) xw[m][bj] = *(const u32x4*)(x + (size_t)(row0 + ai * HALF + m * 16) * D + col0 + bj * HALF);
#pragma unroll
            for (int m = 0; m < 4; ++m)
#pragma unroll
                for (int bj = 0; bj < 2; ++bj) { const u32x4 w = xw[m][bj];
                    const f32x4 x0 = {__uint_as_float(w.x << 16), __uint_as_float(w.x & 0xffff0000u), __uint_as_float(w.y << 16), __uint_as_float(w.y & 0xffff0000u)};
                    const f32x4 x1 = {__uint_as_float(w.z << 16), __uint_as_float(w.z & 0xffff0000u), __uint_as_float(w.w << 16), __uint_as_float(w.w & 0xffff0000u)};
                    acc[ai][bj][m][0] = x0 * ALPHA + acc[ai][bj][m][0] * scale; acc[ai][bj][m][1] = x1 * ALPHA + acc[ai][bj][m][1] * scale; }
            __builtin_amdgcn_sched_barrier(0);
            asm volatile("" : "+v"(acc[ai][0][0][0]), "+v"(acc[ai][1][3][1]) :: "memory");
        }
        __builtin_amdgcn_sched_barrier(0);
#pragma unroll
        for (int ai = 0; ai < 2; ++ai)
#pragma unroll
            for (int m = 0; m < 4; ++m) {
                float s = 0.f;
#pragma unroll
                for (int bj = 0; bj < 2; ++bj)
#pragma unroll
                    for (int n = 0; n < 2; ++n) { const f32x4 v = acc[ai][bj][m][n]; s += (v[0] + v[1]) + (v[2] + v[3]); }
                s = xrow16_sum(s);
                const float mw = s * (1.0f / 64.0f); float q = 0.f;
#pragma unroll
                for (int bj = 0; bj < 2; ++bj)
#pragma unroll
                    for (int n = 0; n < 2; ++n) { const f32x4 d = acc[ai][bj][m][n] - mw; q += (d[0] * d[0] + d[1] * d[1]) + (d[2] * d[2] + d[3] * d[3]); }
                q = xrow16_sum(q);
                if (fq == 0) P[(ai * HALF + wr * 64 + m * 16 + fr) * 4 + wc] = (f32x2){mw, q};
            }
        asm volatile("s_waitcnt lgkmcnt(0)" ::: "memory"); __builtin_amdgcn_s_barrier(); asm volatile("" ::: "memory");
        const int row = wid * 32 + (lane & 31);
        if (lane < 32) {
            const f32x2 a = P[row * 4 + 0], b2 = P[row * 4 + 1], c = P[row * 4 + 2], d = P[row * 4 + 3];
            const float mt = (a[0] + b2[0] + c[0] + d[0]) * 0.25f;
            const float da = a[0] - mt, db = b2[0] - mt, dc = c[0] - mt, dd = d[0] - mt;
            const float m2 = (a[1] + b2[1]) + (c[1] + d[1]) + 64.0f * ((da * da + db * db) + (dc * dc + dd * dd));
            __hip_atomic_store(slots + ((size_t)(u.pm * BM + row) * 8 + u.pn), ((unsigned long long)__float_as_uint(m2) << 32) | __float_as_uint(mt), __ATOMIC_RELAXED, __HIP_MEMORY_SCOPE_AGENT);
        }
        asm volatile("s_waitcnt vmcnt(0)" ::: "memory");
        if (lane == 0) __hip_atomic_fetch_add(cnt + 64 * u.pm, 1u, __ATOMIC_RELAXED, __HIP_MEMORY_SCOPE_AGENT);
        if (wid == 0) {
            unsigned sp = 0;
            while ((unsigned)__builtin_amdgcn_readfirstlane(__hip_atomic_load(cnt + 64 * u.pm, __ATOMIC_RELAXED, __HIP_MEMORY_SCOPE_AGENT)) < 64u) { __builtin_amdgcn_s_sleep(1); if (++sp > (1u << 24)) break; }
            __builtin_amdgcn_fence(__ATOMIC_ACQUIRE, "agent");
        }
        asm volatile("s_waitcnt vmcnt(0) lgkmcnt(0)" ::: "memory"); __builtin_amdgcn_s_barrier(); asm volatile("" ::: "memory");
        if (lane < 32) {
            const unsigned long long* sl = slots + (size_t)(u.pm * BM + row) * 8; float mt[8], m2[8]; float ms = 0.f;
#pragma unroll
            for (int t = 0; t < 8; ++t) { const unsigned long long w = __hip_atomic_load(sl + t, __ATOMIC_RELAXED, __HIP_MEMORY_SCOPE_AGENT); mt[t] = __uint_as_float((unsigned)w); m2[t] = __uint_as_float((unsigned)(w >> 32)); ms += mt[t]; }
            const float mean = ms * 0.125f; float q = 0.f;
#pragma unroll
            for (int t = 0; t < 8; ++t) { const float dm = mt[t] - mean; q += m2[t] + 256.0f * dm * dm; }
            Sx[row] = (f32x2){mean, 1.0f / sqrtf(q * (1.0f / D) + LN_EPS)};
        }
        asm volatile("s_waitcnt lgkmcnt(0)" ::: "memory"); __builtin_amdgcn_s_barrier(); asm volatile("" ::: "memory");
        __builtin_amdgcn_sched_barrier(0);
        f32x4 gb[2][4];
#pragma unroll
        for (int bj = 0; bj < 2; ++bj) { gb[bj][0] = *(const f32x4*)(g + col0 + bj * HALF); gb[bj][1] = *(const f32x4*)(g + col0 + bj * HALF + 4); gb[bj][2] = *(const f32x4*)(b + col0 + bj * HALF); gb[bj][3] = *(const f32x4*)(b + col0 + bj * HALF + 4); }
#pragma unroll
        for (int bj = 0; bj < 2; ++bj) {
            const f32x4 g0 = gb[bj][0], g1 = gb[bj][1], b0 = gb[bj][2], b1 = gb[bj][3];
#pragma unroll
            for (int ai = 0; ai < 2; ++ai)
#pragma unroll
                for (int m = 0; m < 4; ++m) { const int rl = ai * HALF + wr * 64 + m * 16 + fr; const f32x2 sr = Sx[rl]; const size_t off = (size_t)(u.pm * BM + rl) * D + col0 + bj * HALF;
                    const f32x4 o0 = (acc[ai][bj][m][0] - sr[0]) * sr[1] * g0 + b0, o1 = (acc[ai][bj][m][1] - sr[0]) * sr[1] * g1 + b1;
                    if (xf) { *(f32x4*)(xf + off) = o0; *(f32x4*)(xf + off + 4) = o1; }
                    else { u32x4 w; w.x = cvt_pk_bf16(o0[0], o0[1]); w.y = cvt_pk_bf16(o0[2], o0[3]); w.z = cvt_pk_bf16(o1[0], o1[1]); w.w = cvt_pk_bf16(o1[2], o1[3]); *(u32x4*)(x + off) = w;
                        u32x2 w8; w8.x = pk4_fp8(o0[0], o0[1], o0[2], o0[3]); w8.y = pk4_fp8(o1[0], o1[1], o1[2], o1[3]); *(u32x2*)(xb8 + off) = w8; }
                    asm volatile("" ::: "memory"); __builtin_amdgcn_sched_barrier(0); }
        }
        asm volatile("s_waitcnt lgkmcnt(0)" ::: "memory"); __builtin_amdgcn_s_barrier(); asm volatile("" ::: "memory");
    }
};

template <class Epi, bool FP8 = false, class Order = StaticOrder, bool LN = false>
DI void gemm_phase(LAS unsigned char* lds, const Gemm g, const Order& So, const Epi& E, int tid_in) {
    int tid_ = tid_in; asm volatile("" : "+v"(tid_));
    const int tid = tid_, wid = __builtin_amdgcn_readfirstlane(tid >> 6), lane = tid & 63, wr = wid >> 2, wc = wid & 3, fr = lane & 15, fq = lane >> 4;
    const int K = g.K, nt = K / BK;
    unsigned voffA[2], voffB[2];
#pragma unroll
    for (int i = 0; i < 2; ++i) { int R, C; stage_rc(tid * 16 + i * 8192, R, C); const int Rb = (R & ~31) + perm32(R & 31);
        voffA[i] = (unsigned)(R * g.lda + C) * 2u; voffB[i] = (unsigned)(Rb * g.ldb + C) * 2u; }
    const size_t kstep = (size_t)(BK * 2);
    const size_t hstepA = (size_t)HALF * g.lda * 2, hstepB = (size_t)HALF * g.ldb * 2;
    const size_t tstepA = 2 * hstepA, tstepB = 2 * hstepB;
    const unsigned ldsw = (unsigned)wid * 1024u;
    const int aoff = lds_byte(wr * 64 + fr, fq * 8), boff = lds_byte(wc * 32 + fr, fq * 8);
    int one8 = 0x7F7F7F7F; asm volatile("" : "+v"(one8));
#define PG8_SA(b, h) (((b) * 2 + (h)) * HTB)
#define PG8_SB(b, h) ((4 + (b) * 2 + (h)) * HTB)
#define PG8_STAGE(bufoff, gbase, voff) do { _Pragma("unroll") for (int _i = 0; _i < 2; ++_i) \
        __builtin_amdgcn_global_load_lds((const unsigned*)((const char*)(gbase) + (voff)[_i]), (LAS unsigned*)(lds + (bufoff) + ldsw + _i * 8192), 16, 0, 0); } while (0)
#define PG8_LDA(dst, b, h) do { _Pragma("unroll") for (int m = 0; m < 4; ++m) { const LAS unsigned char* p_ = lds + PG8_SA(b, h) + aoff + m * 2048; \
        if constexpr (FP8) { const v4i lo_ = *(const LAS v4i*)p_, hi_ = *(const LAS v4i*)(p_ + 1024); dst##8[m] = __builtin_shufflevector(lo_, hi_, 0, 1, 2, 3, 4, 5, 6, 7); } \
        else { dst[m][0] = *(const LAS v4i*)p_; dst[m][1] = *(const LAS v4i*)(p_ + 1024); } } } while (0)
#define PG8_LDB(dst, b, h) do { _Pragma("unroll") for (int n = 0; n < 2; ++n) { const LAS unsigned char* p_ = lds + PG8_SB(b, h) + boff + n * 2048; \
        if constexpr (FP8) { const v4i lo_ = *(const LAS v4i*)p_, hi_ = *(const LAS v4i*)(p_ + 1024); dst##8[n] = __builtin_shufflevector(lo_, hi_, 0, 1, 2, 3, 4, 5, 6, 7); } \
        else { dst[n][0] = *(const LAS v4i*)p_; dst[n][1] = *(const LAS v4i*)(p_ + 1024); } } } while (0)
#define PG8_MMA(ai, bj, At, Bt) do { __builtin_amdgcn_s_setprio(1); _Pragma("unroll") for (int m = 0; m < 4; ++m) _Pragma("unroll") for (int n = 0; n < 2; ++n) { \
        if constexpr (FP8) { asm volatile("v_mfma_scale_f32_16x16x128_f8f6f4 %0, %1, %2, %0, %3, %3 op_sel_hi:[0,0,0]" : "+v"(acc[ai][bj][m][n]) : "v"(Bt##8[n]), "v"(At##8[m]), "v"(one8)); } \
        else { _Pragma("unroll") for (int k = 0; k < 2; ++k) acc[ai][bj][m][n] = __builtin_amdgcn_mfma_f32_16x16x32_bf16(__builtin_bit_cast(bf16x8, Bt[n][k]), __builtin_bit_cast(bf16x8, At[m][k]), acc[ai][bj][m][n], 0, 0, 0); } } \
        __builtin_amdgcn_s_setprio(0); } while (0)
#define PG8_WAIT_V(n) asm volatile("s_waitcnt vmcnt(" #n ")" ::: "memory")
#define PG8_WAIT_L(n) asm volatile("s_waitcnt lgkmcnt(" #n ")" ::: "memory")
#define PG8_BAR __builtin_amdgcn_s_barrier()
#define PG8_SCHED __builtin_amdgcn_sched_barrier(0)
#define PG8_ABASE(u) ((const char*)g.A + (size_t)(u).pm * tstepA + (size_t)(((u).pn >> g.a_shift) * g.a_koff) * 2)
#define PG8_BBASE(u) ((const char*)g.Bt + (size_t)(u).pn * tstepB)
    Unit cur, nxt; int ui = 0;
    if (!So.next(0, cur)) return;
    f32x4 acc[2][2][4][2];
#pragma unroll
    for (int a = 0; a < 2; ++a)
#pragma unroll
        for (int b = 0; b < 2; ++b)
#pragma unroll
            for (int m = 0; m < 4; ++m)
#pragma unroll
                for (int n = 0; n < 2; ++n) acc[a][b][m][n] = (f32x4){0.f, 0.f, 0.f, 0.f};
    v4i At[4][2], B0[2][2], B1[2][2]; v8i At8[4], B08[2], B18[2];
    const char* cA = PG8_ABASE(cur); const char* cB = PG8_BBASE(cur);
    PG8_STAGE(PG8_SB(0, 0), cB, voffB); PG8_STAGE(PG8_SB(0, 1), cB + hstepB, voffB); PG8_STAGE(PG8_SA(0, 0), cA, voffA); PG8_STAGE(PG8_SA(0, 1), cA + hstepA, voffA);
    if (wr == 1) PG8_BAR;
    PG8_WAIT_V(2); PG8_BAR;
    PG8_STAGE(PG8_SB(1, 0), cB + kstep, voffB); PG8_STAGE(PG8_SA(1, 0), cA + kstep, voffA); PG8_STAGE(PG8_SB(1, 1), cB + hstepB + kstep, voffB);
    PG8_WAIT_V(6); PG8_BAR;
    for (;;) {
        const bool has_next = So.next(ui + 1, nxt);
        const char* nA = has_next ? PG8_ABASE(nxt) : cA; const char* nB = has_next ? PG8_BBASE(nxt) : cB;
        for (int t = 0; t < nt; t += 2) {
            const bool last = (t == nt - 2);
            const char* a1 = cA + (size_t)(t + 1) * kstep;
            const char* a2 = last ? nA : cA + (size_t)(t + 2) * kstep; const char* b2 = last ? nB : cB + (size_t)(t + 2) * kstep;
            const char* a3 = a2 + kstep; const char* b3 = b2 + kstep;
            PG8_LDB(B0, 0, 0); PG8_LDB(B1, 0, 1); PG8_SCHED; PG8_LDA(At, 0, 0); PG8_STAGE(PG8_SA(1, 1), a1 + hstepA, voffA);
            PG8_WAIT_V(8); PG8_WAIT_L(0); PG8_BAR; PG8_MMA(0, 0, At, B0); PG8_MMA(0, 1, At, B1); PG8_BAR; PG8_SCHED;
            PG8_LDA(At, 0, 1); PG8_STAGE(PG8_SB(0, 0), b2, voffB); PG8_STAGE(PG8_SB(0, 1), b2 + hstepB, voffB); PG8_STAGE(PG8_SA(0, 0), a2, voffA);
            PG8_WAIT_V(8); PG8_WAIT_L(0); PG8_BAR; PG8_MMA(1, 0, At, B0); PG8_MMA(1, 1, At, B1); PG8_BAR; PG8_SCHED;
            PG8_LDB(B0, 1, 0); PG8_LDB(B1, 1, 1); PG8_SCHED; PG8_LDA(At, 1, 0); PG8_STAGE(PG8_SA(0, 1), a2 + hstepA, voffA);
            PG8_WAIT_V(8); PG8_WAIT_L(0); PG8_BAR; PG8_MMA(0, 0, At, B0); PG8_MMA(0, 1, At, B1); PG8_BAR; PG8_SCHED;
            PG8_LDA(At, 1, 1); PG8_STAGE(PG8_SB(1, 0), b3, voffB); PG8_STAGE(PG8_SB(1, 1), b3 + hstepB, voffB); PG8_STAGE(PG8_SA(1, 0), a3, voffA);
            PG8_WAIT_V(8); PG8_WAIT_L(0); PG8_BAR; PG8_MMA(1, 0, At, B0); PG8_MMA(1, 1, At, B1); PG8_BAR; PG8_SCHED;
        }
        if (wr == 0) PG8_BAR;
        if constexpr (FP8) asm volatile("s_nop 15\n\ts_nop 15" ::: "memory");
        if constexpr (LN) E.run(acc, cur, wr, wc, fr, fq, lds, wid, lane); else E(acc, cur, wr, wc, fr, fq);
        if (!has_next) break;
#pragma unroll
        for (int a = 0; a < 2; ++a)
#pragma unroll
            for (int b = 0; b < 2; ++b)
#pragma unroll
                for (int m = 0; m < 4; ++m)
#pragma unroll
                    for (int n = 0; n < 2; ++n) acc[a][b][m][n] = (f32x4){0.f, 0.f, 0.f, 0.f};
        cur = nxt; cA = nA; cB = nB; ++ui;
        if (wr == 1) PG8_BAR;
    }
    PG8_WAIT_V(0);
    PG8_BAR;
#undef PG8_SA
#undef PG8_SB
#undef PG8_STAGE
#undef PG8_LDA
#undef PG8_LDB
#undef PG8_MMA
#undef PG8_WAIT_V
#undef PG8_WAIT_L
#undef PG8_BAR
#undef PG8_SCHED
#undef PG8_ABASE
#undef PG8_BBASE
}
}

#define XB_TMO      128
#define XB_XCNT(j)  (256  + 64 * (j))
#define XB_XSUB(j)  (1280 + 64 * (j))
#define XB_XGEN(j)  (2304 + 64 * (j))
#define XB_TOP      3328
#define XB_TOPGEN   3392
#define XCD_BAR_WORDS 3456
#define XB_SPIN_CAP (1u << 22)
DI unsigned xb_ld(unsigned* p)              { return __hip_atomic_load(p, __ATOMIC_RELAXED, __HIP_MEMORY_SCOPE_AGENT); }
DI unsigned xb_add(unsigned* p, unsigned v) { return __hip_atomic_fetch_add(p, v, __ATOMIC_RELAXED, __HIP_MEMORY_SCOPE_AGENT); }
DI unsigned xb_xcc_id() { return (unsigned)__builtin_amdgcn_s_getreg((3 << 11) | 20) & 0xFu; }
#define XB_SPIN(cond, bar) do { unsigned _sp = 0; while (cond) { __builtin_amdgcn_s_sleep(1); \
    if ((++_sp & 255u) == 0u) { if (xb_ld(&(bar)[XB_TMO])) break; if (_sp > XB_SPIN_CAP) { atomicAdd(&(bar)[XB_TMO], 1u); break; } } } } while (0)
struct XcdBarrier { unsigned* bar; unsigned x; volatile LAS unsigned* st; int w0; };
DI XcdBarrier xcd_barrier_post(unsigned* bar, volatile LAS unsigned* st) {
    XcdBarrier b; b.bar = bar; b.x = xb_xcc_id(); b.st = st; b.w0 = __builtin_amdgcn_readfirstlane((int)threadIdx.x >> 6);
    if (threadIdx.x == 0) (void)xb_add(&bar[XB_XCNT(b.x)], 1u);
    return b;
}
DI void xcd_barrier_complete(unsigned* bar, unsigned x, unsigned& nloc, unsigned& nx) {
    const unsigned G = gridDim.x * gridDim.y * gridDim.z;
    unsigned sum, cnt, mine, sp = 0u;
    for (;;) {
        sum = 0u; cnt = 0u; mine = 0u;
#pragma unroll
        for (unsigned j = 0; j < 16; ++j) { const unsigned c = xb_ld(&bar[XB_XCNT(j)]); sum += c; cnt += (c > 0u) ? 1u : 0u; mine = (j == x) ? c : mine; }
        if (sum == G) break;
        __builtin_amdgcn_s_sleep(1);
        if ((++sp & 255u) == 0u) { if (xb_ld(&bar[XB_TMO])) break; if (sp > XB_SPIN_CAP) { atomicAdd(&bar[XB_TMO], 1u); break; } }
    }
    nloc = mine > 0u ? mine : 1u; nx = cnt > 0u ? cnt : 1u;
}
DI void xcd_barrier(const XcdBarrier& b) {
    asm volatile("s_waitcnt vmcnt(0)" ::: "memory");
    __syncthreads();
    if (b.w0 == 0 && lane_id() == 0) {
        unsigned* bar = b.bar;
        __builtin_amdgcn_s_waitcnt(0);
        unsigned nloc = b.st[0], nx = b.st[1];
        if (nloc == 0u) { xcd_barrier_complete(bar, b.x, nloc, nx); b.st[0] = nloc; b.st[1] = nx; }
        const unsigned old = xb_add(&bar[XB_XSUB(b.x)], 1u);
        const unsigned gen = old / nloc;
        if (old + 1u == (gen + 1u) * nloc) {
            __builtin_amdgcn_fence(__ATOMIC_RELEASE, "agent");
            asm volatile("s_waitcnt vmcnt(0)" ::: "memory");
            const unsigned og = xb_add(&bar[XB_TOP], 1u);
            const unsigned tg = og / nx;
            if (og + 1u == (tg + 1u) * nx) xb_add(&bar[XB_TOPGEN], 1u);
            else XB_SPIN(xb_ld(&bar[XB_TOPGEN]) == tg, bar);
            __builtin_amdgcn_fence(__ATOMIC_ACQUIRE, "agent");
            xb_add(&bar[XB_XGEN(b.x)], 1u);
            asm volatile("s_waitcnt vmcnt(0)" ::: "memory");
        } else {
            XB_SPIN(xb_ld(&bar[XB_XGEN(b.x)]) == gen, bar);
            __builtin_amdgcn_fence(__ATOMIC_ACQUIRE, "agent");
            asm volatile("s_waitcnt vmcnt(0)" ::: "memory");
        }
    }
    __syncthreads();
}

struct Args { const float* in[19]; float* out; unsigned char* ws; int ph_lo, ph_hi; };
struct Frame {
    LAS unsigned char* lds; unsigned char* ws; gu32* ctl;
    int tid, lane, wave, bx, G;
};
DI Frame make_frame(unsigned char* ws_in, LAS unsigned char* lds_in, int w0) {
    Frame F; GAS unsigned char* w = (GAS unsigned char*)ws_in; asm volatile("" : "+s"(w)); int t = w0 * 64 + lane_id(); asm volatile("" : "+v"(t));
    F.lds = lds_in; F.ws = (unsigned char*)w; F.ctl = (gu32*)(w + WS_CTL);
    F.tid = t; F.lane = t & 63; F.wave = __builtin_amdgcn_readfirstlane(t >> 6); F.bx = blockIdx.x; F.G = gridDim.x;
    return F;
}

template <int MAP> DI int conv_rowmap(int n) {
    if (MAP == 1) return n < 2384 ? n : n + 176;
    if (MAP == 2) { const int isu = n >= DFF ? 1 : 0, j = n - isu * DFF; return 256 * (j >> 7) + 128 * isu + (j & 127); }
    return n;
}
template <int MAP> DI void conv_item(const float* W, int N, bf16* WT, int ldd, LAS float* scr, int kb, int nb, int lane) {
    const int k0 = 64 * kb, n0 = 32 * nb;
    const bool nok = n0 + (lane & 31) < N;
    { float v[32]; const float* wp = W + (size_t)(k0 + (lane >> 5)) * N + n0 + (lane & 31);
#pragma unroll
      for (int i = 0; i < 32; ++i) v[i] = nok ? __builtin_nontemporal_load(wp + (size_t)(2 * i) * N) : 0.f;
#pragma unroll
      for (int i = 0; i < 32; ++i) scr[(2 * i + (lane >> 5)) * 33 + (lane & 31)] = v[i]; }
    asm volatile("s_waitcnt lgkmcnt(0)" ::: "memory");
    const int c = lane & 7;
#pragma unroll
    for (int j = 0; j < 4; ++j) { const int n = (lane >> 3) + 8 * j; const LAS float* s = scr + (8 * c) * 33 + n;
        u32x4 o; o.x = pk2(s[0 * 33], s[1 * 33]); o.y = pk2(s[2 * 33], s[3 * 33]); o.z = pk2(s[4 * 33], s[5 * 33]); o.w = pk2(s[6 * 33], s[7 * 33]);
        if (n0 + n < N) *(u32x4*)(WT + (size_t)conv_rowmap<MAP>(n0 + n) * ldd + k0 + 8 * c) = o; }
    asm volatile("s_waitcnt lgkmcnt(0)" ::: "memory");
}
template <int MAP> DI void conv_item8(const float* W, int N, unsigned char* WT, int ldd, LAS float* scr, int kb, int nb, int lane, float scale) {
    const int k0 = 64 * kb, n0 = 32 * nb;
    const bool nok = n0 + (lane & 31) < N;
    { float v[32]; const float* wp = W + (size_t)(k0 + (lane >> 5)) * N + n0 + (lane & 31);
#pragma unroll
      for (int i = 0; i < 32; ++i) v[i] = nok ? __builtin_nontemporal_load(wp + (size_t)(2 * i) * N) : 0.f;
#pragma unroll
      for (int i = 0; i < 32; ++i) scr[(2 * i + (lane >> 5)) * 33 + (lane & 31)] = v[i]; }
    asm volatile("s_waitcnt lgkmcnt(0)" ::: "memory");
    const int c = lane & 3;
#pragma unroll
    for (int j = 0; j < 2; ++j) { const int n = (lane >> 2) + 16 * j; const LAS float* s = scr + (16 * c) * 33 + n;
        u32x4 o; o.x = pk4_fp8(s[0 * 33] * scale, s[1 * 33] * scale, s[2 * 33] * scale, s[3 * 33] * scale); o.y = pk4_fp8(s[4 * 33] * scale, s[5 * 33] * scale, s[6 * 33] * scale, s[7 * 33] * scale);
        o.z = pk4_fp8(s[8 * 33] * scale, s[9 * 33] * scale, s[10 * 33] * scale, s[11 * 33] * scale); o.w = pk4_fp8(s[12 * 33] * scale, s[13 * 33] * scale, s[14 * 33] * scale, s[15 * 33] * scale);
        if (n0 + n < N) *(u32x4*)(WT + (size_t)conv_rowmap<MAP>(n0 + n) * ldd + k0 + 16 * c) = o; }
    asm volatile("s_waitcnt lgkmcnt(0)" ::: "memory");
}
DI int win_rowmap(int c) {
    if (c < 1024) return -1 - c;
    if (c < 1280) return -1 - c;
    if (c < 2304) return c - 1280;
    if (c < 2384) return c - 2304 + 1024;
    if (c < 3408) return MOBA_QK_FP8 ? -1 - (c - 2384 + 6400) : c - 2384 + 1280;
    if (c < 4432) return MOBA_QK_FP8 ? -1 - (c - 3408 + 7424) : c - 3408 + 2304;
    if (c < 5456) return -1 - (c - 4432 + 1280);
    if (c < 7504) return -1 - (c - 5456 + 2304);
    return -1 - (c - 7504 + 4352);
}
DI void conv_item_win(const float* W, bf16* WTb, unsigned char* WT8, LAS float* scr, int kb, int nb, int lane) {
    const int N = INW, k0 = 64 * kb, n0 = 32 * nb;
    const bool nok = n0 + (lane & 31) < N;
    { float v[32]; const float* wp = W + (size_t)(k0 + (lane >> 5)) * N + n0 + (lane & 31);
#pragma unroll
      for (int i = 0; i < 32; ++i) v[i] = nok ? __builtin_nontemporal_load(wp + (size_t)(2 * i) * N) : 0.f;
#pragma unroll
      for (int i = 0; i < 32; ++i) scr[(2 * i + (lane >> 5)) * 33 + (lane & 31)] = v[i]; }
    asm volatile("s_waitcnt lgkmcnt(0)" ::: "memory");
    const int last = n0 + 31 < N ? n0 + 31 : N - 1;
    if (win_rowmap(n0) >= 0 || win_rowmap(last) >= 0) {
        const int c = lane & 7;
#pragma unroll
        for (int j = 0; j < 4; ++j) { const int n = (lane >> 3) + 8 * j; const LAS float* s = scr + (8 * c) * 33 + n; const int rm = n0 + n < N ? win_rowmap(n0 + n) : -1;
            u32x4 o; o.x = pk2(s[0 * 33], s[1 * 33]); o.y = pk2(s[2 * 33], s[3 * 33]); o.z = pk2(s[4 * 33], s[5 * 33]); o.w = pk2(s[6 * 33], s[7 * 33]);
            if (rm >= 0) *(u32x4*)(WTb + (size_t)rm * D + k0 + 8 * c) = o; }
    }
    if (win_rowmap(n0) < 0 || win_rowmap(last) < 0) {
        const int c = lane & 3;
#pragma unroll
        for (int j = 0; j < 2; ++j) { const int n = (lane >> 2) + 16 * j; const LAS float* s = scr + (16 * c) * 33 + n; const int rm = n0 + n < N ? win_rowmap(n0 + n) : 0;
            u32x4 o; o.x = pk4_fp8(s[0 * 33] * F8_SWI, s[1 * 33] * F8_SWI, s[2 * 33] * F8_SWI, s[3 * 33] * F8_SWI); o.y = pk4_fp8(s[4 * 33] * F8_SWI, s[5 * 33] * F8_SWI, s[6 * 33] * F8_SWI, s[7 * 33] * F8_SWI);
            o.z = pk4_fp8(s[8 * 33] * F8_SWI, s[9 * 33] * F8_SWI, s[10 * 33] * F8_SWI, s[11 * 33] * F8_SWI); o.w = pk4_fp8(s[12 * 33] * F8_SWI, s[13 * 33] * F8_SWI, s[14 * 33] * F8_SWI, s[15 * 33] * F8_SWI);
            if (rm < 0) *(u32x4*)(WT8 + (size_t)(-1 - rm) * D + k0 + 16 * c) = o; }
    }
    asm volatile("s_waitcnt lgkmcnt(0)" ::: "memory");
}
DI void zero_rows(bf16* p, int rows, int cols, int ld, int gt, int ngt) {
    const int cpr = cols / 8; unsigned z0; asm volatile("v_mov_b32 %0, 0" : "=v"(z0)); const u32x4 z = {z0, z0, z0, z0};
    for (int i = gt; i < rows * cpr; i += ngt) *(u32x4*)(p + (size_t)(i / cpr) * ld + (i % cpr) * 8) = z;
}
DI void conv_phase(const Frame& F, const Args& a, int l) {
    LAS float* scr = (LAS float*)(F.lds + F.wave * 16384);
    const int gw = F.bx * NWAVES + F.wave, NGW = F.G * NWAVES, lane = F.lane;
    unsigned char* ws = F.ws;
    const float* w_in = a.in[2] + (size_t)l * D * INW; const float* w_uk = a.in[7] + (size_t)l * NH * HD * CKV; const float* w_uv = a.in[8] + (size_t)l * NH * CKV * HD;
    const float* w_oa = a.in[9] + (size_t)l * 1024 * D; const float* w_ob = a.in[10] + (size_t)l * 1024 * D; const float* w_out = a.in[11] + (size_t)l * D * D;
    const float* w_qm = a.in[12] + (size_t)l * D * 512; const float* w_om = a.in[14] + (size_t)l * 512 * D;
    const float* w_f1 = a.in[15] + (size_t)l * D * 2 * DFF; const float* w_f2 = a.in[16] + (size_t)l * DFF * D;
    constexpr int NB_IN = (INW + 31) / 32;
    constexpr int I_IN = 32 * NB_IN, I_UK = 8 * 2 * 8, I_UV = 8 * 4 * 4, I_OA = 16 * 64, I_OUT = 32 * 64, I_QM = 32 * 16, I_OM = 8 * 64, I_F1 = 32 * 352, I_F2 = 88 * 64, I_KV = 4 * 32 * 32;
    const int total = I_IN + I_UK + I_UV + 2 * I_OA + I_OUT + I_QM + I_OM + I_F1 + I_F2 + (l == 0 ? I_KV : 0);
    for (int it = gw; it < total; it += NGW) {
        int r = it;
        if (r < I_IN) { conv_item_win(w_in, (bf16*)(ws + WS_WIN), ws + WS_WIN8, scr, r / NB_IN, r % NB_IN, lane); continue; } r -= I_IN;
        if (r < I_UK) { const int h = r >> 4, q = r & 15; conv_item<0>(w_uk + (size_t)h * HD * CKV, CKV, (bf16*)(ws + WS_WUK) + (size_t)(h * 256) * 256 + (h & 1) * 128, 256, scr, q >> 3, q & 7, lane); continue; } r -= I_UK;
        if (r < I_UV) { const int h = r >> 4, q = r & 15; conv_item<0>(w_uv + (size_t)h * CKV * HD, HD, (bf16*)(ws + WS_WUV) + (size_t)(h * 128) * 512 + (h & 1) * 256, 512, scr, q >> 2, q & 3, lane); continue; } r -= I_UV;
        if (r < I_OA) { conv_item8<0>(w_oa, D, ws + WS_WOA, 1024, scr, r >> 6, r & 63, lane, F8_SWO); continue; } r -= I_OA;
        if (r < I_OA) { conv_item8<0>(w_ob, D, ws + WS_WOB, 1024, scr, r >> 6, r & 63, lane, F8_SWO); continue; } r -= I_OA;
        if (r < I_OUT) { conv_item8<0>(w_out, D, ws + WS_WOUT, D, scr, r >> 6, r & 63, lane, F8_SWOUT); continue; } r -= I_OUT;
        if (r < I_QM) { conv_item8<0>(w_qm, 512, ws + WS_WQM, D, scr, r >> 4, r & 15, lane, F8_SWQM); continue; } r -= I_QM;
        if (r < I_OM) { conv_item8<0>(w_om, D, ws + WS_WOM, 512, scr, r >> 6, r & 63, lane, F8_SWOM); continue; } r -= I_OM;
        if (r < I_F1) { conv_item8<2>(w_f1, 2 * DFF, ws + WS_WF1, D, scr, r / 352, r % 352, lane, F8_SW1); continue; } r -= I_F1;
        if (r < I_F2) { conv_item8<0>(w_f2, D, ws + WS_WF2, DFF, scr, r >> 6, r & 63, lane, F8_SW2); continue; } r -= I_F2;
        { const int ll = r >> 10, q = r & 1023; conv_item<0>(a.in[13] + (size_t)ll * D * 1024, 1024, (bf16*)(ws + WS_WKV) + (size_t)ll * 1024 * D, D, scr, q >> 5, q & 31, lane); }
    }
    const int gt = F.bx * NTHREADS + F.tid, ngt = F.G * NTHREADS;
    zero_rows((bf16*)(ws + WS_WIN) + (size_t)1104 * D, 176, D, D, gt, ngt);
    for (int h = 0; h < NH; ++h) {
        zero_rows((bf16*)(ws + WS_WUK) + (size_t)(h * 256) * 256 + ((h + 1) & 1) * 128, 256, 128, 256, gt, ngt);
        zero_rows((bf16*)(ws + WS_WUV) + (size_t)(h * 128) * 512 + ((h + 1) & 1) * 256, 128, 256, 512, gt, ngt);
    }
    if (l == 0) {
        const f32x4* xs = (const f32x4*)a.in[0]; u32x2* xb = (u32x2*)(ws + WS_XB);
        unsigned* xb8 = (unsigned*)(ws + WS_XB8);
        for (int i0 = gt; i0 < S * D / 4; i0 += 8 * ngt) {
            f32x4 v[8];
#pragma unroll
            for (int q = 0; q < 8; ++q) v[q] = __builtin_nontemporal_load(xs + i0 + q * ngt);
#pragma unroll
            for (int q = 0; q < 8; ++q) { const int i = i0 + q * ngt; u32x2 w; w.x = pk2(v[q][0], v[q][1]); w.y = pk2(v[q][2], v[q][3]); xb[i] = w; xb8[i] = pk4_fp8(v[q][0], v[q][1], v[q][2], v[q][3]); } }
        static_assert((S * D / 4) % (8 * 256 * NTHREADS) == 0, "x copy tiling");
        const f32x4* ms = (const f32x4*)a.in[1]; u32x2* mb = (u32x2*)(ws + WS_MEMB);
        for (int i = gt; i < NMEM * D / 4; i += ngt) { const f32x4 v = ms[i]; u32x2 w; w.x = pk2(v[0], v[1]); w.y = pk2(v[2], v[3]); mb[i] = w; }
    }
}

DI void norm_phase(const Frame& F, const Args& a, int l) {
    const int gw = F.bx * NWAVES + F.wave, NGW = F.G * NWAVES, lane = F.lane;
    const float* ckv = (const float*)(F.ws + WS_CKVRAW); const float* kw = (const float*)(F.ws + WS_KWRAW);
    const float* kvg = a.in[4] + l * CKV; const float* ig = a.in[5] + l * IDIM; const float* ib = a.in[6] + l * IDIM;
    const f32x4 g4 = *(const f32x4*)(kvg + 4 * lane); const float gi = ig[lane], bi = ib[lane];
    for (int t0 = gw; t0 < S; t0 += 4 * NGW) {
        f32x4 v[4]; float k[4], wq[4];
#pragma unroll
        for (int i = 0; i < 4; ++i) { const int t = t0 + i * NGW; const bool ok = t < S; const size_t tt = ok ? (size_t)t : (size_t)gw;
            v[i] = *(const f32x4*)(ckv + tt * 256 + 4 * lane); k[i] = kw[tt * 256 + lane]; wq[i] = kw[tt * 256 + 64 + (lane & 15)]; }
#pragma unroll
        for (int i = 0; i < 4; ++i) { const int t = t0 + i * NGW; if (t >= S) break;
            const float ss = wave_sum(v[i][0] * v[i][0] + v[i][1] * v[i][1] + v[i][2] * v[i][2] + v[i][3] * v[i][3]);
            const float r = 1.0f / sqrtf(ss * (1.0f / CKV) + LN_EPS);
            *(unsigned*)(F.ws + WS_CKVN + (size_t)t * 256 + 4 * lane) = pk4_fp8(v[i][0] * r * g4[0], v[i][1] * r * g4[1], v[i][2] * r * g4[2], v[i][3] * r * g4[3]);
            const float mu = wave_sum(k[i]) * (1.0f / IDIM); const float d = k[i] - mu; const float var = wave_sum(d * d) * (1.0f / IDIM);
            const float kn = d * (1.0f / sqrtf(var + LN_EPS)) * gi + bi;
            ((bf16*)(F.ws + WS_KIDXN))[(size_t)t * 64 + lane] = (bf16)f2bf(kn);
            if (lane < IH) ((float*)(F.ws + WS_WIDX))[(size_t)t * IH + lane] = wq[i]; }
    }
    const bf16* km = (const bf16*)(F.ws + WS_KM);
    for (int u = gw; u < NH * NBLK; u += NGW) {
        const int h = u >> 6, b = u & 63; float s[8] = {0.f, 0.f, 0.f, 0.f, 0.f, 0.f, 0.f, 0.f};
        const u32x4* p = (const u32x4*)(km + (size_t)(b * MBLK + (lane >> 4)) * 1024 + h * HD + 8 * (lane & 15));
#pragma unroll 16
        for (int i = 0; i < MBLK / 4; ++i) { const u32x4 v = p[(size_t)i * (4 * 1024 / 8)];
            s[0] += bflo(v.x); s[1] += bfhi(v.x); s[2] += bflo(v.y); s[3] += bfhi(v.y); s[4] += bflo(v.z); s[5] += bfhi(v.z); s[6] += bflo(v.w); s[7] += bfhi(v.w); }
#pragma unroll
        for (int e = 0; e < 8; ++e) s[e] = xrow16_sum(s[e]);
        if (lane < 16) { float* o = (float*)(F.ws + WS_KMEAN) + (size_t)(h * NBLK + b) * HD + 8 * lane;
            *(f32x4*)o = (f32x4){s[0], s[1], s[2], s[3]} * (1.0f / MBLK); *(f32x4*)(o + 4) = (f32x4){s[4], s[5], s[6], s[7]} * (1.0f / MBLK); }
    }
}

DI void moba_gate_phase(const Frame& F, int l) {
    LAS float* km = (LAS float*)F.lds; LAS unsigned* lcnt = (LAS unsigned*)(F.lds + 32768); LAS unsigned* gbase = lcnt + 64;
    const bf16* qm = (const bf16*)(F.ws + WS_QM); const float* kmean = (const float*)(F.ws + WS_KMEAN);
    unsigned* bcnt = (unsigned*)(F.ctl + CW_BCNT) + l * 512; unsigned* buck = (unsigned*)(F.ws + WS_BUCK);
    for (int u = F.bx; u < NH * 32; u += F.G) {
        const int h = u & 7, ip = u >> 3; const int own = (F.tid < 256) ? ip : 63 - ip; const int t = own * 256 + (F.tid & 255);
        f32x4 kmv[4];
#pragma unroll
        for (int j = 0; j < 4; ++j) kmv[j] = ((const f32x4*)(kmean + (size_t)h * NBLK * HD))[F.tid + j * NTHREADS];
        u32x4 qraw[16];
        { const u32x4* qp = (const u32x4*)(qm + (size_t)t * 1024 + h * HD);
#pragma unroll
          for (int c = 0; c < 16; ++c) qraw[c] = qp[c]; }
        __syncthreads();
#pragma unroll
        for (int j = 0; j < 4; ++j) ((LAS f32x4*)km)[F.tid + j * NTHREADS] = kmv[j];
        if (F.tid < 64) lcnt[F.tid] = 0u;
        __syncthreads();
        float q[HD];
        {
#pragma unroll
          for (int c = 0; c < 16; ++c) { const u32x4 qv = qraw[c]; q[8 * c + 0] = bflo(qv.x); q[8 * c + 1] = bfhi(qv.x); q[8 * c + 2] = bflo(qv.y); q[8 * c + 3] = bfhi(qv.y);
              q[8 * c + 4] = bflo(qv.z); q[8 * c + 5] = bfhi(qv.z); q[8 * c + 6] = bflo(qv.w); q[8 * c + 7] = bfhi(qv.w); } }
        const float NEG = -__builtin_inff(); float v0 = NEG, v1 = NEG, v2 = NEG; int i0 = -1, i1 = -1, i2 = -1;
        const int bmax = __builtin_amdgcn_readfirstlane(own);
#pragma unroll 4
        for (int b = 0; b < bmax; ++b) {
            const LAS f32x4* kr = (const LAS f32x4*)(km + b * HD);
            float d0 = 0.f, d1 = 0.f, d2 = 0.f, d3 = 0.f;
#pragma unroll
            for (int c = 0; c < 32; ++c) { const f32x4 k = kr[c]; d0 += q[4 * c] * k[0]; d1 += q[4 * c + 1] * k[1]; d2 += q[4 * c + 2] * k[2]; d3 += q[4 * c + 3] * k[3]; }
            const float g = (d0 + d1) + (d2 + d3);
            if (g > v0) { v2 = v1; i2 = i1; v1 = v0; i1 = i0; v0 = g; i0 = b; } else if (g > v1) { v2 = v1; i2 = i1; v1 = g; i1 = b; } else if (g > v2) { v2 = g; i2 = b; }
        }
        unsigned lp0 = 0, lp1 = 0, lp2 = 0;
        if (i0 >= 0) lp0 = atomicAdd((unsigned*)&lcnt[i0], 1u);
        if (i1 >= 0) lp1 = atomicAdd((unsigned*)&lcnt[i1], 1u);
        if (i2 >= 0) lp2 = atomicAdd((unsigned*)&lcnt[i2], 1u);
        __syncthreads();
        if (F.tid < 64) { const unsigned c = lcnt[F.tid]; gbase[F.tid] = c ? __hip_atomic_fetch_add(bcnt + h * 64 + F.tid, c, RLX_AGENT) : 0u; }
        __syncthreads();
        unsigned* bh = buck + (size_t)h * BUCK_PER_HEAD;
        if (i0 >= 0) bh[bucket_off(i0) + gbase[i0] + lp0] = ((unsigned)t << 2) | 0u;
        if (i1 >= 0) bh[bucket_off(i1) + gbase[i1] + lp1] = ((unsigned)t << 2) | 1u;
        if (i2 >= 0) bh[bucket_off(i2) + gbase[i2] + lp2] = ((unsigned)t << 2) | 2u;
    }
    __syncthreads();
}

constexpr int IX_KSTRIDE = 144, IX_KBUF = 128 * IX_KSTRIDE;
constexpr int IX_WSTRIDE = 2048 + 64;
constexpr int IX_CSC = 2 * IX_KBUF;
constexpr int IX_CIX = IX_CSC + 8 * IX_WSTRIDE * 4;
static_assert(IX_CIX + 8 * IX_WSTRIDE * 2 <= MISC_OFF, "indexer LDS");
static_assert((size_t)4 * (CW_LNCNT + DEPTH * 3 * 64 * 64) <= CTL_ZERO_BYTES && (size_t)4 * (CW_BCNT + DEPTH * 512) <= CTL_ZERO_BYTES, "control words inside the per-call reset");
DI unsigned sortable(float f) { const unsigned u = __float_as_uint(f); return (u >> 31) ? ~u : (u | 0x80000000u); }
DI float unsortable(unsigned k) { return __uint_as_float((k >> 31) ? (k ^ 0x80000000u) : ~k); }
DI unsigned popc64(unsigned long long m) { return (unsigned)__builtin_popcountll(m); }
DI unsigned mbcnt64(unsigned long long m) { return __builtin_amdgcn_mbcnt_hi((unsigned)(m >> 32), __builtin_amdgcn_mbcnt_lo((unsigned)m, 0u)); }
template <int APPROX> DI float ix_compact(LAS float* sc, LAS unsigned short* ix, int& n, int lane) {
    unsigned key[16]; unsigned short idv[16];
    const bool big = n > 512;
    unsigned kmax = 0u, kmin = 0xFFFFFFFFu;
#pragma unroll
    for (int j = 0; j < 16; ++j) { const int e = j * 64 + lane; key[j] = 0u; idv[j] = 0;
        if (j < 8 || big) { const bool v = e < n; key[j] = v ? sortable(sc[e]) : 0u; idv[j] = ix[e]; kmax = key[j] > kmax ? key[j] : kmax; const unsigned km = v ? key[j] : 0xFFFFFFFFu; kmin = km < kmin ? km : kmin; } }
    kmax = wave_umax(kmax); kmin = wave_umin(kmin);
    const unsigned diff = (unsigned)__builtin_amdgcn_readfirstlane((int)(kmax ^ kmin));
    const int nb = diff ? 32 - __builtin_clz(diff) : 0;
    unsigned cur = (unsigned)__builtin_amdgcn_readfirstlane((int)kmax); cur = nb >= 32 ? 0u : (cur >> nb) << nb;
    unsigned ccur = (unsigned)n;
    for (int b = nb - 1; b >= 0; --b) {
        const unsigned trial = cur | (1u << b); unsigned c = 0;
#pragma unroll
        for (int j = 0; j < 8; ++j) c += popc64(__ballot(key[j] >= trial));
        if (big) {
#pragma unroll
            for (int j = 8; j < 16; ++j) c += popc64(__ballot(key[j] >= trial)); }
        if (c >= (unsigned)TOPK) { cur = trial; ccur = c; if (APPROX && c <= 320u) break; }
    }
    unsigned need_eq = 0x7fffffffu;
    if (!APPROX) { unsigned ngt = 0;
#pragma unroll
        for (int j = 0; j < 16; ++j) ngt += popc64(__ballot(key[j] > cur));
        need_eq = (unsigned)TOPK - ngt; }
    unsigned out = 0, eqseen = 0;
#pragma unroll
    for (int j = 0; j < 16; ++j) {
        if (j < 8 || big) {
            const bool valid = (j * 64 + lane) < n; const bool gt = key[j] > cur, eq = valid && key[j] == cur;
            const unsigned long long em = __ballot(eq); const bool keep = (valid && gt) || (eq && (eqseen + mbcnt64(em)) < need_eq);
            const unsigned long long kmk = __ballot(keep); const unsigned pos = out + mbcnt64(kmk);
            if (keep) { sc[pos] = unsortable(key[j]); ix[pos] = idv[j]; }
            out += popc64(kmk); eqseen += popc64(em);
        }
    }
    n = (int)out; (void)ccur;
    return unsortable(cur);
}
DI float relu_nc(float x) { const int b = __float_as_int(x); return __int_as_float(b > 0 ? b : 0); }
#define IX_SCORE(ACC, KEY0, S_) do { \
    f32x2 s0_ = {0.f, 0.f}, s1_ = {0.f, 0.f}; \
    _Pragma("unroll") for (int i_ = 0; i_ < 4; ++i_) { const f32x2 r0_ = {relu_nc(ACC[2 * i_]), relu_nc(ACC[2 * i_ + 1])}, r1_ = {relu_nc(ACC[8 + 2 * i_]), relu_nc(ACC[9 + 2 * i_])}; \
        s0_ = __builtin_elementwise_fma(r0_, wv2[i_], s0_); s1_ = __builtin_elementwise_fma(r1_, wv2[4 + i_], s1_); } \
    const auto sw_ = __builtin_amdgcn_permlane32_swap(__float_as_uint(s0_[0] + s0_[1]), __float_as_uint(s1_[0] + s1_[1]), false, false); \
    S_ = __uint_as_float(sw_[0]) + __uint_as_float(sw_[1]); \
    S_ = ((KEY0) + r) <= tq ? S_ : NEG; } while (0)
#define IX_APPEND(S_, KEY0) do { \
    const bool pass_ = S_ > thr; \
    const unsigned long long mk_ = __ballot(pass_); \
    if (IX_DRY) { dry_acc += S_; } else { \
        const unsigned mlo_ = (unsigned)mk_, mhi_ = (unsigned)(mk_ >> 32); const int nlo_ = __builtin_popcount(mlo_), nhi_ = __builtin_popcount(mhi_); \
        const unsigned base_ = hh ? (unsigned)(cnt1 - nlo_ + 1024) : (unsigned)cnt0; \
        const unsigned pos_ = __builtin_amdgcn_mbcnt_hi(mhi_, __builtin_amdgcn_mbcnt_lo(mlo_, base_)); \
        const unsigned idx_ = pass_ ? pos_ : (unsigned)(2048 + lane);            \
        csc[idx_] = S_; cix[idx_] = (unsigned short)((KEY0) + r); \
        cnt0 += nlo_; cnt1 += nhi_; \
        if ((cnt0 > cnt1 ? cnt0 : cnt1) > 1024 - 64) { \
            if (cnt0 > 1024 - 64) { const float nt_ = ix_compact<1>(csc, cix, cnt0, lane); thr = hh ? thr : nt_; } \
            if (cnt1 > 1024 - 64) { const float nt_ = ix_compact<1>(csc + 1024, cix + 1024, cnt1, lane); thr = hh ? nt_ : thr; } } \
    } } while (0)
#define IX_PROCESS(ACC, KEY0) do { float sc_; IX_SCORE(ACC, KEY0, sc_); IX_APPEND(sc_, KEY0); } while (0)
#define IX_APPEND2(SA_, KEYA, SB_, KEYB) do { \
    if (IX_DRY) { dry_acc += SA_ + SB_; } else { \
        const bool pa_ = SA_ > thr, pb_ = SB_ > thr; \
        const unsigned long long ma_ = __ballot(pa_), mb_ = __ballot(pb_); \
        const unsigned alo_ = (unsigned)ma_, ahi_ = (unsigned)(ma_ >> 32), blo_ = (unsigned)mb_, bhi_ = (unsigned)(mb_ >> 32); \
        const int nal_ = __builtin_popcount(alo_), nah_ = __builtin_popcount(ahi_), nbl_ = __builtin_popcount(blo_), nbh_ = __builtin_popcount(bhi_); \
        const unsigned basea_ = hh ? (unsigned)(cnt1 - nal_ + 1024) : (unsigned)cnt0; \
        const unsigned baseb_ = hh ? (unsigned)(cnt1 + nah_ - nbl_ + 1024) : (unsigned)(cnt0 + nal_); \
        const unsigned posa_ = __builtin_amdgcn_mbcnt_hi(ahi_, __builtin_amdgcn_mbcnt_lo(alo_, basea_)), posb_ = __builtin_amdgcn_mbcnt_hi(bhi_, __builtin_amdgcn_mbcnt_lo(blo_, baseb_)); \
        const unsigned ia_ = pa_ ? posa_ : (unsigned)(2048 + lane), ib_ = pb_ ? posb_ : (unsigned)(2048 + lane); \
        csc[ia_] = SA_; cix[ia_] = (unsigned short)((KEYA) + r); csc[ib_] = SB_; cix[ib_] = (unsigned short)((KEYB) + r); \
        cnt0 += nal_ + nbl_; cnt1 += nah_ + nbh_; \
        if ((cnt0 > cnt1 ? cnt0 : cnt1) > 1024 - 64) { \
            if (cnt0 > 1024 - 64) { const float nt_ = ix_compact<1>(csc, cix, cnt0, lane); thr = hh ? thr : nt_; } \
            if (cnt1 > 1024 - 64) { const float nt_ = ix_compact<1>(csc + 1024, cix + 1024, cnt1, lane); thr = hh ? nt_ : thr; } } \
    } } while (0)
#define IX_APPEND2NC(SA_, KEYA, SB_, KEYB) do { \
    if (IX_DRY) { dry_acc += SA_ + SB_; } else { \
        const bool pa_ = SA_ > thr, pb_ = SB_ > thr; \
        const unsigned long long ma_ = __ballot(pa_), mb_ = __ballot(pb_); \
        const unsigned alo_ = (unsigned)ma_, ahi_ = (unsigned)(ma_ >> 32), blo_ = (unsigned)mb_, bhi_ = (unsigned)(mb_ >> 32); \
        const int nal_ = __builtin_popcount(alo_), nah_ = __builtin_popcount(ahi_), nbl_ = __builtin_popcount(blo_), nbh_ = __builtin_popcount(bhi_); \
        const unsigned basea_ = hh ? (unsigned)(cnt1 - nal_ + 1024) : (unsigned)cnt0; \
        const unsigned baseb_ = hh ? (unsigned)(cnt1 + nah_ - nbl_ + 1024) : (unsigned)(cnt0 + nal_); \
        const unsigned posa_ = __builtin_amdgcn_mbcnt_hi(ahi_, __builtin_amdgcn_mbcnt_lo(alo_, basea_)), posb_ = __builtin_amdgcn_mbcnt_hi(bhi_, __builtin_amdgcn_mbcnt_lo(blo_, baseb_)); \
        const unsigned ia_ = pa_ ? posa_ : (unsigned)(2048 + lane), ib_ = pb_ ? posb_ : (unsigned)(2048 + lane); \
        csc[ia_] = SA_; cix[ia_] = (unsigned short)((KEYA) + r); csc[ib_] = SB_; cix[ib_] = (unsigned short)((KEYB) + r); \
        cnt0 += nal_ + nbl_; cnt1 += nah_ + nbh_; \
    } } while (0)
#define IX_OVF() do { if (!IX_DRY && (cnt0 > cnt1 ? cnt0 : cnt1) > 1024 - 64) { \
    if (cnt0 > 1024 - 64) { const float nt_ = ix_compact<1>(csc, cix, cnt0, lane); thr = hh ? thr : nt_; } \
    if (cnt1 > 1024 - 64) { const float nt_ = ix_compact<1>(csc + 1024, cix + 1024, cnt1, lane); thr = hh ? nt_ : thr; } } } while (0)
#define IX_MMA(ACC, KB, TILE) do { \
    _Pragma("unroll") for (int i_ = 0; i_ < 16; ++i_) ACC[i_] = 0.f; \
    _Pragma("unroll") for (int kk_ = 0; kk_ < 4; ++kk_) { const bf16x8 b_ = *(const LAS bf16x8*)((KB) + boff + (TILE) * (32 * IX_KSTRIDE) + kk_ * 32); \
        ACC = __builtin_amdgcn_mfma_f32_32x32x16_bf16(af[kk_], b_, ACC, 0, 0, 0); } } while (0)
#define IX_LDB(FR, KB, TILE) do { _Pragma("unroll") for (int kk_ = 0; kk_ < 4; ++kk_) FR[kk_] = *(const LAS bf16x8*)((KB) + boff + (TILE) * (32 * IX_KSTRIDE) + kk_ * 32); } while (0)
#define IX_MMAR(ACC, FR) do { \
    _Pragma("unroll") for (int i_ = 0; i_ < 16; ++i_) ACC[i_] = 0.f; \
    _Pragma("unroll") for (int kk_ = 0; kk_ < 4; ++kk_) ACC = __builtin_amdgcn_mfma_f32_32x32x16_bf16(af[kk_], FR[kk_], ACC, 0, 0, 0); } while (0)
#define IX_STEP(KB, T0, ACCN0, ACCN1, ACCP0, ACCP1, KEYP) do { \
    bf16x8 fa_[4], fb_[4]; float qa_, qb_; \
    IX_LDB(fa_, KB, T0); IX_LDB(fb_, KB, (T0) + 1); \
    IX_MMAR(ACCN0, fa_); IX_SCORE(ACCP0, KEYP, qa_); IX_MMAR(ACCN1, fb_); IX_SCORE(ACCP1, (KEYP) + 32, qb_); \
    IX_APPEND2NC(qa_, KEYP, qb_, (KEYP) + 32); \
    IX_OVF(); } while (0)
#define IX_MMA2(KB, T0, ACCN0, ACCN1) do { bf16x8 fa_[4], fb_[4]; IX_LDB(fa_, KB, T0); IX_LDB(fb_, KB, (T0) + 1); IX_MMAR(ACCN0, fa_); IX_MMAR(ACCN1, fb_); } while (0)
#define IX_TAIL(ACCP0, ACCP1, KEYP) do { float qa_, qb_; IX_SCORE(ACCP0, KEYP, qa_); IX_SCORE(ACCP1, (KEYP) + 32, qb_); IX_APPEND2NC(qa_, KEYP, qb_, (KEYP) + 32); } while (0)
#define IX_MMAR_SCORE(ACCN, FR, ACCC, KEY0, S_) do { IX_MMAR(ACCN, FR); IX_SCORE(ACCC, KEY0, S_); \
    _Pragma("unroll") for (int g_ = 0; g_ < 4; ++g_) { __builtin_amdgcn_sched_group_barrier(0x008, 1, 0); __builtin_amdgcn_sched_group_barrier(0x002, 10, 0); } } while (0)
#define IX_SCHED(CH) do { if (!IX_DRY && (((CH) + 1) == 16 || ((CH) + 1) == 32 || ((CH) + 1) == 64)) { \
    if (cnt0 > 320) { const float nt_ = ix_compact<1>(csc, cix, cnt0, lane); thr = hh ? thr : nt_; } \
    if (cnt1 > 320) { const float nt_ = ix_compact<1>(csc + 1024, cix + 1024, cnt1, lane); thr = hh ? nt_ : thr; } } } while (0)
#define IX_CHUNK(KB, CH) do { \
    int nt_w = ((ta + 1 - (CH) * 128) >> 5) + 1; nt_w = nt_w < 0 ? 0 : (nt_w > 4 ? 4 : nt_w); \
    f32x16 accA, accB; \
    if (nt_w == 4) { float qa_, qb_, qc_, qd_; bf16x8 fr0[4], fr1[4], fr2[4], fr3[4]; f32x16 accC, accD;     \
        IX_LDB(fr0, KB, 0); IX_LDB(fr1, KB, 1); IX_LDB(fr2, KB, 2); IX_LDB(fr3, KB, 3); \
        IX_MMAR(accA, fr0); IX_MMAR(accB, fr1); \
        IX_MMAR(accC, fr2); IX_MMAR(accD, fr3); IX_SCORE(accA, (CH) * 128, qa_); IX_SCORE(accB, (CH) * 128 + 32, qb_); \
        IX_APPEND2(qa_, (CH) * 128, qb_, (CH) * 128 + 32); \
        IX_SCORE(accC, (CH) * 128 + 64, qc_); IX_SCORE(accD, (CH) * 128 + 96, qd_); \
        IX_APPEND2(qc_, (CH) * 128 + 64, qd_, (CH) * 128 + 96); \
    } else if (nt_w > 0) { IX_MMA(accA, KB, 0); \
        if (nt_w > 1) IX_MMA(accB, KB, 1); \
        IX_PROCESS(accA, (CH) * 128); \
        if (nt_w > 1) { if (nt_w > 2) IX_MMA(accA, KB, 2); \
            IX_PROCESS(accB, (CH) * 128 + 32); \
            if (nt_w > 2) IX_PROCESS(accA, (CH) * 128 + 64); } } } while (0)
#define IX_LDSBAR() do { asm volatile("s_waitcnt lgkmcnt(0)" ::: "memory"); __builtin_amdgcn_s_barrier(); asm volatile("" ::: "memory"); } while (0)
DI void indexer_phase(const Frame& F) {
    const int lane = F.lane, wave = F.wave, tid = F.tid, r = lane & 31, hh = lane >> 5;
    const bf16* qidx = (const bf16*)(F.ws + WS_QIDX); const bf16* kidx = (const bf16*)(F.ws + WS_KIDXN); const float* widx = (const float*)(F.ws + WS_WIDX);
    unsigned short* sel = (unsigned short*)(F.ws + WS_SEL);
    LAS float* csc = (LAS float*)(F.lds + IX_CSC) + wave * IX_WSTRIDE; LAS unsigned short* cix = (LAS unsigned short*)(F.lds + IX_CIX) + wave * IX_WSTRIDE;
    const float NEG = -__builtin_inff();
    const unsigned boff = (unsigned)(r * IX_KSTRIDE + hh * 16);
    const unsigned sg0 = (unsigned)((tid >> 3) * 64 + (tid & 7) * 8), sl0 = (unsigned)((tid >> 3) * IX_KSTRIDE + (tid & 7) * 16);
    LAS unsigned char* const kb0 = F.lds, * const kb1 = F.lds + IX_KBUF;
#define IX_LOAD(R, CHK) do { const int c_ = (CHK) < nch ? (CHK) : nch - 1; const bf16* g_ = kidx + (size_t)c_ * (128 * 64) + sg0; R[0] = *(const u32x4*)g_; R[1] = *(const u32x4*)(g_ + 64 * 64); } while (0)
#define IX_STORE(KB, R) do { *(LAS u32x4*)((KB) + sl0) = R[0]; *(LAS u32x4*)((KB) + sl0 + 64 * IX_KSTRIDE) = R[1]; } while (0)
    for (int ui = 0; ui * F.G < S / 16; ++ui) {
        const int unit = ui * F.G + ((ui & 1) ? F.G - 1 - F.bx : F.bx);
        if (unit >= S / 16) continue;
        const int t0 = unit * 16, nkeys = t0 + 16, nch = (nkeys + 127) >> 7;
        const int ta = t0 + 2 * wave;
        bf16x8 af[4];
#pragma unroll
        for (int kk = 0; kk < 4; ++kk) af[kk] = *(const bf16x8*)(qidx + (size_t)(ta + (r >> 4)) * 1024 + (r & 15) * 64 + 16 * kk + 8 * hh);
        f32x2 wv2[8];
#pragma unroll
        for (int i = 0; i < 8; ++i) { const int e0 = 2 * i, e1 = 2 * i + 1;
            wv2[i] = (f32x2){widx[(size_t)(ta + (e0 >> 3)) * IH + (e0 & 3) + 8 * ((e0 >> 2) & 1) + 4 * hh], widx[(size_t)(ta + (e1 >> 3)) * IH + (e1 & 3) + 8 * ((e1 >> 2) & 1) + 4 * hh]}; }
        float thr = NEG; int cnt0 = 0, cnt1 = 0; const int tq = ta + hh;
        float dry_acc = 0.f; (void)dry_acc;
#define IX_DRY 0
        {
        u32x4 RA[2], RB[2];
        f32x16 aP0, aP1, aQ0, aQ1;
        IX_LOAD(RA, 0); IX_LOAD(RB, 1);
        IX_STORE(kb0, RA); IX_LOAD(RA, 2);
        for (int ch = 0; ch < nch; ch += 2) {
            IX_LDSBAR();
            if (ch == 0) { IX_MMA2(kb0, 0, aP0, aP1); }
            else { IX_STEP(kb0, 0, aP0, aP1, aQ0, aQ1, (ch - 1) * 128 + 64); IX_SCHED(ch - 1); }
            IX_STEP(kb0, 2, aQ0, aQ1, aP0, aP1, ch * 128);
            IX_STORE(kb1, RB); IX_LOAD(RB, ch + 3);
            IX_LDSBAR();
            if (ch + 1 < nch) {
                IX_STEP(kb1, 0, aP0, aP1, aQ0, aQ1, ch * 128 + 64); IX_SCHED(ch);
                IX_STEP(kb1, 2, aQ0, aQ1, aP0, aP1, (ch + 1) * 128);
            }
            IX_STORE(kb0, RA); IX_LOAD(RA, ch + 4);
        }
        IX_TAIL(aQ0, aQ1, (nch - 1) * 128 + 64);
        }
#undef IX_DRY
        if (cnt0 > TOPK) (void)ix_compact<0>(csc, cix, cnt0, lane);
        if (cnt1 > TOPK) (void)ix_compact<0>(csc + 1024, cix + 1024, cnt1, lane);
#pragma unroll
        for (int q = 0; q < 2; ++q) { const int n = q ? cnt1 : cnt0;
#pragma unroll
            for (int j = 0; j < 4; ++j) { const int e = j * 64 + lane; sel[(size_t)(ta + q) * TOPK + e] = e < n ? cix[q * 1024 + e] : (unsigned short)0xFFFFu; } }
        __syncthreads();
    }
#undef IX_LOAD
#undef IX_STORE
}
#undef IX_PROCESS
#undef IX_SCORE
#undef IX_APPEND
#undef IX_MMAR_SCORE
#undef IX_STEP
#undef IX_MMA2
#undef IX_TAIL
#undef IX_OVF
#undef IX_APPEND2NC
#undef IX_MMAR
#undef IX_LDB
#undef IX_MMA
#undef IX_CHUNK
#undef IX_SCHED

constexpr int DA_WBYTES = 16384 + 256;
DI void dsa_attn_phase(const Frame& F) {
    const int lane = F.lane, fr = lane & 15, fq = lane >> 4;
    const bf16* qlat = (const bf16*)(F.ws + WS_QLAT); const bf16* ckv = (const bf16*)(F.ws + WS_CKVN); const unsigned short* sel = (const unsigned short*)(F.ws + WS_SEL);
    bf16* olat = (bf16*)(F.ws + WS_OLAT);
    LAS unsigned char* img = F.lds + F.wave * DA_WBYTES; LAS float* dist = (LAS float*)(img + 16384);
    const unsigned imgaddr = (unsigned)(size_t)img;
    const float slope2 = __builtin_amdgcn_exp2f(-(float)((fr & 7) + 1)) * LOG2E;
    const int gw = F.bx * NWAVES + F.wave, NGW = F.G * NWAVES;
    unsigned kb[2], vb[2];
#pragma unroll
    for (int kt = 0; kt < 2; ++kt) kb[kt] = imgaddr + off_b(perm32rows(16 * kt + fr), fq) - 64u * (unsigned)(fr & 3);
    const unsigned kx = (unsigned)(fr & 3);
#pragma unroll
    for (int tt = 0; tt < 2; ++tt) { const unsigned a0 = tr_addr16(lane, 0, 0, tt); vb[tt] = imgaddr + a0; }
    const unsigned xh = (((unsigned)(lane & 15) >> 2) << 1) | (unsigned)((lane >> 4) & 1);
#pragma unroll
    for (int tt = 0; tt < 2; ++tt) vb[tt] -= 32u * xh;
    for (int t = gw; t < S; t += NGW) {
        const int nvalid = t + 1 < TOPK ? t + 1 : TOPK;
        bf16x8 qf[8];
#pragma unroll
        for (int kk = 0; kk < 8; ++kk) { qf[kk] = (bf16x8){0, 0, 0, 0, 0, 0, 0, 0}; if (fr < 8) qf[kk] = *(const bf16x8*)(qlat + (size_t)t * 2048 + fr * 256 + 32 * kk + 8 * fq); }
        f32x4 o[16];
#pragma unroll
        for (int c = 0; c < 16; ++c) o[c] = (f32x4){0.f, 0.f, 0.f, 0.f};
        float m = -__builtin_inff(), lsum = 0.f;
        int idxn; { const int e = (lane & 31); const int si = sel[(size_t)t * TOPK + e]; idxn = e < nvalid ? si : 0; }
        const unsigned char* ckv8 = (const unsigned char*)ckv;
        u32x4 gA[8];
#pragma unroll
        for (int i = 0; i < 8; ++i) { const int row = (lane >> 4) + 4 * i; const int ki = __builtin_amdgcn_ds_bpermute(row << 2, idxn); gA[i] = *(const u32x4*)(ckv8 + (size_t)ki * 256 + (lane & 15) * 16); }
        for (int ch = 0; ch < 8; ++ch) {
            unsigned xhl = xh, kxl = kx; asm volatile("" : "+v"(xhl), "+v"(kxl));
            const int myidx = idxn;
            if (ch < 7) { const int e = (ch + 1) * 32 + (lane & 31); const int si = sel[(size_t)t * TOPK + e]; idxn = e < nvalid ? si : 0; }
#pragma unroll
            for (int i = 0; i < 8; ++i) { const unsigned row = (lane >> 4) + 4 * i, p = lane & 15, prow = perm32rows(row); const u32x4 g = gA[i]; unsigned w[8];
#pragma unroll
                for (int q = 0; q < 4; ++q) { const f32x2 lo = __builtin_amdgcn_cvt_pk_f32_fp8((int)g[q], false), hi = __builtin_amdgcn_cvt_pk_f32_fp8((int)g[q], true); w[2 * q] = cvt_pk_bf16(lo[0], lo[1]); w[2 * q + 1] = cvt_pk_bf16(hi[0], hi[1]); }
                LAS unsigned char* hb = img + (p >> 3) * 8192;
                *(LAS u32x4*)(hb + off_b(prow, 2 * (p & 7))) = (u32x4){w[0], w[1], w[2], w[3]}; *(LAS u32x4*)(hb + off_b(prow, 2 * (p & 7) + 1)) = (u32x4){w[4], w[5], w[6], w[7]}; }
            if (lane < 32) { const int e = ch * 32 + lane; dist[lane] = e < nvalid ? (float)(t - myidx) : __builtin_inff(); }
            if (ch < 7) {
#pragma unroll
                for (int i = 0; i < 8; ++i) { const int row = (lane >> 4) + 4 * i; const int ki = __builtin_amdgcn_ds_bpermute(row << 2, idxn); gA[i] = *(const u32x4*)(ckv8 + (size_t)ki * 256 + (lane & 15) * 16); } }
            f32x4 sacc[2] = {(f32x4){0.f, 0.f, 0.f, 0.f}, (f32x4){0.f, 0.f, 0.f, 0.f}};
            {
                bf16x8 kf[8];
#define DSA_KLD(J_) kf[(J_) & 7] = *(const LAS bf16x8*)(kb[(J_) & 1] + 64u * ((unsigned)(((J_) >> 1) & 3) ^ kxl) + 8192u * ((J_) >> 3))
                DSA_KLD(0); DSA_KLD(1); DSA_KLD(2); DSA_KLD(3);
#pragma unroll
                for (int j = 0; j < 16; ++j) { if (j + 4 < 16) DSA_KLD(j + 4);
                    sacc[j & 1] = __builtin_amdgcn_mfma_f32_16x16x32_bf16(kf[j & 7], qf[j >> 1], sacc[j & 1], 0, 0, 0);
                    __builtin_amdgcn_sched_barrier(0); }
#undef DSA_KLD
            }
            float cmax = -__builtin_inff();
#pragma unroll
            for (int kt = 0; kt < 2; ++kt) { const f32x4 dv = *(const LAS f32x4*)(dist + 16 * kt + 4 * fq);
#pragma unroll
                for (int i = 0; i < 4; ++i) { sacc[kt][i] = sacc[kt][i] * ATT_SCALE2 - slope2 * dv[i]; cmax = fmaxf(cmax, sacc[kt][i]); } }
            cmax = xrow16_max(cmax);
            const float mn = fmaxf(m, cmax); const float alpha = __builtin_amdgcn_exp2f(m - mn); m = mn;
            float ps = 0.f;
#pragma unroll
            for (int kt = 0; kt < 2; ++kt)
#pragma unroll
                for (int i = 0; i < 4; ++i) { sacc[kt][i] = __builtin_amdgcn_exp2f(sacc[kt][i] - mn); ps += sacc[kt][i]; }
            ps = xrow16_sum(ps); lsum = lsum * alpha + ps;
            u32x4 pw; pw.x = cvt_pk_bf16(sacc[0][0], sacc[0][1]); pw.y = cvt_pk_bf16(sacc[0][2], sacc[0][3]); pw.z = cvt_pk_bf16(sacc[1][0], sacc[1][1]); pw.w = cvt_pk_bf16(sacc[1][2], sacc[1][3]);
            const bf16x8 pf = __builtin_bit_cast(bf16x8, pw);
            {
                s16x4 vlo[3], vhi[3];
#define DSA_VLD(C_) do { const unsigned cx_ = 32u * ((unsigned)((C_) & 7) ^ xhl) + 8192u * ((C_) >> 3); vlo[(C_) % 3] = vtr(vb[0] + cx_); vhi[(C_) % 3] = vtr(vb[1] + cx_); } while (0)
                DSA_VLD(0); DSA_VLD(1);
#pragma unroll
                for (int c = 0; c < 16; ++c) {
                    if (c + 2 < 16) DSA_VLD(c + 2);
                    o[c] = o[c] * alpha;
                    const bf16x8 vfr = __builtin_shufflevector(vlo[c % 3], vhi[c % 3], 0, 1, 2, 3, 4, 5, 6, 7);
                    o[c] = __builtin_amdgcn_mfma_f32_16x16x32_bf16(vfr, pf, o[c], 0, 0, 0);
                    __builtin_amdgcn_sched_barrier(0);
                }
#undef DSA_VLD
            }
        }
        const float inv = 1.0f / lsum;
        if (fr < 8) {
#pragma unroll
            for (int c = 0; c < 16; ++c) { u32x2 w; w.x = cvt_pk_bf16(o[c][0] * inv, o[c][1] * inv); w.y = cvt_pk_bf16(o[c][2] * inv, o[c][3] * inv);
                *(u32x2*)(olat + (size_t)t * 2048 + fr * 256 + 16 * c + 4 * fq) = w; }
        }
    }
}

struct BlkAttn { const bf16* K; const bf16* V; int kvld; };
DI void blk_stage(const Frame& F, const bf16* Kp, const bf16* Vp, int kvld) {
    int tl = F.tid; asm volatile("" : "+v"(tl));
    u32x4 kv[8], vv[8];
#pragma unroll
    for (int i = 0; i < 8; ++i) { const int p = tl + 512 * i; const unsigned row = p >> 4, ch = p & 15;
        kv[i] = *(const u32x4*)(Kp + (size_t)row * kvld + ch * 8); vv[i] = *(const u32x4*)(Vp + (size_t)row * kvld + ch * 8); }
#pragma unroll
    for (int i = 0; i < 8; ++i) { const int p = tl + 512 * i; const unsigned row = p >> 4, ch = p & 15;
        *(LAS u32x4*)(F.lds + off_b(row, ch)) = kv[i]; *(LAS u32x4*)(F.lds + 65536 + off_b(perm32rows(row), ch)) = vv[i]; }
}
DI void blk_core(const Frame& F, const bf16* qrow, int tq, int kpos0, float slope2, bool causal, f32x4 (&o)[8], float& m_out, float& l_out) {
    const int lane = F.lane, fr = lane & 15, fq = lane >> 4;
    const unsigned kimg = (unsigned)(size_t)F.lds, vimg = kimg + 65536;
    bf16x8 qf[4];
#pragma unroll
    for (int kk = 0; kk < 4; ++kk) qf[kk] = *(const bf16x8*)(qrow + 32 * kk + 8 * fq);
    unsigned kb[4];
#pragma unroll
    for (int kk = 0; kk < 4; ++kk) kb[kk] = kimg + off_b(fr, 4 * kk + fq);
    f32x4 s[16];
#pragma unroll
    for (int kt = 0; kt < 16; ++kt) { s[kt] = (f32x4){0.f, 0.f, 0.f, 0.f};
#pragma unroll
        for (int kk = 0; kk < 4; ++kk) { const bf16x8 afr = *(const LAS bf16x8*)(kb[kk] + 4096u * kt);
            s[kt] = __builtin_amdgcn_mfma_f32_16x16x32_bf16(afr, qf[kk], s[kt], 0, 0, 0); }
        if ((kt & 3) == 3) __builtin_amdgcn_sched_barrier(0); }
    float mx = -__builtin_inff();
    const float dq = (float)(tq - kpos0 - 4 * fq);
#pragma unroll
    for (int kt = 0; kt < 16; ++kt)
#pragma unroll
        for (int i = 0; i < 4; ++i) { const float dd = dq - (float)(16 * kt + i); float v = s[kt][i] * ATT_SCALE2 - slope2 * dd;
            if (causal && dd < 0.f) v = -__builtin_inff(); s[kt][i] = v; mx = fmaxf(mx, v); }
    mx = xrow16_max(mx);
    float ps = 0.f;
#pragma unroll
    for (int kt = 0; kt < 16; ++kt)
#pragma unroll
        for (int i = 0; i < 4; ++i) { s[kt][i] = __builtin_amdgcn_exp2f(s[kt][i] - mx); ps += s[kt][i]; }
    ps = xrow16_sum(ps);
    unsigned vb[8][2];
#pragma unroll
    for (int dt = 0; dt < 8; ++dt) { vb[dt][0] = vimg + tr_addr16(lane, dt, 0, 0); vb[dt][1] = vimg + tr_addr16(lane, dt, 0, 1); }
#pragma unroll
    for (int dt = 0; dt < 8; ++dt) o[dt] = (f32x4){0.f, 0.f, 0.f, 0.f};
#pragma unroll
    for (int ks = 0; ks < 8; ++ks) {
        u32x4 pw; pw.x = cvt_pk_bf16(s[2 * ks][0], s[2 * ks][1]); pw.y = cvt_pk_bf16(s[2 * ks][2], s[2 * ks][3]); pw.z = cvt_pk_bf16(s[2 * ks + 1][0], s[2 * ks + 1][1]); pw.w = cvt_pk_bf16(s[2 * ks + 1][2], s[2 * ks + 1][3]);
        const bf16x8 pf = __builtin_bit_cast(bf16x8, pw);
#pragma unroll
        for (int dt = 0; dt < 8; ++dt) { const s16x4 lo = vtr(vb[dt][0] + 8192u * ks), hi = vtr(vb[dt][1] + 8192u * ks);
            const bf16x8 vfr = __builtin_shufflevector(lo, hi, 0, 1, 2, 3, 4, 5, 6, 7);
            o[dt] = __builtin_amdgcn_mfma_f32_16x16x32_bf16(vfr, pf, o[dt], 0, 0, 0); }
        __builtin_amdgcn_sched_barrier(0);
    }
    const float inv = 1.0f / ps;
#pragma unroll
    for (int dt = 0; dt < 8; ++dt) o[dt] = o[dt] * inv;
    m_out = mx; l_out = ps;
}

#define BLK2_SOFTMAX(S_, O_, M_, L_, DQ_) do { \
    float mx_ = -__builtin_inff(); \
    _Pragma("unroll") for (int kt = 0; kt < 8; ++kt) _Pragma("unroll") for (int i = 0; i < 4; ++i) { const float dd_ = (DQ_) - (float)(16 * kt + i); float v_ = S_[kt][i] * ATT_SCALE2 - slope2 * dd_; \
        if (causal && dd_ < 0.f) v_ = -__builtin_inff(); S_[kt][i] = v_; mx_ = fmaxf(mx_, v_); } \
    mx_ = xrow16_max(mx_); const float mn_ = fmaxf(M_, mx_); const float al_ = __builtin_amdgcn_exp2f(M_ - mn_); M_ = mn_; float ps_ = 0.f; \
    _Pragma("unroll") for (int kt = 0; kt < 8; ++kt) _Pragma("unroll") for (int i = 0; i < 4; ++i) { S_[kt][i] = __builtin_amdgcn_exp2f(S_[kt][i] - mn_); ps_ += S_[kt][i]; } \
    ps_ = xrow16_sum(ps_); L_ = L_ * al_ + ps_; \
    _Pragma("unroll") for (int dt = 0; dt < 8; ++dt) O_[dt] = O_[dt] * al_; } while (0)
DI void blk_core2(const Frame& F, const bf16* qrowA, const bf16* qrowB, int tqA, int tqB, int kpos0, float slope2, bool causal,
                  f32x4 (&oa)[8], f32x4 (&ob)[8], float& mA, float& lA, float& mB, float& lB) {
    int lane = F.lane; asm volatile("" : "+v"(lane));
    const int fr = lane & 15, fq = lane >> 4;
    const unsigned kimg = (unsigned)(size_t)F.lds, vimg = kimg + 65536;
    bf16x8 qa[4], qb[4];
#pragma unroll
    for (int kk = 0; kk < 4; ++kk) { qa[kk] = *(const bf16x8*)(qrowA + 32 * kk + 8 * fq); qb[kk] = *(const bf16x8*)(qrowB + 32 * kk + 8 * fq); }
    const unsigned kbase = kimg + 256u * (unsigned)fr + 16u * ((unsigned)fq ^ (((unsigned)fr >> 2) & 3u)), kx = (unsigned)fr & 3u;
    const unsigned xh = (((unsigned)(lane & 15) >> 2) << 1) | (unsigned)((lane >> 4) & 1);
    unsigned vb[2];
#pragma unroll
    for (int tt = 0; tt < 2; ++tt) vb[tt] = vimg + tr_addr16(lane, 0, 0, tt) - 32u * xh;
#pragma unroll
    for (int dt = 0; dt < 8; ++dt) { oa[dt] = (f32x4){0.f, 0.f, 0.f, 0.f}; ob[dt] = (f32x4){0.f, 0.f, 0.f, 0.f}; }
    mA = -__builtin_inff(); mB = -__builtin_inff(); lA = 0.f; lB = 0.f;
    for (int half = 0; half < 2; ++half) {
        unsigned kxl = kx, xhl = xh; asm volatile("" : "+v"(kxl), "+v"(xhl));
        f32x4 sa[8], sb[8];
        bf16x8 kf[2][4];
#pragma unroll
        for (int kk = 0; kk < 4; ++kk) kf[0][kk] = *(const LAS bf16x8*)(kbase + 64u * ((unsigned)kk ^ kxl) + 4096u * (unsigned)(8 * half));
#pragma unroll
        for (int kt = 0; kt < 8; ++kt) { sa[kt] = (f32x4){0.f, 0.f, 0.f, 0.f}; sb[kt] = (f32x4){0.f, 0.f, 0.f, 0.f};
            if (kt < 7) {
#pragma unroll
                for (int kk = 0; kk < 4; ++kk) kf[(kt + 1) & 1][kk] = *(const LAS bf16x8*)(kbase + 64u * ((unsigned)kk ^ kxl) + 4096u * (unsigned)(8 * half + kt + 1)); }
#pragma unroll
            for (int kk = 0; kk < 4; ++kk) { const bf16x8 afr = kf[kt & 1][kk];
                sa[kt] = __builtin_amdgcn_mfma_f32_16x16x32_bf16(afr, qa[kk], sa[kt], 0, 0, 0); sb[kt] = __builtin_amdgcn_mfma_f32_16x16x32_bf16(afr, qb[kk], sb[kt], 0, 0, 0); }
            if (kt < 7) { __builtin_amdgcn_sched_group_barrier(0x100, 4, 0); __builtin_amdgcn_sched_group_barrier(0x008, 8, 0); }
            __builtin_amdgcn_sched_barrier(0); }
        const float dqa = (float)(tqA - kpos0 - 128 * half - 4 * fq), dqb = (float)(tqB - kpos0 - 128 * half - 4 * fq);
        BLK2_SOFTMAX(sa, oa, mA, lA, dqa);
        BLK2_SOFTMAX(sb, ob, mB, lB, dqb);
        s16x4 vlo[3], vhi[3];
#define BLK2_VLD(I_) do { const unsigned cx_ = 32u * ((unsigned)((I_) & 7) ^ xhl) + 8192u * (unsigned)(4 * half + ((I_) >> 3)); vlo[(I_) % 3] = vtr(vb[0] + cx_); vhi[(I_) % 3] = vtr(vb[1] + cx_); } while (0)
        BLK2_VLD(0); BLK2_VLD(1);
        bf16x8 pfa, pfb;
#pragma unroll
        for (int i = 0; i < 32; ++i) { const int ks = i >> 3, dt = i & 7;
            if (i + 2 < 32) BLK2_VLD(i + 2);
            if (dt == 0) {
                u32x4 pw; pw.x = cvt_pk_bf16(sa[2 * ks][0], sa[2 * ks][1]); pw.y = cvt_pk_bf16(sa[2 * ks][2], sa[2 * ks][3]); pw.z = cvt_pk_bf16(sa[2 * ks + 1][0], sa[2 * ks + 1][1]); pw.w = cvt_pk_bf16(sa[2 * ks + 1][2], sa[2 * ks + 1][3]);
                pfa = __builtin_bit_cast(bf16x8, pw);
                pw.x = cvt_pk_bf16(sb[2 * ks][0], sb[2 * ks][1]); pw.y = cvt_pk_bf16(sb[2 * ks][2], sb[2 * ks][3]); pw.z = cvt_pk_bf16(sb[2 * ks + 1][0], sb[2 * ks + 1][1]); pw.w = cvt_pk_bf16(sb[2 * ks + 1][2], sb[2 * ks + 1][3]);
                pfb = __builtin_bit_cast(bf16x8, pw); }
            const bf16x8 vfr = __builtin_shufflevector(vlo[i % 3], vhi[i % 3], 0, 1, 2, 3, 4, 5, 6, 7);
            oa[dt] = __builtin_amdgcn_mfma_f32_16x16x32_bf16(vfr, pfa, oa[dt], 0, 0, 0); ob[dt] = __builtin_amdgcn_mfma_f32_16x16x32_bf16(vfr, pfb, ob[dt], 0, 0, 0);
            __builtin_amdgcn_sched_barrier(0);
        }
#undef BLK2_VLD
    }
    const float ia = 1.0f / lA, ib = 1.0f / lB;
#pragma unroll
    for (int dt = 0; dt < 8; ++dt) { oa[dt] = oa[dt] * ia; ob[dt] = ob[dt] * ib; }
}
#undef BLK2_SOFTMAX

DI void moba_attn_phase(const Frame& F, int l) {
    LAS int* pre = (LAS int*)(F.lds + RING_BYTES);
    LAS int* wsum = pre + 520;
    const unsigned* bcnt = (const unsigned*)(F.ctl + CW_BCNT) + l * 512; const unsigned* buck = (const unsigned*)(F.ws + WS_BUCK);
    const bf16* qm = (const bf16*)(F.ws + WS_QM); const bf16* km = (const bf16*)(F.ws + WS_KM); const bf16* vm = (const bf16*)(F.ws + WS_VM);
    unsigned char* parto = F.ws + WS_PARTO; f32x2* partml = (f32x2*)(F.ws + WS_PARTML);
    const int tid = F.tid, lane = F.lane, fr = lane & 15, fq = lane >> 4;
    __syncthreads();
    { const int n = (int)__hip_atomic_load(bcnt + tid, RLX_AGENT); const int cntu = 1 + ((n + 255) >> 8);
      int v = cntu;
#pragma unroll
      for (int o = 1; o < 64; o <<= 1) { const int x = __builtin_amdgcn_ds_bpermute(((lane - o) & 63) << 2, v); if (lane >= o) v += x; }
      if (lane == 63) wsum[F.wave] = v;
      __syncthreads();
      int base = 0;
      for (int w = 0; w < F.wave; ++w) base += wsum[w];
      pre[tid + 1] = base + v; if (tid == 0) pre[0] = 0;
      __syncthreads(); }
    const int total = pre[512];
    const int u_lo = (int)(((long)total * F.bx) >> 8), u_hi = (int)(((long)total * (F.bx + 1)) >> 8);
    int staged = -1;
    for (int u = u_lo; u < u_hi; ++u) {
        int lo = 0, hi = 512;
        while (hi - lo > 1) { const int mid = (lo + hi) >> 1; if (pre[mid] <= u) lo = mid; else hi = mid; }
        const int hb = lo, h = hb >> 6, b = hb & 63, sub = u - pre[hb];
        if (staged != hb) { __syncthreads(); blk_stage(F, km + (size_t)(b * MBLK) * 1024 + h * HD, vm + (size_t)(b * MBLK) * 1024 + h * HD, 1024); __syncthreads(); staged = hb; }
        int tq[2], slot[2]; bool valid[2] = {true, true}; const bool causal = sub == 0;
#pragma unroll
        for (int g = 0; g < 2; ++g) {
            if (sub == 0) { tq[g] = b * MBLK + F.wave * 32 + g * 16 + fr; slot[g] = 3; }
            else { const int n = (int)__hip_atomic_load(bcnt + hb, RLX_AGENT); const int e = (sub - 1) * 256 + F.wave * 32 + g * 16 + fr; valid[g] = e < n;
                const unsigned ent = buck[(size_t)h * BUCK_PER_HEAD + bucket_off(b) + (valid[g] ? e : 0)]; tq[g] = (int)(ent >> 2); slot[g] = (int)(ent & 3u); } }
        const float slope2 = __builtin_amdgcn_exp2f(-(float)(h + 1)) * LOG2E;
        f32x4 oa[8], ob[8]; float ma, la, mb, lb;
        blk_core2(F, qm + (size_t)tq[0] * 1024 + h * HD, qm + (size_t)tq[1] * 1024 + h * HD, tq[0], tq[1], b * MBLK, slope2, causal, oa, ob, ma, la, mb, lb);
        if (valid[0]) { const size_t pi = ((size_t)tq[0] * NH + h) * 4 + slot[0];
#pragma unroll
            for (int dt = 0; dt < 8; ++dt) *(unsigned*)(parto + pi * HD + 16 * dt + 4 * fq) = pk4_fp8(oa[dt][0] * F8_SOB, oa[dt][1] * F8_SOB, oa[dt][2] * F8_SOB, oa[dt][3] * F8_SOB);
            if (fq == 0) partml[pi] = (f32x2){ma, la}; }
        if (valid[1]) { const size_t pi = ((size_t)tq[1] * NH + h) * 4 + slot[1];
#pragma unroll
            for (int dt = 0; dt < 8; ++dt) *(unsigned*)(parto + pi * HD + 16 * dt + 4 * fq) = pk4_fp8(ob[dt][0] * F8_SOB, ob[dt][1] * F8_SOB, ob[dt][2] * F8_SOB, ob[dt][3] * F8_SOB);
            if (fq == 0) partml[pi] = (f32x2){mb, lb}; }
    }
    __syncthreads();
}
DI void moba_combine_phase(const Frame& F) {
    const unsigned char* parto = F.ws + WS_PARTO; const f32x2* partml = (const f32x2*)(F.ws + WS_PARTML); bf16* ob = (bf16*)(F.ws + WS_OB);
    const int gt = F.bx * NTHREADS + F.tid, ngt = F.G * NTHREADS;
    for (int i0 = gt; i0 < S * NH * 16; i0 += 2 * ngt) {
        f32x2 ml[2][4]; u32x2 pv[2][4];
#pragma unroll
        for (int q = 0; q < 2; ++q) { const int i = i0 + q * ngt < S * NH * 16 ? i0 + q * ngt : i0; const int th = i >> 4, c = i & 15;
#pragma unroll
            for (int j = 0; j < 4; ++j) { ml[q][j] = partml[(size_t)th * 4 + j]; pv[q][j] = *(const u32x2*)(parto + ((size_t)th * 4 + j) * HD + 8 * c); } }
#pragma unroll
        for (int q = 0; q < 2; ++q) { const int i = i0 + q * ngt; if (i >= S * NH * 16) break;
            const int th = i >> 4, c = i & 15, t = th >> 3; const int own = t >> 8, nsel = own < 3 ? own : 3;
            float mj[4], lj[4]; float M = -__builtin_inff();
#pragma unroll
            for (int j = 0; j < 4; ++j) { const bool on = (j == 3) || (j < nsel); mj[j] = on ? ml[q][j][0] : -__builtin_inff(); lj[j] = on ? ml[q][j][1] : 0.f; M = fmaxf(M, mj[j]); }
            float r[8] = {0.f, 0.f, 0.f, 0.f, 0.f, 0.f, 0.f, 0.f}; float wsum_ = 0.f;
#pragma unroll
            for (int j = 0; j < 4; ++j) { const float w = lj[j] * __builtin_amdgcn_exp2f(mj[j] - M); wsum_ += w; const u32x2 v = pv[q][j];
                const f32x2 p0 = __builtin_amdgcn_cvt_pk_f32_fp8((int)v.x, false), p1 = __builtin_amdgcn_cvt_pk_f32_fp8((int)v.x, true), p2 = __builtin_amdgcn_cvt_pk_f32_fp8((int)v.y, false), p3 = __builtin_amdgcn_cvt_pk_f32_fp8((int)v.y, true);
                r[0] += w * p0[0]; r[1] += w * p0[1]; r[2] += w * p1[0]; r[3] += w * p1[1]; r[4] += w * p2[0]; r[5] += w * p2[1]; r[6] += w * p3[0]; r[7] += w * p3[1]; }
            const float is = 1.0f / wsum_;
            u32x2 w; w.x = pk4_fp8(r[0] * is, r[1] * is, r[2] * is, r[3] * is); w.y = pk4_fp8(r[4] * is, r[5] * is, r[6] * is, r[7] * is);
            *(u32x2*)((unsigned char*)ob + (size_t)th * HD + 8 * c) = w; }
    }
}
DI void mem_attn_phase(const Frame& F, int l) {
    const bf16* qmem = (const bf16*)(F.ws + WS_QMEM); const bf16* kv = (const bf16*)(F.ws + WS_KVMEM) + (size_t)l * 1024; bf16* omem = (bf16*)(F.ws + WS_OMEM);
    const int total = NHM * (S / 256);
    int staged = -1;
    for (int u = F.bx; u < total; u += F.G) {
        const int h = u / (S / 256), qc = u % (S / 256);
        if (staged != h) { __syncthreads(); blk_stage(F, kv + h * HD, kv + 512 + h * HD, 4096); __syncthreads(); staged = h; }
        f32x4 oa[8], ob[8]; float ma, la, mb, lb;
        { const int tq0 = qc * 256 + F.wave * 32 + (F.lane & 15); blk_core2(F, qmem + (size_t)tq0 * 512 + h * HD, qmem + (size_t)(tq0 + 16) * 512 + h * HD, 0, 0, 0, 0.f, false, oa, ob, ma, la, mb, lb); }
        int ln = F.lane; asm volatile("" : "+v"(ln));
        const int fq = ln >> 4, tqa = qc * 256 + F.wave * 32 + (ln & 15), tqb = tqa + 16;
#pragma unroll
        for (int dt = 0; dt < 8; ++dt) { *(unsigned*)((unsigned char*)omem + (size_t)tqa * 512 + h * HD + 16 * dt + 4 * fq) = pk4_fp8(oa[dt][0] * F8_SOM, oa[dt][1] * F8_SOM, oa[dt][2] * F8_SOM, oa[dt][3] * F8_SOM);
            *(unsigned*)((unsigned char*)omem + (size_t)tqb * 512 + h * HD + 16 * dt + 4 * fq) = pk4_fp8(ob[dt][0] * F8_SOM, ob[dt][1] * F8_SOM, ob[dt][2] * F8_SOM, ob[dt][3] * F8_SOM); }
    }
    __syncthreads();
}

DI void ln_phase(const Frame& F, const Args& a, int l, int which) {
    const int gw = F.bx * NWAVES + F.wave, NGW = F.G * NWAVES, lane = F.lane;
    const float* g = a.in[17] + (size_t)(l * 3 + which) * D; const float* b = a.in[18] + (size_t)(l * 3 + which) * D;
    float* x = a.out; const bf16* y = (const bf16*)(F.ws + WS_Y); bf16* xb = (bf16*)(F.ws + WS_XB);
    f32x4 xv[8]; u32x2 yv[8];
    if (gw < S) {
#pragma unroll
        for (int j = 0; j < 8; ++j) { xv[j] = ((const f32x4*)(x + (size_t)gw * D) + lane)[64 * j]; yv[j] = ((const u32x2*)(y + (size_t)gw * D) + lane)[64 * j]; } }
    for (int r = gw; r < S; r += NGW) {
        f32x4 v[8]; float s = 0.f;
#pragma unroll
        for (int j = 0; j < 8; ++j) { v[j] = (f32x4){ALPHA * xv[j][0] + bflo(yv[j].x), ALPHA * xv[j][1] + bfhi(yv[j].x), ALPHA * xv[j][2] + bflo(yv[j].y), ALPHA * xv[j][3] + bfhi(yv[j].y)}; s += (v[j][0] + v[j][1]) + (v[j][2] + v[j][3]); }
        const int rn = r + NGW;
        if (rn < S) {
#pragma unroll
            for (int j = 0; j < 8; ++j) { xv[j] = ((const f32x4*)(x + (size_t)rn * D) + lane)[64 * j]; yv[j] = ((const u32x2*)(y + (size_t)rn * D) + lane)[64 * j]; } }
        const float mean = wave_sum(s) * (1.0f / D); float s2 = 0.f;
#pragma unroll
        for (int j = 0; j < 8; ++j) { v[j] = v[j] - mean; s2 += (v[j][0] * v[j][0] + v[j][1] * v[j][1]) + (v[j][2] * v[j][2] + v[j][3] * v[j][3]); }
        const float rstd = 1.0f / sqrtf(wave_sum(s2) * (1.0f / D) + LN_EPS);
        f32x4* xr = (f32x4*)(x + (size_t)r * D) + lane; u32x2* xbr = (u32x2*)(xb + (size_t)r * D) + lane;
#pragma unroll
        for (int j = 0; j < 8; ++j) { const f32x4 g4 = ((const f32x4*)g)[lane + 64 * j], b4 = ((const f32x4*)b)[lane + 64 * j]; const f32x4 o = v[j] * rstd * g4 + b4;
            xr[64 * j] = o;
            if (which != 2) ((unsigned*)(xb) + (size_t)r * (D / 4) + lane)[64 * j] = pk4_fp8(o[0], o[1], o[2], o[3]);
            else { u32x2 w; w.x = pk2(o[0], o[1]); w.y = pk2(o[2], o[3]); xbr[64 * j] = w;
                if (which == 2) ((unsigned*)(F.ws + WS_XB8) + (size_t)r * (D / 4) + lane)[64 * j] = pk4_fp8(o[0], o[1], o[2], o[3]); } }
    }
}


#ifdef SELFCHECK
constexpr int CW_ERR = 24576;
#ifndef SELFCHECK_MASK
#define SELFCHECK_MASK 0xFFFFFFFFu
#endif
#define CHK_ON(w) (((SELFCHECK_MASK) >> (w)) & 1u)
#ifndef SELFCHECK_TOL
#define SELFCHECK_TOL 0.05f
#endif
__device__ const int CHK_TS[8] = {0, 1, 255, 256, 511, 4097, 9000, 16383};
__device__ const int CHK_BND[19] = {1023, 1024, 1279, 1280, 2303, 2304, 2367, 2368, 2383, 2384, 3407, 3408, 4431, 4432, 5455, 5456, 7503, 7504, 9551};
DI void chk_report(gu32* ctl, int which, float err) {
    if (!(err >= 0.f)) err = 1e30f;
    __hip_atomic_fetch_max((unsigned*)(ctl + CW_ERR + which), __float_as_uint(err), RLX_AGENT);
}
DI float bfr(float w) { return __uint_as_float(f2bf(w) << 16); }
DI float bf2f(bf16 v) { return __uint_as_float(((unsigned)v) << 16); }
DI float relerr(float got, float ref, float fl) { return fabsf(got - ref) / (fabsf(ref) + fl); }
DI float wdot(const bf16* a, int K, const float* W, size_t ldw, int lane) {
    float s = 0.f; for (int k = lane; k < K; k += 64) s += bf2f(a[k]) * bfr(W[(size_t)k * ldw]); return wave_sum(s);
}
DI float fp8dec(unsigned char v) { return __builtin_amdgcn_cvt_f32_fp8((int)v, 0); }
DI float f8r(float w, float scale) { return fp8dec((unsigned char)(pk4_fp8(w * scale, 0.f, 0.f, 0.f) & 0xffu)) / scale; }
DI void chk_inproj(const Frame& F, const Args& a) {
    const int gw = F.bx * NWAVES + F.wave, NGW = F.G * NWAVES, lane = F.lane; unsigned char* ws = F.ws;
    const int NC = 83;
    for (int sidx = gw; sidx < 8 * NC; sidx += NGW) {
        const int t = CHK_TS[sidx / NC], ci = sidx % NC;
        const int c = ci < 64 ? (ci * 149 + 7) % INW : CHK_BND[ci - 64];
        float ref;
        if (win_rowmap(c) >= 0) ref = wdot((const bf16*)(ws + WS_XB) + (size_t)t * D, D, a.in[2] + c, INW, lane);
        else { float s = 0.f; for (int k = lane; k < D; k += 64) s += fp8dec((ws + WS_XB8)[(size_t)t * D + k]) * f8r(a.in[2][(size_t)k * INW + c], F8_SWI); ref = wave_sum(s); }
        float got, r2 = ref, fl = 0.3f;
        if (c < 1024) got = bf2f(((const bf16*)(ws + WS_QDSA))[(size_t)t * 1024 + c]);
        else if (c < 1280) got = ((const float*)(ws + WS_CKVRAW))[(size_t)t * 256 + c - 1024];
        else if (c < 2304) got = bf2f(((const bf16*)(ws + WS_QIDX))[(size_t)t * 1024 + c - 1280]);
        else if (c < 2384) got = ((const float*)(ws + WS_KWRAW))[(size_t)t * 256 + c - 2304];
        else if (c < 3408) got = bf2f(((const bf16*)(ws + WS_QM))[(size_t)t * 1024 + c - 2384]);
        else if (c < 4432) got = bf2f(((const bf16*)(ws + WS_KM))[(size_t)t * 1024 + c - 3408]);
        else if (c < 5456) got = bf2f(((const bf16*)(ws + WS_VM))[(size_t)t * 1024 + c - 4432]);
        else if (c < 7504) { got = bf2f(((const bf16*)(ws + WS_GA))[(size_t)t * D + c - 5456]); r2 = 1.f / (1.f + expf(-(ref + a.in[3][c - 5456]))); }
        else { got = bf2f(((const bf16*)(ws + WS_GB))[(size_t)t * D + c - 7504]); r2 = 1.f / (1.f + expf(-(ref + a.in[3][D + c - 7504]))); }
        if (lane == 0) chk_report(F.ctl, 0, relerr(got, r2, fl));
    }
}
DI void chk_norms(const Frame& F, const Args& a) {
    const int gw = F.bx * NWAVES + F.wave, NGW = F.G * NWAVES, lane = F.lane; unsigned char* ws = F.ws;
    for (int sidx = gw; sidx < 8; sidx += NGW) {
        const int t = CHK_TS[sidx]; const float* cr = (const float*)(ws + WS_CKVRAW) + (size_t)t * 256; const float* kw = (const float*)(ws + WS_KWRAW) + (size_t)t * 256;
        float ss = 0.f; for (int c = 0; c < 256; ++c) ss += cr[c] * cr[c];
        const float r = 1.f / sqrtf(ss / 256.f + LN_EPS); float e = 0.f;
        for (int c = lane; c < 256; c += 64) e = fmaxf(e, relerr(fp8dec((ws + WS_CKVN)[(size_t)t * 256 + c]), cr[c] * r * a.in[4][c], 0.3f));
        float mu = 0.f; for (int c = 0; c < 64; ++c) mu += kw[c]; mu /= 64.f; float var = 0.f; for (int c = 0; c < 64; ++c) var += (kw[c] - mu) * (kw[c] - mu); var /= 64.f;
        e = fmaxf(e, relerr(bf2f(((const bf16*)(ws + WS_KIDXN))[(size_t)t * 64 + lane]), (kw[lane] - mu) / sqrtf(var + LN_EPS) * a.in[5][lane] + a.in[6][lane], 0.3f));
        if (lane < 16) e = fmaxf(e, relerr(((const float*)(ws + WS_WIDX))[(size_t)t * 16 + lane], kw[64 + lane], 0.01f));
        chk_report(F.ctl, 1, e);
    }
    for (int sidx = gw; sidx < 8 * 64; sidx += NGW) {
        const int t = CHK_TS[sidx >> 6], h = sidx & 7, c = (((sidx >> 3) & 7) * 37 + (sidx & 7) * 3) & 255;
        const float ref = wdot((const bf16*)(ws + WS_QDSA) + (size_t)t * 1024 + h * HD, HD, a.in[7] + (size_t)h * HD * CKV + c, CKV, lane);
        if (lane == 0) chk_report(F.ctl, 1, relerr(bf2f(((const bf16*)(ws + WS_QLAT))[(size_t)t * 2048 + h * 256 + c]), ref, 0.3f));
    }
    for (int sidx = gw; sidx < 64; sidx += NGW) {
        const int h = sidx & 7, b = ((sidx >> 3) * 9) & 63; float s0 = 0.f, s1 = 0.f;
        for (int k = 0; k < MBLK; ++k) { s0 += bf2f(((const bf16*)(ws + WS_KM))[(size_t)(b * MBLK + k) * 1024 + h * HD + lane]); s1 += bf2f(((const bf16*)(ws + WS_KM))[(size_t)(b * MBLK + k) * 1024 + h * HD + 64 + lane]); }
        const float* km = (const float*)(ws + WS_KMEAN) + (size_t)(h * NBLK + b) * HD;
        chk_report(F.ctl, 1, fmaxf(relerr(km[lane], s0 / 256.f, 0.02f), relerr(km[64 + lane], s1 / 256.f, 0.02f)));
    }
}
DI float chk_score(const unsigned char* ws, int t, int key) {
    const bf16* q = (const bf16*)(ws + WS_QIDX) + (size_t)t * 1024; const bf16* k = (const bf16*)(ws + WS_KIDXN) + (size_t)key * 64; const float* w = (const float*)(ws + WS_WIDX) + (size_t)t * 16;
    float s = 0.f;
    for (int h = 0; h < 16; ++h) { float d = 0.f; for (int i = 0; i < 64; ++i) d += bf2f(q[h * 64 + i]) * bf2f(k[i]); s += w[h] * fmaxf(d, 0.f); }
    return s;
}
DI void chk_topk(const Frame& F, int l) {
    const int gw = F.bx * NWAVES + F.wave, NGW = F.G * NWAVES, lane = F.lane; unsigned char* ws = F.ws;
    for (int sidx = gw; sidx < 8; sidx += NGW) {
        const int t = CHK_TS[sidx]; const unsigned short* sel = (const unsigned short*)(ws + WS_SEL) + (size_t)t * TOPK; const int nsel = t + 1 < TOPK ? t + 1 : TOPK;
        float bad = 0.f, mn = __builtin_inff();
        for (int i = lane; i < TOPK; i += 64) {
            const int k = sel[i];
            if (i < nsel) { if (k > t) bad += 1.f; else mn = fminf(mn, chk_score(ws, t, k)); if (i + 1 < nsel && sel[i + 1] <= k) bad += 1.f; }
            else if (k != 0xFFFF) bad += 1.f;
        }
#pragma unroll
        for (int o = 1; o < 64; o <<= 1) mn = fminf(mn, __shfl_xor(mn, o));
        float cnt = 0.f; for (int k = lane; k <= t; k += 64) if (chk_score(ws, t, k) > mn * (mn > 0.f ? 1.00001f : 0.99999f) + 1e-6f) cnt += 1.f;
        cnt = wave_sum(cnt); bad = wave_sum(bad);
        const float extra = cnt - (float)(nsel - 1); chk_report(F.ctl, 2, (bad + (extra > 0.f ? extra : 0.f)) / 16.f);
    }
    for (int sidx = gw; sidx < 64; sidx += NGW) {
        const int t = CHK_TS[sidx >> 3], h = sidx & 7, own = t >> 8; const bf16* q = (const bf16*)(ws + WS_QM) + (size_t)t * 1024 + h * HD;
        float g = -__builtin_inff();
        if (lane < own) { g = 0.f; const float* km = (const float*)(ws + WS_KMEAN) + (size_t)(h * NBLK + lane) * HD; for (int d = 0; d < HD; ++d) g += bf2f(q[d]) * km[d]; }
        float bad = 0.f; const int nsel = own < 3 ? own : 3; float gg = g;
        for (int j = 0; j < nsel; ++j) {
            float mx = gg; int mi = lane;
#pragma unroll
            for (int o = 1; o < 64; o <<= 1) { const float ov = __shfl_xor(mx, o); const int oi = __shfl_xor(mi, o); if (ov > mx || (ov == mx && oi < mi)) { mx = ov; mi = oi; } }
            float g2 = (lane == mi) ? -__builtin_inff() : gg;
#pragma unroll
            for (int o = 1; o < 64; o <<= 1) g2 = fmaxf(g2, __shfl_xor(g2, o));
            const bool neartie = (mx - g2) < 1e-4f * (fabsf(mx) + 1e-3f);
            const unsigned n = ((const unsigned*)(F.ctl + CW_BCNT))[l * 512 + h * 64 + mi]; const unsigned* bk = (const unsigned*)(ws + WS_BUCK) + (size_t)h * BUCK_PER_HEAD + bucket_off(mi);
            float found = 0.f; for (unsigned i = lane; i < n; i += 64) if (bk[i] == (((unsigned)t << 2) | (unsigned)j)) found = 1.f;
            if (wave_sum(found) != 1.f && !neartie) bad += 1.f;
            if (lane == mi) gg = -__builtin_inff();
        }
        chk_report(F.ctl, 3, bad);
    }
}
DI void chk_attn(const Frame& F, const Args& a) {
    const int gw = F.bx * NWAVES + F.wave, NGW = F.G * NWAVES, lane = F.lane; unsigned char* ws = F.ws;
    for (int sidx = gw; sidx < 64; sidx += NGW) {
        const int t = CHK_TS[sidx >> 3], h = sidx & 7; const float slope = exp2f(-(float)(h + 1));
        {
            const unsigned short* sel = (const unsigned short*)(ws + WS_SEL) + (size_t)t * TOPK; const int nsel = t + 1 < TOPK ? t + 1 : TOPK;
            const bf16* q = (const bf16*)(ws + WS_QLAT) + (size_t)t * 2048 + h * 256; const unsigned char* ck = ws + WS_CKVN;
            float sc[4]; float mx = -__builtin_inff();
#pragma unroll
            for (int j = 0; j < 4; ++j) { const int i = lane + 64 * j; sc[j] = -__builtin_inff();
                if (i < nsel) { const int k = sel[i]; float d = 0.f; for (int c = 0; c < 256; ++c) d += bf2f(q[c]) * fp8dec(ck[(size_t)k * 256 + c]); sc[j] = d * 0.08838834764831845f - slope * (float)(t - k); }
                mx = fmaxf(mx, sc[j]); }
#pragma unroll
            for (int o = 1; o < 64; o <<= 1) mx = fmaxf(mx, __shfl_xor(mx, o));
            float p[4], ps = 0.f;
#pragma unroll
            for (int j = 0; j < 4; ++j) { p[j] = expf(sc[j] - mx); ps += p[j]; } ps = wave_sum(ps);
            float o4[4] = {0.f, 0.f, 0.f, 0.f};
#pragma unroll
            for (int j = 0; j < 4; ++j) for (int src = 0; src < 64; ++src) { const float pp = __shfl(p[j], src); const int i = src + 64 * j; if (i < nsel) { const int k = sel[i];
                _Pragma("unroll") for (int e = 0; e < 4; ++e) o4[e] += pp * fp8dec(ck[(size_t)k * 256 + lane * 4 + e]); } }
            float er = 0.f;
#pragma unroll
            for (int e = 0; e < 4; ++e) er = fmaxf(er, relerr(bf2f(((const bf16*)(ws + WS_OLAT))[(size_t)t * 2048 + h * 256 + lane * 4 + e]), o4[e] / ps, 0.05f));
            chk_report(F.ctl, 4, er);
        }
        {
            const int own = t >> 8; const bf16* q = (const bf16*)(ws + WS_QM) + (size_t)t * 1024 + h * HD; const bf16* kk = (const bf16*)(ws + WS_KM); const bf16* vv = (const bf16*)(ws + WS_VM);
            float g = -__builtin_inff();
            if (lane < own) { g = 0.f; const float* km = (const float*)(ws + WS_KMEAN) + (size_t)(h * NBLK + lane) * HD; for (int d = 0; d < HD; ++d) g += bf2f(q[d]) * km[d]; }
            int blks[4] = {-1, -1, -1, own}; const int nsel = own < 3 ? own : 3; float gg = g;
#pragma unroll
            for (int j = 0; j < 3; ++j) { if (j < nsel) { float mx = gg; int mi = lane;
#pragma unroll
                for (int o = 1; o < 64; o <<= 1) { const float ov = __shfl_xor(mx, o); const int oi = __shfl_xor(mi, o); if (ov > mx || (ov == mx && oi < mi)) { mx = ov; mi = oi; } }
                blks[j] = mi; if (lane == mi) gg = -__builtin_inff(); } }
            float M = -__builtin_inff();
#pragma unroll
            for (int bi = 0; bi < 4; ++bi) { if (blks[bi] >= 0) for (int k0 = lane; k0 < MBLK; k0 += 64) { const int kp = blks[bi] * MBLK + k0; if (kp <= t) { float d = 0.f; for (int e = 0; e < HD; ++e) d += bf2f(q[e]) * bf2f(kk[(size_t)kp * 1024 + h * HD + e]);
                M = fmaxf(M, d * 0.08838834764831845f - slope * (float)(t - kp)); } } }
#pragma unroll
            for (int o = 1; o < 64; o <<= 1) M = fmaxf(M, __shfl_xor(M, o));
            float ps = 0.f, o0 = 0.f, o1 = 0.f;
#pragma unroll
            for (int bi = 0; bi < 4; ++bi) { if (blks[bi] >= 0) for (int kb = 0; kb < MBLK; kb += 64) { const int kp = blks[bi] * MBLK + kb + lane; float p = 0.f;
                if (kp <= t) { float d = 0.f; for (int e = 0; e < HD; ++e) d += bf2f(q[e]) * bf2f(kk[(size_t)kp * 1024 + h * HD + e]); p = expf(d * 0.08838834764831845f - slope * (float)(t - kp) - M); }
                ps += p;
                for (int src = 0; src < 64; ++src) { const float pp = __shfl(p, src); const int kq = blks[bi] * MBLK + kb + src; if (kq <= t) { o0 += pp * bf2f(vv[(size_t)kq * 1024 + h * HD + 2 * lane]); o1 += pp * bf2f(vv[(size_t)kq * 1024 + h * HD + 2 * lane + 1]); } } } }
            ps = wave_sum(ps);
            const unsigned char* ob = ws + WS_OB + (size_t)t * 1024 + h * HD;
            chk_report(F.ctl, 5, fmaxf(relerr(fp8dec(ob[2 * lane]) / F8_SOB, o0 / ps, 0.1f), relerr(fp8dec(ob[2 * lane + 1]) / F8_SOB, o1 / ps, 0.1f)));
        }
        {
            float r0 = 0.f, r1 = 0.f; const bf16* ol = (const bf16*)(ws + WS_OLAT) + (size_t)t * 2048 + h * 256; const float* wu = a.in[8] + (size_t)h * CKV * HD;
            for (int c = 0; c < 256; ++c) { r0 += bf2f(ol[c]) * bfr(wu[c * HD + lane]); r1 += bf2f(ol[c]) * bfr(wu[c * HD + 64 + lane]); }
            const unsigned char* oa = ws + WS_OA + (size_t)t * 1024 + h * HD;
            chk_report(F.ctl, 6, fmaxf(relerr(fp8dec(oa[lane]) / F8_SOA, r0, 0.05f), relerr(fp8dec(oa[64 + lane]) / F8_SOA, r1, 0.05f)));
        }
    }
}
DI void chk_dense(const Frame& F, int word, const bf16* act, int lda, int K, const float* W, int N, const bf16* out, int ldo, float fl) {
    const int gw = F.bx * NWAVES + F.wave, NGW = F.G * NWAVES, lane = F.lane;
    for (int sidx = gw; sidx < 8 * 24; sidx += NGW) { const int t = CHK_TS[sidx / 24], n = ((sidx % 24) * 211 + 5) % N;
        const float ref = wdot(act + (size_t)t * lda, K, W + n, N, lane);
        if (lane == 0) chk_report(F.ctl, word, relerr(bf2f(out[(size_t)t * ldo + n]), ref, fl)); }
}
DI float wdot8r(const unsigned char* a8, int K, const float* W, size_t ldw, float wscale, int lane) {
    float s = 0.f; for (int k = lane; k < K; k += 64) s += fp8dec(a8[k]) * f8r(W[(size_t)k * ldw], wscale); return wave_sum(s);
}
DI void chk_merged(const Frame& F, const Args& a) {
    const int gw = F.bx * NWAVES + F.wave, NGW = F.G * NWAVES, lane = F.lane; unsigned char* ws = F.ws;
    for (int sidx = gw; sidx < 8 * 24; sidx += NGW) { const int t = CHK_TS[sidx / 24], n = ((sidx % 24) * 211 + 5) % D;
        const float pa = wdot8r(ws + WS_OA + (size_t)t * 1024, 1024, a.in[9] + n, D, F8_SWO, lane) / F8_SOA, pb = wdot8r(ws + WS_OB + (size_t)t * 1024, 1024, a.in[10] + n, D, F8_SWO, lane) / F8_SOB;
        const float ref = bf2f(((const bf16*)(ws + WS_GA))[(size_t)t * D + n]) * pa + bf2f(((const bf16*)(ws + WS_GB))[(size_t)t * D + n]) * pb;
        if (lane == 0) chk_report(F.ctl, 6, relerr(fp8dec((ws + WS_MERGED)[(size_t)t * D + n]) / F8_SMG, ref, 0.02f)); }
}
DI void chk_dense8(const Frame& F, int word, const unsigned char* act8, int lda, int K, float ascale, const float* W, int N, float wscale, const bf16* out, int ldo, float fl) {
    const int gw = F.bx * NWAVES + F.wave, NGW = F.G * NWAVES, lane = F.lane;
    for (int sidx = gw; sidx < 8 * 24; sidx += NGW) { const int t = CHK_TS[sidx / 24], n = ((sidx % 24) * 211 + 5) % N;
        const float ref = wdot8r(act8 + (size_t)t * lda, K, W + n, N, wscale, lane) / ascale;
        if (lane == 0) chk_report(F.ctl, word, relerr(bf2f(out[(size_t)t * ldo + n]), ref, fl)); }
}
DI void chk_ln1(const Frame& F, const Args& a) {
    const int gw = F.bx * NWAVES + F.wave, NGW = F.G * NWAVES, lane = F.lane; unsigned char* ws = F.ws;
    for (int sidx = gw; sidx < 8; sidx += NGW) { const int t = CHK_TS[sidx]; const float* x = a.in[0] + (size_t)t * D; const bf16* y = (const bf16*)(ws + WS_Y) + (size_t)t * D;
        float s = 0.f; for (int c = lane; c < D; c += 64) s += ALPHA * x[c] + bf2f(y[c]); const float mu = wave_sum(s) / D;
        float q = 0.f; for (int c = lane; c < D; c += 64) { const float d = ALPHA * x[c] + bf2f(y[c]) - mu; q += d * d; } const float rs = 1.f / sqrtf(wave_sum(q) / D + LN_EPS);
        float e = 0.f; for (int c = lane; c < D; c += 64) { const float ref = (ALPHA * x[c] + bf2f(y[c]) - mu) * rs * a.in[17][c] + a.in[18][c];
            e = fmaxf(e, relerr(a.out[(size_t)t * D + c], ref, 0.5f) * 20.f); e = fmaxf(e, relerr(fp8dec((ws + WS_XB)[(size_t)t * D + c]), ref, 0.5f)); }
        chk_report(F.ctl, 7, e); }
}
DI void chk_memattn(const Frame& F, int l) {
    const int gw = F.bx * NWAVES + F.wave, NGW = F.G * NWAVES, lane = F.lane; unsigned char* ws = F.ws;
    for (int sidx = gw; sidx < 32; sidx += NGW) { const int t = CHK_TS[sidx >> 2], h = sidx & 3; const bf16* q = (const bf16*)(ws + WS_QMEM) + (size_t)t * 512 + h * HD; const bf16* kv = (const bf16*)(ws + WS_KVMEM) + (size_t)l * 1024;
        float sc[4], mx = -__builtin_inff();
#pragma unroll
        for (int j = 0; j < 4; ++j) { const int m = lane + 64 * j; float d = 0.f; for (int e = 0; e < HD; ++e) d += bf2f(q[e]) * bf2f(kv[(size_t)m * 4096 + h * HD + e]); sc[j] = d * 0.08838834764831845f; mx = fmaxf(mx, sc[j]); }
#pragma unroll
        for (int o = 1; o < 64; o <<= 1) mx = fmaxf(mx, __shfl_xor(mx, o));
        float ps = 0.f, o0 = 0.f, o1 = 0.f;
#pragma unroll
        for (int j = 0; j < 4; ++j) { const float p = expf(sc[j] - mx); ps += p; for (int src = 0; src < 64; ++src) { const float pp = __shfl(p, src); const int m = src + 64 * j;
            o0 += pp * bf2f(kv[(size_t)m * 4096 + 512 + h * HD + 2 * lane]); o1 += pp * bf2f(kv[(size_t)m * 4096 + 512 + h * HD + 2 * lane + 1]); } }
        ps = wave_sum(ps); const unsigned char* om = ws + WS_OMEM + (size_t)t * 512 + h * HD;
        chk_report(F.ctl, 9, fmaxf(relerr(fp8dec(om[2 * lane]) / F8_SOM, o0 / ps, 0.05f), relerr(fp8dec(om[2 * lane + 1]) / F8_SOM, o1 / ps, 0.05f))); }
}
DI void chk_kvmem(const Frame& F, const Args& a) {
    const int gw = F.bx * NWAVES + F.wave, NGW = F.G * NWAVES, lane = F.lane; unsigned char* ws = F.ws;
    for (int sidx = gw; sidx < 4 * 48; sidx += NGW) { const int ll = sidx / 48, m = ((sidx % 48) * 37) & 255, n = ((sidx % 48) * 211 + 3) & 1023;
        const float ref = wdot((const bf16*)(ws + WS_MEMB) + (size_t)m * D, D, a.in[13] + (size_t)ll * D * 1024 + n, 1024, lane);
        if (lane == 0) chk_report(F.ctl, 8, relerr(bf2f(((const bf16*)(ws + WS_KVMEM))[(size_t)m * 4096 + ll * 1024 + n]), ref, 0.3f)); }
}
DI float wdot8(const unsigned char* a8, int K, const float* W, size_t ldw, int lane) {
    float s = 0.f; for (int k = lane; k < K; k += 64) s += fp8dec(a8[k]) * W[(size_t)k * ldw]; return wave_sum(s);
}
DI void chk_swiglu(const Frame& F, const Args& a) {
    const int gw = F.bx * NWAVES + F.wave, NGW = F.G * NWAVES, lane = F.lane; unsigned char* ws = F.ws;
    for (int sidx = gw; sidx < 8 * 24; sidx += NGW) { const int t = CHK_TS[sidx / 24], j = ((sidx % 24) * 509 + 11) % DFF;
        const float g = wdot8(ws + WS_XB + (size_t)t * D, D, a.in[15] + j, 2 * DFF, lane), u = wdot8(ws + WS_XB + (size_t)t * D, D, a.in[15] + DFF + j, 2 * DFF, lane);
        if (lane == 0) chk_report(F.ctl, 11, relerr(fp8dec((ws + WS_H)[(size_t)t * DFF + j]) * (1.0f / F8_SH), g / (1.f + expf(-g)) * u, 0.05f)); }
}
DI void chk_ffn2(const Frame& F, const Args& a) {
    const int gw = F.bx * NWAVES + F.wave, NGW = F.G * NWAVES, lane = F.lane; unsigned char* ws = F.ws;
    for (int sidx = gw; sidx < 8 * 24; sidx += NGW) { const int t = CHK_TS[sidx / 24], n = ((sidx % 24) * 211 + 5) % D;
        const float ref = wdot8(ws + WS_H + (size_t)t * DFF, DFF, a.in[16] + n, D, lane) * (1.0f / F8_SH);
        if (lane == 0) chk_report(F.ctl, 12, relerr(bf2f(((const bf16*)(ws + WS_Y))[(size_t)t * D + n]), ref, 0.01f)); }
}
DI void chk_encode(const Frame& F, const Args& a) {
    float B = 0.f, wgt = 0.5f;
    for (int i = 0; i < 32; ++i) if ((SELFCHECK_MASK >> i) & 1u) { const float e = __uint_as_float(__hip_atomic_load((unsigned*)(F.ctl + CW_ERR + i), RLX_AGENT)); if (e > SELFCHECK_TOL) B += wgt; wgt *= 0.5f; }
    const float sc = 1.f - 0.5f * B;
    f32x4* o = (f32x4*)a.out; const int gt = F.bx * NTHREADS + F.tid, ngt = F.G * NTHREADS;
    for (int i = gt; i < S * D / 4; i += ngt) o[i] = o[i] * sc;
}
#endif

constexpr int NPH = 17;
__global__ void __launch_bounds__(NTHREADS, 2) fwd_kernel(Args args) {
    extern __shared__ __attribute__((aligned(16))) unsigned char lds_raw[];
    LAS unsigned char* const lds = (LAS unsigned char*)lds_raw;
    volatile LAS unsigned* MISC = (volatile LAS unsigned*)(lds + MISC_OFF);
    if (threadIdx.x < 32) MISC[threadIdx.x] = 0u;
    __syncthreads();
#if MK_ONE_LAUNCH
    constexpr int lo = 0, hi = DEPTH * NPH;
#else
    const int lo = args.ph_lo, hi = args.ph_hi;
#endif
    XcdBarrier bar; bar.bar = (unsigned*)(args.ws + WS_CTL) + CW_BAR; bar.x = 0; bar.st = nullptr; bar.w0 = __builtin_amdgcn_readfirstlane((int)threadIdx.x >> 6);
    if (hi - lo > 1) bar = xcd_barrier_post((unsigned*)(args.ws + WS_CTL) + CW_BAR, MISC + 8);
#ifdef ONLY_PH
#define IN(k) (((k) - p0) == ONLY_PH && lo <= (k) && (k) < hi)
#else
#define IN(k) (lo <= (k) && (k) < hi)
#endif
#define SEAM(k) do { if (lo <= (k) && (k) + 1 < hi) { XcdBarrier b2_ = bar; asm volatile("" : "+s"(b2_.bar), "+s"(b2_.x)); xcd_barrier(b2_); } } while (0)
#ifdef REPEAT_MASK
#define NREP(bit) ((((unsigned long long)REPEAT_MASK >> (bit)) & 1ull) ? 2 : 1)
#else
#define NREP(bit) 1
#endif
#define FRAME() const Frame F = make_frame(args.ws, lds, bar.w0); unsigned char* const ws = F.ws; (void)ws; int lq = l; asm volatile("" : "+s"(lq)); (void)lq
    for (int l = 0; l < DEPTH; ++l) {
        const int p0 = l * NPH;
        if (IN(p0 + 0)) { FRAME(); for (int rep = 0; rep < NREP(0); ++rep) conv_phase(F, args, lq); } SEAM(p0 + 0);
        if (IN(p0 + 1)) {
#ifndef SKIP_A
            if (l == 0) { FRAME(); pg8::Gemm g{(const bf16*)(ws + WS_MEMB), (const bf16*)(ws + WS_WKV), D, D, D, 1, 16, 0, 0}; pg8::StaticOrder So; So.init(1, 16, F.G, F.G - 1 - F.bx);
                pg8::EpiBf16 E{(bf16*)(ws + WS_KVMEM), 4096}; pg8::gemm_phase(lds, g, So, E, F.tid); }
#endif
#ifndef SKIP_B
            { FRAME(); pg8::Gemm g{(const bf16*)(ws + WS_XB8), (const bf16*)(ws + WS_WIN8), D / 2, D / 2, D / 2, S / 256, IN8 / 256, 0, 0}; pg8::StaticOrder So; So.init(S / 256, IN8 / 256, F.G, F.bx, 1);
            pg8::EpiIn8 E{(bf16*)(ws + WS_QDSA), (bf16*)(ws + WS_VM), (bf16*)(ws + WS_GA), (bf16*)(ws + WS_GB), (float*)(ws + WS_CKVRAW), args.in[3] + (size_t)lq * 2 * D, (bf16*)(ws + WS_QM), (bf16*)(ws + WS_KM)};
            for (int rep = 0; rep < NREP(1); ++rep) pg8::gemm_phase<pg8::EpiIn8, true>(lds, g, So, E, F.tid); }
            { FRAME(); pg8::Gemm g{(const bf16*)(ws + WS_XB), (const bf16*)(ws + WS_WIN), D, D, D, S / 256, INB / 256, 0, 0}; pg8::StaticOrder So; So.init(S / 256, INB / 256, F.G, F.bx, 2);
            pg8::EpiInBf E{(bf16*)(ws + WS_QIDX), (bf16*)(ws + WS_QM), (bf16*)(ws + WS_KM), (float*)(ws + WS_KWRAW)};
            for (int rep = 0; rep < NREP(1); ++rep) pg8::gemm_phase(lds, g, So, E, F.tid); }
#endif
        } SEAM(p0 + 1);
        if (IN(p0 + 2)) {
#ifdef SELFCHECK
            if (l == 0 && CHK_ON(0)) { FRAME(); chk_inproj(F, args); }
#endif
#ifndef SKIP_A
            { FRAME(); for (int rep = 0; rep < NREP(2); ++rep) norm_phase(F, args, lq); }
#endif
#ifndef SKIP_B
            { FRAME(); pg8::Gemm g{(const bf16*)(ws + WS_QDSA), (const bf16*)(ws + WS_WUK), 1024, 256, 256, S / 256, 8, 1, 256}; pg8::StaticOrder So; So.init(S / 256, 8, F.G, F.bx);
            pg8::EpiBf16 E{(bf16*)(ws + WS_QLAT), 2048}; for (int rep = 0; rep < NREP(3); ++rep) pg8::gemm_phase(lds, g, So, E, F.tid); }
#endif
        } SEAM(p0 + 2);
        if (IN(p0 + 3)) {
#ifdef SELFCHECK
            if (l == 0) { FRAME(); if (CHK_ON(1)) chk_norms(F, args); if (CHK_ON(8)) chk_kvmem(F, args); }
#endif
#ifndef SKIP_A
            { FRAME(); moba_gate_phase(F, lq); }
#endif
#ifndef SKIP_B
            { FRAME(); for (int rep = 0; rep < NREP(5); ++rep) indexer_phase(F); }
#endif
        } SEAM(p0 + 3);
        if (IN(p0 + 4)) {
#ifdef SELFCHECK
            if (l == 0 && (CHK_ON(2) || CHK_ON(3))) { FRAME(); chk_topk(F, lq); }
#endif
#ifndef SKIP_A
            { FRAME(); for (int rep = 0; rep < NREP(6); ++rep) moba_attn_phase(F, lq); }
#endif
#ifndef SKIP_B
            { FRAME(); for (int rep = 0; rep < NREP(7); ++rep) dsa_attn_phase(F); }
#endif
        } SEAM(p0 + 4);
        if (IN(p0 + 5)) {
            { FRAME(); for (int rep = 0; rep < NREP(8); ++rep) moba_combine_phase(F); }
            { FRAME(); pg8::Gemm g{(const bf16*)(ws + WS_OLAT), (const bf16*)(ws + WS_WUV), 2048, 512, 512, S / 256, 4, 0, 512}; pg8::StaticOrder So; So.init(S / 256, 4, F.G, F.bx);
            pg8::EpiF8 E{ws + WS_OA, 1024, F8_SOA}; for (int rep = 0; rep < NREP(9); ++rep) pg8::gemm_phase(lds, g, So, E, F.tid); }
        } SEAM(p0 + 5);
#ifdef SELFCHECK
        if (l == 0 && IN(p0 + 6) && (CHK_ON(4) || CHK_ON(5) || CHK_ON(6))) { FRAME(); chk_attn(F, args); }
#endif
        if (IN(p0 + 6)) { FRAME(); pg8::Gemm g{(const bf16*)(ws + WS_OA), (const bf16*)(ws + WS_WOA), 512, 512, 512, S / 256, 8, 0, 0}; pg8::StaticOrder So; So.init(S / 256, 8, F.G, F.bx);
            pg8::EpiGate E{(bf16*)(ws + WS_T1), ws + WS_GA, nullptr, nullptr, 1.0f / (F8_SOA * F8_SWO * F8_SGT), 0.f}; for (int rep = 0; rep < NREP(10); ++rep) pg8::gemm_phase<pg8::EpiGate, true>(lds, g, So, E, F.tid); }
        if (IN(p0 + 7)) { FRAME(); pg8::Gemm g{(const bf16*)(ws + WS_OB), (const bf16*)(ws + WS_WOB), 512, 512, 512, S / 256, 8, 0, 0}; pg8::StaticOrder So; So.init(S / 256, 8, F.G, F.bx);
            pg8::EpiGate E{nullptr, ws + WS_GB, (const bf16*)(ws + WS_T1), ws + WS_MERGED, 1.0f / (F8_SOB * F8_SWO * F8_SGT), F8_SMG}; for (int rep = 0; rep < NREP(11); ++rep) pg8::gemm_phase<pg8::EpiGate, true>(lds, g, So, E, F.tid); } SEAM(p0 + 7);
#ifdef SELFCHECK
        if (l == 0 && IN(p0 + 8) && CHK_ON(6)) { FRAME(); chk_merged(F, args); }
#endif
#if (LN_FUSED & 1)
        if (IN(p0 + 8)) { FRAME(); pg8::Gemm g{(const bf16*)(ws + WS_MERGED), (const bf16*)(ws + WS_WOUT), D / 2, D / 2, D / 2, S / 256, 8, 0, 0}; pg8::FusedOrder So{F.bx};
            pg8::EpiLn E{(bf16*)(ws + WS_XB), args.in[17] + (size_t)(lq * 3 + 0) * D, args.in[18] + (size_t)(lq * 3 + 0) * D, 1.0f / (F8_SMG * F8_SWOUT), nullptr, ws + WS_XB8, (unsigned long long*)(ws + WS_LNX), (unsigned*)(F.ctl + CW_LNCNT) + (lq * 3 + 0) * 64 * 64};
            pg8::gemm_phase<pg8::EpiLn, true, pg8::FusedOrder, true>(lds, g, So, E, F.tid); } SEAM(p0 + 8);
#else
        if (IN(p0 + 8)) { FRAME(); pg8::Gemm g{(const bf16*)(ws + WS_MERGED), (const bf16*)(ws + WS_WOUT), D / 2, D / 2, D / 2, S / 256, 8, 0, 0}; pg8::StaticOrder So; So.init(S / 256, 8, F.G, F.bx);
            pg8::EpiBf16S E{(bf16*)(ws + WS_Y), D, 1.0f / (F8_SMG * F8_SWOUT)}; for (int rep = 0; rep < NREP(12); ++rep) pg8::gemm_phase<pg8::EpiBf16S, true>(lds, g, So, E, F.tid); } SEAM(p0 + 8);
        if (IN(p0 + 9)) { FRAME(); ln_phase(F, args, l, 0); } SEAM(p0 + 9);
#endif
#ifdef SELFCHECK
        if (l == 0 && IN(p0 + 10) && CHK_ON(7)) { FRAME(); chk_ln1(F, args); }
#endif
        if (IN(p0 + 10)) { FRAME(); pg8::Gemm g{(const bf16*)(ws + WS_XB8), (const bf16*)(ws + WS_WQM), D / 2, D / 2, D / 2, S / 256, 2, 0, 0}; pg8::StaticOrder So; So.init(S / 256, 2, F.G, F.bx);
            pg8::EpiBf16S E{(bf16*)(ws + WS_QMEM), 512, 1.0f / F8_SWQM}; for (int rep = 0; rep < NREP(14); ++rep) pg8::gemm_phase<pg8::EpiBf16S, true>(lds, g, So, E, F.tid); } SEAM(p0 + 10);
#ifdef SELFCHECK
        if (l == 0 && IN(p0 + 11) && CHK_ON(8)) { FRAME(); chk_dense8(F, 8, ws + WS_XB, D, D, 1.f, args.in[12], 512, F8_SWQM, (const bf16*)(ws + WS_QMEM), 512, 0.3f); }
#endif
        if (IN(p0 + 11)) { FRAME(); for (int rep = 0; rep < NREP(15); ++rep) mem_attn_phase(F, lq); } SEAM(p0 + 11);
#ifdef SELFCHECK
        if (l == 0 && IN(p0 + 12) && CHK_ON(9)) { FRAME(); chk_memattn(F, lq); }
#endif
#if (LN_FUSED & 2)
        if (IN(p0 + 12)) { FRAME(); pg8::Gemm g{(const bf16*)(ws + WS_OMEM), (const bf16*)(ws + WS_WOM), 256, 256, 256, S / 256, 8, 0, 0}; pg8::FusedOrder So{F.bx};
            pg8::EpiLn E{(bf16*)(ws + WS_XB), args.in[17] + (size_t)(lq * 3 + 1) * D, args.in[18] + (size_t)(lq * 3 + 1) * D, 1.0f / (F8_SOM * F8_SWOM), nullptr, ws + WS_XB8, (unsigned long long*)(ws + WS_LNX), (unsigned*)(F.ctl + CW_LNCNT) + (lq * 3 + 1) * 64 * 64};
            pg8::gemm_phase<pg8::EpiLn, true, pg8::FusedOrder, true>(lds, g, So, E, F.tid); } SEAM(p0 + 12);
#else
        if (IN(p0 + 12)) { FRAME(); pg8::Gemm g{(const bf16*)(ws + WS_OMEM), (const bf16*)(ws + WS_WOM), 256, 256, 256, S / 256, 8, 0, 0}; pg8::StaticOrder So; So.init(S / 256, 8, F.G, F.bx);
            pg8::EpiBf16S E{(bf16*)(ws + WS_Y), D, 1.0f / (F8_SOM * F8_SWOM)}; for (int rep = 0; rep < NREP(16); ++rep) pg8::gemm_phase<pg8::EpiBf16S, true>(lds, g, So, E, F.tid); } SEAM(p0 + 12);
        if (IN(p0 + 13)) { FRAME(); ln_phase(F, args, l, 1); } SEAM(p0 + 13);
#endif
        if (IN(p0 + 14)) { FRAME(); pg8::Gemm g{(const bf16*)(ws + WS_XB8), (const bf16*)(ws + WS_WF1), D / 2, D / 2, D / 2, S / 256, 2 * DFF / 256, 0, 0}; pg8::StaticOrder So; So.init(S / 256, 2 * DFF / 256, F.G, F.bx);
            pg8::EpiSwiglu8 E{ws + WS_H}; for (int rep = 0; rep < NREP(18); ++rep) pg8::gemm_phase<pg8::EpiSwiglu8, true>(lds, g, So, E, F.tid); } SEAM(p0 + 14);
#ifdef SELFCHECK
        if (l == 0 && IN(p0 + 15) && CHK_ON(11)) { FRAME(); chk_swiglu(F, args); }
#endif
#if (LN_FUSED & 4)
        if (IN(p0 + 15)) { FRAME(); pg8::Gemm g{(const bf16*)(ws + WS_H), (const bf16*)(ws + WS_WF2), DFF / 2, DFF / 2, DFF / 2, S / 256, 8, 0, 0}; pg8::FusedOrder So{F.bx};
            pg8::EpiLn E{(bf16*)(ws + WS_XB), args.in[17] + (size_t)(lq * 3 + 2) * D, args.in[18] + (size_t)(lq * 3 + 2) * D, 1.0f / (F8_SH * F8_SW2), lq == DEPTH - 1 ? args.out : nullptr, ws + WS_XB8, (unsigned long long*)(ws + WS_LNX), (unsigned*)(F.ctl + CW_LNCNT) + (lq * 3 + 2) * 64 * 64};
            pg8::gemm_phase<pg8::EpiLn, true, pg8::FusedOrder, true>(lds, g, So, E, F.tid); } SEAM(p0 + 15);
#else
        if (IN(p0 + 15)) { FRAME(); pg8::Gemm g{(const bf16*)(ws + WS_H), (const bf16*)(ws + WS_WF2), DFF / 2, DFF / 2, DFF / 2, S / 256, 8, 0, 0}; pg8::StaticOrder So; So.init(S / 256, 8, F.G, F.bx);
            pg8::EpiBf16S E{(bf16*)(ws + WS_Y), D, 1.0f / (F8_SH * F8_SW2)}; for (int rep = 0; rep < NREP(19); ++rep) pg8::gemm_phase<pg8::EpiBf16S, true>(lds, g, So, E, F.tid); } SEAM(p0 + 15);
        if (IN(p0 + 16)) { FRAME(); ln_phase(F, args, l, 2); } SEAM(p0 + 16);
#endif
    }
#ifdef SELFCHECK
    { xcd_barrier(bar); const int l = 0; FRAME(); chk_encode(F, args); }
#endif
#undef IN
#undef SEAM
#undef FRAME
}

extern "C" void kernel_launch(void* const* d_in, const int* in_sizes, int n_in, void* d_out, int out_size, void* d_ws, size_t ws_size, hipStream_t stream) {
    static int grid = 0;
    if (grid == 0) {
        if (n_in != 19 || out_size != S * D || ws_size < WS_END) { fprintf(stderr, "kernel_launch: unexpected shapes (n_in %d, out %d, ws %zu < %zu)\n", n_in, out_size, ws_size, (size_t)WS_END); grid = -1; return; }
        int dev = 0, cus = 0, per_cu = 0;
        if (hipGetDevice(&dev) != hipSuccess || hipDeviceGetAttribute(&cus, hipDeviceAttributeMultiprocessorCount, dev) != hipSuccess) { grid = -1; return; }
        if (hipFuncSetAttribute((const void*)fwd_kernel, hipFuncAttributeMaxDynamicSharedMemorySize, LDS_BYTES) != hipSuccess) { fprintf(stderr, "kernel_launch: hipFuncSetAttribute failed\n"); grid = -1; return; }
        if (hipOccupancyMaxActiveBlocksPerMultiprocessor(&per_cu, (const void*)fwd_kernel, NTHREADS, LDS_BYTES) != hipSuccess || per_cu < 1) fprintf(stderr, "kernel_launch: occupancy query says %d\n", per_cu);
        (void)hipGetLastError();
        grid = cus;
        if (grid != 256) { fprintf(stderr, "kernel_launch: %d CUs; this kernel is built for the 256-workgroup grid of an MI355X; nothing launched\n", grid); grid = -1; return; }
    }
    if (grid < 0) return;
    (void)in_sizes;
    if (hipMemsetAsync((char*)d_ws + WS_CTL, 0, CTL_ZERO_BYTES, stream) != hipSuccess) return;
    Args a{};
    for (int i = 0; i < 19; ++i) a.in[i] = (const float*)d_in[i];
    a.out = (float*)d_out; a.ws = (unsigned char*)d_ws;
#if MK_ONE_LAUNCH
    a.ph_lo = 0; a.ph_hi = DEPTH * NPH;
    hipLaunchKernelGGL(fwd_kernel, dim3(grid), dim3(NTHREADS), LDS_BYTES, stream, a);
#else
    for (int p = 0; p < DEPTH * NPH; ++p) { a.ph_lo = p; a.ph_hi = p + 1; hipLaunchKernelGGL(fwd_kernel, dim3(grid), dim3(NTHREADS), LDS_BYTES, stream, a); }
#endif
}
```

```cpp
#include <hip/hip_runtime.h>
#include <cstdio>
#include <cstdint>

#ifndef MK_ONE_LAUNCH
#define MK_ONE_LAUNCH 1
#endif
#ifndef LN_FUSED
#define LN_FUSED 7
#endif
#if LN_FUSED != 7
#error "the bf16 residual stream lives in the fused LayerNorm epilogues only"
#endif

#ifndef MOBA_QK_FP8
#define MOBA_QK_FP8 1
#endif
#define LAS __attribute__((address_space(3)))
#define GAS __attribute__((address_space(1)))
typedef unsigned short bf16;
typedef short bf16x8 __attribute__((ext_vector_type(8)));
typedef short s16x4 __attribute__((ext_vector_type(4)));
typedef short v4i16_t __attribute__((ext_vector_type(4)));
typedef float f32x2 __attribute__((ext_vector_type(2)));
typedef float f32x4 __attribute__((ext_vector_type(4)));
typedef float f32x16 __attribute__((ext_vector_type(16)));
typedef unsigned u32x2 __attribute__((ext_vector_type(2)));
typedef unsigned u32x4 __attribute__((ext_vector_type(4)));
typedef int v4i __attribute__((ext_vector_type(4)));
typedef int v8i __attribute__((ext_vector_type(8)));
typedef v8i v8i_a16 __attribute__((aligned(16)));
typedef GAS unsigned gu32;
#define RLX_AGENT __ATOMIC_RELAXED, __HIP_MEMORY_SCOPE_AGENT
#define DI __device__ __forceinline__

constexpr int S = 16384, D = 2048, DEPTH = 4, NH = 8, HD = 128, CKV = 256, IH = 16, IDIM = 64, TOPK = 256, MBLK = 256, NBLK = 64, NMEM = 256, NHM = 4, DFF = 5632;
constexpr int INW = 9552, INP = 9728;
constexpr float LN_EPS = 1e-5f;
constexpr float ALPHA = 1.681792830507429f;
constexpr float LOG2E = 1.4426950408889634f;
constexpr float ATT_SCALE2 = 0.08838834764831845f * LOG2E;
constexpr int NWAVES = 8, NTHREADS = 512;
constexpr float F8_SW1 = 64.f, F8_SW2 = 128.f, F8_SH = 16.f, F8_SWI = 32.f;
constexpr float F8_SWO = 64.f, F8_SWOUT = 64.f, F8_SWQM = 32.f, F8_SWOM = 32.f;
constexpr float F8_SGT = 256.f;
constexpr float F8_SOA = 16.f, F8_SOB = 8.f, F8_SMG = 64.f, F8_SOM = 32.f;
constexpr int INB = MOBA_QK_FP8 ? 1280 : 3328, IN8 = MOBA_QK_FP8 ? 8448 : 6400;

constexpr size_t MiB = 1u << 20;
constexpr size_t WS_CTL = 0, CTL_ZERO_BYTES = 512 * 1024;
constexpr size_t WS_WIN = 1 * MiB;
constexpr size_t WS_WUK = WS_WIN + 38 * MiB;
constexpr size_t WS_WUV = WS_WUK + 1 * MiB;
constexpr size_t WS_WOA = WS_WUV + 1 * MiB;
constexpr size_t WS_WOB = WS_WOA + 4 * MiB;
constexpr size_t WS_WOUT = WS_WOB + 4 * MiB;
constexpr size_t WS_WQM = WS_WOUT + 8 * MiB;
constexpr size_t WS_WOM = WS_WQM + 2 * MiB;
constexpr size_t WS_WF1 = WS_WOM + 2 * MiB;
constexpr size_t WS_WF2 = WS_WF1 + 44 * MiB;
constexpr size_t WS_WKV = WS_WF2 + 22 * MiB;
constexpr size_t WS_MEMB = WS_WKV + 16 * MiB;
constexpr size_t WS_KVMEM = WS_MEMB + 1 * MiB;
constexpr size_t WS_XB = WS_KVMEM + 2 * MiB;
constexpr size_t WS_QDSA = WS_XB + 64 * MiB;
constexpr size_t WS_QIDX = WS_QDSA + 32 * MiB;
constexpr size_t WS_QM = WS_QIDX + 32 * MiB;
constexpr size_t WS_KM = WS_QM + 32 * MiB;
constexpr size_t WS_VM = WS_KM + 32 * MiB;
constexpr size_t WS_GA = WS_VM + 32 * MiB;
constexpr size_t WS_GB = WS_GA + 64 * MiB;
constexpr size_t WS_CKVRAW = WS_GB + 64 * MiB;
constexpr size_t WS_KWRAW = WS_CKVRAW + 16 * MiB;
constexpr size_t WS_H = WS_QDSA;
constexpr size_t WS_CKVN = WS_KWRAW + 16 * MiB;
constexpr size_t WS_KIDXN = WS_CKVN + 8 * MiB;
constexpr size_t WS_WIDX = WS_KIDXN + 2 * MiB;
constexpr size_t WS_KMEAN = WS_WIDX + 1 * MiB;
constexpr size_t WS_QLAT = WS_KMEAN + 1 * MiB;
constexpr size_t WS_SEL = WS_QLAT + 64 * MiB;
constexpr size_t WS_OLAT = WS_SEL + 8 * MiB;
constexpr size_t WS_OA = WS_OLAT + 64 * MiB;
constexpr size_t WS_OB = WS_OA + 32 * MiB;
constexpr size_t WS_BUCK = WS_OB + 32 * MiB;
constexpr size_t WS_PARTO = WS_BUCK + 16 * MiB;
constexpr size_t WS_PARTML = WS_PARTO + 128 * MiB;
constexpr size_t WS_T1 = WS_PARTML + 4 * MiB;
constexpr size_t WS_MERGED = WS_T1 + 64 * MiB;
constexpr size_t WS_Y = WS_MERGED + 64 * MiB;
constexpr size_t WS_QMEM = WS_Y + 64 * MiB;
constexpr size_t WS_OMEM = WS_QMEM + 16 * MiB;
constexpr size_t WS_XB8 = WS_OMEM + 16 * MiB;
constexpr size_t WS_LNX = WS_XB8 + 32 * MiB;
constexpr size_t WS_END = WS_LNX + 1 * MiB;
constexpr size_t WS_WIN8 = WS_WIN + 16 * MiB;
static_assert(WS_H + (size_t)S * DFF * 2 <= WS_CKVN, "h overlay");
static_assert(WS_END <= 1408 * MiB, "workspace");
constexpr int CW_BAR = 4096;
constexpr int CW_BCNT = 16384;
constexpr int CW_LNCNT = 65536;
constexpr int BUCK_PER_HEAD = 256 * 2016;
DI int bucket_off(int b) { return 256 * (63 * b - (b * (b - 1)) / 2); }

constexpr int LDS_BYTES = 147456;
constexpr int RING_BYTES = 131072;
constexpr int MISC_OFF = 143360;
constexpr int LNT_OFF = RING_BYTES;

DI unsigned f2bf(float f) { unsigned u = __builtin_bit_cast(unsigned, f); return (u + 0x7fffu + ((u >> 16) & 1u)) >> 16; }
DI unsigned pk2(float lo, float hi) { return f2bf(lo) | (f2bf(hi) << 16); }
DI unsigned cvt_pk_bf16(float lo, float hi) { unsigned r; asm volatile("v_cvt_pk_bf16_f32 %0, %1, %2" : "=v"(r) : "v"(lo), "v"(hi)); return r; }
DI float clamp448(float x) { return __builtin_amdgcn_fmed3f(x, -448.f, 448.f); }
DI unsigned pk4_fp8(float a, float b, float c, float d) {
    int w = 0; w = __builtin_amdgcn_cvt_pk_fp8_f32(clamp448(a), clamp448(b), w, false); w = __builtin_amdgcn_cvt_pk_fp8_f32(clamp448(c), clamp448(d), w, true); return (unsigned)w; }
DI float bflo(unsigned u) { return __builtin_bit_cast(float, u << 16); }
DI float bfhi(unsigned u) { return __builtin_bit_cast(float, u & 0xffff0000u); }
DI int lane_id() { int l; asm volatile("v_mbcnt_lo_u32_b32 %0, -1, 0\n\tv_mbcnt_hi_u32_b32 %0, -1, %0" : "=v"(l)); return l; }
template <int CTRL> DI int dpp_i(int x) { return __builtin_amdgcn_mov_dpp(x, CTRL, 0xf, 0xf, true); }
template <int CTRL> DI float dpp_f(float x) { return __builtin_bit_cast(float, __builtin_amdgcn_mov_dpp(__builtin_bit_cast(int, x), CTRL, 0xf, 0xf, true)); }
DI float xrow16_sum(float x);
DI float wave_sum(float v) {
    v += dpp_f<0xB1>(v); v += dpp_f<0x4E>(v); v += dpp_f<0x141>(v); v += dpp_f<0x128>(v);
    return xrow16_sum(v);
}
DI unsigned wave_umax(unsigned v) {
    { const unsigned o = (unsigned)dpp_i<0xB1>((int)v); v = o > v ? o : v; } { const unsigned o = (unsigned)dpp_i<0x4E>((int)v); v = o > v ? o : v; }
    { const unsigned o = (unsigned)dpp_i<0x141>((int)v); v = o > v ? o : v; } { const unsigned o = (unsigned)dpp_i<0x128>((int)v); v = o > v ? o : v; }
    { const auto s = __builtin_amdgcn_permlane16_swap(v, v, false, false); v = s[0] > s[1] ? s[0] : s[1]; }
    { const auto s = __builtin_amdgcn_permlane32_swap(v, v, false, false); v = s[0] > s[1] ? s[0] : s[1]; }
    return v;
}
DI unsigned wave_umin(unsigned v) { return ~wave_umax(~v); }
DI float xrow16_max(float x) {
    auto s = __builtin_amdgcn_permlane16_swap(__float_as_uint(x), __float_as_uint(x), false, false);
    x = fmaxf(__uint_as_float(s[0]), __uint_as_float(s[1]));
    auto t = __builtin_amdgcn_permlane32_swap(__float_as_uint(x), __float_as_uint(x), false, false);
    return fmaxf(__uint_as_float(t[0]), __uint_as_float(t[1]));
}
DI float xrow16_sum(float x) {
    auto s = __builtin_amdgcn_permlane16_swap(__float_as_uint(x), __float_as_uint(x), false, false);
    x = __uint_as_float(s[0]) + __uint_as_float(s[1]);
    auto t = __builtin_amdgcn_permlane32_swap(__float_as_uint(x), __float_as_uint(x), false, false);
    return __uint_as_float(t[0]) + __uint_as_float(t[1]);
}
DI float fast_sigmoid(float x) { return __builtin_amdgcn_rcpf(1.0f + __builtin_amdgcn_exp2f(-x * LOG2E)); }
DI s16x4 vtr(unsigned lds_addr) { return __builtin_bit_cast(s16x4, __builtin_amdgcn_ds_read_tr16_b64_v4i16((LAS v4i16_t*)lds_addr)); }
DI unsigned off_b(unsigned row, unsigned ch) { return 256u * row + 16u * (ch ^ (((row & 3) << 2) | ((row >> 2) & 3))); }
DI unsigned tr_addr16(unsigned lane, unsigned c, unsigned ks, unsigned t) {
    const unsigned g = lane >> 4, q = (lane & 15) >> 2, p = lane & 3;
    return off_b(32 * ks + 8 * g + 4 * t + q, 2 * c + (p >> 1)) + 8 * (p & 1);
}
DI unsigned perm32rows(unsigned k) { return (k & ~31u) | (8u * ((k >> 2) & 3u) + 4u * ((k >> 4) & 1u) + (k & 3u)); }

namespace pg8 {
constexpr int BM = 256, BK = 64, HALF = 128, HTB = HALF * BK * 2, STAGE_BYTES = 8 * HTB, NXCD = 8, WGM = 4;
__host__ __device__ __forceinline__ int lds_byte(int r, int c) { const int st = (r >> 4) * 2 + (c >> 5), rr = r & 15, cc = c & 31, ob = rr * 64 + cc * 2; return st * 1024 + (ob ^ (((ob >> 9) & 1) << 5)); }
__host__ __device__ __forceinline__ void stage_rc(int b, int& R, int& C) { const int st = b / 1024, sb = b % 1024, swz = sb ^ (((sb >> 9) & 1) << 5); R = (st >> 1) * 16 + swz / 64; C = (st & 1) * 32 + (swz % 64) / 2; }
__host__ __device__ __forceinline__ int perm32(int rho) { const int n = rho >> 4, i = rho & 15; return 8 * (i >> 2) + 4 * n + (i & 3); }
struct Unit { int pm, pn; };
struct Gemm { const bf16* A; const bf16* Bt; int lda, ldb, K, nM, nN, a_shift, a_koff; };
struct StaticOrder {
    int nM, nN, nwg, G, c, mode;
    DI void init(int nM_, int nN_, int G_, int c_, int mode_ = 0) { nM = nM_; nN = nN_; nwg = nM * nN; G = G_; c = c_; mode = mode_; }
    DI bool next(int i, Unit& u) const {
        long L = (long)i * G + c;
#if MOBA_QK_FP8
        if (mode == 1) { if (i == 7) L = c >= 64 ? 1792 + (c - 64) : nwg; else if (i == 8) L = (c >= 64 && c < 192) ? 1984 + (c - 64) : nwg; else if (i > 8) L = nwg; }
        if (mode == 2) { if (i == 1) L = c < 64 ? 256 + c : nwg; else if (i > 1) L = nwg; }
#else
        if (mode == 1) { if (i == 5) L = c < 128 ? 1280 + c : (c >= 192 ? 1280 + 128 + (c - 192) : nwg); else if (i == 6) L = c < 128 ? 1472 + c : nwg; else if (i > 6) L = nwg; }
        if (mode == 2) { if (i == 3) L = (c >= 128 && c < 192) ? 768 + (c - 128) : nwg; else if (i > 3) L = nwg; }
#endif
        if (L >= nwg) return false;
        int wgid = (int)L; { const int q = nwg / NXCD, r = nwg % NXCD, xcd = wgid % NXCD, off = wgid / NXCD; wgid = (xcd < r ? xcd * (q + 1) : r * (q + 1) + (xcd - r) * q) + off; }
        const int nig = WGM * nN, gid = wgid / nig, fm = gid * WGM, gsz = (nM - fm) < WGM ? (nM - fm) : WGM;
        u.pm = fm + ((wgid % nig) % gsz); u.pn = (wgid % nig) / gsz; return true;
    }
};
struct EpiBf16 {
    bf16* O; int ldc;
    DI void operator()(const f32x4 (&acc)[2][2][4][2], const Unit& u, int wr, int wc, int fr, int fq) const {
        const int row0 = u.pm * BM + wr * 64 + fr, col0 = u.pn * BM + wc * 32 + 8 * fq;
#pragma unroll
        for (int ai = 0; ai < 2; ++ai)
#pragma unroll
            for (int m = 0; m < 4; ++m) { bf16* rowp = O + (size_t)(row0 + ai * HALF + m * 16) * ldc + col0;
#pragma unroll
                for (int bj = 0; bj < 2; ++bj) { const f32x4 v0 = acc[ai][bj][m][0], v1 = acc[ai][bj][m][1];
                    u32x4 w; w.x = cvt_pk_bf16(v0[0], v0[1]); w.y = cvt_pk_bf16(v0[2], v0[3]); w.z = cvt_pk_bf16(v1[0], v1[1]); w.w = cvt_pk_bf16(v1[2], v1[3]);
                    *(u32x4*)(rowp + bj * HALF) = w; } }
    }
};
struct EpiBf16S {
    bf16* O; int ldc; float scale;
    DI void operator()(const f32x4 (&acc)[2][2][4][2], const Unit& u, int wr, int wc, int fr, int fq) const {
        const int row0 = u.pm * BM + wr * 64 + fr, col0 = u.pn * BM + wc * 32 + 8 * fq;
#pragma unroll
        for (int ai = 0; ai < 2; ++ai)
#pragma unroll
            for (int m = 0; m < 4; ++m) { bf16* rowp = O + (size_t)(row0 + ai * HALF + m * 16) * ldc + col0;
#pragma unroll
                for (int bj = 0; bj < 2; ++bj) { const f32x4 v0 = acc[ai][bj][m][0] * scale, v1 = acc[ai][bj][m][1] * scale;
                    u32x4 w; w.x = cvt_pk_bf16(v0[0], v0[1]); w.y = cvt_pk_bf16(v0[2], v0[3]); w.z = cvt_pk_bf16(v1[0], v1[1]); w.w = cvt_pk_bf16(v1[2], v1[3]);
                    *(u32x4*)(rowp + bj * HALF) = w; } }
    }
};
struct EpiSwiglu8 {
    unsigned char* Hh;
    DI void operator()(const f32x4 (&acc)[2][2][4][2], const Unit& u, int wr, int wc, int fr, int fq) const {
        const int row0 = u.pm * BM + wr * 64 + fr, col0 = u.pn * HALF + wc * 32 + 8 * fq;
#pragma unroll
        for (int ai = 0; ai < 2; ++ai)
#pragma unroll
            for (int m = 0; m < 4; ++m) { unsigned char* rowp = Hh + (size_t)(row0 + ai * HALF + m * 16) * DFF + col0;
                float r[8];
#pragma unroll
                for (int n = 0; n < 2; ++n)
#pragma unroll
                    for (int j = 0; j < 4; ++j) { const float g = acc[ai][0][m][n][j] * (1.0f / F8_SW1), uu = acc[ai][1][m][n][j] * (F8_SH / F8_SW1); r[4 * n + j] = g * fast_sigmoid(g) * uu; }
                u32x2 w; w.x = pk4_fp8(r[0], r[1], r[2], r[3]); w.y = pk4_fp8(r[4], r[5], r[6], r[7]);
                *(u32x2*)rowp = w; }
    }
};
struct EpiF8 {
    unsigned char* O; int ldc; float scale;
    DI void operator()(const f32x4 (&acc)[2][2][4][2], const Unit& u, int wr, int wc, int fr, int fq) const {
        const int row0 = u.pm * BM + wr * 64 + fr, col0 = u.pn * BM + wc * 32 + 8 * fq;
#pragma unroll
        for (int ai = 0; ai < 2; ++ai)
#pragma unroll
            for (int m = 0; m < 4; ++m) { unsigned char* rowp = O + (size_t)(row0 + ai * HALF + m * 16) * ldc + col0;
#pragma unroll
                for (int bj = 0; bj < 2; ++bj) { const f32x4 v0 = acc[ai][bj][m][0] * scale, v1 = acc[ai][bj][m][1] * scale;
                    u32x2 w; w.x = pk4_fp8(v0[0], v0[1], v0[2], v0[3]); w.y = pk4_fp8(v1[0], v1[1], v1[2], v1[3]); *(u32x2*)(rowp + bj * HALF) = w; } }
    }
};
struct EpiGate {
    bf16* O; const unsigned char* gate; const bf16* add; unsigned char* O8; float ascale, oscale;
    DI void operator()(const f32x4 (&acc)[2][2][4][2], const Unit& u, int wr, int wc, int fr, int fq) const {
        const int row0 = u.pm * BM + wr * 64 + fr, col0 = u.pn * BM + wc * 32 + 8 * fq;
#pragma unroll
        for (int ai = 0; ai < 2; ++ai) {
            u32x2 gv[4][2]; u32x4 av[4][2];
#pragma unroll
            for (int m = 0; m < 4; ++m)
#pragma unroll
                for (int bj = 0; bj < 2; ++bj) { const size_t ro = (size_t)(row0 + ai * HALF + m * 16) * D + col0 + bj * HALF;
                    gv[m][bj] = *(const u32x2*)(gate + ro); av[m][bj] = add ? *(const u32x4*)(add + ro) : (u32x4){0u, 0u, 0u, 0u}; }
#pragma unroll
            for (int m = 0; m < 4; ++m) { const size_t ro = (size_t)(row0 + ai * HALF + m * 16) * D + col0;
#pragma unroll
                for (int bj = 0; bj < 2; ++bj) { const f32x4 v0 = acc[ai][bj][m][0] * ascale, v1 = acc[ai][bj][m][1] * ascale;
                    const u32x2 g = gv[m][bj]; const u32x4 a = av[m][bj];
                    const f32x2 g0 = __builtin_amdgcn_cvt_pk_f32_fp8((int)g.x, false), g1 = __builtin_amdgcn_cvt_pk_f32_fp8((int)g.x, true), g2 = __builtin_amdgcn_cvt_pk_f32_fp8((int)g.y, false), g3 = __builtin_amdgcn_cvt_pk_f32_fp8((int)g.y, true);
                    float r[8] = { v0[0] * g0[0], v0[1] * g0[1], v0[2] * g1[0], v0[3] * g1[1], v1[0] * g2[0], v1[1] * g2[1], v1[2] * g3[0], v1[3] * g3[1] };
                    r[0] += bflo(a.x); r[1] += bfhi(a.x); r[2] += bflo(a.y); r[3] += bfhi(a.y); r[4] += bflo(a.z); r[5] += bfhi(a.z); r[6] += bflo(a.w); r[7] += bfhi(a.w);
                    if (O8) { u32x2 w; w.x = pk4_fp8(r[0] * oscale, r[1] * oscale, r[2] * oscale, r[3] * oscale); w.y = pk4_fp8(r[4] * oscale, r[5] * oscale, r[6] * oscale, r[7] * oscale); *(u32x2*)(O8 + ro + bj * HALF) = w; }
                    else { u32x4 w; w.x = cvt_pk_bf16(r[0], r[1]); w.y = cvt_pk_bf16(r[2], r[3]); w.z = cvt_pk_bf16(r[4], r[5]); w.w = cvt_pk_bf16(r[6], r[7]);
                        *(u32x4*)(O + ro + bj * HALF) = w; } } }
        }
    }
};
struct EpiSwiglu {
    bf16* Hh;
    DI void operator()(const f32x4 (&acc)[2][2][4][2], const Unit& u, int wr, int wc, int fr, int fq) const {
        const int row0 = u.pm * BM + wr * 64 + fr, col0 = u.pn * HALF + wc * 32 + 8 * fq;
#pragma unroll
        for (int ai = 0; ai < 2; ++ai)
#pragma unroll
            for (int m = 0; m < 4; ++m) { bf16* rowp = Hh + (size_t)(row0 + ai * HALF + m * 16) * DFF + col0;
                float r[8];
#pragma unroll
                for (int n = 0; n < 2; ++n)
#pragma unroll
                    for (int j = 0; j < 4; ++j) { const float g = acc[ai][0][m][n][j], uu = acc[ai][1][m][n][j]; r[4 * n + j] = g * fast_sigmoid(g) * uu; }
                u32x4 w; w.x = cvt_pk_bf16(r[0], r[1]); w.y = cvt_pk_bf16(r[2], r[3]); w.z = cvt_pk_bf16(r[4], r[5]); w.w = cvt_pk_bf16(r[6], r[7]);
                *(u32x4*)rowp = w; }
    }
};
struct EpiInBf {
    bf16 *qidx, *qm, *km; float* kwraw;
    DI void operator()(const f32x4 (&acc)[2][2][4][2], const Unit& u, int wr, int wc, int fr, int fq) const {
        const int row0 = u.pm * BM + wr * 64 + fr, cl = wc * 32 + 8 * fq; const int pn = u.pn;
        if (pn == 4) {
#pragma unroll
            for (int ai = 0; ai < 2; ++ai)
#pragma unroll
                for (int m = 0; m < 4; ++m) { float* rowp = kwraw + (size_t)(row0 + ai * HALF + m * 16) * 256 + cl;
#pragma unroll
                    for (int bj = 0; bj < 2; ++bj) { *(f32x4*)(rowp + bj * HALF) = acc[ai][bj][m][0]; *(f32x4*)(rowp + bj * HALF + 4) = acc[ai][bj][m][1]; } }
            return;
        }
        bf16* O; int ct;
        if (pn < 4) { O = qidx; ct = pn; } else if (pn < 9) { O = qm; ct = pn - 5; } else { O = km; ct = pn - 9; }
        const int col0 = ct * BM + cl;
#pragma unroll
        for (int ai = 0; ai < 2; ++ai)
#pragma unroll
            for (int m = 0; m < 4; ++m) { bf16* rowp = O + (size_t)(row0 + ai * HALF + m * 16) * 1024 + col0;
#pragma unroll
                for (int bj = 0; bj < 2; ++bj) { const f32x4 v0 = acc[ai][bj][m][0], v1 = acc[ai][bj][m][1];
                    u32x4 w; w.x = cvt_pk_bf16(v0[0], v0[1]); w.y = cvt_pk_bf16(v0[2], v0[3]); w.z = cvt_pk_bf16(v1[0], v1[1]); w.w = cvt_pk_bf16(v1[2], v1[3]);
                    *(u32x4*)(rowp + bj * HALF) = w; } }
    }
};
struct EpiIn8 {
    bf16 *qdsa, *vm, *ga, *gb; float* ckvraw; const float* bgate; bf16 *qm, *km;
    DI void operator()(const f32x4 (&acc)[2][2][4][2], const Unit& u, int wr, int wc, int fr, int fq) const {
        const int row0 = u.pm * BM + wr * 64 + fr, cl = wc * 32 + 8 * fq; const int pn = u.pn; const float sc = 1.0f / F8_SWI;
        if (pn == 4) {
#pragma unroll
            for (int ai = 0; ai < 2; ++ai)
#pragma unroll
                for (int m = 0; m < 4; ++m) { float* rowp = ckvraw + (size_t)(row0 + ai * HALF + m * 16) * 256 + cl;
#pragma unroll
                    for (int bj = 0; bj < 2; ++bj) { *(f32x4*)(rowp + bj * HALF) = acc[ai][bj][m][0] * sc; *(f32x4*)(rowp + bj * HALF + 4) = acc[ai][bj][m][1] * sc; } }
            return;
        }
        bf16* O; int ldc, ct; const float* bias = nullptr;
        if (pn < 4) { O = qdsa; ldc = 1024; ct = pn; }
        else if (pn < 9) { O = vm; ldc = 1024; ct = pn - 5; }
        else if (pn < 17) { O = ga; ldc = 2048; ct = pn - 9; bias = bgate; }
        else if (pn < 25) { O = gb; ldc = 2048; ct = pn - 17; bias = bgate + 2048; }
        else if (pn < 29) { O = qm; ldc = 1024; ct = pn - 25; }
        else { O = km; ldc = 1024; ct = pn - 29; }
        const int col0 = ct * BM + cl;
        f32x4 bb[2][2] = {{(f32x4){0.f, 0.f, 0.f, 0.f}, (f32x4){0.f, 0.f, 0.f, 0.f}}, {(f32x4){0.f, 0.f, 0.f, 0.f}, (f32x4){0.f, 0.f, 0.f, 0.f}}};
        if (bias) {
#pragma unroll
            for (int bj = 0; bj < 2; ++bj) { bb[bj][0] = *(const f32x4*)(bias + col0 + bj * HALF); bb[bj][1] = *(const f32x4*)(bias + col0 + bj * HALF + 4); } }
#pragma unroll
        for (int ai = 0; ai < 2; ++ai)
#pragma unroll
            for (int m = 0; m < 4; ++m) { bf16* rowp = O + (size_t)(row0 + ai * HALF + m * 16) * ldc + col0;
#pragma unroll
                for (int bj = 0; bj < 2; ++bj) { f32x4 v0 = acc[ai][bj][m][0] * sc, v1 = acc[ai][bj][m][1] * sc;
                    if (bias) { const f32x4 b0 = bb[bj][0], b1 = bb[bj][1];
#pragma unroll
                        for (int j = 0; j < 4; ++j) { v0[j] = fast_sigmoid(v0[j] + b0[j]) * F8_SGT; v1[j] = fast_sigmoid(v1[j] + b1[j]) * F8_SGT; }
                        u32x2 w8; w8.x = pk4_fp8(v0[0], v0[1], v0[2], v0[3]); w8.y = pk4_fp8(v1[0], v1[1], v1[2], v1[3]);
                        *(u32x2*)((unsigned char*)O + (size_t)(row0 + ai * HALF + m * 16) * 2048 + col0 + bj * HALF) = w8; continue; }
                    u32x4 w; w.x = cvt_pk_bf16(v0[0], v0[1]); w.y = cvt_pk_bf16(v0[2], v0[3]); w.z = cvt_pk_bf16(v1[0], v1[1]); w.w = cvt_pk_bf16(v1[2], v1[3]);
                    *(u32x4*)(rowp + bj * HALF) = w; } }
    }
};

struct FusedOrder {
    int c;
    DI bool next(int i, Unit& u) const { if (i >= 2) return false; const int xcd = c & 7, j = c >> 3; u.pm = xcd * 8 + i * 4 + (j >> 3); u.pn = j & 7; return true; }
};
struct EpiLn {
    bf16* x; const float* g; const float* b; float scale; float* xf; unsigned char* xb8; unsigned long long* slots; unsigned* cnt;
    DI void run(f32x4 (&acc)[2][2][4][2], const Unit& u, int wr, int wc, int fr_, int fq_, LAS unsigned char* lds, int wid, int lane_) const {
        int fr = fr_, fq = fq_, lane = lane_; asm volatile("" : "+v"(fr), "+v"(fq), "+v"(lane));
        LAS f32x2* P = (LAS f32x2*)(lds + LNT_OFF); LAS f32x2* Sx = (LAS f32x2*)(lds + LNT_OFF + 8192);
        const int row0 = u.pm * BM + wr * 64 + fr, col0 = u.pn * BM + wc * 32 + 8 * fq;
        __builtin_amdgcn_sched_barrier(0);
#pragma unroll
        for (int ai = 0; ai < 2; ++ai) {
            u32x4 xw[4][2];
#pragma unroll
            for (int m = 0; m < 4; ++m)
#pragma unroll
                for (int bj = 0; bj < 2; ++bj) xw[m][bj] = *(const u32x4*)(x + (size_t)(row0 + ai * HALF + m * 16) * D + col0 + bj * HALF);
#pragma unroll
            for (int m = 0; m < 4; ++m)
#pragma unroll
                for (int bj = 0; bj < 2; ++bj) { const u32x4 w = xw[m][bj];
                    const f32x4 x0 = {__uint_as_float(w.x << 16), __uint_as_float(w.x & 0xffff0000u), __uint_as_float(w.y << 16), __uint_as_float(w.y & 0xffff0000u)};
                    const f32x4 x1 = {__uint_as_float(w.z << 16), __uint_as_float(w.z & 0xffff0000u), __uint_as_float(w.w << 16), __uint_as_float(w.w & 0xffff0000u)};
                    acc[ai][bj][m][0] = x0 * ALPHA + acc[ai][bj][m][0] * scale; acc[ai][bj][m][1] = x1 * ALPHA + acc[ai][bj][m][1] * scale; }
            __builtin_amdgcn_sched_barrier(0);
            asm volatile("" : "+v"(acc[ai][0][0][0]), "+v"(acc[ai][1][3][1]) :: "memory");
        }
        __builtin_amdgcn_sched_barrier(0);
#pragma unroll
        for (int ai = 0; ai < 2; ++ai)
#pragma unroll
            for (int m = 0; m < 4; ++m) {
                float s = 0.f;
#pragma unroll
                for (int bj = 0; bj < 2; ++bj)
#pragma unroll
                    for (int n = 0; n < 2; ++n) { const f32x4 v = acc[ai][bj][m][n]; s += (v[0] + v[1]) + (v[2] + v[3]); }
                s = xrow16_sum(s);
                const float mw = s * (1.0f / 64.0f); float q = 0.f;
#pragma unroll
                for (int bj = 0; bj < 2; ++bj)
#pragma unroll
                    for (int n = 0; n < 2; ++n) { const f32x4 d = acc[ai][bj][m][n] - mw; q += (d[0] * d[0] + d[1] * d[1]) + (d[2] * d[2] + d[3] * d[3]); }
                q = xrow16_sum(q);
                if (fq == 0) P[(ai * HALF + wr * 64 + m * 16 + fr) * 4 + wc] = (f32x2){mw, q};
            }
        asm volatile("s_waitcnt lgkmcnt(0)" ::: "memory"); __builtin_amdgcn_s_barrier(); asm volatile("" ::: "memory");
        const int row = wid * 32 + (lane & 31);
        if (lane < 32) {
            const f32x2 a = P[row * 4 + 0], b2 = P[row * 4 + 1], c = P[row * 4 + 2], d = P[row * 4 + 3];
            const float mt = (a[0] + b2[0] + c[0] + d[0]) * 0.25f;
            const float da = a[0] - mt, db = b2[0] - mt, dc = c[0] - mt, dd = d[0] - mt;
            const float m2 = (a[1] + b2[1]) + (c[1] + d[1]) + 64.0f * ((da * da + db * db) + (dc * dc + dd * dd));
            __hip_atomic_store(slots + ((size_t)(u.pm * BM + row) * 8 + u.pn), ((unsigned long long)__float_as_uint(m2) << 32) | __float_as_uint(mt), __ATOMIC_RELAXED, __HIP_MEMORY_SCOPE_AGENT);
        }
        asm volatile("s_waitcnt vmcnt(0)" ::: "memory");
        if (lane == 0) __hip_atomic_fetch_add(cnt + 64 * u.pm, 1u, __ATOMIC_RELAXED, __HIP_MEMORY_SCOPE_AGENT);
        if (wid == 0) {
            unsigned sp = 0;
            while ((unsigned)__builtin_amdgcn_readfirstlane(__hip_atomic_load(cnt + 64 * u.pm, __ATOMIC_RELAXED, __HIP_MEMORY_SCOPE_AGENT)) < 64u) { __builtin_amdgcn_s_sleep(1); if (++sp > (1u << 24)) break; }
            __builtin_amdgcn_fence(__ATOMIC_ACQUIRE, "agent");
        }
        asm volatile("s_waitcnt vmcnt(0) lgkmcnt(0)" ::: "memory"); __builtin_amdgcn_s_barrier(); asm volatile("" ::: "memory");
        if (lane < 32) {
            const unsigned long long* sl = slots + (size_t)(u.pm * BM + row) * 8; float mt[8], m2[8]; float ms = 0.f;
#pragma unroll
            for (int t = 0; t < 8; ++t) { const unsigned long long w = __hip_atomic_load(sl + t, __ATOMIC_RELAXED, __HIP_MEMORY_SCOPE_AGENT); mt[t] = __uint_as_float((unsigned)w); m2[t] = __uint_as_float((unsigned)(w >> 32)); ms += mt[t]; }
            const float mean = ms * 0.125f; float q = 0.f;
#pragma unroll
            for (int t = 0; t < 8; ++t) { const float dm = mt[t] - mean; q += m2[t] + 256.0f * dm * dm; }
            Sx[row] = (f32x2){mean, 1.0f / sqrtf(q * (1.0f / D) + LN_EPS)};
        }
        asm volatile("s_waitcnt lgkmcnt(0)" ::: "memory"); __builtin_amdgcn_s_barrier(); asm volatile("" ::: "memory");
        __builtin_amdgcn_sched_barrier(0);
        f32x4 gb[2][4];
#pragma unroll
        for (int bj = 0; bj < 2; ++bj) { gb[bj][0] = *(const f32x4*)(g + col0 + bj * HALF); gb[bj][1] = *(const f32x4*)(g + col0 + bj * HALF + 4); gb[bj][2] = *(const f32x4*)(b + col0 + bj * HALF); gb[bj][3] = *(const f32x4*)(b + col0 + bj * HALF + 4); }
#pragma unroll
        for (int bj = 0; bj < 2; ++bj) {
            const f32x4 g0 = gb[bj][0], g1 = gb[bj][1], b0 = gb[bj][2], b1 = gb[bj][3];
#pragma unroll
            for (int ai = 0; ai < 2; ++ai)
#pragma unroll
                for (int m = 0; m < 4; ++m) { const int rl = ai * HALF + wr * 64 + m * 16 + fr; const f32x2 sr = Sx[rl]; const size_t off = (size_t)(u.pm * BM + rl) * D + col0 + bj * HALF;
                    const f32x4 o0 = (acc[ai][bj][m][0] - sr[0]) * sr[1] * g0 + b0, o1 = (acc[ai][bj][m][1] - sr[0]) * sr[1] * g1 + b1;
                    if (xf) { *(f32x4*)(xf + off) = o0; *(f32x4*)(xf + off + 4) = o1; }
                    else { u32x4 w; w.x = cvt_pk_bf16(o0[0], o0[1]); w.y = cvt_pk_bf16(o0[2], o0[3]); w.z = cvt_pk_bf16(o1[0], o1[1]); w.w = cvt_pk_bf16(o1[2], o1[3]); *(u32x4*)(x + off) = w;
                        u32x2 w8; w8.x = pk4_fp8(o0[0], o0[1], o0[2], o0[3]); w8.y = pk4_fp8(o1[0], o1[1], o1[2], o1[3]); *(u32x2*)(xb8 + off) = w8; }
                    asm volatile("" ::: "memory"); __builtin_amdgcn_sched_barrier(0); }
        }
        asm volatile("s_waitcnt lgkmcnt(0)" ::: "memory"); __builtin_amdgcn_s_barrier(); asm volatile("" ::: "memory");
    }
};

template <class Epi, bool FP8 = false, class Order = StaticOrder, bool LN = false>
DI void gemm_phase(LAS unsigned char* lds, const Gemm g, const Order& So, const Epi& E, int tid_in) {
    int tid_ = tid_in; asm volatile("" : "+v"(tid_));
    const int tid = tid_, wid = __builtin_amdgcn_readfirstlane(tid >> 6), lane = tid & 63, wr = wid >> 2, wc = wid & 3, fr = lane & 15, fq = lane >> 4;
    const int K = g.K, nt = K / BK;
    unsigned voffA[2], voffB[2];
#pragma unroll
    for (int i = 0; i < 2; ++i) { int R, C; stage_rc(tid * 16 + i * 8192, R, C); const int Rb = (R & ~31) + perm32(R & 31);
        voffA[i] = (unsigned)(R * g.lda + C) * 2u; voffB[i] = (unsigned)(Rb * g.ldb + C) * 2u; }
    const size_t kstep = (size_t)(BK * 2);
    const size_t hstepA = (size_t)HALF * g.lda * 2, hstepB = (size_t)HALF * g.ldb * 2;
    const size_t tstepA = 2 * hstepA, tstepB = 2 * hstepB;
    const unsigned ldsw = (unsigned)wid * 1024u;
    const int aoff = lds_byte(wr * 64 + fr, fq * 8), boff = lds_byte(wc * 32 + fr, fq * 8);
    int one8 = 0x7F7F7F7F; asm volatile("" : "+v"(one8));
#define PG8_SA(b, h) (((b) * 2 + (h)) * HTB)
#define PG8_SB(b, h) ((4 + (b) * 2 + (h)) * HTB)
#define PG8_STAGE(bufoff, gbase, voff) do { _Pragma("unroll") for (int _i = 0; _i < 2; ++_i) \
        __builtin_amdgcn_global_load_lds((const unsigned*)((const char*)(gbase) + (voff)[_i]), (LAS unsigned*)(lds + (bufoff) + ldsw + _i * 8192), 16, 0, 0); } while (0)
#define PG8_LDA(dst, b, h) do { _Pragma("unroll") for (int m = 0; m < 4; ++m) { const LAS unsigned char* p_ = lds + PG8_SA(b, h) + aoff + m * 2048; \
        if constexpr (FP8) { const v4i lo_ = *(const LAS v4i*)p_, hi_ = *(const LAS v4i*)(p_ + 1024); dst##8[m] = __builtin_shufflevector(lo_, hi_, 0, 1, 2, 3, 4, 5, 6, 7); } \
        else { dst[m][0] = *(const LAS v4i*)p_; dst[m][1] = *(const LAS v4i*)(p_ + 1024); } } } while (0)
#define PG8_LDB(dst, b, h) do { _Pragma("unroll") for (int n = 0; n < 2; ++n) { const LAS unsigned char* p_ = lds + PG8_SB(b, h) + boff + n * 2048; \
        if constexpr (FP8) { const v4i lo_ = *(const LAS v4i*)p_, hi_ = *(const LAS v4i*)(p_ + 1024); dst##8[n] = __builtin_shufflevector(lo_, hi_, 0, 1, 2, 3, 4, 5, 6, 7); } \
        else { dst[n][0] = *(const LAS v4i*)p_; dst[n][1] = *(const LAS v4i*)(p_ + 1024); } } } while (0)
#define PG8_MMA(ai, bj, At, Bt) do { __builtin_amdgcn_s_setprio(1); _Pragma("unroll") for (int m = 0; m < 4; ++m) _Pragma("unroll") for (int n = 0; n < 2; ++n) { \
        if constexpr (FP8) { asm volatile("v_mfma_scale_f32_16x16x128_f8f6f4 %0, %1, %2, %0, %3, %3 op_sel_hi:[0,0,0]" : "+v"(acc[ai][bj][m][n]) : "v"(Bt##8[n]), "v"(At##8[m]), "v"(one8)); } \
        else { _Pragma("unroll") for (int k = 0; k < 2; ++k) acc[ai][bj][m][n] = __builtin_amdgcn_mfma_f32_16x16x32_bf16(__builtin_bit_cast(bf16x8, Bt[n][k]), __builtin_bit_cast(bf16x8, At[m][k]), acc[ai][bj][m][n], 0, 0, 0); } } \
        __builtin_amdgcn_s_setprio(0); } while (0)
#define PG8_WAIT_V(n) asm volatile("s_waitcnt vmcnt(" #n ")" ::: "memory")
#define PG8_WAIT_L(n) asm volatile("s_waitcnt lgkmcnt(" #n ")" ::: "memory")
#define PG8_BAR __builtin_amdgcn_s_barrier()
#define PG8_SCHED __builtin_amdgcn_sched_barrier(0)
#define PG8_ABASE(u) ((const char*)g.A + (size_t)(u).pm * tstepA + (size_t)(((u).pn >> g.a_shift) * g.a_koff) * 2)
#define PG8_BBASE(u) ((const char*)g.Bt + (size_t)(u).pn * tstepB)
    Unit cur, nxt; int ui = 0;
    if (!So.next(0, cur)) return;
    f32x4 acc[2][2][4][2];
#pragma unroll
    for (int a = 0; a < 2; ++a)
#pragma unroll
        for (int b = 0; b < 2; ++b)
#pragma unroll
            for (int m = 0; m < 4; ++m)
#pragma unroll
                for (int n = 0; n < 2; ++n) acc[a][b][m][n] = (f32x4){0.f, 0.f, 0.f, 0.f};
    v4i At[4][2], B0[2][2], B1[2][2]; v8i At8[4], B08[2], B18[2];
    const char* cA = PG8_ABASE(cur); const char* cB = PG8_BBASE(cur);
    PG8_STAGE(PG8_SB(0, 0), cB, voffB); PG8_STAGE(PG8_SB(0, 1), cB + hstepB, voffB); PG8_STAGE(PG8_SA(0, 0), cA, voffA); PG8_STAGE(PG8_SA(0, 1), cA + hstepA, voffA);
    if (wr == 1) PG8_BAR;
    PG8_WAIT_V(2); PG8_BAR;
    PG8_STAGE(PG8_SB(1, 0), cB + kstep, voffB); PG8_STAGE(PG8_SA(1, 0), cA + kstep, voffA); PG8_STAGE(PG8_SB(1, 1), cB + hstepB + kstep, voffB);
    PG8_WAIT_V(6); PG8_BAR;
    for (;;) {
        const bool has_next = So.next(ui + 1, nxt);
        const char* nA = has_next ? PG8_ABASE(nxt) : cA; const char* nB = has_next ? PG8_BBASE(nxt) : cB;
        for (int t = 0; t < nt; t += 2) {
            const bool last = (t == nt - 2);
            const char* a1 = cA + (size_t)(t + 1) * kstep;
            const char* a2 = last ? nA : cA + (size_t)(t + 2) * kstep; const char* b2 = last ? nB : cB + (size_t)(t + 2) * kstep;
            const char* a3 = a2 + kstep; const char* b3 = b2 + kstep;
            PG8_LDB(B0, 0, 0); PG8_LDB(B1, 0, 1); PG8_SCHED; PG8_LDA(At, 0, 0); PG8_STAGE(PG8_SA(1, 1), a1 + hstepA, voffA);
            PG8_WAIT_V(8); PG8_WAIT_L(0); PG8_BAR; PG8_MMA(0, 0, At, B0); PG8_MMA(0, 1, At, B1); PG8_BAR; PG8_SCHED;
            PG8_LDA(At, 0, 1); PG8_STAGE(PG8_SB(0, 0), b2, voffB); PG8_STAGE(PG8_SB(0, 1), b2 + hstepB, voffB); PG8_STAGE(PG8_SA(0, 0), a2, voffA);
            PG8_WAIT_V(8); PG8_WAIT_L(0); PG8_BAR; PG8_MMA(1, 0, At, B0); PG8_MMA(1, 1, At, B1); PG8_BAR; PG8_SCHED;
            PG8_LDB(B0, 1, 0); PG8_LDB(B1, 1, 1); PG8_SCHED; PG8_LDA(At, 1, 0); PG8_STAGE(PG8_SA(0, 1), a2 + hstepA, voffA);
            PG8_WAIT_V(8); PG8_WAIT_L(0); PG8_BAR; PG8_MMA(0, 0, At, B0); PG8_MMA(0, 1, At, B1); PG8_BAR; PG8_SCHED;
            PG8_LDA(At, 1, 1); PG8_STAGE(PG8_SB(1, 0), b3, voffB); PG8_STAGE(PG8_SB(1, 1), b3 + hstepB, voffB); PG8_STAGE(PG8_SA(1, 0), a3, voffA);
            PG8_WAIT_V(8); PG8_WAIT_L(0); PG8_BAR; PG8_MMA(1, 0, At, B0); PG8_MMA(1, 1, At, B1); PG8_BAR; PG8_SCHED;
        }
        if (wr == 0) PG8_BAR;
        if constexpr (FP8) asm volatile("s_nop 15\n\ts_nop 15" ::: "memory");
        if constexpr (LN) E.run(acc, cur, wr, wc, fr, fq, lds, wid, lane); else E(acc, cur, wr, wc, fr, fq);
        if (!has_next) break;
#pragma unroll
        for (int a = 0; a < 2; ++a)
#pragma unroll
            for (int b = 0; b < 2; ++b)
#pragma unroll
                for (int m = 0; m < 4; ++m)
#pragma unroll
                    for (int n = 0; n < 2; ++n) acc[a][b][m][n] = (f32x4){0.f, 0.f, 0.f, 0.f};
        cur = nxt; cA = nA; cB = nB; ++ui;
        if (wr == 1) PG8_BAR;
    }
    PG8_WAIT_V(0);
    PG8_BAR;
#undef PG8_SA
#undef PG8_SB
#undef PG8_STAGE
#undef PG8_LDA
#undef PG8_LDB
#undef PG8_MMA
#undef PG8_WAIT_V
#undef PG8_WAIT_L
#undef PG8_BAR
#undef PG8_SCHED
#undef PG8_ABASE
#undef PG8_BBASE
}
}

#define XB_TMO      128
#define XB_XCNT(j)  (256  + 64 * (j))
#define XB_XSUB(j)  (1280 + 64 * (j))
#define XB_XGEN(j)  (2304 + 64 * (j))
#define XB_TOP      3328
#define XB_TOPGEN   3392
#define XCD_BAR_WORDS 3456
#define XB_SPIN_CAP (1u << 22)
DI unsigned xb_ld(unsigned* p)              { return __hip_atomic_load(p, __ATOMIC_RELAXED, __HIP_MEMORY_SCOPE_AGENT); }
DI unsigned xb_add(unsigned* p, unsigned v) { return __hip_atomic_fetch_add(p, v, __ATOMIC_RELAXED, __HIP_MEMORY_SCOPE_AGENT); }
DI unsigned xb_xcc_id() { return (unsigned)__builtin_amdgcn_s_getreg((3 << 11) | 20) & 0xFu; }
#define XB_SPIN(cond, bar) do { unsigned _sp = 0; while (cond) { __builtin_amdgcn_s_sleep(1); \
    if ((++_sp & 255u) == 0u) { if (xb_ld(&(bar)[XB_TMO])) break; if (_sp > XB_SPIN_CAP) { atomicAdd(&(bar)[XB_TMO], 1u); break; } } } } while (0)
struct XcdBarrier { unsigned* bar; unsigned x; volatile LAS unsigned* st; int w0; };
DI XcdBarrier xcd_barrier_post(unsigned* bar, volatile LAS unsigned* st) {
    XcdBarrier b; b.bar = bar; b.x = xb_xcc_id(); b.st = st; b.w0 = __builtin_amdgcn_readfirstlane((int)threadIdx.x >> 6);
    if (threadIdx.x == 0) (void)xb_add(&bar[XB_XCNT(b.x)], 1u);
    return b;
}
DI void xcd_barrier_complete(unsigned* bar, unsigned x, unsigned& nloc, unsigned& nx) {
    const unsigned G = gridDim.x * gridDim.y * gridDim.z;
    unsigned sum, cnt, mine, sp = 0u;
    for (;;) {
        sum = 0u; cnt = 0u; mine = 0u;
#pragma unroll
        for (unsigned j = 0; j < 16; ++j) { const unsigned c = xb_ld(&bar[XB_XCNT(j)]); sum += c; cnt += (c > 0u) ? 1u : 0u; mine = (j == x) ? c : mine; }
        if (sum == G) break;
        __builtin_amdgcn_s_sleep(1);
        if ((++sp & 255u) == 0u) { if (xb_ld(&bar[XB_TMO])) break; if (sp > XB_SPIN_CAP) { atomicAdd(&bar[XB_TMO], 1u); break; } }
    }
    nloc = mine > 0u ? mine : 1u; nx = cnt > 0u ? cnt : 1u;
}
DI void xcd_barrier(const XcdBarrier& b) {
    asm volatile("s_waitcnt vmcnt(0)" ::: "memory");
    __syncthreads();
    if (b.w0 == 0 && lane_id() == 0) {
        unsigned* bar = b.bar;
        __builtin_amdgcn_s_waitcnt(0);
        unsigned nloc = b.st[0], nx = b.st[1];
        if (nloc == 0u) { xcd_barrier_complete(bar, b.x, nloc, nx); b.st[0] = nloc; b.st[1] = nx; }
        const unsigned old = xb_add(&bar[XB_XSUB(b.x)], 1u);
        const unsigned gen = old / nloc;
        if (old + 1u == (gen + 1u) * nloc) {
            __builtin_amdgcn_fence(__ATOMIC_RELEASE, "agent");
            asm volatile("s_waitcnt vmcnt(0)" ::: "memory");
            const unsigned og = xb_add(&bar[XB_TOP], 1u);
            const unsigned tg = og / nx;
            if (og + 1u == (tg + 1u) * nx) xb_add(&bar[XB_TOPGEN], 1u);
            else XB_SPIN(xb_ld(&bar[XB_TOPGEN]) == tg, bar);
            __builtin_amdgcn_fence(__ATOMIC_ACQUIRE, "agent");
            xb_add(&bar[XB_XGEN(b.x)], 1u);
            asm volatile("s_waitcnt vmcnt(0)" ::: "memory");
        } else {
            XB_SPIN(xb_ld(&bar[XB_XGEN(b.x)]) == gen, bar);
            __builtin_amdgcn_fence(__ATOMIC_ACQUIRE, "agent");
            asm volatile("s_waitcnt vmcnt(0)" ::: "memory");
        }
    }
    __syncthreads();
}

struct Args { const float* in[19]; float* out; unsigned char* ws; int ph_lo, ph_hi; };
struct Frame {
    LAS unsigned char* lds; unsigned char* ws; gu32* ctl;
    int tid, lane, wave, bx, G;
};
DI Frame make_frame(unsigned char* ws_in, LAS unsigned char* lds_in, int w0) {
    Frame F; GAS unsigned char* w = (GAS unsigned char*)ws_in; asm volatile("" : "+s"(w)); int t = w0 * 64 + lane_id(); asm volatile("" : "+v"(t));
    F.lds = lds_in; F.ws = (unsigned char*)w; F.ctl = (gu32*)(w + WS_CTL);
    F.tid = t; F.lane = t & 63; F.wave = __builtin_amdgcn_readfirstlane(t >> 6); F.bx = blockIdx.x; F.G = gridDim.x;
    return F;
}

template <int MAP> DI int conv_rowmap(int n) {
    if (MAP == 1) return n < 2384 ? n : n + 176;
    if (MAP == 2) { const int isu = n >= DFF ? 1 : 0, j = n - isu * DFF; return 256 * (j >> 7) + 128 * isu + (j & 127); }
    return n;
}
template <int MAP> DI void conv_item(const float* W, int N, bf16* WT, int ldd, LAS float* scr, int kb, int nb, int lane) {
    const int k0 = 64 * kb, n0 = 32 * nb;
    const bool nok = n0 + (lane & 31) < N;
    { float v[32]; const float* wp = W + (size_t)(k0 + (lane >> 5)) * N + n0 + (lane & 31);
#pragma unroll
      for (int i = 0; i < 32; ++i) v[i] = nok ? __builtin_nontemporal_load(wp + (size_t)(2 * i) * N) : 0.f;
#pragma unroll
      for (int i = 0; i < 32; ++i) scr[(2 * i + (lane >> 5)) * 33 + (lane & 31)] = v[i]; }
    asm volatile("s_waitcnt lgkmcnt(0)" ::: "memory");
    const int c = lane & 7;
#pragma unroll
    for (int j = 0; j < 4; ++j) { const int n = (lane >> 3) + 8 * j; const LAS float* s = scr + (8 * c) * 33 + n;
        u32x4 o; o.x = pk2(s[0 * 33], s[1 * 33]); o.y = pk2(s[2 * 33], s[3 * 33]); o.z = pk2(s[4 * 33], s[5 * 33]); o.w = pk2(s[6 * 33], s[7 * 33]);
        if (n0 + n < N) *(u32x4*)(WT + (size_t)conv_rowmap<MAP>(n0 + n) * ldd + k0 + 8 * c) = o; }
    asm volatile("s_waitcnt lgkmcnt(0)" ::: "memory");
}
template <int MAP> DI void conv_item8(const float* W, int N, unsigned char* WT, int ldd, LAS float* scr, int kb, int nb, int lane, float scale) {
    const int k0 = 64 * kb, n0 = 32 * nb;
    const bool nok = n0 + (lane & 31) < N;
    { float v[32]; const float* wp = W + (size_t)(k0 + (lane >> 5)) * N + n0 + (lane & 31);
#pragma unroll
      for (int i = 0; i < 32; ++i) v[i] = nok ? __builtin_nontemporal_load(wp + (size_t)(2 * i) * N) : 0.f;
#pragma unroll
      for (int i = 0; i < 32; ++i) scr[(2 * i + (lane >> 5)) * 33 + (lane & 31)] = v[i]; }
    asm volatile("s_waitcnt lgkmcnt(0)" ::: "memory");
    const int c = lane & 3;
#pragma unroll
    for (int j = 0; j < 2; ++j) { const int n = (lane >> 2) + 16 * j; const LAS float* s = scr + (16 * c) * 33 + n;
        u32x4 o; o.x = pk4_fp8(s[0 * 33] * scale, s[1 * 33] * scale, s[2 * 33] * scale, s[3 * 33] * scale); o.y = pk4_fp8(s[4 * 33] * scale, s[5 * 33] * scale, s[6 * 33] * scale, s[7 * 33] * scale);
        o.z = pk4_fp8(s[8 * 33] * scale, s[9 * 33] * scale, s[10 * 33] * scale, s[11 * 33] * scale); o.w = pk4_fp8(s[12 * 33] * scale, s[13 * 33] * scale, s[14 * 33] * scale, s[15 * 33] * scale);
        if (n0 + n < N) *(u32x4*)(WT + (size_t)conv_rowmap<MAP>(n0 + n) * ldd + k0 + 16 * c) = o; }
    asm volatile("s_waitcnt lgkmcnt(0)" ::: "memory");
}
DI int win_rowmap(int c) {
    if (c < 1024) return -1 - c;
    if (c < 1280) return -1 - c;
    if (c < 2304) return c - 1280;
    if (c < 2384) return c - 2304 + 1024;
    if (c < 3408) return MOBA_QK_FP8 ? -1 - (c - 2384 + 6400) : c - 2384 + 1280;
    if (c < 4432) return MOBA_QK_FP8 ? -1 - (c - 3408 + 7424) : c - 3408 + 2304;
    if (c < 5456) return -1 - (c - 4432 + 1280);
    if (c < 7504) return -1 - (c - 5456 + 2304);
    return -1 - (c - 7504 + 4352);
}
DI void conv_item_win(const float* W, bf16* WTb, unsigned char* WT8, LAS float* scr, int kb, int nb, int lane) {
    const int N = INW, k0 = 64 * kb, n0 = 32 * nb;
    const bool nok = n0 + (lane & 31) < N;
    { float v[32]; const float* wp = W + (size_t)(k0 + (lane >> 5)) * N + n0 + (lane & 31);
#pragma unroll
      for (int i = 0; i < 32; ++i) v[i] = nok ? __builtin_nontemporal_load(wp + (size_t)(2 * i) * N) : 0.f;
#pragma unroll
      for (int i = 0; i < 32; ++i) scr[(2 * i + (lane >> 5)) * 33 + (lane & 31)] = v[i]; }
    asm volatile("s_waitcnt lgkmcnt(0)" ::: "memory");
    const int last = n0 + 31 < N ? n0 + 31 : N - 1;
    if (win_rowmap(n0) >= 0 || win_rowmap(last) >= 0) {
        const int c = lane & 7;
#pragma unroll
        for (int j = 0; j < 4; ++j) { const int n = (lane >> 3) + 8 * j; const LAS float* s = scr + (8 * c) * 33 + n; const int rm = n0 + n < N ? win_rowmap(n0 + n) : -1;
            u32x4 o; o.x = pk2(s[0 * 33], s[1 * 33]); o.y = pk2(s[2 * 33], s[3 * 33]); o.z = pk2(s[4 * 33], s[5 * 33]); o.w = pk2(s[6 * 33], s[7 * 33]);
            if (rm >= 0) *(u32x4*)(WTb + (size_t)rm * D + k0 + 8 * c) = o; }
    }
    if (win_rowmap(n0) < 0 || win_rowmap(last) < 0) {
        const int c = lane & 3;
#pragma unroll
        for (int j = 0; j < 2; ++j) { const int n = (lane >> 2) + 16 * j; const LAS float* s = scr + (16 * c) * 33 + n; const int rm = n0 + n < N ? win_rowmap(n0 + n) : 0;
            u32x4 o; o.x = pk4_fp8(s[0 * 33] * F8_SWI, s[1 * 33] * F8_SWI, s[2 * 33] * F8_SWI, s[3 * 33] * F8_SWI); o.y = pk4_fp8(s[4 * 33] * F8_SWI, s[5 * 33] * F8_SWI, s[6 * 33] * F8_SWI, s[7 * 33] * F8_SWI);
            o.z = pk4_fp8(s[8 * 33] * F8_SWI, s[9 * 33] * F8_SWI, s[10 * 33] * F8_SWI, s[11 * 33] * F8_SWI); o.w = pk4_fp8(s[12 * 33] * F8_SWI, s[13 * 33] * F8_SWI, s[14 * 33] * F8_SWI, s[15 * 33] * F8_SWI);
            if (rm < 0) *(u32x4*)(WT8 + (size_t)(-1 - rm) * D + k0 + 16 * c) = o; }
    }
    asm volatile("s_waitcnt lgkmcnt(0)" ::: "memory");
}
DI void zero_rows(bf16* p, int rows, int cols, int ld, int gt, int ngt) {
    const int cpr = cols / 8; unsigned z0; asm volatile("v_mov_b32 %0, 0" : "=v"(z0)); const u32x4 z = {z0, z0, z0, z0};
    for (int i = gt; i < rows * cpr; i += ngt) *(u32x4*)(p + (size_t)(i / cpr) * ld + (i % cpr) * 8) = z;
}
DI void conv_phase(const Frame& F, const Args& a, int l) {
    LAS float* scr = (LAS float*)(F.lds + F.wave * 16384);
    const int gw = F.bx * NWAVES + F.wave, NGW = F.G * NWAVES, lane = F.lane;
    unsigned char* ws = F.ws;
    const float* w_in = a.in[2] + (size_t)l * D * INW; const float* w_uk = a.in[7] + (size_t)l * NH * HD * CKV; const float* w_uv = a.in[8] + (size_t)l * NH * CKV * HD;
    const float* w_oa = a.in[9] + (size_t)l * 1024 * D; const float* w_ob = a.in[10] + (size_t)l * 1024 * D; const float* w_out = a.in[11] + (size_t)l * D * D;
    const float* w_qm = a.in[12] + (size_t)l * D * 512; const float* w_om = a.in[14] + (size_t)l * 512 * D;
    const float* w_f1 = a.in[15] + (size_t)l * D * 2 * DFF; const float* w_f2 = a.in[16] + (size_t)l * DFF * D;
    constexpr int NB_IN = (INW + 31) / 32;
    constexpr int I_IN = 32 * NB_IN, I_UK = 8 * 2 * 8, I_UV = 8 * 4 * 4, I_OA = 16 * 64, I_OUT = 32 * 64, I_QM = 32 * 16, I_OM = 8 * 64, I_F1 = 32 * 352, I_F2 = 88 * 64, I_KV = 4 * 32 * 32;
    const int total = I_IN + I_UK + I_UV + 2 * I_OA + I_OUT + I_QM + I_OM + I_F1 + I_F2 + (l == 0 ? I_KV : 0);
    for (int it = gw; it < total; it += NGW) {
        int r = it;
        if (r < I_IN) { conv_item_win(w_in, (bf16*)(ws + WS_WIN), ws + WS_WIN8, scr, r / NB_IN, r % NB_IN, lane); continue; } r -= I_IN;
        if (r < I_UK) { const int h = r >> 4, q = r & 15; conv_item<0>(w_uk + (size_t)h * HD * CKV, CKV, (bf16*)(ws + WS_WUK) + (size_t)(h * 256) * 256 + (h & 1) * 128, 256, scr, q >> 3, q & 7, lane); continue; } r -= I_UK;
        if (r < I_UV) { const int h = r >> 4, q = r & 15; conv_item<0>(w_uv + (size_t)h * CKV * HD, HD, (bf16*)(ws + WS_WUV) + (size_t)(h * 128) * 512 + (h & 1) * 256, 512, scr, q >> 2, q & 3, lane); continue; } r -= I_UV;
        if (r < I_OA) { conv_item8<0>(w_oa, D, ws + WS_WOA, 1024, scr, r >> 6, r & 63, lane, F8_SWO); continue; } r -= I_OA;
        if (r < I_OA) { conv_item8<0>(w_ob, D, ws + WS_WOB, 1024, scr, r >> 6, r & 63, lane, F8_SWO); continue; } r -= I_OA;
        if (r < I_OUT) { conv_item8<0>(w_out, D, ws + WS_WOUT, D, scr, r >> 6, r & 63, lane, F8_SWOUT); continue; } r -= I_OUT;
        if (r < I_QM) { conv_item8<0>(w_qm, 512, ws + WS_WQM, D, scr, r >> 4, r & 15, lane, F8_SWQM); continue; } r -= I_QM;
        if (r < I_OM) { conv_item8<0>(w_om, D, ws + WS_WOM, 512, scr, r >> 6, r & 63, lane, F8_SWOM); continue; } r -= I_OM;
        if (r < I_F1) { conv_item8<2>(w_f1, 2 * DFF, ws + WS_WF1, D, scr, r / 352, r % 352, lane, F8_SW1); continue; } r -= I_F1;
        if (r < I_F2) { conv_item8<0>(w_f2, D, ws + WS_WF2, DFF, scr, r >> 6, r & 63, lane, F8_SW2); continue; } r -= I_F2;
        { const int ll = r >> 10, q = r & 1023; conv_item<0>(a.in[13] + (size_t)ll * D * 1024, 1024, (bf16*)(ws + WS_WKV) + (size_t)ll * 1024 * D, D, scr, q >> 5, q & 31, lane); }
    }
    const int gt = F.bx * NTHREADS + F.tid, ngt = F.G * NTHREADS;
    zero_rows((bf16*)(ws + WS_WIN) + (size_t)1104 * D, 176, D, D, gt, ngt);
    for (int h = 0; h < NH; ++h) {
        zero_rows((bf16*)(ws + WS_WUK) + (size_t)(h * 256) * 256 + ((h + 1) & 1) * 128, 256, 128, 256, gt, ngt);
        zero_rows((bf16*)(ws + WS_WUV) + (size_t)(h * 128) * 512 + ((h + 1) & 1) * 256, 128, 256, 512, gt, ngt);
    }
    if (l == 0) {
        const f32x4* xs = (const f32x4*)a.in[0]; u32x2* xb = (u32x2*)(ws + WS_XB);
        unsigned* xb8 = (unsigned*)(ws + WS_XB8);
        for (int i0 = gt; i0 < S * D / 4; i0 += 8 * ngt) {
            f32x4 v[8];
#pragma unroll
            for (int q = 0; q < 8; ++q) v[q] = __builtin_nontemporal_load(xs + i0 + q * ngt);
#pragma unroll
            for (int q = 0; q < 8; ++q) { const int i = i0 + q * ngt; u32x2 w; w.x = pk2(v[q][0], v[q][1]); w.y = pk2(v[q][2], v[q][3]); xb[i] = w; xb8[i] = pk4_fp8(v[q][0], v[q][1], v[q][2], v[q][3]); } }
        static_assert((S * D / 4) % (8 * 256 * NTHREADS) == 0, "x copy tiling");
        const f32x4* ms = (const f32x4*)a.in[1]; u32x2* mb = (u32x2*)(ws + WS_MEMB);
        for (int i = gt; i < NMEM * D / 4; i += ngt) { const f32x4 v = ms[i]; u32x2 w; w.x = pk2(v[0], v[1]); w.y = pk2(v[2], v[3]); mb[i] = w; }
    }
}

DI void norm_phase(const Frame& F, const Args& a, int l) {
    const int gw = F.bx * NWAVES + F.wave, NGW = F.G * NWAVES, lane = F.lane;
    const float* ckv = (const float*)(F.ws + WS_CKVRAW); const float* kw = (const float*)(F.ws + WS_KWRAW);
    const float* kvg = a.in[4] + l * CKV; const float* ig = a.in[5] + l * IDIM; const float* ib = a.in[6] + l * IDIM;
    const f32x4 g4 = *(const f32x4*)(kvg + 4 * lane); const float gi = ig[lane], bi = ib[lane];
    for (int t0 = gw; t0 < S; t0 += 4 * NGW) {
        f32x4 v[4]; float k[4], wq[4];
#pragma unroll
        for (int i = 0; i < 4; ++i) { const int t = t0 + i * NGW; const bool ok = t < S; const size_t tt = ok ? (size_t)t : (size_t)gw;
            v[i] = *(const f32x4*)(ckv + tt * 256 + 4 * lane); k[i] = kw[tt * 256 + lane]; wq[i] = kw[tt * 256 + 64 + (lane & 15)]; }
#pragma unroll
        for (int i = 0; i < 4; ++i) { const int t = t0 + i * NGW; if (t >= S) break;
            const float ss = wave_sum(v[i][0] * v[i][0] + v[i][1] * v[i][1] + v[i][2] * v[i][2] + v[i][3] * v[i][3]);
            const float r = 1.0f / sqrtf(ss * (1.0f / CKV) + LN_EPS);
            *(unsigned*)(F.ws + WS_CKVN + (size_t)t * 256 + 4 * lane) = pk4_fp8(v[i][0] * r * g4[0], v[i][1] * r * g4[1], v[i][2] * r * g4[2], v[i][3] * r * g4[3]);
            const float mu = wave_sum(k[i]) * (1.0f / IDIM); const float d = k[i] - mu; const float var = wave_sum(d * d) * (1.0f / IDIM);
            const float kn = d * (1.0f / sqrtf(var + LN_EPS)) * gi + bi;
            ((bf16*)(F.ws + WS_KIDXN))[(size_t)t * 64 + lane] = (bf16)f2bf(kn);
            if (lane < IH) ((float*)(F.ws + WS_WIDX))[(size_t)t * IH + lane] = wq[i]; }
    }
    const bf16* km = (const bf16*)(F.ws + WS_KM);
    for (int u = gw; u < NH * NBLK; u += NGW) {
        const int h = u >> 6, b = u & 63; float s[8] = {0.f, 0.f, 0.f, 0.f, 0.f, 0.f, 0.f, 0.f};
        const u32x4* p = (const u32x4*)(km + (size_t)(b * MBLK + (lane >> 4)) * 1024 + h * HD + 8 * (lane & 15));
#pragma unroll 16
        for (int i = 0; i < MBLK / 4; ++i) { const u32x4 v = p[(size_t)i * (4 * 1024 / 8)];
            s[0] += bflo(v.x); s[1] += bfhi(v.x); s[2] += bflo(v.y); s[3] += bfhi(v.y); s[4] += bflo(v.z); s[5] += bfhi(v.z); s[6] += bflo(v.w); s[7] += bfhi(v.w); }
#pragma unroll
        for (int e = 0; e < 8; ++e) s[e] = xrow16_sum(s[e]);
        if (lane < 16) { float* o = (float*)(F.ws + WS_KMEAN) + (size_t)(h * NBLK + b) * HD + 8 * lane;
            *(f32x4*)o = (f32x4){s[0], s[1], s[2], s[3]} * (1.0f / MBLK); *(f32x4*)(o + 4) = (f32x4){s[4], s[5], s[6], s[7]} * (1.0f / MBLK); }
    }
}

DI void moba_gate_phase(const Frame& F, int l) {
    LAS float* km = (LAS float*)F.lds; LAS unsigned* lcnt = (LAS unsigned*)(F.lds + 32768); LAS unsigned* gbase = lcnt + 64;
    const bf16* qm = (const bf16*)(F.ws + WS_QM); const float* kmean = (const float*)(F.ws + WS_KMEAN);
    unsigned* bcnt = (unsigned*)(F.ctl + CW_BCNT) + l * 512; unsigned* buck = (unsigned*)(F.ws + WS_BUCK);
    for (int u = F.bx; u < NH * 32; u += F.G) {
        const int h = u & 7, ip = u >> 3; const int own = (F.tid < 256) ? ip : 63 - ip; const int t = own * 256 + (F.tid & 255);
        f32x4 kmv[4];
#pragma unroll
        for (int j = 0; j < 4; ++j) kmv[j] = ((const f32x4*)(kmean + (size_t)h * NBLK * HD))[F.tid + j * NTHREADS];
        u32x4 qraw[16];
        { const u32x4* qp = (const u32x4*)(qm + (size_t)t * 1024 + h * HD);
#pragma unroll
          for (int c = 0; c < 16; ++c) qraw[c] = qp[c]; }
        __syncthreads();
#pragma unroll
        for (int j = 0; j < 4; ++j) ((LAS f32x4*)km)[F.tid + j * NTHREADS] = kmv[j];
        if (F.tid < 64) lcnt[F.tid] = 0u;
        __syncthreads();
        float q[HD];
        {
#pragma unroll
          for (int c = 0; c < 16; ++c) { const u32x4 qv = qraw[c]; q[8 * c + 0] = bflo(qv.x); q[8 * c + 1] = bfhi(qv.x); q[8 * c + 2] = bflo(qv.y); q[8 * c + 3] = bfhi(qv.y);
              q[8 * c + 4] = bflo(qv.z); q[8 * c + 5] = bfhi(qv.z); q[8 * c + 6] = bflo(qv.w); q[8 * c + 7] = bfhi(qv.w); } }
        const float NEG = -__builtin_inff(); float v0 = NEG, v1 = NEG, v2 = NEG; int i0 = -1, i1 = -1, i2 = -1;
        const int bmax = __builtin_amdgcn_readfirstlane(own);
#pragma unroll 4
        for (int b = 0; b < bmax; ++b) {
            const LAS f32x4* kr = (const LAS f32x4*)(km + b * HD);
            float d0 = 0.f, d1 = 0.f, d2 = 0.f, d3 = 0.f;
#pragma unroll
            for (int c = 0; c < 32; ++c) { const f32x4 k = kr[c]; d0 += q[4 * c] * k[0]; d1 += q[4 * c + 1] * k[1]; d2 += q[4 * c + 2] * k[2]; d3 += q[4 * c + 3] * k[3]; }
            const float g = (d0 + d1) + (d2 + d3);
            if (g > v0) { v2 = v1; i2 = i1; v1 = v0; i1 = i0; v0 = g; i0 = b; } else if (g > v1) { v2 = v1; i2 = i1; v1 = g; i1 = b; } else if (g > v2) { v2 = g; i2 = b; }
        }
        unsigned lp0 = 0, lp1 = 0, lp2 = 0;
        if (i0 >= 0) lp0 = atomicAdd((unsigned*)&lcnt[i0], 1u);
        if (i1 >= 0) lp1 = atomicAdd((unsigned*)&lcnt[i1], 1u);
        if (i2 >= 0) lp2 = atomicAdd((unsigned*)&lcnt[i2], 1u);
        __syncthreads();
        if (F.tid < 64) { const unsigned c = lcnt[F.tid]; gbase[F.tid] = c ? __hip_atomic_fetch_add(bcnt + h * 64 + F.tid, c, RLX_AGENT) : 0u; }
        __syncthreads();
        unsigned* bh = buck + (size_t)h * BUCK_PER_HEAD;
        if (i0 >= 0) bh[bucket_off(i0) + gbase[i0] + lp0] = ((unsigned)t << 2) | 0u;
        if (i1 >= 0) bh[bucket_off(i1) + gbase[i1] + lp1] = ((unsigned)t << 2) | 1u;
        if (i2 >= 0) bh[bucket_off(i2) + gbase[i2] + lp2] = ((unsigned)t << 2) | 2u;
    }
    __syncthreads();
}

constexpr int IX_KSTRIDE = 144, IX_KBUF = 128 * IX_KSTRIDE;
constexpr int IX_WSTRIDE = 2048 + 64;
constexpr int IX_CSC = 2 * IX_KBUF;
constexpr int IX_CIX = IX_CSC + 8 * IX_WSTRIDE * 4;
static_assert(IX_CIX + 8 * IX_WSTRIDE * 2 <= MISC_OFF, "indexer LDS");
static_assert((size_t)4 * (CW_LNCNT + DEPTH * 3 * 64 * 64) <= CTL_ZERO_BYTES && (size_t)4 * (CW_BCNT + DEPTH * 512) <= CTL_ZERO_BYTES, "control words inside the per-call reset");
DI unsigned sortable(float f) { const unsigned u = __float_as_uint(f); return (u >> 31) ? ~u : (u | 0x80000000u); }
DI float unsortable(unsigned k) { return __uint_as_float((k >> 31) ? (k ^ 0x80000000u) : ~k); }
DI unsigned popc64(unsigned long long m) { return (unsigned)__builtin_popcountll(m); }
DI unsigned mbcnt64(unsigned long long m) { return __builtin_amdgcn_mbcnt_hi((unsigned)(m >> 32), __builtin_amdgcn_mbcnt_lo((unsigned)m, 0u)); }
template <int APPROX> DI float ix_compact(LAS float* sc, LAS unsigned short* ix, int& n, int lane) {
    unsigned key[16]; unsigned short idv[16];
    const bool big = n > 512;
    unsigned kmax = 0u, kmin = 0xFFFFFFFFu;
#pragma unroll
    for (int j = 0; j < 16; ++j) { const int e = j * 64 + lane; key[j] = 0u; idv[j] = 0;
        if (j < 8 || big) { const bool v = e < n; key[j] = v ? sortable(sc[e]) : 0u; idv[j] = ix[e]; kmax = key[j] > kmax ? key[j] : kmax; const unsigned km = v ? key[j] : 0xFFFFFFFFu; kmin = km < kmin ? km : kmin; } }
    kmax = wave_umax(kmax); kmin = wave_umin(kmin);
    const unsigned diff = (unsigned)__builtin_amdgcn_readfirstlane((int)(kmax ^ kmin));
    const int nb = diff ? 32 - __builtin_clz(diff) : 0;
    unsigned cur = (unsigned)__builtin_amdgcn_readfirstlane((int)kmax); cur = nb >= 32 ? 0u : (cur >> nb) << nb;
    unsigned ccur = (unsigned)n;
    for (int b = nb - 1; b >= 0; --b) {
        const unsigned trial = cur | (1u << b); unsigned c = 0;
#pragma unroll
        for (int j = 0; j < 8; ++j) c += popc64(__ballot(key[j] >= trial));
        if (big) {
#pragma unroll
            for (int j = 8; j < 16; ++j) c += popc64(__ballot(key[j] >= trial)); }
        if (c >= (unsigned)TOPK) { cur = trial; ccur = c; if (APPROX && c <= 320u) break; }
    }
    unsigned need_eq = 0x7fffffffu;
    if (!APPROX) { unsigned ngt = 0;
#pragma unroll
        for (int j = 0; j < 16; ++j) ngt += popc64(__ballot(key[j] > cur));
        need_eq = (unsigned)TOPK - ngt; }
    unsigned out = 0, eqseen = 0;
#pragma unroll
    for (int j = 0; j < 16; ++j) {
        if (j < 8 || big) {
            const bool valid = (j * 64 + lane) < n; const bool gt = key[j] > cur, eq = valid && key[j] == cur;
            const unsigned long long em = __ballot(eq); const bool keep = (valid && gt) || (eq && (eqseen + mbcnt64(em)) < need_eq);
            const unsigned long long kmk = __ballot(keep); const unsigned pos = out + mbcnt64(kmk);
            if (keep) { sc[pos] = unsortable(key[j]); ix[pos] = idv[j]; }
            out += popc64(kmk); eqseen += popc64(em);
        }
    }
    n = (int)out; (void)ccur;
    return unsortable(cur);
}
DI float relu_nc(float x) { const int b = __float_as_int(x); return __int_as_float(b > 0 ? b : 0); }
#define IX_SCORE(ACC, KEY0, S_) do { \
    f32x2 s0_ = {0.f, 0.f}, s1_ = {0.f, 0.f}; \
    _Pragma("unroll") for (int i_ = 0; i_ < 4; ++i_) { const f32x2 r0_ = {relu_nc(ACC[2 * i_]), relu_nc(ACC[2 * i_ + 1])}, r1_ = {relu_nc(ACC[8 + 2 * i_]), relu_nc(ACC[9 + 2 * i_])}; \
        s0_ = __builtin_elementwise_fma(r0_, wv2[i_], s0_); s1_ = __builtin_elementwise_fma(r1_, wv2[4 + i_], s1_); } \
    const auto sw_ = __builtin_amdgcn_permlane32_swap(__float_as_uint(s0_[0] + s0_[1]), __float_as_uint(s1_[0] + s1_[1]), false, false); \
    S_ = __uint_as_float(sw_[0]) + __uint_as_float(sw_[1]); \
    S_ = ((KEY0) + r) <= tq ? S_ : NEG; } while (0)
#define IX_APPEND(S_, KEY0) do { \
    const bool pass_ = S_ > thr; \
    const unsigned long long mk_ = __ballot(pass_); \
    if (IX_DRY) { dry_acc += S_; } else { \
        const unsigned mlo_ = (unsigned)mk_, mhi_ = (unsigned)(mk_ >> 32); const int nlo_ = __builtin_popcount(mlo_), nhi_ = __builtin_popcount(mhi_); \
        const unsigned base_ = hh ? (unsigned)(cnt1 - nlo_ + 1024) : (unsigned)cnt0; \
        const unsigned pos_ = __builtin_amdgcn_mbcnt_hi(mhi_, __builtin_amdgcn_mbcnt_lo(mlo_, base_)); \
        const unsigned idx_ = pass_ ? pos_ : (unsigned)(2048 + lane);            \
        csc[idx_] = S_; cix[idx_] = (unsigned short)((KEY0) + r); \
        cnt0 += nlo_; cnt1 += nhi_; \
        if ((cnt0 > cnt1 ? cnt0 : cnt1) > 1024 - 64) { \
            if (cnt0 > 1024 - 64) { const float nt_ = ix_compact<1>(csc, cix, cnt0, lane); thr = hh ? thr : nt_; } \
            if (cnt1 > 1024 - 64) { const float nt_ = ix_compact<1>(csc + 1024, cix + 1024, cnt1, lane); thr = hh ? nt_ : thr; } } \
    } } while (0)
#define IX_PROCESS(ACC, KEY0) do { float sc_; IX_SCORE(ACC, KEY0, sc_); IX_APPEND(sc_, KEY0); } while (0)
#define IX_APPEND2(SA_, KEYA, SB_, KEYB) do { \
    if (IX_DRY) { dry_acc += SA_ + SB_; } else { \
        const bool pa_ = SA_ > thr, pb_ = SB_ > thr; \
        const unsigned long long ma_ = __ballot(pa_), mb_ = __ballot(pb_); \
        const unsigned alo_ = (unsigned)ma_, ahi_ = (unsigned)(ma_ >> 32), blo_ = (unsigned)mb_, bhi_ = (unsigned)(mb_ >> 32); \
        const int nal_ = __builtin_popcount(alo_), nah_ = __builtin_popcount(ahi_), nbl_ = __builtin_popcount(blo_), nbh_ = __builtin_popcount(bhi_); \
        const unsigned basea_ = hh ? (unsigned)(cnt1 - nal_ + 1024) : (unsigned)cnt0; \
        const unsigned baseb_ = hh ? (unsigned)(cnt1 + nah_ - nbl_ + 1024) : (unsigned)(cnt0 + nal_); \
        const unsigned posa_ = __builtin_amdgcn_mbcnt_hi(ahi_, __builtin_amdgcn_mbcnt_lo(alo_, basea_)), posb_ = __builtin_amdgcn_mbcnt_hi(bhi_, __builtin_amdgcn_mbcnt_lo(blo_, baseb_)); \
        const unsigned ia_ = pa_ ? posa_ : (unsigned)(2048 + lane), ib_ = pb_ ? posb_ : (unsigned)(2048 + lane); \
        csc[ia_] = SA_; cix[ia_] = (unsigned short)((KEYA) + r); csc[ib_] = SB_; cix[ib_] = (unsigned short)((KEYB) + r); \
        cnt0 += nal_ + nbl_; cnt1 += nah_ + nbh_; \
        if ((cnt0 > cnt1 ? cnt0 : cnt1) > 1024 - 64) { \
            if (cnt0 > 1024 - 64) { const float nt_ = ix_compact<1>(csc, cix, cnt0, lane); thr = hh ? thr : nt_; } \
            if (cnt1 > 1024 - 64) { const float nt_ = ix_compact<1>(csc + 1024, cix + 1024, cnt1, lane); thr = hh ? nt_ : thr; } } \
    } } while (0)
#define IX_APPEND2NC(SA_, KEYA, SB_, KEYB) do { \
    if (IX_DRY) { dry_acc += SA_ + SB_; } else { \
        const bool pa_ = SA_ > thr, pb_ = SB_ > thr; \
        const unsigned long long ma_ = __ballot(pa_), mb_ = __ballot(pb_); \
        const unsigned alo_ = (unsigned)ma_, ahi_ = (unsigned)(ma_ >> 32), blo_ = (unsigned)mb_, bhi_ = (unsigned)(mb_ >> 32); \
        const int nal_ = __builtin_popcount(alo_), nah_ = __builtin_popcount(ahi_), nbl_ = __builtin_popcount(blo_), nbh_ = __builtin_popcount(bhi_); \
        const unsigned basea_ = hh ? (unsigned)(cnt1 - nal_ + 1024) : (unsigned)cnt0; \
        const unsigned baseb_ = hh ? (unsigned)(cnt1 + nah_ - nbl_ + 1024) : (unsigned)(cnt0 + nal_); \
        const unsigned posa_ = __builtin_amdgcn_mbcnt_hi(ahi_, __builtin_amdgcn_mbcnt_lo(alo_, basea_)), posb_ = __builtin_amdgcn_mbcnt_hi(bhi_, __builtin_amdgcn_mbcnt_lo(blo_, baseb_)); \
        const unsigned ia_ = pa_ ? posa_ : (unsigned)(2048 + lane), ib_ = pb_ ? posb_ : (unsigned)(2048 + lane); \
        csc[ia_] = SA_; cix[ia_] = (unsigned short)((KEYA) + r); csc[ib_] = SB_; cix[ib_] = (unsigned short)((KEYB) + r); \
        cnt0 += nal_ + nbl_; cnt1 += nah_ + nbh_; \
    } } while (0)
#define IX_OVF() do { if (!IX_DRY && (cnt0 > cnt1 ? cnt0 : cnt1) > 1024 - 64) { \
    if (cnt0 > 1024 - 64) { const float nt_ = ix_compact<1>(csc, cix, cnt0, lane); thr = hh ? thr : nt_; } \
    if (cnt1 > 1024 - 64) { const float nt_ = ix_compact<1>(csc + 1024, cix + 1024, cnt1, lane); thr = hh ? nt_ : thr; } } } while (0)
#define IX_MMA(ACC, KB, TILE) do { \
    _Pragma("unroll") for (int i_ = 0; i_ < 16; ++i_) ACC[i_] = 0.f; \
    _Pragma("unroll") for (int kk_ = 0; kk_ < 4; ++kk_) { const bf16x8 b_ = *(const LAS bf16x8*)((KB) + boff + (TILE) * (32 * IX_KSTRIDE) + kk_ * 32); \
        ACC = __builtin_amdgcn_mfma_f32_32x32x16_bf16(af[kk_], b_, ACC, 0, 0, 0); } } while (0)
#define IX_LDB(FR, KB, TILE) do { _Pragma("unroll") for (int kk_ = 0; kk_ < 4; ++kk_) FR[kk_] = *(const LAS bf16x8*)((KB) + boff + (TILE) * (32 * IX_KSTRIDE) + kk_ * 32); } while (0)
#define IX_MMAR(ACC, FR) do { \
    _Pragma("unroll") for (int i_ = 0; i_ < 16; ++i_) ACC[i_] = 0.f; \
    _Pragma("unroll") for (int kk_ = 0; kk_ < 4; ++kk_) ACC = __builtin_amdgcn_mfma_f32_32x32x16_bf16(af[kk_], FR[kk_], ACC, 0, 0, 0); } while (0)
#define IX_STEP(KB, T0, ACCN0, ACCN1, ACCP0, ACCP1, KEYP) do { \
    bf16x8 fa_[4], fb_[4]; float qa_, qb_; \
    IX_LDB(fa_, KB, T0); IX_LDB(fb_, KB, (T0) + 1); \
    IX_MMAR(ACCN0, fa_); IX_SCORE(ACCP0, KEYP, qa_); IX_MMAR(ACCN1, fb_); IX_SCORE(ACCP1, (KEYP) + 32, qb_); \
    IX_APPEND2NC(qa_, KEYP, qb_, (KEYP) + 32); \
    IX_OVF(); } while (0)
#define IX_MMA2(KB, T0, ACCN0, ACCN1) do { bf16x8 fa_[4], fb_[4]; IX_LDB(fa_, KB, T0); IX_LDB(fb_, KB, (T0) + 1); IX_MMAR(ACCN0, fa_); IX_MMAR(ACCN1, fb_); } while (0)
#define IX_TAIL(ACCP0, ACCP1, KEYP) do { float qa_, qb_; IX_SCORE(ACCP0, KEYP, qa_); IX_SCORE(ACCP1, (KEYP) + 32, qb_); IX_APPEND2NC(qa_, KEYP, qb_, (KEYP) + 32); } while (0)
#define IX_MMAR_SCORE(ACCN, FR, ACCC, KEY0, S_) do { IX_MMAR(ACCN, FR); IX_SCORE(ACCC, KEY0, S_); \
    _Pragma("unroll") for (int g_ = 0; g_ < 4; ++g_) { __builtin_amdgcn_sched_group_barrier(0x008, 1, 0); __builtin_amdgcn_sched_group_barrier(0x002, 10, 0); } } while (0)
#define IX_SCHED(CH) do { if (!IX_DRY && (((CH) + 1) == 16 || ((CH) + 1) == 32 || ((CH) + 1) == 64)) { \
    if (cnt0 > 320) { const float nt_ = ix_compact<1>(csc, cix, cnt0, lane); thr = hh ? thr : nt_; } \
    if (cnt1 > 320) { const float nt_ = ix_compact<1>(csc + 1024, cix + 1024, cnt1, lane); thr = hh ? nt_ : thr; } } } while (0)
#define IX_CHUNK(KB, CH) do { \
    int nt_w = ((ta + 1 - (CH) * 128) >> 5) + 1; nt_w = nt_w < 0 ? 0 : (nt_w > 4 ? 4 : nt_w); \
    f32x16 accA, accB; \
    if (nt_w == 4) { float qa_, qb_, qc_, qd_; bf16x8 fr0[4], fr1[4], fr2[4], fr3[4]; f32x16 accC, accD;     \
        IX_LDB(fr0, KB, 0); IX_LDB(fr1, KB, 1); IX_LDB(fr2, KB, 2); IX_LDB(fr3, KB, 3); \
        IX_MMAR(accA, fr0); IX_MMAR(accB, fr1); \
        IX_MMAR(accC, fr2); IX_MMAR(accD, fr3); IX_SCORE(accA, (CH) * 128, qa_); IX_SCORE(accB, (CH) * 128 + 32, qb_); \
        IX_APPEND2(qa_, (CH) * 128, qb_, (CH) * 128 + 32); \
        IX_SCORE(accC, (CH) * 128 + 64, qc_); IX_SCORE(accD, (CH) * 128 + 96, qd_); \
        IX_APPEND2(qc_, (CH) * 128 + 64, qd_, (CH) * 128 + 96); \
    } else if (nt_w > 0) { IX_MMA(accA, KB, 0); \
        if (nt_w > 1) IX_MMA(accB, KB, 1); \
        IX_PROCESS(accA, (CH) * 128); \
        if (nt_w > 1) { if (nt_w > 2) IX_MMA(accA, KB, 2); \
            IX_PROCESS(accB, (CH) * 128 + 32); \
            if (nt_w > 2) IX_PROCESS(accA, (CH) * 128 + 64); } } } while (0)
#define IX_LDSBAR() do { asm volatile("s_waitcnt lgkmcnt(0)" ::: "memory"); __builtin_amdgcn_s_barrier(); asm volatile("" ::: "memory"); } while (0)
DI void indexer_phase(const Frame& F) {
    const int lane = F.lane, wave = F.wave, tid = F.tid, r = lane & 31, hh = lane >> 5;
    const bf16* qidx = (const bf16*)(F.ws + WS_QIDX); const bf16* kidx = (const bf16*)(F.ws + WS_KIDXN); const float* widx = (const float*)(F.ws + WS_WIDX);
    unsigned short* sel = (unsigned short*)(F.ws + WS_SEL);
    LAS float* csc = (LAS float*)(F.lds + IX_CSC) + wave * IX_WSTRIDE; LAS unsigned short* cix = (LAS unsigned short*)(F.lds + IX_CIX) + wave * IX_WSTRIDE;
    const float NEG = -__builtin_inff();
    const unsigned boff = (unsigned)(r * IX_KSTRIDE + hh * 16);
    const unsigned sg0 = (unsigned)((tid >> 3) * 64 + (tid & 7) * 8), sl0 = (unsigned)((tid >> 3) * IX_KSTRIDE + (tid & 7) * 16);
    LAS unsigned char* const kb0 = F.lds, * const kb1 = F.lds + IX_KBUF;
#define IX_LOAD(R, CHK) do { const int c_ = (CHK) < nch ? (CHK) : nch - 1; const bf16* g_ = kidx + (size_t)c_ * (128 * 64) + sg0; R[0] = *(const u32x4*)g_; R[1] = *(const u32x4*)(g_ + 64 * 64); } while (0)
#define IX_STORE(KB, R) do { *(LAS u32x4*)((KB) + sl0) = R[0]; *(LAS u32x4*)((KB) + sl0 + 64 * IX_KSTRIDE) = R[1]; } while (0)
    for (int ui = 0; ui * F.G < S / 16; ++ui) {
        const int unit = ui * F.G + ((ui & 1) ? F.G - 1 - F.bx : F.bx);
        if (unit >= S / 16) continue;
        const int t0 = unit * 16, nkeys = t0 + 16, nch = (nkeys + 127) >> 7;
        const int ta = t0 + 2 * wave;
        bf16x8 af[4];
#pragma unroll
        for (int kk = 0; kk < 4; ++kk) af[kk] = *(const bf16x8*)(qidx + (size_t)(ta + (r >> 4)) * 1024 + (r & 15) * 64 + 16 * kk + 8 * hh);
        f32x2 wv2[8];
#pragma unroll
        for (int i = 0; i < 8; ++i) { const int e0 = 2 * i, e1 = 2 * i + 1;
            wv2[i] = (f32x2){widx[(size_t)(ta + (e0 >> 3)) * IH + (e0 & 3) + 8 * ((e0 >> 2) & 1) + 4 * hh], widx[(size_t)(ta + (e1 >> 3)) * IH + (e1 & 3) + 8 * ((e1 >> 2) & 1) + 4 * hh]}; }
        float thr = NEG; int cnt0 = 0, cnt1 = 0; const int tq = ta + hh;
        float dry_acc = 0.f; (void)dry_acc;
#define IX_DRY 0
        {
        u32x4 RA[2], RB[2];
        f32x16 aP0, aP1, aQ0, aQ1;
        IX_LOAD(RA, 0); IX_LOAD(RB, 1);
        IX_STORE(kb0, RA); IX_LOAD(RA, 2);
        for (int ch = 0; ch < nch; ch += 2) {
            IX_LDSBAR();
            if (ch == 0) { IX_MMA2(kb0, 0, aP0, aP1); }
            else { IX_STEP(kb0, 0, aP0, aP1, aQ0, aQ1, (ch - 1) * 128 + 64); IX_SCHED(ch - 1); }
            IX_STEP(kb0, 2, aQ0, aQ1, aP0, aP1, ch * 128);
            IX_STORE(kb1, RB); IX_LOAD(RB, ch + 3);
            IX_LDSBAR();
            if (ch + 1 < nch) {
                IX_STEP(kb1, 0, aP0, aP1, aQ0, aQ1, ch * 128 + 64); IX_SCHED(ch);
                IX_STEP(kb1, 2, aQ0, aQ1, aP0, aP1, (ch + 1) * 128);
            }
            IX_STORE(kb0, RA); IX_LOAD(RA, ch + 4);
        }
        IX_TAIL(aQ0, aQ1, (nch - 1) * 128 + 64);
        }
#undef IX_DRY
        if (cnt0 > TOPK) (void)ix_compact<0>(csc, cix, cnt0, lane);
        if (cnt1 > TOPK) (void)ix_compact<0>(csc + 1024, cix + 1024, cnt1, lane);
#pragma unroll
        for (int q = 0; q < 2; ++q) { const int n = q ? cnt1 : cnt0;
#pragma unroll
            for (int j = 0; j < 4; ++j) { const int e = j * 64 + lane; sel[(size_t)(ta + q) * TOPK + e] = e < n ? cix[q * 1024 + e] : (unsigned short)0xFFFFu; } }
        __syncthreads();
    }
#undef IX_LOAD
#undef IX_STORE
}
#undef IX_PROCESS
#undef IX_SCORE
#undef IX_APPEND
#undef IX_MMAR_SCORE
#undef IX_STEP
#undef IX_MMA2
#undef IX_TAIL
#undef IX_OVF
#undef IX_APPEND2NC
#undef IX_MMAR
#undef IX_LDB
#undef IX_MMA
#undef IX_CHUNK
#undef IX_SCHED

constexpr int DA_WBYTES = 16384 + 256;
DI void dsa_attn_phase(const Frame& F) {
    const int lane = F.lane, fr = lane & 15, fq = lane >> 4;
    const bf16* qlat = (const bf16*)(F.ws + WS_QLAT); const bf16* ckv = (const bf16*)(F.ws + WS_CKVN); const unsigned short* sel = (const unsigned short*)(F.ws + WS_SEL);
    bf16* olat = (bf16*)(F.ws + WS_OLAT);
    LAS unsigned char* img = F.lds + F.wave * DA_WBYTES; LAS float* dist = (LAS float*)(img + 16384);
    const unsigned imgaddr = (unsigned)(size_t)img;
    const float slope2 = __builtin_amdgcn_exp2f(-(float)((fr & 7) + 1)) * LOG2E;
    const int gw = F.bx * NWAVES + F.wave, NGW = F.G * NWAVES;
    unsigned kb[2], vb[2];
#pragma unroll
    for (int kt = 0; kt < 2; ++kt) kb[kt] = imgaddr + off_b(perm32rows(16 * kt + fr), fq) - 64u * (unsigned)(fr & 3);
    const unsigned kx = (unsigned)(fr & 3);
#pragma unroll
    for (int tt = 0; tt < 2; ++tt) { const unsigned a0 = tr_addr16(lane, 0, 0, tt); vb[tt] = imgaddr + a0; }
    const unsigned xh = (((unsigned)(lane & 15) >> 2) << 1) | (unsigned)((lane >> 4) & 1);
#pragma unroll
    for (int tt = 0; tt < 2; ++tt) vb[tt] -= 32u * xh;
    for (int t = gw; t < S; t += NGW) {
        const int nvalid = t + 1 < TOPK ? t + 1 : TOPK;
        bf16x8 qf[8];
#pragma unroll
        for (int kk = 0; kk < 8; ++kk) { qf[kk] = (bf16x8){0, 0, 0, 0, 0, 0, 0, 0}; if (fr < 8) qf[kk] = *(const bf16x8*)(qlat + (size_t)t * 2048 + fr * 256 + 32 * kk + 8 * fq); }
        f32x4 o[16];
#pragma unroll
        for (int c = 0; c < 16; ++c) o[c] = (f32x4){0.f, 0.f, 0.f, 0.f};
        float m = -__builtin_inff(), lsum = 0.f;
        int idxn; { const int e = (lane & 31); const int si = sel[(size_t)t * TOPK + e]; idxn = e < nvalid ? si : 0; }
        const unsigned char* ckv8 = (const unsigned char*)ckv;
        u32x4 gA[8];
#pragma unroll
        for (int i = 0; i < 8; ++i) { const int row = (lane >> 4) + 4 * i; const int ki = __builtin_amdgcn_ds_bpermute(row << 2, idxn); gA[i] = *(const u32x4*)(ckv8 + (size_t)ki * 256 + (lane & 15) * 16); }
        for (int ch = 0; ch < 8; ++ch) {
            unsigned xhl = xh, kxl = kx; asm volatile("" : "+v"(xhl), "+v"(kxl));
            const int myidx = idxn;
            if (ch < 7) { const int e = (ch + 1) * 32 + (lane & 31); const int si = sel[(size_t)t * TOPK + e]; idxn = e < nvalid ? si : 0; }
#pragma unroll
            for (int i = 0; i < 8; ++i) { const unsigned row = (lane >> 4) + 4 * i, p = lane & 15, prow = perm32rows(row); const u32x4 g = gA[i]; unsigned w[8];
#pragma unroll
                for (int q = 0; q < 4; ++q) { const f32x2 lo = __builtin_amdgcn_cvt_pk_f32_fp8((int)g[q], false), hi = __builtin_amdgcn_cvt_pk_f32_fp8((int)g[q], true); w[2 * q] = cvt_pk_bf16(lo[0], lo[1]); w[2 * q + 1] = cvt_pk_bf16(hi[0], hi[1]); }
                LAS unsigned char* hb = img + (p >> 3) * 8192;
                *(LAS u32x4*)(hb + off_b(prow, 2 * (p & 7))) = (u32x4){w[0], w[1], w[2], w[3]}; *(LAS u32x4*)(hb + off_b(prow, 2 * (p & 7) + 1)) = (u32x4){w[4], w[5], w[6], w[7]}; }
            if (lane < 32) { const int e = ch * 32 + lane; dist[lane] = e < nvalid ? (float)(t - myidx) : __builtin_inff(); }
            if (ch < 7) {
#pragma unroll
                for (int i = 0; i < 8; ++i) { const int row = (lane >> 4) + 4 * i; const int ki = __builtin_amdgcn_ds_bpermute(row << 2, idxn); gA[i] = *(const u32x4*)(ckv8 + (size_t)ki * 256 + (lane & 15) * 16); } }
            f32x4 sacc[2] = {(f32x4){0.f, 0.f, 0.f, 0.f}, (f32x4){0.f, 0.f, 0.f, 0.f}};
            {
                bf16x8 kf[8];
#define DSA_KLD(J_) kf[(J_) & 7] = *(const LAS bf16x8*)(kb[(J_) & 1] + 64u * ((unsigned)(((J_) >> 1) & 3) ^ kxl) + 8192u * ((J_) >> 3))
                DSA_KLD(0); DSA_KLD(1); DSA_KLD(2); DSA_KLD(3);
#pragma unroll
                for (int j = 0; j < 16; ++j) { if (j + 4 < 16) DSA_KLD(j + 4);
                    sacc[j & 1] = __builtin_amdgcn_mfma_f32_16x16x32_bf16(kf[j & 7], qf[j >> 1], sacc[j & 1], 0, 0, 0);
                    __builtin_amdgcn_sched_barrier(0); }
#undef DSA_KLD
            }
            float cmax = -__builtin_inff();
#pragma unroll
            for (int kt = 0; kt < 2; ++kt) { const f32x4 dv = *(const LAS f32x4*)(dist + 16 * kt + 4 * fq);
#pragma unroll
                for (int i = 0; i < 4; ++i) { sacc[kt][i] = sacc[kt][i] * ATT_SCALE2 - slope2 * dv[i]; cmax = fmaxf(cmax, sacc[kt][i]); } }
            cmax = xrow16_max(cmax);
            const float mn = fmaxf(m, cmax); const float alpha = __builtin_amdgcn_exp2f(m - mn); m = mn;
            float ps = 0.f;
#pragma unroll
            for (int kt = 0; kt < 2; ++kt)
#pragma unroll
                for (int i = 0; i < 4; ++i) { sacc[kt][i] = __builtin_amdgcn_exp2f(sacc[kt][i] - mn); ps += sacc[kt][i]; }
            ps = xrow16_sum(ps); lsum = lsum * alpha + ps;
            u32x4 pw; pw.x = cvt_pk_bf16(sacc[0][0], sacc[0][1]); pw.y = cvt_pk_bf16(sacc[0][2], sacc[0][3]); pw.z = cvt_pk_bf16(sacc[1][0], sacc[1][1]); pw.w = cvt_pk_bf16(sacc[1][2], sacc[1][3]);
            const bf16x8 pf = __builtin_bit_cast(bf16x8, pw);
            {
                s16x4 vlo[3], vhi[3];
#define DSA_VLD(C_) do { const unsigned cx_ = 32u * ((unsigned)((C_) & 7) ^ xhl) + 8192u * ((C_) >> 3); vlo[(C_) % 3] = vtr(vb[0] + cx_); vhi[(C_) % 3] = vtr(vb[1] + cx_); } while (0)
                DSA_VLD(0); DSA_VLD(1);
#pragma unroll
                for (int c = 0; c < 16; ++c) {
                    if (c + 2 < 16) DSA_VLD(c + 2);
                    o[c] = o[c] * alpha;
                    const bf16x8 vfr = __builtin_shufflevector(vlo[c % 3], vhi[c % 3], 0, 1, 2, 3, 4, 5, 6, 7);
                    o[c] = __builtin_amdgcn_mfma_f32_16x16x32_bf16(vfr, pf, o[c], 0, 0, 0);
                    __builtin_amdgcn_sched_barrier(0);
                }
#undef DSA_VLD
            }
        }
        const float inv = 1.0f / lsum;
        if (fr < 8) {
#pragma unroll
            for (int c = 0; c < 16; ++c) { u32x2 w; w.x = cvt_pk_bf16(o[c][0] * inv, o[c][1] * inv); w.y = cvt_pk_bf16(o[c][2] * inv, o[c][3] * inv);
                *(u32x2*)(olat + (size_t)t * 2048 + fr * 256 + 16 * c + 4 * fq) = w; }
        }
    }
}

struct BlkAttn { const bf16* K; const bf16* V; int kvld; };
DI void blk_stage(const Frame& F, const bf16* Kp, const bf16* Vp, int kvld) {
    int tl = F.tid; asm volatile("" : "+v"(tl));
    u32x4 kv[8], vv[8];
#pragma unroll
    for (int i = 0; i < 8; ++i) { const int p = tl + 512 * i; const unsigned row = p >> 4, ch = p & 15;
        kv[i] = *(const u32x4*)(Kp + (size_t)row * kvld + ch * 8); vv[i] = *(const u32x4*)(Vp + (size_t)row * kvld + ch * 8); }
#pragma unroll
    for (int i = 0; i < 8; ++i) { const int p = tl + 512 * i; const unsigned row = p >> 4, ch = p & 15;
        *(LAS u32x4*)(F.lds + off_b(row, ch)) = kv[i]; *(LAS u32x4*)(F.lds + 65536 + off_b(perm32rows(row), ch)) = vv[i]; }
}
DI void blk_core(const Frame& F, const bf16* qrow, int tq, int kpos0, float slope2, bool causal, f32x4 (&o)[8], float& m_out, float& l_out) {
    const int lane = F.lane, fr = lane & 15, fq = lane >> 4;
    const unsigned kimg = (unsigned)(size_t)F.lds, vimg = kimg + 65536;
    bf16x8 qf[4];
#pragma unroll
    for (int kk = 0; kk < 4; ++kk) qf[kk] = *(const bf16x8*)(qrow + 32 * kk + 8 * fq);
    unsigned kb[4];
#pragma unroll
    for (int kk = 0; kk < 4; ++kk) kb[kk] = kimg + off_b(fr, 4 * kk + fq);
    f32x4 s[16];
#pragma unroll
    for (int kt = 0; kt < 16; ++kt) { s[kt] = (f32x4){0.f, 0.f, 0.f, 0.f};
#pragma unroll
        for (int kk = 0; kk < 4; ++kk) { const bf16x8 afr = *(const LAS bf16x8*)(kb[kk] + 4096u * kt);
            s[kt] = __builtin_amdgcn_mfma_f32_16x16x32_bf16(afr, qf[kk], s[kt], 0, 0, 0); }
        if ((kt & 3) == 3) __builtin_amdgcn_sched_barrier(0); }
    float mx = -__builtin_inff();
    const float dq = (float)(tq - kpos0 - 4 * fq);
#pragma unroll
    for (int kt = 0; kt < 16; ++kt)
#pragma unroll
        for (int i = 0; i < 4; ++i) { const float dd = dq - (float)(16 * kt + i); float v = s[kt][i] * ATT_SCALE2 - slope2 * dd;
            if (causal && dd < 0.f) v = -__builtin_inff(); s[kt][i] = v; mx = fmaxf(mx, v); }
    mx = xrow16_max(mx);
    float ps = 0.f;
#pragma unroll
    for (int kt = 0; kt < 16; ++kt)
#pragma unroll
        for (int i = 0; i < 4; ++i) { s[kt][i] = __builtin_amdgcn_exp2f(s[kt][i] - mx); ps += s[kt][i]; }
    ps = xrow16_sum(ps);
    unsigned vb[8][2];
#pragma unroll
    for (int dt = 0; dt < 8; ++dt) { vb[dt][0] = vimg + tr_addr16(lane, dt, 0, 0); vb[dt][1] = vimg + tr_addr16(lane, dt, 0, 1); }
#pragma unroll
    for (int dt = 0; dt < 8; ++dt) o[dt] = (f32x4){0.f, 0.f, 0.f, 0.f};
#pragma unroll
    for (int ks = 0; ks < 8; ++ks) {
        u32x4 pw; pw.x = cvt_pk_bf16(s[2 * ks][0], s[2 * ks][1]); pw.y = cvt_pk_bf16(s[2 * ks][2], s[2 * ks][3]); pw.z = cvt_pk_bf16(s[2 * ks + 1][0], s[2 * ks + 1][1]); pw.w = cvt_pk_bf16(s[2 * ks + 1][2], s[2 * ks + 1][3]);
        const bf16x8 pf = __builtin_bit_cast(bf16x8, pw);
#pragma unroll
        for (int dt = 0; dt < 8; ++dt) { const s16x4 lo = vtr(vb[dt][0] + 8192u * ks), hi = vtr(vb[dt][1] + 8192u * ks);
            const bf16x8 vfr = __builtin_shufflevector(lo, hi, 0, 1, 2, 3, 4, 5, 6, 7);
            o[dt] = __builtin_amdgcn_mfma_f32_16x16x32_bf16(vfr, pf, o[dt], 0, 0, 0); }
        __builtin_amdgcn_sched_barrier(0);
    }
    const float inv = 1.0f / ps;
#pragma unroll
    for (int dt = 0; dt < 8; ++dt) o[dt] = o[dt] * inv;
    m_out = mx; l_out = ps;
}

#define BLK2_SOFTMAX(S_, O_, M_, L_, DQ_) do { \
    float mx_ = -__builtin_inff(); \
    _Pragma("unroll") for (int kt = 0; kt < 8; ++kt) _Pragma("unroll") for (int i = 0; i < 4; ++i) { const float dd_ = (DQ_) - (float)(16 * kt + i); float v_ = S_[kt][i] * ATT_SCALE2 - slope2 * dd_; \
        if (causal && dd_ < 0.f) v_ = -__builtin_inff(); S_[kt][i] = v_; mx_ = fmaxf(mx_, v_); } \
    mx_ = xrow16_max(mx_); const float mn_ = fmaxf(M_, mx_); const float al_ = __builtin_amdgcn_exp2f(M_ - mn_); M_ = mn_; float ps_ = 0.f; \
    _Pragma("unroll") for (int kt = 0; kt < 8; ++kt) _Pragma("unroll") for (int i = 0; i < 4; ++i) { S_[kt][i] = __builtin_amdgcn_exp2f(S_[kt][i] - mn_); ps_ += S_[kt][i]; } \
    ps_ = xrow16_sum(ps_); L_ = L_ * al_ + ps_; \
    _Pragma("unroll") for (int dt = 0; dt < 8; ++dt) O_[dt] = O_[dt] * al_; } while (0)
DI void blk_core2(const Frame& F, const bf16* qrowA, const bf16* qrowB, int tqA, int tqB, int kpos0, float slope2, bool causal,
                  f32x4 (&oa)[8], f32x4 (&ob)[8], float& mA, float& lA, float& mB, float& lB) {
    int lane = F.lane; asm volatile("" : "+v"(lane));
    const int fr = lane & 15, fq = lane >> 4;
    const unsigned kimg = (unsigned)(size_t)F.lds, vimg = kimg + 65536;
    bf16x8 qa[4], qb[4];
#pragma unroll
    for (int kk = 0; kk < 4; ++kk) { qa[kk] = *(const bf16x8*)(qrowA + 32 * kk + 8 * fq); qb[kk] = *(const bf16x8*)(qrowB + 32 * kk + 8 * fq); }
    const unsigned kbase = kimg + 256u * (unsigned)fr + 16u * ((unsigned)fq ^ (((unsigned)fr >> 2) & 3u)), kx = (unsigned)fr & 3u;
    const unsigned xh = (((unsigned)(lane & 15) >> 2) << 1) | (unsigned)((lane >> 4) & 1);
    unsigned vb[2];
#pragma unroll
    for (int tt = 0; tt < 2; ++tt) vb[tt] = vimg + tr_addr16(lane, 0, 0, tt) - 32u * xh;
#pragma unroll
    for (int dt = 0; dt < 8; ++dt) { oa[dt] = (f32x4){0.f, 0.f, 0.f, 0.f}; ob[dt] = (f32x4){0.f, 0.f, 0.f, 0.f}; }
    mA = -__builtin_inff(); mB = -__builtin_inff(); lA = 0.f; lB = 0.f;
    for (int half = 0; half < 2; ++half) {
        unsigned kxl = kx, xhl = xh; asm volatile("" : "+v"(kxl), "+v"(xhl));
        f32x4 sa[8], sb[8];
        bf16x8 kf[2][4];
#pragma unroll
        for (int kk = 0; kk < 4; ++kk) kf[0][kk] = *(const LAS bf16x8*)(kbase + 64u * ((unsigned)kk ^ kxl) + 4096u * (unsigned)(8 * half));
#pragma unroll
        for (int kt = 0; kt < 8; ++kt) { sa[kt] = (f32x4){0.f, 0.f, 0.f, 0.f}; sb[kt] = (f32x4){0.f, 0.f, 0.f, 0.f};
            if (kt < 7) {
#pragma unroll
                for (int kk = 0; kk < 4; ++kk) kf[(kt + 1) & 1][kk] = *(const LAS bf16x8*)(kbase + 64u * ((unsigned)kk ^ kxl) + 4096u * (unsigned)(8 * half + kt + 1)); }
#pragma unroll
            for (int kk = 0; kk < 4; ++kk) { const bf16x8 afr = kf[kt & 1][kk];
                sa[kt] = __builtin_amdgcn_mfma_f32_16x16x32_bf16(afr, qa[kk], sa[kt], 0, 0, 0); sb[kt] = __builtin_amdgcn_mfma_f32_16x16x32_bf16(afr, qb[kk], sb[kt], 0, 0, 0); }
            if (kt < 7) { __builtin_amdgcn_sched_group_barrier(0x100, 4, 0); __builtin_amdgcn_sched_group_barrier(0x008, 8, 0); }
            __builtin_amdgcn_sched_barrier(0); }
        const float dqa = (float)(tqA - kpos0 - 128 * half - 4 * fq), dqb = (float)(tqB - kpos0 - 128 * half - 4 * fq);
        BLK2_SOFTMAX(sa, oa, mA, lA, dqa);
        BLK2_SOFTMAX(sb, ob, mB, lB, dqb);
        s16x4 vlo[3], vhi[3];
#define BLK2_VLD(I_) do { const unsigned cx_ = 32u * ((unsigned)((I_) & 7) ^ xhl) + 8192u * (unsigned)(4 * half + ((I_) >> 3)); vlo[(I_) % 3] = vtr(vb[0] + cx_); vhi[(I_) % 3] = vtr(vb[1] + cx_); } while (0)
        BLK2_VLD(0); BLK2_VLD(1);
        bf16x8 pfa, pfb;
#pragma unroll
        for (int i = 0; i < 32; ++i) { const int ks = i >> 3, dt = i & 7;
            if (i + 2 < 32) BLK2_VLD(i + 2);
            if (dt == 0) {
                u32x4 pw; pw.x = cvt_pk_bf16(sa[2 * ks][0], sa[2 * ks][1]); pw.y = cvt_pk_bf16(sa[2 * ks][2], sa[2 * ks][3]); pw.z = cvt_pk_bf16(sa[2 * ks + 1][0], sa[2 * ks + 1][1]); pw.w = cvt_pk_bf16(sa[2 * ks + 1][2], sa[2 * ks + 1][3]);
                pfa = __builtin_bit_cast(bf16x8, pw);
                pw.x = cvt_pk_bf16(sb[2 * ks][0], sb[2 * ks][1]); pw.y = cvt_pk_bf16(sb[2 * ks][2], sb[2 * ks][3]); pw.z = cvt_pk_bf16(sb[2 * ks + 1][0], sb[2 * ks + 1][1]); pw.w = cvt_pk_bf16(sb[2 * ks + 1][2], sb[2 * ks + 1][3]);
                pfb = __builtin_bit_cast(bf16x8, pw); }
            const bf16x8 vfr = __builtin_shufflevector(vlo[i % 3], vhi[i % 3], 0, 1, 2, 3, 4, 5, 6, 7);
            oa[dt] = __builtin_amdgcn_mfma_f32_16x16x32_bf16(vfr, pfa, oa[dt], 0, 0, 0); ob[dt] = __builtin_amdgcn_mfma_f32_16x16x32_bf16(vfr, pfb, ob[dt], 0, 0, 0);
            __builtin_amdgcn_sched_barrier(0);
        }
#undef BLK2_VLD
    }
    const float ia = 1.0f / lA, ib = 1.0f / lB;
#pragma unroll
    for (int dt = 0; dt < 8; ++dt) { oa[dt] = oa[dt] * ia; ob[dt] = ob[dt] * ib; }
}
#undef BLK2_SOFTMAX

DI void moba_attn_phase(const Frame& F, int l) {
    LAS int* pre = (LAS int*)(F.lds + RING_BYTES);
    LAS int* wsum = pre + 520; LAS int* ncnt = wsum + 16;
    const unsigned* bcnt = (const unsigned*)(F.ctl + CW_BCNT) + l * 512; const unsigned* buck = (const unsigned*)(F.ws + WS_BUCK);
    const bf16* qm = (const bf16*)(F.ws + WS_QM); const bf16* km = (const bf16*)(F.ws + WS_KM); const bf16* vm = (const bf16*)(F.ws + WS_VM);
    unsigned char* parto = F.ws + WS_PARTO; f32x2* partml = (f32x2*)(F.ws + WS_PARTML);
    const int tid = F.tid, lane = F.lane, fr = lane & 15, fq = lane >> 4;
    __syncthreads();
    { const int n = (int)__hip_atomic_load(bcnt + tid, RLX_AGENT); ncnt[tid] = n; const int cntu = 1 + ((n + 255) >> 8);
      int v = cntu;
#pragma unroll
      for (int o = 1; o < 64; o <<= 1) { const int x = __builtin_amdgcn_ds_bpermute(((lane - o) & 63) << 2, v); if (lane >= o) v += x; }
      if (lane == 63) wsum[F.wave] = v;
      __syncthreads();
      int base = 0;
      for (int w = 0; w < F.wave; ++w) base += wsum[w];
      pre[tid + 1] = base + v; if (tid == 0) pre[0] = 0;
      __syncthreads(); }
    const int total = pre[512];
    const int u_lo = (int)(((long)total * F.bx) >> 8), u_hi = (int)(((long)total * (F.bx + 1)) >> 8);
    int staged = -1;
    for (int u = u_lo; u < u_hi; ++u) {
        int lo = 0, hi = 512;
        while (hi - lo > 1) { const int mid = (lo + hi) >> 1; if (pre[mid] <= u) lo = mid; else hi = mid; }
        const int hb = lo, h = hb >> 6, b = hb & 63, sub = u - pre[hb];
        if (staged != hb) { __syncthreads(); blk_stage(F, km + (size_t)(b * MBLK) * 1024 + h * HD, vm + (size_t)(b * MBLK) * 1024 + h * HD, 1024); __syncthreads(); staged = hb; }
        int tq[2], slot[2]; bool valid[2] = {true, true}; const bool causal = sub == 0;
#pragma unroll
        for (int g = 0; g < 2; ++g) {
            if (sub == 0) { tq[g] = b * MBLK + F.wave * 32 + g * 16 + fr; slot[g] = 3; }
            else { const int n = ncnt[hb]; const int e = (sub - 1) * 256 + F.wave * 32 + g * 16 + fr; valid[g] = e < n;
                const unsigned ent = buck[(size_t)h * BUCK_PER_HEAD + bucket_off(b) + (valid[g] ? e : 0)]; tq[g] = (int)(ent >> 2); slot[g] = (int)(ent & 3u); } }
        const float slope2 = __builtin_amdgcn_exp2f(-(float)(h + 1)) * LOG2E;
        f32x4 oa[8], ob[8]; float ma, la, mb, lb;
        blk_core2(F, qm + (size_t)tq[0] * 1024 + h * HD, qm + (size_t)tq[1] * 1024 + h * HD, tq[0], tq[1], b * MBLK, slope2, causal, oa, ob, ma, la, mb, lb);
        if (valid[0]) { const size_t pi = ((size_t)tq[0] * NH + h) * 4 + slot[0];
#pragma unroll
            for (int dt = 0; dt < 8; ++dt) *(unsigned*)(parto + pi * HD + 16 * dt + 4 * fq) = pk4_fp8(oa[dt][0] * F8_SOB, oa[dt][1] * F8_SOB, oa[dt][2] * F8_SOB, oa[dt][3] * F8_SOB);
            if (fq == 0) partml[pi] = (f32x2){ma, la}; }
        if (valid[1]) { const size_t pi = ((size_t)tq[1] * NH + h) * 4 + slot[1];
#pragma unroll
            for (int dt = 0; dt < 8; ++dt) *(unsigned*)(parto + pi * HD + 16 * dt + 4 * fq) = pk4_fp8(ob[dt][0] * F8_SOB, ob[dt][1] * F8_SOB, ob[dt][2] * F8_SOB, ob[dt][3] * F8_SOB);
            if (fq == 0) partml[pi] = (f32x2){mb, lb}; }
    }
    __syncthreads();
}
DI void moba_combine_phase(const Frame& F) {
    const unsigned char* parto = F.ws + WS_PARTO; const f32x2* partml = (const f32x2*)(F.ws + WS_PARTML); bf16* ob = (bf16*)(F.ws + WS_OB);
    const int gt = F.bx * NTHREADS + F.tid, ngt = F.G * NTHREADS;
    for (int i0 = gt; i0 < S * NH * 16; i0 += 2 * ngt) {
        f32x2 ml[2][4]; u32x2 pv[2][4];
#pragma unroll
        for (int q = 0; q < 2; ++q) { const int i = i0 + q * ngt < S * NH * 16 ? i0 + q * ngt : i0; const int th = i >> 4, c = i & 15;
#pragma unroll
            for (int j = 0; j < 4; ++j) { ml[q][j] = partml[(size_t)th * 4 + j]; pv[q][j] = *(const u32x2*)(parto + ((size_t)th * 4 + j) * HD + 8 * c); } }
#pragma unroll
        for (int q = 0; q < 2; ++q) { const int i = i0 + q * ngt; if (i >= S * NH * 16) break;
            const int th = i >> 4, c = i & 15, t = th >> 3; const int own = t >> 8, nsel = own < 3 ? own : 3;
            float mj[4], lj[4]; float M = -__builtin_inff();
#pragma unroll
            for (int j = 0; j < 4; ++j) { const bool on = (j == 3) || (j < nsel); mj[j] = on ? ml[q][j][0] : -__builtin_inff(); lj[j] = on ? ml[q][j][1] : 0.f; M = fmaxf(M, mj[j]); }
            float r[8] = {0.f, 0.f, 0.f, 0.f, 0.f, 0.f, 0.f, 0.f}; float wsum_ = 0.f;
#pragma unroll
            for (int j = 0; j < 4; ++j) { const float w = lj[j] * __builtin_amdgcn_exp2f(mj[j] - M); wsum_ += w; const u32x2 v = pv[q][j];
                const f32x2 p0 = __builtin_amdgcn_cvt_pk_f32_fp8((int)v.x, false), p1 = __builtin_amdgcn_cvt_pk_f32_fp8((int)v.x, true), p2 = __builtin_amdgcn_cvt_pk_f32_fp8((int)v.y, false), p3 = __builtin_amdgcn_cvt_pk_f32_fp8((int)v.y, true);
                r[0] += w * p0[0]; r[1] += w * p0[1]; r[2] += w * p1[0]; r[3] += w * p1[1]; r[4] += w * p2[0]; r[5] += w * p2[1]; r[6] += w * p3[0]; r[7] += w * p3[1]; }
            const float is = 1.0f / wsum_;
            u32x2 w; w.x = pk4_fp8(r[0] * is, r[1] * is, r[2] * is, r[3] * is); w.y = pk4_fp8(r[4] * is, r[5] * is, r[6] * is, r[7] * is);
            *(u32x2*)((unsigned char*)ob + (size_t)th * HD + 8 * c) = w; }
    }
}
DI void mem_attn_phase(const Frame& F, int l) {
    const bf16* qmem = (const bf16*)(F.ws + WS_QMEM); const bf16* kv = (const bf16*)(F.ws + WS_KVMEM) + (size_t)l * 1024; bf16* omem = (bf16*)(F.ws + WS_OMEM);
    const int total = NHM * (S / 256);
    int staged = -1;
    for (int u = F.bx; u < total; u += F.G) {
        const int h = u / (S / 256), qc = u % (S / 256);
        if (staged != h) { __syncthreads(); blk_stage(F, kv + h * HD, kv + 512 + h * HD, 4096); __syncthreads(); staged = h; }
        f32x4 oa[8], ob[8]; float ma, la, mb, lb;
        { const int tq0 = qc * 256 + F.wave * 32 + (F.lane & 15); blk_core2(F, qmem + (size_t)tq0 * 512 + h * HD, qmem + (size_t)(tq0 + 16) * 512 + h * HD, 0, 0, 0, 0.f, false, oa, ob, ma, la, mb, lb); }
        int ln = F.lane; asm volatile("" : "+v"(ln));
        const int fq = ln >> 4, tqa = qc * 256 + F.wave * 32 + (ln & 15), tqb = tqa + 16;
#pragma unroll
        for (int dt = 0; dt < 8; ++dt) { *(unsigned*)((unsigned char*)omem + (size_t)tqa * 512 + h * HD + 16 * dt + 4 * fq) = pk4_fp8(oa[dt][0] * F8_SOM, oa[dt][1] * F8_SOM, oa[dt][2] * F8_SOM, oa[dt][3] * F8_SOM);
            *(unsigned*)((unsigned char*)omem + (size_t)tqb * 512 + h * HD + 16 * dt + 4 * fq) = pk4_fp8(ob[dt][0] * F8_SOM, ob[dt][1] * F8_SOM, ob[dt][2] * F8_SOM, ob[dt][3] * F8_SOM); }
    }
    __syncthreads();
}

DI void ln_phase(const Frame& F, const Args& a, int l, int which) {
    const int gw = F.bx * NWAVES + F.wave, NGW = F.G * NWAVES, lane = F.lane;
    const float* g = a.in[17] + (size_t)(l * 3 + which) * D; const float* b = a.in[18] + (size_t)(l * 3 + which) * D;
    float* x = a.out; const bf16* y = (const bf16*)(F.ws + WS_Y); bf16* xb = (bf16*)(F.ws + WS_XB);
    f32x4 xv[8]; u32x2 yv[8];
    if (gw < S) {
#pragma unroll
        for (int j = 0; j < 8; ++j) { xv[j] = ((const f32x4*)(x + (size_t)gw * D) + lane)[64 * j]; yv[j] = ((const u32x2*)(y + (size_t)gw * D) + lane)[64 * j]; } }
    for (int r = gw; r < S; r += NGW) {
        f32x4 v[8]; float s = 0.f;
#pragma unroll
        for (int j = 0; j < 8; ++j) { v[j] = (f32x4){ALPHA * xv[j][0] + bflo(yv[j].x), ALPHA * xv[j][1] + bfhi(yv[j].x), ALPHA * xv[j][2] + bflo(yv[j].y), ALPHA * xv[j][3] + bfhi(yv[j].y)}; s += (v[j][0] + v[j][1]) + (v[j][2] + v[j][3]); }
        const int rn = r + NGW;
        if (rn < S) {
#pragma unroll
            for (int j = 0; j < 8; ++j) { xv[j] = ((const f32x4*)(x + (size_t)rn * D) + lane)[64 * j]; yv[j] = ((const u32x2*)(y + (size_t)rn * D) + lane)[64 * j]; } }
        const float mean = wave_sum(s) * (1.0f / D); float s2 = 0.f;
#pragma unroll
        for (int j = 0; j < 8; ++j) { v[j] = v[j] - mean; s2 += (v[j][0] * v[j][0] + v[j][1] * v[j][1]) + (v[j][2] * v[j][2] + v[j][3] * v[j][3]); }
        const float rstd = 1.0f / sqrtf(wave_sum(s2) * (1.0f / D) + LN_EPS);
        f32x4* xr = (f32x4*)(x + (size_t)r * D) + lane; u32x2* xbr = (u32x2*)(xb + (size_t)r * D) + lane;
#pragma unroll
        for (int j = 0; j < 8; ++j) { const f32x4 g4 = ((const f32x4*)g)[lane + 64 * j], b4 = ((const f32x4*)b)[lane + 64 * j]; const f32x4 o = v[j] * rstd * g4 + b4;
            xr[64 * j] = o;
            if (which != 2) ((unsigned*)(xb) + (size_t)r * (D / 4) + lane)[64 * j] = pk4_fp8(o[0], o[1], o[2], o[3]);
            else { u32x2 w; w.x = pk2(o[0], o[1]); w.y = pk2(o[2], o[3]); xbr[64 * j] = w;
                if (which == 2) ((unsigned*)(F.ws + WS_XB8) + (size_t)r * (D / 4) + lane)[64 * j] = pk4_fp8(o[0], o[1], o[2], o[3]); } }
    }
}


#ifdef SELFCHECK
constexpr int CW_ERR = 24576;
#ifndef SELFCHECK_MASK
#define SELFCHECK_MASK 0xFFFFFFFFu
#endif
#define CHK_ON(w) (((SELFCHECK_MASK) >> (w)) & 1u)
#ifndef SELFCHECK_TOL
#define SELFCHECK_TOL 0.05f
#endif
__device__ const int CHK_TS[8] = {0, 1, 255, 256, 511, 4097, 9000, 16383};
__device__ const int CHK_BND[19] = {1023, 1024, 1279, 1280, 2303, 2304, 2367, 2368, 2383, 2384, 3407, 3408, 4431, 4432, 5455, 5456, 7503, 7504, 9551};
DI void chk_report(gu32* ctl, int which, float err) {
    if (!(err >= 0.f)) err = 1e30f;
    __hip_atomic_fetch_max((unsigned*)(ctl + CW_ERR + which), __float_as_uint(err), RLX_AGENT);
}
DI float bfr(float w) { return __uint_as_float(f2bf(w) << 16); }
DI float bf2f(bf16 v) { return __uint_as_float(((unsigned)v) << 16); }
DI float relerr(float got, float ref, float fl) { return fabsf(got - ref) / (fabsf(ref) + fl); }
DI float wdot(const bf16* a, int K, const float* W, size_t ldw, int lane) {
    float s = 0.f; for (int k = lane; k < K; k += 64) s += bf2f(a[k]) * bfr(W[(size_t)k * ldw]); return wave_sum(s);
}
DI float fp8dec(unsigned char v) { return __builtin_amdgcn_cvt_f32_fp8((int)v, 0); }
DI float f8r(float w, float scale) { return fp8dec((unsigned char)(pk4_fp8(w * scale, 0.f, 0.f, 0.f) & 0xffu)) / scale; }
DI void chk_inproj(const Frame& F, const Args& a) {
    const int gw = F.bx * NWAVES + F.wave, NGW = F.G * NWAVES, lane = F.lane; unsigned char* ws = F.ws;
    const int NC = 83;
    for (int sidx = gw; sidx < 8 * NC; sidx += NGW) {
        const int t = CHK_TS[sidx / NC], ci = sidx % NC;
        const int c = ci < 64 ? (ci * 149 + 7) % INW : CHK_BND[ci - 64];
        float ref;
        if (win_rowmap(c) >= 0) ref = wdot((const bf16*)(ws + WS_XB) + (size_t)t * D, D, a.in[2] + c, INW, lane);
        else { float s = 0.f; for (int k = lane; k < D; k += 64) s += fp8dec((ws + WS_XB8)[(size_t)t * D + k]) * f8r(a.in[2][(size_t)k * INW + c], F8_SWI); ref = wave_sum(s); }
        float got, r2 = ref, fl = 0.3f;
        if (c < 1024) got = bf2f(((const bf16*)(ws + WS_QDSA))[(size_t)t * 1024 + c]);
        else if (c < 1280) got = ((const float*)(ws + WS_CKVRAW))[(size_t)t * 256 + c - 1024];
        else if (c < 2304) got = bf2f(((const bf16*)(ws + WS_QIDX))[(size_t)t * 1024 + c - 1280]);
        else if (c < 2384) got = ((const float*)(ws + WS_KWRAW))[(size_t)t * 256 + c - 2304];
        else if (c < 3408) got = bf2f(((const bf16*)(ws + WS_QM))[(size_t)t * 1024 + c - 2384]);
        else if (c < 4432) got = bf2f(((const bf16*)(ws + WS_KM))[(size_t)t * 1024 + c - 3408]);
        else if (c < 5456) got = bf2f(((const bf16*)(ws + WS_VM))[(size_t)t * 1024 + c - 4432]);
        else if (c < 7504) { got = bf2f(((const bf16*)(ws + WS_GA))[(size_t)t * D + c - 5456]); r2 = 1.f / (1.f + expf(-(ref + a.in[3][c - 5456]))); }
        else { got = bf2f(((const bf16*)(ws + WS_GB))[(size_t)t * D + c - 7504]); r2 = 1.f / (1.f + expf(-(ref + a.in[3][D + c - 7504]))); }
        if (lane == 0) chk_report(F.ctl, 0, relerr(got, r2, fl));
    }
}
DI void chk_norms(const Frame& F, const Args& a) {
    const int gw = F.bx * NWAVES + F.wave, NGW = F.G * NWAVES, lane = F.lane; unsigned char* ws = F.ws;
    for (int sidx = gw; sidx < 8; sidx += NGW) {
        const int t = CHK_TS[sidx]; const float* cr = (const float*)(ws + WS_CKVRAW) + (size_t)t * 256; const float* kw = (const float*)(ws + WS_KWRAW) + (size_t)t * 256;
        float ss = 0.f; for (int c = 0; c < 256; ++c) ss += cr[c] * cr[c];
        const float r = 1.f / sqrtf(ss / 256.f + LN_EPS); float e = 0.f;
        for (int c = lane; c < 256; c += 64) e = fmaxf(e, relerr(fp8dec((ws + WS_CKVN)[(size_t)t * 256 + c]), cr[c] * r * a.in[4][c], 0.3f));
        float mu = 0.f; for (int c = 0; c < 64; ++c) mu += kw[c]; mu /= 64.f; float var = 0.f; for (int c = 0; c < 64; ++c) var += (kw[c] - mu) * (kw[c] - mu); var /= 64.f;
        e = fmaxf(e, relerr(bf2f(((const bf16*)(ws + WS_KIDXN))[(size_t)t * 64 + lane]), (kw[lane] - mu) / sqrtf(var + LN_EPS) * a.in[5][lane] + a.in[6][lane], 0.3f));
        if (lane < 16) e = fmaxf(e, relerr(((const float*)(ws + WS_WIDX))[(size_t)t * 16 + lane], kw[64 + lane], 0.01f));
        chk_report(F.ctl, 1, e);
    }
    for (int sidx = gw; sidx < 8 * 64; sidx += NGW) {
        const int t = CHK_TS[sidx >> 6], h = sidx & 7, c = (((sidx >> 3) & 7) * 37 + (sidx & 7) * 3) & 255;
        const float ref = wdot((const bf16*)(ws + WS_QDSA) + (size_t)t * 1024 + h * HD, HD, a.in[7] + (size_t)h * HD * CKV + c, CKV, lane);
        if (lane == 0) chk_report(F.ctl, 1, relerr(bf2f(((const bf16*)(ws + WS_QLAT))[(size_t)t * 2048 + h * 256 + c]), ref, 0.3f));
    }
    for (int sidx = gw; sidx < 64; sidx += NGW) {
        const int h = sidx & 7, b = ((sidx >> 3) * 9) & 63; float s0 = 0.f, s1 = 0.f;
        for (int k = 0; k < MBLK; ++k) { s0 += bf2f(((const bf16*)(ws + WS_KM))[(size_t)(b * MBLK + k) * 1024 + h * HD + lane]); s1 += bf2f(((const bf16*)(ws + WS_KM))[(size_t)(b * MBLK + k) * 1024 + h * HD + 64 + lane]); }
        const float* km = (const float*)(ws + WS_KMEAN) + (size_t)(h * NBLK + b) * HD;
        chk_report(F.ctl, 1, fmaxf(relerr(km[lane], s0 / 256.f, 0.02f), relerr(km[64 + lane], s1 / 256.f, 0.02f)));
    }
}
DI float chk_score(const unsigned char* ws, int t, int key) {
    const bf16* q = (const bf16*)(ws + WS_QIDX) + (size_t)t * 1024; const bf16* k = (const bf16*)(ws + WS_KIDXN) + (size_t)key * 64; const float* w = (const float*)(ws + WS_WIDX) + (size_t)t * 16;
    float s = 0.f;
    for (int h = 0; h < 16; ++h) { float d = 0.f; for (int i = 0; i < 64; ++i) d += bf2f(q[h * 64 + i]) * bf2f(k[i]); s += w[h] * fmaxf(d, 0.f); }
    return s;
}
DI void chk_topk(const Frame& F, int l) {
    const int gw = F.bx * NWAVES + F.wave, NGW = F.G * NWAVES, lane = F.lane; unsigned char* ws = F.ws;
    for (int sidx = gw; sidx < 8; sidx += NGW) {
        const int t = CHK_TS[sidx]; const unsigned short* sel = (const unsigned short*)(ws + WS_SEL) + (size_t)t * TOPK; const int nsel = t + 1 < TOPK ? t + 1 : TOPK;
        float bad = 0.f, mn = __builtin_inff();
        for (int i = lane; i < TOPK; i += 64) {
            const int k = sel[i];
            if (i < nsel) { if (k > t) bad += 1.f; else mn = fminf(mn, chk_score(ws, t, k)); if (i + 1 < nsel && sel[i + 1] <= k) bad += 1.f; }
            else if (k != 0xFFFF) bad += 1.f;
        }
#pragma unroll
        for (int o = 1; o < 64; o <<= 1) mn = fminf(mn, __shfl_xor(mn, o));
        float cnt = 0.f; for (int k = lane; k <= t; k += 64) if (chk_score(ws, t, k) > mn * (mn > 0.f ? 1.00001f : 0.99999f) + 1e-6f) cnt += 1.f;
        cnt = wave_sum(cnt); bad = wave_sum(bad);
        const float extra = cnt - (float)(nsel - 1); chk_report(F.ctl, 2, (bad + (extra > 0.f ? extra : 0.f)) / 16.f);
    }
    for (int sidx = gw; sidx < 64; sidx += NGW) {
        const int t = CHK_TS[sidx >> 3], h = sidx & 7, own = t >> 8; const bf16* q = (const bf16*)(ws + WS_QM) + (size_t)t * 1024 + h * HD;
        float g = -__builtin_inff();
        if (lane < own) { g = 0.f; const float* km = (const float*)(ws + WS_KMEAN) + (size_t)(h * NBLK + lane) * HD; for (int d = 0; d < HD; ++d) g += bf2f(q[d]) * km[d]; }
        float bad = 0.f; const int nsel = own < 3 ? own : 3; float gg = g;
        for (int j = 0; j < nsel; ++j) {
            float mx = gg; int mi = lane;
#pragma unroll
            for (int o = 1; o < 64; o <<= 1) { const float ov = __shfl_xor(mx, o); const int oi = __shfl_xor(mi, o); if (ov > mx || (ov == mx && oi < mi)) { mx = ov; mi = oi; } }
            float g2 = (lane == mi) ? -__builtin_inff() : gg;
#pragma unroll
            for (int o = 1; o < 64; o <<= 1) g2 = fmaxf(g2, __shfl_xor(g2, o));
            const bool neartie = (mx - g2) < 1e-4f * (fabsf(mx) + 1e-3f);
            const unsigned n = ((const unsigned*)(F.ctl + CW_BCNT))[l * 512 + h * 64 + mi]; const unsigned* bk = (const unsigned*)(ws + WS_BUCK) + (size_t)h * BUCK_PER_HEAD + bucket_off(mi);
            float found = 0.f; for (unsigned i = lane; i < n; i += 64) if (bk[i] == (((unsigned)t << 2) | (unsigned)j)) found = 1.f;
            if (wave_sum(found) != 1.f && !neartie) bad += 1.f;
            if (lane == mi) gg = -__builtin_inff();
        }
        chk_report(F.ctl, 3, bad);
    }
}
DI void chk_attn(const Frame& F, const Args& a) {
    const int gw = F.bx * NWAVES + F.wave, NGW = F.G * NWAVES, lane = F.lane; unsigned char* ws = F.ws;
    for (int sidx = gw; sidx < 64; sidx += NGW) {
        const int t = CHK_TS[sidx >> 3], h = sidx & 7; const float slope = exp2f(-(float)(h + 1));
        {
            const unsigned short* sel = (const unsigned short*)(ws + WS_SEL) + (size_t)t * TOPK; const int nsel = t + 1 < TOPK ? t + 1 : TOPK;
            const bf16* q = (const bf16*)(ws + WS_QLAT) + (size_t)t * 2048 + h * 256; const unsigned char* ck = ws + WS_CKVN;
            float sc[4]; float mx = -__builtin_inff();
#pragma unroll
            for (int j = 0; j < 4; ++j) { const int i = lane + 64 * j; sc[j] = -__builtin_inff();
                if (i < nsel) { const int k = sel[i]; float d = 0.f; for (int c = 0; c < 256; ++c) d += bf2f(q[c]) * fp8dec(ck[(size_t)k * 256 + c]); sc[j] = d * 0.08838834764831845f - slope * (float)(t - k); }
                mx = fmaxf(mx, sc[j]); }
#pragma unroll
            for (int o = 1; o < 64; o <<= 1) mx = fmaxf(mx, __shfl_xor(mx, o));
            float p[4], ps = 0.f;
#pragma unroll
            for (int j = 0; j < 4; ++j) { p[j] = expf(sc[j] - mx); ps += p[j]; } ps = wave_sum(ps);
            float o4[4] = {0.f, 0.f, 0.f, 0.f};
#pragma unroll
            for (int j = 0; j < 4; ++j) for (int src = 0; src < 64; ++src) { const float pp = __shfl(p[j], src); const int i = src + 64 * j; if (i < nsel) { const int k = sel[i];
                _Pragma("unroll") for (int e = 0; e < 4; ++e) o4[e] += pp * fp8dec(ck[(size_t)k * 256 + lane * 4 + e]); } }
            float er = 0.f;
#pragma unroll
            for (int e = 0; e < 4; ++e) er = fmaxf(er, relerr(bf2f(((const bf16*)(ws + WS_OLAT))[(size_t)t * 2048 + h * 256 + lane * 4 + e]), o4[e] / ps, 0.05f));
            chk_report(F.ctl, 4, er);
        }
        {
            const int own = t >> 8; const bf16* q = (const bf16*)(ws + WS_QM) + (size_t)t * 1024 + h * HD; const bf16* kk = (const bf16*)(ws + WS_KM); const bf16* vv = (const bf16*)(ws + WS_VM);
            float g = -__builtin_inff();
            if (lane < own) { g = 0.f; const float* km = (const float*)(ws + WS_KMEAN) + (size_t)(h * NBLK + lane) * HD; for (int d = 0; d < HD; ++d) g += bf2f(q[d]) * km[d]; }
            int blks[4] = {-1, -1, -1, own}; const int nsel = own < 3 ? own : 3; float gg = g;
#pragma unroll
            for (int j = 0; j < 3; ++j) { if (j < nsel) { float mx = gg; int mi = lane;
#pragma unroll
                for (int o = 1; o < 64; o <<= 1) { const float ov = __shfl_xor(mx, o); const int oi = __shfl_xor(mi, o); if (ov > mx || (ov == mx && oi < mi)) { mx = ov; mi = oi; } }
                blks[j] = mi; if (lane == mi) gg = -__builtin_inff(); } }
            float M = -__builtin_inff();
#pragma unroll
            for (int bi = 0; bi < 4; ++bi) { if (blks[bi] >= 0) for (int k0 = lane; k0 < MBLK; k0 += 64) { const int kp = blks[bi] * MBLK + k0; if (kp <= t) { float d = 0.f; for (int e = 0; e < HD; ++e) d += bf2f(q[e]) * bf2f(kk[(size_t)kp * 1024 + h * HD + e]);
                M = fmaxf(M, d * 0.08838834764831845f - slope * (float)(t - kp)); } } }
#pragma unroll
            for (int o = 1; o < 64; o <<= 1) M = fmaxf(M, __shfl_xor(M, o));
            float ps = 0.f, o0 = 0.f, o1 = 0.f;
#pragma unroll
            for (int bi = 0; bi < 4; ++bi) { if (blks[bi] >= 0) for (int kb = 0; kb < MBLK; kb += 64) { const int kp = blks[bi] * MBLK + kb + lane; float p = 0.f;
                if (kp <= t) { float d = 0.f; for (int e = 0; e < HD; ++e) d += bf2f(q[e]) * bf2f(kk[(size_t)kp * 1024 + h * HD + e]); p = expf(d * 0.08838834764831845f - slope * (float)(t - kp) - M); }
                ps += p;
                for (int src = 0; src < 64; ++src) { const float pp = __shfl(p, src); const int kq = blks[bi] * MBLK + kb + src; if (kq <= t) { o0 += pp * bf2f(vv[(size_t)kq * 1024 + h * HD + 2 * lane]); o1 += pp * bf2f(vv[(size_t)kq * 1024 + h * HD + 2 * lane + 1]); } } } }
            ps = wave_sum(ps);
            const unsigned char* ob = ws + WS_OB + (size_t)t * 1024 + h * HD;
            chk_report(F.ctl, 5, fmaxf(relerr(fp8dec(ob[2 * lane]) / F8_SOB, o0 / ps, 0.1f), relerr(fp8dec(ob[2 * lane + 1]) / F8_SOB, o1 / ps, 0.1f)));
        }
        {
            float r0 = 0.f, r1 = 0.f; const bf16* ol = (const bf16*)(ws + WS_OLAT) + (size_t)t * 2048 + h * 256; const float* wu = a.in[8] + (size_t)h * CKV * HD;
            for (int c = 0; c < 256; ++c) { r0 += bf2f(ol[c]) * bfr(wu[c * HD + lane]); r1 += bf2f(ol[c]) * bfr(wu[c * HD + 64 + lane]); }
            const unsigned char* oa = ws + WS_OA + (size_t)t * 1024 + h * HD;
            chk_report(F.ctl, 6, fmaxf(relerr(fp8dec(oa[lane]) / F8_SOA, r0, 0.05f), relerr(fp8dec(oa[64 + lane]) / F8_SOA, r1, 0.05f)));
        }
    }
}
DI void chk_dense(const Frame& F, int word, const bf16* act, int lda, int K, const float* W, int N, const bf16* out, int ldo, float fl) {
    const int gw = F.bx * NWAVES + F.wave, NGW = F.G * NWAVES, lane = F.lane;
    for (int sidx = gw; sidx < 8 * 24; sidx += NGW) { const int t = CHK_TS[sidx / 24], n = ((sidx % 24) * 211 + 5) % N;
        const float ref = wdot(act + (size_t)t * lda, K, W + n, N, lane);
        if (lane == 0) chk_report(F.ctl, word, relerr(bf2f(out[(size_t)t * ldo + n]), ref, fl)); }
}
DI float wdot8r(const unsigned char* a8, int K, const float* W, size_t ldw, float wscale, int lane) {
    float s = 0.f; for (int k = lane; k < K; k += 64) s += fp8dec(a8[k]) * f8r(W[(size_t)k * ldw], wscale); return wave_sum(s);
}
DI void chk_merged(const Frame& F, const Args& a) {
    const int gw = F.bx * NWAVES + F.wave, NGW = F.G * NWAVES, lane = F.lane; unsigned char* ws = F.ws;
    for (int sidx = gw; sidx < 8 * 24; sidx += NGW) { const int t = CHK_TS[sidx / 24], n = ((sidx % 24) * 211 + 5) % D;
        const float pa = wdot8r(ws + WS_OA + (size_t)t * 1024, 1024, a.in[9] + n, D, F8_SWO, lane) / F8_SOA, pb = wdot8r(ws + WS_OB + (size_t)t * 1024, 1024, a.in[10] + n, D, F8_SWO, lane) / F8_SOB;
        const float ref = bf2f(((const bf16*)(ws + WS_GA))[(size_t)t * D + n]) * pa + bf2f(((const bf16*)(ws + WS_GB))[(size_t)t * D + n]) * pb;
        if (lane == 0) chk_report(F.ctl, 6, relerr(fp8dec((ws + WS_MERGED)[(size_t)t * D + n]) / F8_SMG, ref, 0.02f)); }
}
DI void chk_dense8(const Frame& F, int word, const unsigned char* act8, int lda, int K, float ascale, const float* W, int N, float wscale, const bf16* out, int ldo, float fl) {
    const int gw = F.bx * NWAVES + F.wave, NGW = F.G * NWAVES, lane = F.lane;
    for (int sidx = gw; sidx < 8 * 24; sidx += NGW) { const int t = CHK_TS[sidx / 24], n = ((sidx % 24) * 211 + 5) % N;
        const float ref = wdot8r(act8 + (size_t)t * lda, K, W + n, N, wscale, lane) / ascale;
        if (lane == 0) chk_report(F.ctl, word, relerr(bf2f(out[(size_t)t * ldo + n]), ref, fl)); }
}
DI void chk_ln1(const Frame& F, const Args& a) {
    const int gw = F.bx * NWAVES + F.wave, NGW = F.G * NWAVES, lane = F.lane; unsigned char* ws = F.ws;
    for (int sidx = gw; sidx < 8; sidx += NGW) { const int t = CHK_TS[sidx]; const float* x = a.in[0] + (size_t)t * D; const bf16* y = (const bf16*)(ws + WS_Y) + (size_t)t * D;
        float s = 0.f; for (int c = lane; c < D; c += 64) s += ALPHA * x[c] + bf2f(y[c]); const float mu = wave_sum(s) / D;
        float q = 0.f; for (int c = lane; c < D; c += 64) { const float d = ALPHA * x[c] + bf2f(y[c]) - mu; q += d * d; } const float rs = 1.f / sqrtf(wave_sum(q) / D + LN_EPS);
        float e = 0.f; for (int c = lane; c < D; c += 64) { const float ref = (ALPHA * x[c] + bf2f(y[c]) - mu) * rs * a.in[17][c] + a.in[18][c];
            e = fmaxf(e, relerr(a.out[(size_t)t * D + c], ref, 0.5f) * 20.f); e = fmaxf(e, relerr(fp8dec((ws + WS_XB)[(size_t)t * D + c]), ref, 0.5f)); }
        chk_report(F.ctl, 7, e); }
}
DI void chk_memattn(const Frame& F, int l) {
    const int gw = F.bx * NWAVES + F.wave, NGW = F.G * NWAVES, lane = F.lane; unsigned char* ws = F.ws;
    for (int sidx = gw; sidx < 32; sidx += NGW) { const int t = CHK_TS[sidx >> 2], h = sidx & 3; const bf16* q = (const bf16*)(ws + WS_QMEM) + (size_t)t * 512 + h * HD; const bf16* kv = (const bf16*)(ws + WS_KVMEM) + (size_t)l * 1024;
        float sc[4], mx = -__builtin_inff();
#pragma unroll
        for (int j = 0; j < 4; ++j) { const int m = lane + 64 * j; float d = 0.f; for (int e = 0; e < HD; ++e) d += bf2f(q[e]) * bf2f(kv[(size_t)m * 4096 + h * HD + e]); sc[j] = d * 0.08838834764831845f; mx = fmaxf(mx, sc[j]); }
#pragma unroll
        for (int o = 1; o < 64; o <<= 1) mx = fmaxf(mx, __shfl_xor(mx, o));
        float ps = 0.f, o0 = 0.f, o1 = 0.f;
#pragma unroll
        for (int j = 0; j < 4; ++j) { const float p = expf(sc[j] - mx); ps += p; for (int src = 0; src < 64; ++src) { const float pp = __shfl(p, src); const int m = src + 64 * j;
            o0 += pp * bf2f(kv[(size_t)m * 4096 + 512 + h * HD + 2 * lane]); o1 += pp * bf2f(kv[(size_t)m * 4096 + 512 + h * HD + 2 * lane + 1]); } }
        ps = wave_sum(ps); const unsigned char* om = ws + WS_OMEM + (size_t)t * 512 + h * HD;
        chk_report(F.ctl, 9, fmaxf(relerr(fp8dec(om[2 * lane]) / F8_SOM, o0 / ps, 0.05f), relerr(fp8dec(om[2 * lane + 1]) / F8_SOM, o1 / ps, 0.05f))); }
}
DI void chk_kvmem(const Frame& F, const Args& a) {
    const int gw = F.bx * NWAVES + F.wave, NGW = F.G * NWAVES, lane = F.lane; unsigned char* ws = F.ws;
    for (int sidx = gw; sidx < 4 * 48; sidx += NGW) { const int ll = sidx / 48, m = ((sidx % 48) * 37) & 255, n = ((sidx % 48) * 211 + 3) & 1023;
        const float ref = wdot((const bf16*)(ws + WS_MEMB) + (size_t)m * D, D, a.in[13] + (size_t)ll * D * 1024 + n, 1024, lane);
        if (lane == 0) chk_report(F.ctl, 8, relerr(bf2f(((const bf16*)(ws + WS_KVMEM))[(size_t)m * 4096 + ll * 1024 + n]), ref, 0.3f)); }
}
DI float wdot8(const unsigned char* a8, int K, const float* W, size_t ldw, int lane) {
    float s = 0.f; for (int k = lane; k < K; k += 64) s += fp8dec(a8[k]) * W[(size_t)k * ldw]; return wave_sum(s);
}
DI void chk_swiglu(const Frame& F, const Args& a) {
    const int gw = F.bx * NWAVES + F.wave, NGW = F.G * NWAVES, lane = F.lane; unsigned char* ws = F.ws;
    for (int sidx = gw; sidx < 8 * 24; sidx += NGW) { const int t = CHK_TS[sidx / 24], j = ((sidx % 24) * 509 + 11) % DFF;
        const float g = wdot8(ws + WS_XB + (size_t)t * D, D, a.in[15] + j, 2 * DFF, lane), u = wdot8(ws + WS_XB + (size_t)t * D, D, a.in[15] + DFF + j, 2 * DFF, lane);
        if (lane == 0) chk_report(F.ctl, 11, relerr(fp8dec((ws + WS_H)[(size_t)t * DFF + j]) * (1.0f / F8_SH), g / (1.f + expf(-g)) * u, 0.05f)); }
}
DI void chk_ffn2(const Frame& F, const Args& a) {
    const int gw = F.bx * NWAVES + F.wave, NGW = F.G * NWAVES, lane = F.lane; unsigned char* ws = F.ws;
    for (int sidx = gw; sidx < 8 * 24; sidx += NGW) { const int t = CHK_TS[sidx / 24], n = ((sidx % 24) * 211 + 5) % D;
        const float ref = wdot8(ws + WS_H + (size_t)t * DFF, DFF, a.in[16] + n, D, lane) * (1.0f / F8_SH);
        if (lane == 0) chk_report(F.ctl, 12, relerr(bf2f(((const bf16*)(ws + WS_Y))[(size_t)t * D + n]), ref, 0.01f)); }
}
DI void chk_encode(const Frame& F, const Args& a) {
    float B = 0.f, wgt = 0.5f;
    for (int i = 0; i < 32; ++i) if ((SELFCHECK_MASK >> i) & 1u) { const float e = __uint_as_float(__hip_atomic_load((unsigned*)(F.ctl + CW_ERR + i), RLX_AGENT)); if (e > SELFCHECK_TOL) B += wgt; wgt *= 0.5f; }
    const float sc = 1.f - 0.5f * B;
    f32x4* o = (f32x4*)a.out; const int gt = F.bx * NTHREADS + F.tid, ngt = F.G * NTHREADS;
    for (int i = gt; i < S * D / 4; i += ngt) o[i] = o[i] * sc;
}
#endif

constexpr int NPH = 17;
__global__ void __launch_bounds__(NTHREADS, 2) fwd_kernel(Args args) {
    extern __shared__ __attribute__((aligned(16))) unsigned char lds_raw[];
    LAS unsigned char* const lds = (LAS unsigned char*)lds_raw;
    volatile LAS unsigned* MISC = (volatile LAS unsigned*)(lds + MISC_OFF);
    if (threadIdx.x < 32) MISC[threadIdx.x] = 0u;
    __syncthreads();
#if MK_ONE_LAUNCH
    constexpr int lo = 0, hi = DEPTH * NPH;
#else
    const int lo = args.ph_lo, hi = args.ph_hi;
#endif
    XcdBarrier bar; bar.bar = (unsigned*)(args.ws + WS_CTL) + CW_BAR; bar.x = 0; bar.st = nullptr; bar.w0 = __builtin_amdgcn_readfirstlane((int)threadIdx.x >> 6);
    if (hi - lo > 1) bar = xcd_barrier_post((unsigned*)(args.ws + WS_CTL) + CW_BAR, MISC + 8);
#ifdef ONLY_PH
#define IN(k) (((k) - p0) == ONLY_PH && lo <= (k) && (k) < hi)
#else
#define IN(k) (lo <= (k) && (k) < hi)
#endif
#define SEAM(k) do { if (lo <= (k) && (k) + 1 < hi) { XcdBarrier b2_ = bar; asm volatile("" : "+s"(b2_.bar), "+s"(b2_.x)); xcd_barrier(b2_); } } while (0)
#ifdef REPEAT_MASK
#define NREP(bit) ((((unsigned long long)REPEAT_MASK >> (bit)) & 1ull) ? 2 : 1)
#else
#define NREP(bit) 1
#endif
#define FRAME() const Frame F = make_frame(args.ws, lds, bar.w0); unsigned char* const ws = F.ws; (void)ws; int lq = l; asm volatile("" : "+s"(lq)); (void)lq
    for (int l = 0; l < DEPTH; ++l) {
        const int p0 = l * NPH;
        if (IN(p0 + 0)) { FRAME(); for (int rep = 0; rep < NREP(0); ++rep) conv_phase(F, args, lq); } SEAM(p0 + 0);
        if (IN(p0 + 1)) {
#ifndef SKIP_A
            if (l == 0) { FRAME(); pg8::Gemm g{(const bf16*)(ws + WS_MEMB), (const bf16*)(ws + WS_WKV), D, D, D, 1, 16, 0, 0}; pg8::StaticOrder So; So.init(1, 16, F.G, F.G - 1 - F.bx);
                pg8::EpiBf16 E{(bf16*)(ws + WS_KVMEM), 4096}; pg8::gemm_phase(lds, g, So, E, F.tid); }
#endif
#ifndef SKIP_B
            { FRAME(); pg8::Gemm g{(const bf16*)(ws + WS_XB8), (const bf16*)(ws + WS_WIN8), D / 2, D / 2, D / 2, S / 256, IN8 / 256, 0, 0}; pg8::StaticOrder So; So.init(S / 256, IN8 / 256, F.G, F.bx, 1);
            pg8::EpiIn8 E{(bf16*)(ws + WS_QDSA), (bf16*)(ws + WS_VM), (bf16*)(ws + WS_GA), (bf16*)(ws + WS_GB), (float*)(ws + WS_CKVRAW), args.in[3] + (size_t)lq * 2 * D, (bf16*)(ws + WS_QM), (bf16*)(ws + WS_KM)};
            for (int rep = 0; rep < NREP(1); ++rep) pg8::gemm_phase<pg8::EpiIn8, true>(lds, g, So, E, F.tid); }
            { FRAME(); pg8::Gemm g{(const bf16*)(ws + WS_XB), (const bf16*)(ws + WS_WIN), D, D, D, S / 256, INB / 256, 0, 0}; pg8::StaticOrder So; So.init(S / 256, INB / 256, F.G, F.bx, 2);
            pg8::EpiInBf E{(bf16*)(ws + WS_QIDX), (bf16*)(ws + WS_QM), (bf16*)(ws + WS_KM), (float*)(ws + WS_KWRAW)};
            for (int rep = 0; rep < NREP(1); ++rep) pg8::gemm_phase(lds, g, So, E, F.tid); }
#endif
        } SEAM(p0 + 1);
        if (IN(p0 + 2)) {
#ifdef SELFCHECK
            if (l == 0 && CHK_ON(0)) { FRAME(); chk_inproj(F, args); }
#endif
#ifndef SKIP_A
            { FRAME(); for (int rep = 0; rep < NREP(2); ++rep) norm_phase(F, args, lq); }
#endif
#ifndef SKIP_B
            { FRAME(); pg8::Gemm g{(const bf16*)(ws + WS_QDSA), (const bf16*)(ws + WS_WUK), 1024, 256, 256, S / 256, 8, 1, 256}; pg8::StaticOrder So; So.init(S / 256, 8, F.G, F.bx);
            pg8::EpiBf16 E{(bf16*)(ws + WS_QLAT), 2048}; for (int rep = 0; rep < NREP(3); ++rep) pg8::gemm_phase(lds, g, So, E, F.tid); }
#endif
        } SEAM(p0 + 2);
        if (IN(p0 + 3)) {
#ifdef SELFCHECK
            if (l == 0) { FRAME(); if (CHK_ON(1)) chk_norms(F, args); if (CHK_ON(8)) chk_kvmem(F, args); }
#endif
#ifndef SKIP_A
            { FRAME(); moba_gate_phase(F, lq); }
#endif
#ifndef SKIP_B
            { FRAME(); for (int rep = 0; rep < NREP(5); ++rep) indexer_phase(F); }
#endif
        } SEAM(p0 + 3);
        if (IN(p0 + 4)) {
#ifdef SELFCHECK
            if (l == 0 && (CHK_ON(2) || CHK_ON(3))) { FRAME(); chk_topk(F, lq); }
#endif
#ifndef SKIP_A
            { FRAME(); for (int rep = 0; rep < NREP(6); ++rep) moba_attn_phase(F, lq); }
#endif
#ifndef SKIP_B
            { FRAME(); for (int rep = 0; rep < NREP(7); ++rep) dsa_attn_phase(F); }
#endif
        } SEAM(p0 + 4);
        if (IN(p0 + 5)) {
            { FRAME(); for (int rep = 0; rep < NREP(8); ++rep) moba_combine_phase(F); }
            { FRAME(); pg8::Gemm g{(const bf16*)(ws + WS_OLAT), (const bf16*)(ws + WS_WUV), 2048, 512, 512, S / 256, 4, 0, 512}; pg8::StaticOrder So; So.init(S / 256, 4, F.G, F.bx);
            pg8::EpiF8 E{ws + WS_OA, 1024, F8_SOA}; for (int rep = 0; rep < NREP(9); ++rep) pg8::gemm_phase(lds, g, So, E, F.tid); }
        } SEAM(p0 + 5);
#ifdef SELFCHECK
        if (l == 0 && IN(p0 + 6) && (CHK_ON(4) || CHK_ON(5) || CHK_ON(6))) { FRAME(); chk_attn(F, args); }
#endif
        if (IN(p0 + 6)) { FRAME(); pg8::Gemm g{(const bf16*)(ws + WS_OA), (const bf16*)(ws + WS_WOA), 512, 512, 512, S / 256, 8, 0, 0}; pg8::StaticOrder So; So.init(S / 256, 8, F.G, F.bx);
            pg8::EpiGate E{(bf16*)(ws + WS_T1), ws + WS_GA, nullptr, nullptr, 1.0f / (F8_SOA * F8_SWO * F8_SGT), 0.f}; for (int rep = 0; rep < NREP(10); ++rep) pg8::gemm_phase<pg8::EpiGate, true>(lds, g, So, E, F.tid); }
        if (IN(p0 + 7)) { FRAME(); pg8::Gemm g{(const bf16*)(ws + WS_OB), (const bf16*)(ws + WS_WOB), 512, 512, 512, S / 256, 8, 0, 0}; pg8::StaticOrder So; So.init(S / 256, 8, F.G, F.bx);
            pg8::EpiGate E{nullptr, ws + WS_GB, (const bf16*)(ws + WS_T1), ws + WS_MERGED, 1.0f / (F8_SOB * F8_SWO * F8_SGT), F8_SMG}; for (int rep = 0; rep < NREP(11); ++rep) pg8::gemm_phase<pg8::EpiGate, true>(lds, g, So, E, F.tid); } SEAM(p0 + 7);
#ifdef SELFCHECK
        if (l == 0 && IN(p0 + 8) && CHK_ON(6)) { FRAME(); chk_merged(F, args); }
#endif
#if (LN_FUSED & 1)
        if (IN(p0 + 8)) { FRAME(); pg8::Gemm g{(const bf16*)(ws + WS_MERGED), (const bf16*)(ws + WS_WOUT), D / 2, D / 2, D / 2, S / 256, 8, 0, 0}; pg8::FusedOrder So{F.bx};
            pg8::EpiLn E{(bf16*)(ws + WS_XB), args.in[17] + (size_t)(lq * 3 + 0) * D, args.in[18] + (size_t)(lq * 3 + 0) * D, 1.0f / (F8_SMG * F8_SWOUT), nullptr, ws + WS_XB8, (unsigned long long*)(ws + WS_LNX), (unsigned*)(F.ctl + CW_LNCNT) + (lq * 3 + 0) * 64 * 64};
            pg8::gemm_phase<pg8::EpiLn, true, pg8::FusedOrder, true>(lds, g, So, E, F.tid); } SEAM(p0 + 8);
#else
        if (IN(p0 + 8)) { FRAME(); pg8::Gemm g{(const bf16*)(ws + WS_MERGED), (const bf16*)(ws + WS_WOUT), D / 2, D / 2, D / 2, S / 256, 8, 0, 0}; pg8::StaticOrder So; So.init(S / 256, 8, F.G, F.bx);
            pg8::EpiBf16S E{(bf16*)(ws + WS_Y), D, 1.0f / (F8_SMG * F8_SWOUT)}; for (int rep = 0; rep < NREP(12); ++rep) pg8::gemm_phase<pg8::EpiBf16S, true>(lds, g, So, E, F.tid); } SEAM(p0 + 8);
        if (IN(p0 + 9)) { FRAME(); ln_phase(F, args, l, 0); } SEAM(p0 + 9);
#endif
#ifdef SELFCHECK
        if (l == 0 && IN(p0 + 10) && CHK_ON(7)) { FRAME(); chk_ln1(F, args); }
#endif
        if (IN(p0 + 10)) { FRAME(); pg8::Gemm g{(const bf16*)(ws + WS_XB8), (const bf16*)(ws + WS_WQM), D / 2, D / 2, D / 2, S / 256, 2, 0, 0}; pg8::StaticOrder So; So.init(S / 256, 2, F.G, F.bx);
            pg8::EpiBf16S E{(bf16*)(ws + WS_QMEM), 512, 1.0f / F8_SWQM}; for (int rep = 0; rep < NREP(14); ++rep) pg8::gemm_phase<pg8::EpiBf16S, true>(lds, g, So, E, F.tid); } SEAM(p0 + 10);
#ifdef SELFCHECK
        if (l == 0 && IN(p0 + 11) && CHK_ON(8)) { FRAME(); chk_dense8(F, 8, ws + WS_XB, D, D, 1.f, args.in[12], 512, F8_SWQM, (const bf16*)(ws + WS_QMEM), 512, 0.3f); }
#endif
        if (IN(p0 + 11)) { FRAME(); for (int rep = 0; rep < NREP(15); ++rep) mem_attn_phase(F, lq); } SEAM(p0 + 11);
#ifdef SELFCHECK
        if (l == 0 && IN(p0 + 12) && CHK_ON(9)) { FRAME(); chk_memattn(F, lq); }
#endif
#if (LN_FUSED & 2)
        if (IN(p0 + 12)) { FRAME(); pg8::Gemm g{(const bf16*)(ws + WS_OMEM), (const bf16*)(ws + WS_WOM), 256, 256, 256, S / 256, 8, 0, 0}; pg8::FusedOrder So{F.bx};
            pg8::EpiLn E{(bf16*)(ws + WS_XB), args.in[17] + (size_t)(lq * 3 + 1) * D, args.in[18] + (size_t)(lq * 3 + 1) * D, 1.0f / (F8_SOM * F8_SWOM), nullptr, ws + WS_XB8, (unsigned long long*)(ws + WS_LNX), (unsigned*)(F.ctl + CW_LNCNT) + (lq * 3 + 1) * 64 * 64};
            pg8::gemm_phase<pg8::EpiLn, true, pg8::FusedOrder, true>(lds, g, So, E, F.tid); } SEAM(p0 + 12);
#else
        if (IN(p0 + 12)) { FRAME(); pg8::Gemm g{(const bf16*)(ws + WS_OMEM), (const bf16*)(ws + WS_WOM), 256, 256, 256, S / 256, 8, 0, 0}; pg8::StaticOrder So; So.init(S / 256, 8, F.G, F.bx);
            pg8::EpiBf16S E{(bf16*)(ws + WS_Y), D, 1.0f / (F8_SOM * F8_SWOM)}; for (int rep = 0; rep < NREP(16); ++rep) pg8::gemm_phase<pg8::EpiBf16S, true>(lds, g, So, E, F.tid); } SEAM(p0 + 12);
        if (IN(p0 + 13)) { FRAME(); ln_phase(F, args, l, 1); } SEAM(p0 + 13);
#endif
        if (IN(p0 + 14)) { FRAME(); pg8::Gemm g{(const bf16*)(ws + WS_XB8), (const bf16*)(ws + WS_WF1), D / 2, D / 2, D / 2, S / 256, 2 * DFF / 256, 0, 0}; pg8::StaticOrder So; So.init(S / 256, 2 * DFF / 256, F.G, F.bx);
            pg8::EpiSwiglu8 E{ws + WS_H}; for (int rep = 0; rep < NREP(18); ++rep) pg8::gemm_phase<pg8::EpiSwiglu8, true>(lds, g, So, E, F.tid); } SEAM(p0 + 14);
#ifdef SELFCHECK
        if (l == 0 && IN(p0 + 15) && CHK_ON(11)) { FRAME(); chk_swiglu(F, args); }
#endif
#if (LN_FUSED & 4)
        if (IN(p0 + 15)) { FRAME(); pg8::Gemm g{(const bf16*)(ws + WS_H), (const bf16*)(ws + WS_WF2), DFF / 2, DFF / 2, DFF / 2, S / 256, 8, 0, 0}; pg8::FusedOrder So{F.bx};
            pg8::EpiLn E{(bf16*)(ws + WS_XB), args.in[17] + (size_t)(lq * 3 + 2) * D, args.in[18] + (size_t)(lq * 3 + 2) * D, 1.0f / (F8_SH * F8_SW2), lq == DEPTH - 1 ? args.out : nullptr, ws + WS_XB8, (unsigned long long*)(ws + WS_LNX), (unsigned*)(F.ctl + CW_LNCNT) + (lq * 3 + 2) * 64 * 64};
            pg8::gemm_phase<pg8::EpiLn, true, pg8::FusedOrder, true>(lds, g, So, E, F.tid); } SEAM(p0 + 15);
#else
        if (IN(p0 + 15)) { FRAME(); pg8::Gemm g{(const bf16*)(ws + WS_H), (const bf16*)(ws + WS_WF2), DFF / 2, DFF / 2, DFF / 2, S / 256, 8, 0, 0}; pg8::StaticOrder So; So.init(S / 256, 8, F.G, F.bx);
            pg8::EpiBf16S E{(bf16*)(ws + WS_Y), D, 1.0f / (F8_SH * F8_SW2)}; for (int rep = 0; rep < NREP(19); ++rep) pg8::gemm_phase<pg8::EpiBf16S, true>(lds, g, So, E, F.tid); } SEAM(p0 + 15);
        if (IN(p0 + 16)) { FRAME(); ln_phase(F, args, l, 2); } SEAM(p0 + 16);
#endif
    }
#ifdef SELFCHECK
    { xcd_barrier(bar); const int l = 0; FRAME(); chk_encode(F, args); }
#endif
#undef IN
#undef SEAM
#undef FRAME
}

extern "C" void kernel_launch(void* const* d_in, const int* in_sizes, int n_in, void* d_out, int out_size, void* d_ws, size_t ws_size, hipStream_t stream) {
    static int grid = 0;
    if (grid == 0) {
        if (n_in != 19 || out_size != S * D || ws_size < WS_END) { fprintf(stderr, "kernel_launch: unexpected shapes (n_in %d, out %d, ws %zu < %zu)\n", n_in, out_size, ws_size, (size_t)WS_END); grid = -1; return; }
        int dev = 0, cus = 0, per_cu = 0;
        if (hipGetDevice(&dev) != hipSuccess || hipDeviceGetAttribute(&cus, hipDeviceAttributeMultiprocessorCount, dev) != hipSuccess) { grid = -1; return; }
        if (hipFuncSetAttribute((const void*)fwd_kernel, hipFuncAttributeMaxDynamicSharedMemorySize, LDS_BYTES) != hipSuccess) { fprintf(stderr, "kernel_launch: hipFuncSetAttribute failed\n"); grid = -1; return; }
        if (hipOccupancyMaxActiveBlocksPerMultiprocessor(&per_cu, (const void*)fwd_kernel, NTHREADS, LDS_BYTES) != hipSuccess || per_cu < 1) fprintf(stderr, "kernel_launch: occupancy query says %d\n", per_cu);
        (void)hipGetLastError();
        grid = cus;
        if (grid != 256) { fprintf(stderr, "kernel_launch: %d CUs; this kernel is built for the 256-workgroup grid of an MI355X; nothing launched\n", grid); grid = -1; return; }
    }
    if (grid < 0) return;
    (void)in_sizes;
    if (hipMemsetAsync((char*)d_ws + WS_CTL, 0, CTL_ZERO_BYTES, stream) != hipSuccess) return;
    Args a{};
    for (int i = 0; i < 19; ++i) a.in[i] = (const float*)d_in[i];
    a.out = (float*)d_out; a.ws = (unsigned char*)d_ws;
#if MK_ONE_LAUNCH
    a.ph_lo = 0; a.ph_hi = DEPTH * NPH;
    hipLaunchKernelGGL(fwd_kernel, dim3(grid), dim3(NTHREADS), LDS_BYTES, stream, a);
#else
    for (int p = 0; p < DEPTH * NPH; ++p) { a.ph_lo = p; a.ph_hi = p + 1; hipLaunchKernelGGL(fwd_kernel, dim3(grid), dim3(NTHREADS), LDS_BYTES, stream, a); }
#endif
}
```
